# Optimizing an MI355X kernel written in HIP

```python
import math
import jax
import jax.numpy as jnp
from jax import lax
import numpy as np

D_MODEL = 1024
BATCH = 4
SEQ = 4096
DEPTH = 1

GRID_W = 64
CTX_LEN = 256
EPS = 1e-6

GLA_HEADS = 4
GLA_DK = 128
GLA_DV = 256
GLA_KEY = GLA_HEADS * GLA_DK
GLA_VAL = GLA_HEADS * GLA_DV
GLA_RANK = 16
GLA_GATE_NORM = 16.0
GLA_CHUNK = 16

SSD_HEADS = 16
SSD_P = 64
SSD_INNER = SSD_HEADS * SSD_P
SSD_GROUPS = 2
SSD_HPG = SSD_HEADS // SSD_GROUPS
SSD_N = 128
SSD_CONV = 3
SSD_CHUNK = 64
SSD_XBC = SSD_INNER + 2 * SSD_GROUPS * SSD_N

MIX_WIDTH = GLA_VAL + SSD_INNER

OFF_K = GLA_KEY
OFF_V = 2 * GLA_KEY
OFF_R = OFF_V + GLA_VAL
OFF_G = OFF_R + GLA_VAL
OFF_Z = OFF_G + 2 * GLA_RANK
OFF_XBC = OFF_Z + SSD_INNER
OFF_DT = OFF_XBC + SSD_XBC
IN_WIDTH = OFF_DT + 2 * SSD_HEADS
IN_SPLIT_POINTS = (OFF_K, OFF_V, OFF_R, OFF_G, OFF_Z, OFF_XBC, OFF_DT)

N_GROUPS = 4
EXPERTS_PER_GROUP = 8
N_EXPERTS = N_GROUPS * EXPERTS_PER_GROUP
TOP_K = 2
D_FF = 512

kernel_name = 'hybrid_gla_ssd_hmoe_dit_block'


def rmsnorm(x, g):
    x32 = x.astype(jnp.float32)
    y = x32 * lax.rsqrt(jnp.mean(x32 * x32, axis=-1, keepdims=True) + EPS)
    return (y * g.astype(jnp.float32)).astype(x.dtype)


def modulate(h, shift, scale):
    return h * (1.0 + scale) + shift


def adaln(cond, w, b):
    return jnp.split((jax.nn.silu(cond) @ w + b)[:, None, :], 6, axis=-1)


def dwconv2d(u, w, b, rows, cols):
    bn, l, ch = u.shape
    img = u.reshape(bn, rows, cols, ch)
    out = lax.conv_general_dilated(img, w[:, :, None, :].astype(u.dtype), (1, 1), 'SAME',
                                   dimension_numbers=('NHWC', 'HWIO', 'NHWC'), feature_group_count=ch)
    return out.reshape(bn, l, ch) + b


def gla_chunk_scan(q, k, v, log_a, s0):
    bn, l, nh, _ = q.shape
    dv = v.shape[-1]
    n = l // GLA_CHUNK

    def chunks(t):
        return jnp.moveaxis(t.astype(jnp.float32).reshape(bn, n, GLA_CHUNK, nh, t.shape[-1]), 1, 0)

    mask = jnp.tril(jnp.ones((GLA_CHUNK, GLA_CHUNK), dtype=bool))[None, :, :, None, None]

    def step(s, inp):
        qc, kc, vc, ac = inp
        b = jnp.cumsum(ac, axis=1)
        decay = jnp.exp(jnp.where(mask, b[:, :, None] - b[:, None, :], -jnp.inf))
        scores = jnp.einsum('bihd,bjhd,bijhd->bhij', qc, kc, decay)
        o = (jnp.einsum('bhij,bjhv->bihv', scores, vc)
             + jnp.einsum('bihd,bhdv->bihv', qc * jnp.exp(b), s))
        b_last = b[:, -1]
        s = (jnp.exp(b_last)[..., None] * s
             + jnp.einsum('bjhd,bjhv->bhdv', kc * jnp.exp(b_last[:, None] - b), vc))
        return s, o

    s_fin, o = lax.scan(step, s0, (chunks(q), chunks(k), chunks(v), chunks(log_a)))
    o = jnp.moveaxis(o, 0, 1).reshape(bn, l, nh, dv)
    return o.astype(q.dtype), s_fin


def ssd_chunk_scan(xs, dt, a_neg, bm, cm, s0):
    bn, l, g, hg, p = xs.shape
    n = l // SSD_CHUNK
    f32 = jnp.float32

    def chunks(t):
        return t.astype(f32).reshape((bn, n, SSD_CHUNK) + t.shape[2:])

    xc, dtc, bc, cc = chunks(xs), chunks(dt), chunks(bm), chunks(cm)
    a_cum = jnp.cumsum(dtc * a_neg.astype(f32), axis=2)
    xdt = xc * dtc[..., None]
    mask = jnp.tril(jnp.ones((SSD_CHUNK, SSD_CHUNK), dtype=bool))[None, None, :, :, None, None]
    seg = jnp.exp(jnp.where(mask, a_cum[:, :, :, None] - a_cum[:, :, None, :], -jnp.inf))
    cb = jnp.einsum('bcign,bcjgn->bcijg', cc, bc)
    y_diag = jnp.einsum('bcijgh,bcjghp->bcighp', cb[..., None] * seg, xdt)
    decay_end = jnp.exp(a_cum[:, :, -1:] - a_cum)
    chunk_states = jnp.einsum('bcjgn,bcjghp->bcghpn', bc, xdt * decay_end[..., None])
    chunk_decay = jnp.exp(a_cum[:, :, -1])

    def step(s, inp):
        st, dec = inp
        return dec[..., None, None] * s + st, s

    s_fin, s_in = lax.scan(step, s0, (jnp.moveaxis(chunk_states, 1, 0), jnp.moveaxis(chunk_decay, 1, 0)))
    s_in = jnp.moveaxis(s_in, 0, 1)
    y_off = jnp.einsum('bcign,bcghpn->bcighp', cc, s_in) * jnp.exp(a_cum)[..., None]
    y = (y_diag + y_off).reshape(bn, l, g, hg, p)
    return y.astype(xs.dtype), s_fin


def token_mixer(h, rows, cols, states, w_in, gla_w_up, gla_b, gla_norm, conv_w, conv_b,
                dt_bias, a_log, d_skip, ssd_norm, with_output):
    bn, l, _ = h.shape
    proj = h @ w_in
    q, k, v, r, g_lr, z, xbc, dt_raw = jnp.split(proj, IN_SPLIT_POINTS, axis=-1)
    gs_f, gs_b, ss_f, ss_b = states
    flip = lambda t: jnp.flip(t, axis=1)

    q = q.reshape(bn, l, GLA_HEADS, GLA_DK) * (GLA_DK ** -0.5)
    k = k.reshape(bn, l, GLA_HEADS, GLA_DK)
    v = v.reshape(bn, l, GLA_HEADS, GLA_DV)
    g_f, g_b = jnp.split(g_lr, 2, axis=-1)
    la_f = (jax.nn.log_sigmoid(g_f @ gla_w_up[0] + gla_b[0]) / GLA_GATE_NORM).reshape(bn, l, GLA_HEADS, GLA_DK)
    la_b = (jax.nn.log_sigmoid(g_b @ gla_w_up[1] + gla_b[1]) / GLA_GATE_NORM).reshape(bn, l, GLA_HEADS, GLA_DK)
    o_f, gs_f = gla_chunk_scan(q, k, v, la_f, gs_f)
    o_b, gs_b = gla_chunk_scan(flip(q), flip(k), flip(v), flip(la_b), gs_b)

    xbc = jax.nn.silu(dwconv2d(xbc, conv_w, conv_b, rows, cols))
    xs, bm, cm = jnp.split(xbc, (SSD_INNER, SSD_INNER + SSD_GROUPS * SSD_N), axis=-1)
    xs = xs.reshape(bn, l, SSD_GROUPS, SSD_HPG, SSD_P)
    bm = bm.reshape(bn, l, SSD_GROUPS, SSD_N)
    cm = cm.reshape(bn, l, SSD_GROUPS, SSD_N)
    dt_f, dt_b = jnp.split(dt_raw, 2, axis=-1)
    dt_f = jax.nn.softplus(dt_f + dt_bias[0]).reshape(bn, l, SSD_GROUPS, SSD_HPG)
    dt_b = jax.nn.softplus(dt_b + dt_bias[1]).reshape(bn, l, SSD_GROUPS, SSD_HPG)
    a_f = -jnp.exp(a_log[0]).reshape(SSD_GROUPS, SSD_HPG)
    a_b = -jnp.exp(a_log[1]).reshape(SSD_GROUPS, SSD_HPG)
    y_f, ss_f = ssd_chunk_scan(xs, dt_f, a_f, bm, cm, ss_f)
    y_b, ss_b = ssd_chunk_scan(flip(xs), flip(dt_b), a_b, flip(bm), flip(cm), ss_b)
    new_states = (gs_f, gs_b, ss_f, ss_b)
    if not with_output:
        return None, new_states

    o = rmsnorm(o_f + flip(o_b), gla_norm).reshape(bn, l, GLA_VAL) * jax.nn.silu(r)
    y = y_f + flip(y_b) + xs * d_skip.reshape(SSD_GROUPS, SSD_HPG)[..., None]
    y = y.reshape(bn, l, SSD_INNER) * jax.nn.silu(z)
    y = rmsnorm(y.reshape(bn, l, SSD_GROUPS, SSD_INNER // SSD_GROUPS),
                ssd_norm.reshape(SSD_GROUPS, SSD_INNER // SSD_GROUPS)).reshape(bn, l, SSD_INNER)
    return jnp.concatenate([o, y], axis=-1), new_states


def hier_moe(h, wg, bg, we, be, w_gate, w_up, w_down):
    bn, l, d = h.shape
    t = h.reshape(bn * l, d)
    g_logits = (t @ wg + bg).astype(jnp.float32)
    g_sel = jnp.argmax(g_logits, axis=-1)
    p_group = jnp.take_along_axis(jax.nn.softmax(g_logits, axis=-1), g_sel[:, None], axis=-1)
    e_logits = (t @ we + be).astype(jnp.float32).reshape(-1, N_GROUPS, EXPERTS_PER_GROUP)
    e_in = jnp.take_along_axis(e_logits, g_sel[:, None, None], axis=1)[:, 0]
    top_v, top_i = lax.top_k(e_in, TOP_K)
    w = jax.nn.softmax(top_v, axis=-1) * p_group
    idx = g_sel[:, None] * EXPERTS_PER_GROUP + top_i
    combine = jnp.einsum('tk,tke->te', w, jax.nn.one_hot(idx, N_EXPERTS, dtype=jnp.float32))
    out = jnp.zeros((t.shape[0], d), jnp.float32)
    for e in range(N_EXPERTS):
        he = jax.nn.silu(t @ w_gate[e]) * (t @ w_up[e])
        out = out + combine[:, e:e + 1] * (he @ w_down[e]).astype(jnp.float32)
    return out.reshape(bn, l, d).astype(h.dtype)


def setup_inputs(seed: int = 0) -> dict:
    key = jax.random.key(seed)
    ks = jax.random.split(key, 32)
    f32 = jnp.float32

    def nrm(k, shape, s):
        return jax.random.normal(k, shape, f32) * s

    x = nrm(ks[0], (BATCH, SEQ, D_MODEL), 1.0)
    c = nrm(ks[1], (BATCH, D_MODEL), 1.0)
    ctx = nrm(ks[2], (BATCH, CTX_LEN, D_MODEL), 1.0)
    c_ctx = nrm(ks[3], (D_MODEL,), 1.0)
    w_ada = nrm(ks[4], (DEPTH, D_MODEL, 6 * D_MODEL), 0.5 * D_MODEL ** -0.5)
    b_ada = nrm(ks[5], (DEPTH, 6 * D_MODEL), 0.02)
    norm_mix = 1.0 + nrm(ks[6], (DEPTH, D_MODEL), 0.02)
    norm_ffn = 1.0 + nrm(ks[7], (DEPTH, D_MODEL), 0.02)
    w_in = nrm(ks[8], (DEPTH, D_MODEL, IN_WIDTH), D_MODEL ** -0.5)
    gla_w_up = nrm(ks[9], (DEPTH, 2, GLA_RANK, GLA_KEY), GLA_RANK ** -0.5)
    gla_b = nrm(ks[10], (DEPTH, 2, GLA_KEY), 0.1)
    gla_norm = 1.0 + nrm(ks[11], (DEPTH, GLA_DV), 0.02)
    ssd_conv_w = nrm(ks[12], (DEPTH, SSD_CONV, SSD_CONV, SSD_XBC), 1.0 / SSD_CONV)
    ssd_conv_b = nrm(ks[13], (DEPTH, SSD_XBC), 0.02)
    dt0 = jnp.exp(jax.random.uniform(ks[14], (DEPTH, 2, SSD_HEADS), f32, math.log(1e-3), math.log(1e-1)))
    ssd_dt_bias = dt0 + jnp.log(-jnp.expm1(-dt0))
    ssd_a_log = jnp.log(jax.random.uniform(ks[15], (DEPTH, 2, SSD_HEADS), f32, 1.0, 16.0))
    ssd_d = 1.0 + nrm(ks[16], (DEPTH, SSD_HEADS), 0.1)
    ssd_norm = 1.0 + nrm(ks[17], (DEPTH, SSD_INNER), 0.02)
    w_out = nrm(ks[18], (DEPTH, MIX_WIDTH, D_MODEL), MIX_WIDTH ** -0.5)
    router_group_w = nrm(ks[19], (DEPTH, D_MODEL, N_GROUPS), D_MODEL ** -0.5)
    router_group_b = nrm(ks[20], (DEPTH, N_GROUPS), 0.01)
    router_expert_w = nrm(ks[21], (DEPTH, D_MODEL, N_EXPERTS), D_MODEL ** -0.5)
    router_expert_b = nrm(ks[22], (DEPTH, N_EXPERTS), 0.01)
    expert_w_gate = nrm(ks[23], (DEPTH, N_EXPERTS, D_MODEL, D_FF), D_MODEL ** -0.5)
    expert_w_up = nrm(ks[24], (DEPTH, N_EXPERTS, D_MODEL, D_FF), D_MODEL ** -0.5)
    expert_w_down = nrm(ks[25], (DEPTH, N_EXPERTS, D_FF, D_MODEL), D_FF ** -0.5)
    final_norm = 1.0 + nrm(ks[26], (D_MODEL,), 0.02)
    return {'x': x, 'c': c, 'ctx': ctx, 'c_ctx': c_ctx, 'w_ada': w_ada, 'b_ada': b_ada,
            'norm_mix': norm_mix, 'norm_ffn': norm_ffn, 'w_in': w_in, 'gla_w_up': gla_w_up,
            'gla_b': gla_b, 'gla_norm': gla_norm, 'ssd_conv_w': ssd_conv_w, 'ssd_conv_b': ssd_conv_b,
            'ssd_dt_bias': ssd_dt_bias, 'ssd_a_log': ssd_a_log, 'ssd_d': ssd_d, 'ssd_norm': ssd_norm,
            'w_out': w_out, 'router_group_w': router_group_w, 'router_group_b': router_group_b,
            'router_expert_w': router_expert_w, 'router_expert_b': router_expert_b,
            'expert_w_gate': expert_w_gate, 'expert_w_up': expert_w_up, 'expert_w_down': expert_w_down,
            'final_norm': final_norm}


def reference(x, c, ctx, c_ctx, w_ada, b_ada, norm_mix, norm_ffn, w_in, gla_w_up, gla_b, gla_norm,
              ssd_conv_w, ssd_conv_b, ssd_dt_bias, ssd_a_log, ssd_d, ssd_norm, w_out,
              router_group_w, router_group_b, router_expert_w, router_expert_b,
              expert_w_gate, expert_w_up, expert_w_down, final_norm):
    bn, seq_len, _ = x.shape
    rows = seq_len // GRID_W
    ctx_len = ctx.shape[1]
    zero_states = (jnp.zeros((bn, GLA_HEADS, GLA_DK, GLA_DV), jnp.float32),
                   jnp.zeros((bn, GLA_HEADS, GLA_DK, GLA_DV), jnp.float32),
                   jnp.zeros((bn, SSD_GROUPS, SSD_HPG, SSD_P, SSD_N), jnp.float32),
                   jnp.zeros((bn, SSD_GROUPS, SSD_HPG, SSD_P, SSD_N), jnp.float32))
    h_lat, h_ctx = x, ctx
    for layer in range(DEPTH):
        last = layer == DEPTH - 1
        sh1, sc1, g1, sh2, sc2, g2 = adaln(c, w_ada[layer], b_ada[layer])
        csh1, csc1, cg1, csh2, csc2, cg2 = adaln(c_ctx[None, :], w_ada[layer], b_ada[layer])
        mix_w = (w_in[layer], gla_w_up[layer], gla_b[layer], gla_norm[layer], ssd_conv_w[layer],
                 ssd_conv_b[layer], ssd_dt_bias[layer], ssd_a_log[layer], ssd_d[layer], ssd_norm[layer])
        moe_w = (router_group_w[layer], router_group_b[layer], router_expert_w[layer], router_expert_b[layer],
                 expert_w_gate[layer], expert_w_up[layer], expert_w_down[layer])
        hc = modulate(rmsnorm(h_ctx, norm_mix[layer]), csh1, csc1)
        yc, ctx_states = token_mixer(hc, 1, ctx_len, zero_states, *mix_w, with_output=not last)
        hx = modulate(rmsnorm(h_lat, norm_mix[layer]), sh1, sc1)
        yx, _ = token_mixer(hx, rows, GRID_W, ctx_states, *mix_w, with_output=True)
        h_lat = h_lat + g1 * (yx @ w_out[layer])
        h_lat = h_lat + g2 * hier_moe(modulate(rmsnorm(h_lat, norm_ffn[layer]), sh2, sc2), *moe_w)
        if not last:
            h_ctx = h_ctx + cg1 * (yc @ w_out[layer])
            h_ctx = h_ctx + cg2 * hier_moe(modulate(rmsnorm(h_ctx, norm_ffn[layer]), csh2, csc2), *moe_w)
    return rmsnorm(h_lat, final_norm)
```

```cpp
#include <hip/hip_runtime.h>
#include <hip/hip_cooperative_groups.h>
#include <cstdio>
#include <cstdint>
namespace cg = cooperative_groups;

#ifndef MK_COOP
#define MK_COOP 0
#endif

constexpr int NB = 4, SEQ = 4096, DM = 1024, CTXL = 256;
constexpr int T_CTX = NB * CTXL, T_LAT = NB * SEQ, T_ALL = T_CTX + T_LAT;
constexpr float EPS = 1e-6f;
constexpr int NW_IN = 5888;
constexpr int NPH = 12;
constexpr int NTHREADS = 512;
constexpr int LDS_BYTES = 147456;

typedef unsigned short bf16_t;
typedef float f32x4 __attribute__((ext_vector_type(4)));
typedef unsigned u32x4 __attribute__((ext_vector_type(4)));
typedef unsigned u32x2 __attribute__((ext_vector_type(2)));
typedef unsigned short u16x8 __attribute__((ext_vector_type(8)));
typedef unsigned short u16x4 __attribute__((ext_vector_type(4)));

constexpr size_t MiB = 1u << 20;
constexpr size_t WS_QK = 0;
constexpr size_t WS_XBC = 34 * MiB;
constexpr size_t WS_OB = 34 * MiB;
constexpr size_t WS_QKF = 85 * MiB;
constexpr size_t WS_XN = 85 * MiB;
constexpr size_t WS_YX = 85 * MiB;
constexpr size_t WS_V = 119 * MiB;
constexpr size_t WS_XC = 153 * MiB;
constexpr size_t WS_WINT = 153 * MiB;
constexpr size_t WS_RZ = 204 * MiB;
constexpr size_t WS_XN2 = 204 * MiB;
constexpr size_t WS_YB = 268 * MiB;
constexpr size_t WS_GDT = 300 * MiB;
constexpr size_t WS_WOUTT = 305 * MiB;
constexpr size_t WS_MOD = 309 * MiB;
constexpr size_t WS_GLAD = WS_MOD + 256 * 1024;
constexpr size_t WS_CTL = 311 * MiB;
constexpr size_t CTL_BYTES = 64 * 1024;
constexpr size_t WS_PAIR = 312 * MiB;
constexpr size_t WS_END = 313 * MiB;
constexpr size_t WS_WDT = 0;
constexpr size_t WS_WGU_LO = 34 * MiB;
constexpr size_t WS_WGU_HI = 268 * MiB;
constexpr size_t WS_H = 66 * MiB;
constexpr size_t WS_XN2S = 106 * MiB;
constexpr size_t WS_Y = 106 * MiB;
constexpr int MAX_SLOTS = 40960;
constexpr int CW_CNT = 0;

__device__ __forceinline__ float bf2f(bf16_t v) { return __uint_as_float((unsigned)v << 16); }
__device__ __forceinline__ unsigned f2bf(float f) { unsigned u = __float_as_uint(f); return (u + 0x7fffu + ((u >> 16) & 1u)) >> 16; }
__device__ __forceinline__ unsigned pk2(float lo, float hi) { return f2bf(lo) | (f2bf(hi) << 16); }
__device__ __forceinline__ float siluf(float x) { return x / (1.f + __expf(-x)); }
__device__ __forceinline__ float softplusf(float x) { return fmaxf(x, 0.f) + log1pf(__expf(-fabsf(x))); }
__device__ __forceinline__ float logsigf(float x) { return fminf(x, 0.f) - log1pf(__expf(-fabsf(x))); }
__device__ __forceinline__ float wave_sum(float v) {
#pragma unroll
    for (int o = 1; o < 64; o <<= 1) v += __shfl_xor(v, o);
    return v;
}

struct Args { const float* in[27]; float* out; unsigned char* ws; int ph_lo, ph_hi; };
enum { I_X = 0, I_C, I_CTX, I_CCTX, I_WADA, I_BADA, I_NMIX, I_NFFN, I_WIN, I_GWUP, I_GB, I_GNORM, I_CONVW, I_CONVB, I_DTB, I_ALOG, I_SSDD, I_SSDN,
       I_WOUT, I_RGW, I_RGB, I_REW, I_REB, I_EWG, I_EWU, I_EWD, I_FNORM };

struct Ctx {
    const float* in[27]; float* out; unsigned char* ws; unsigned char* lds;
    int tid, lane, wave, bid, G;
};

__device__ __forceinline__ void transpose_tile(const float* src  , int ldw, bf16_t* dst  , int ldt, float* scr, int lane, bool zero) {
#pragma unroll 8
    for (int i = 0; i < 32; ++i) { const int kk = 2 * i + (lane >> 5); scr[kk * 33 + (lane & 31)] = zero ? 0.f : src[(size_t)kk * ldw + (lane & 31)]; }
    asm volatile("s_waitcnt lgkmcnt(0)" ::: "memory");
    const int c = lane & 7;
#pragma unroll
    for (int j = 0; j < 4; ++j) { const int n = (lane >> 3) + 8 * j; const float* s = scr + (8 * c) * 33 + n;
        u32x4 o; o.x = pk2(s[0 * 33], s[1 * 33]); o.y = pk2(s[2 * 33], s[3 * 33]); o.z = pk2(s[4 * 33], s[5 * 33]); o.w = pk2(s[6 * 33], s[7 * 33]);
        *(u32x4*)(dst + (size_t)n * ldt + 8 * c) = o; }
    asm volatile("s_waitcnt lgkmcnt(0)" ::: "memory");
}

__device__ __forceinline__ int win_src_col(int n) {
    if (n < 3072) return n;
    if (n < 4096) return 3104 + (n - 3072);
    if (n < 5632) return 4128 + (n - 4096);
    if (n < 5664) return 3072 + (n - 5632);
    if (n < 5696) return 5664 + (n - 5664);
    return -1;
}

__device__ __forceinline__ void phase0(Ctx& C) {
    float* lds = (float*)C.lds;
    const int gw = C.bid * 8 + C.wave, NGW = C.G * 8;
    {
        float* scr = lds + 8192 + C.wave * (64 * 33);
        bf16_t* WinT = (bf16_t*)(C.ws + WS_WINT); bf16_t* WoutT = (bf16_t*)(C.ws + WS_WOUTT);
        constexpr int IT_IN = 16 * (NW_IN / 32), IT_OUT = 32 * 32;
        for (int it = gw; it < IT_IN + IT_OUT; it += NGW) {
            if (it < IT_IN) { const int kb = it / (NW_IN / 32), nb = it % (NW_IN / 32); const int sc = win_src_col(nb * 32);
                transpose_tile(C.in[I_WIN] + (size_t)(kb * 64) * 5696 + (sc < 0 ? 0 : sc), 5696, WinT + (size_t)(nb * 32) * 1024 + kb * 64, 1024, scr, C.lane, sc < 0); }
            else { const int r = it - IT_IN, kb = r / 32, nb = r % 32;
                transpose_tile(C.in[I_WOUT] + (size_t)(kb * 64) * 1024 + nb * 32, 1024, WoutT + (size_t)(nb * 32) * 2048 + kb * 64, 2048, scr, C.lane, false); }
        }
    }
    __syncthreads();
    float* sc = lds;
    float* red = lds + 5120;
    for (int i = C.tid; i < 5 * 1024; i += NTHREADS) { const int r = i >> 10, k = i & 1023; const float v = r < 4 ? C.in[I_C][r * 1024 + k] : C.in[I_CCTX][k]; sc[i] = siluf(v); }
    __syncthreads();
    float* MOD = (float*)(C.ws + WS_MOD);
    for (int grp = C.bid; grp < 192; grp += C.G) {
        const int col = grp * 32 + (C.tid & 31), kg = C.tid >> 5;
        float acc[5] = {0.f, 0.f, 0.f, 0.f, 0.f};
        for (int k = kg; k < 1024; k += 16) { const float w = C.in[I_WADA][(size_t)k * 6144 + col];
#pragma unroll
            for (int i = 0; i < 5; ++i) acc[i] += sc[i * 1024 + k] * w; }
#pragma unroll
        for (int i = 0; i < 5; ++i) red[(kg * 5 + i) * 32 + (C.tid & 31)] = acc[i];
        __syncthreads();
        if (C.tid < 160) { const int i = C.tid >> 5, c = C.tid & 31; float s = 0.f;
            for (int g = 0; g < 16; ++g) s += red[(g * 5 + i) * 32 + c];
            MOD[i * 6144 + grp * 32 + c] = s + C.in[I_BADA][grp * 32 + c]; }
        __syncthreads();
    }
}

__device__ __forceinline__ const float* tok_row(const Ctx& C, int row, int& mi) {
    if (row < T_CTX) { mi = 4; return C.in[I_CTX] + (size_t)row * DM; }
    mi = (row - T_CTX) >> 12; return C.in[I_X] + (size_t)(row - T_CTX) * DM;
}

__device__ __forceinline__ void phase1(Ctx& C) {
    const int gw = C.bid * 8 + C.wave, NGW = C.G * 8;
    const float* MOD = (const float*)(C.ws + WS_MOD); bf16_t* XN = (bf16_t*)(C.ws + WS_XN);
    for (int row = gw; row < T_ALL; row += NGW) {
        int mi; const float* xr = tok_row(C, row, mi);
        f32x4 v[4]; float ss = 0.f;
#pragma unroll
        for (int j = 0; j < 4; ++j) { v[j] = *(const f32x4*)(xr + j * 256 + C.lane * 4); ss += v[j].x * v[j].x + v[j].y * v[j].y + v[j].z * v[j].z + v[j].w * v[j].w; }
        const float rs = rsqrtf(wave_sum(ss) * (1.f / DM) + EPS);
#pragma unroll
        for (int j = 0; j < 4; ++j) { const int c0 = j * 256 + C.lane * 4;
            const f32x4 g = *(const f32x4*)(C.in[I_NMIX] + c0), sh = *(const f32x4*)(MOD + mi * 6144 + c0), scl = *(const f32x4*)(MOD + mi * 6144 + 1024 + c0);
            const f32x4 y = v[j] * rs * g * (1.f + scl) + sh;
            u32x2 o; o.x = pk2(y.x, y.y); o.y = pk2(y.z, y.w); *(u32x2*)(XN + (size_t)row * DM + c0) = o; }
    }
}

template <bool DUAL, class BSel, class Epi>
__device__ __forceinline__ void gemm_simple(Ctx& C, const bf16_t* A, int lda, int Mtiles, int Ntiles, int K, BSel bsel, Epi epi) {
    float* As = (float*)C.lds;
    float* Bs = As + 32 * 132;
    float* Bs2 = Bs + 32 * 132;
    const int ty = C.tid >> 4, tx = C.tid & 15;
    const int lr = C.tid >> 2, lk = (C.tid & 3) * 8;
    for (int tile = C.bid; tile < Mtiles * Ntiles; tile += C.G) {
        const int tm = tile / Ntiles, tn = tile % Ntiles;
        int ldb; const bf16_t* Bt = bsel(tm, tn, ldb);
        float acc[4][8], acc2[DUAL ? 4 : 1][8];
#pragma unroll
        for (int i = 0; i < 4; ++i)
#pragma unroll
            for (int j = 0; j < 8; ++j) { acc[i][j] = 0.f; if constexpr (DUAL) acc2[i][j] = 0.f; }
        const bf16_t* ap = A + (size_t)(tm * 128 + lr) * lda + lk;
        const bf16_t* bp = Bt + (size_t)lr * ldb + lk;
        for (int k0 = 0; k0 < K; k0 += 32) {
            const u16x8 av = *(const u16x8*)(ap + k0), bv = *(const u16x8*)(bp + k0);
            u16x8 bv2 = bv; if constexpr (DUAL) bv2 = *(const u16x8*)(bp + (size_t)128 * ldb + k0);
            __syncthreads();
#pragma unroll
            for (int j = 0; j < 8; ++j) { As[(lk + j) * 132 + lr] = bf2f(av[j]); Bs[(lk + j) * 132 + lr] = bf2f(bv[j]); if constexpr (DUAL) Bs2[(lk + j) * 132 + lr] = bf2f(bv2[j]); }
            __syncthreads();
#pragma unroll 8
            for (int k = 0; k < 32; ++k) {
                const f32x4 a = *(const f32x4*)(As + k * 132 + ty * 4);
                const f32x4 b0 = *(const f32x4*)(Bs + k * 132 + tx * 8), b1 = *(const f32x4*)(Bs + k * 132 + tx * 8 + 4);
                const float af[4] = {a.x, a.y, a.z, a.w}; const float bf[8] = {b0.x, b0.y, b0.z, b0.w, b1.x, b1.y, b1.z, b1.w};
#pragma unroll
                for (int i = 0; i < 4; ++i)
#pragma unroll
                    for (int j = 0; j < 8; ++j) acc[i][j] += af[i] * bf[j];
                if constexpr (DUAL) {
                    const f32x4 c0 = *(const f32x4*)(Bs2 + k * 132 + tx * 8), c1 = *(const f32x4*)(Bs2 + k * 132 + tx * 8 + 4);
                    const float cf[8] = {c0.x, c0.y, c0.z, c0.w, c1.x, c1.y, c1.z, c1.w};
#pragma unroll
                    for (int i = 0; i < 4; ++i)
#pragma unroll
                        for (int j = 0; j < 8; ++j) acc2[i][j] += af[i] * cf[j];
                }
            }
        }
#pragma unroll
        for (int i = 0; i < 4; ++i)
#pragma unroll
            for (int j = 0; j < 8; ++j) { float a2 = 0.f; if constexpr (DUAL) a2 = acc2[i][j]; epi(tm * 128 + ty * 4 + i, tn, tx * 8 + j, acc[i][j], a2); }
        __syncthreads();
    }
}

__device__ __forceinline__ void phase2(Ctx& C) {
    const bf16_t* XN = (const bf16_t*)(C.ws + WS_XN); const bf16_t* WinT = (const bf16_t*)(C.ws + WS_WINT);
    bf16_t* QK = (bf16_t*)(C.ws + WS_QK); bf16_t* V = (bf16_t*)(C.ws + WS_V); bf16_t* RZ = (bf16_t*)(C.ws + WS_RZ); bf16_t* XBC = (bf16_t*)(C.ws + WS_XBC);
    float* GDT = (float*)(C.ws + WS_GDT);
    auto bsel = [=](int, int tn, int& ldb) { ldb = 1024; return WinT + (size_t)tn * 128 * 1024; };
    auto epi = [=](int row, int tn, int cc, float v, float) {
        const int col = tn * 128 + cc;
        if (col < 1024) QK[(size_t)row * 1024 + col] = (bf16_t)f2bf(v);
        else if (col < 2048) V[(size_t)row * 1024 + col - 1024] = (bf16_t)f2bf(v);
        else if (col < 4096) { if (row >= T_CTX) RZ[(size_t)(row - T_CTX) * 2048 + col - 2048] = (bf16_t)f2bf(siluf(v)); }
        else if (col < 5632) XBC[(size_t)row * 1536 + col - 4096] = (bf16_t)f2bf(v);
        else if (col < 5696) GDT[(size_t)row * 64 + col - 5632] = v;
    };
    gemm_simple<false>(C, XN, 1024, T_ALL / 128, NW_IN / 128, 1024, bsel, epi);
}

__device__ __forceinline__ void phase3(Ctx& C) {
    float* lds = (float*)C.lds;
    {
        float* gs = lds;
        float* tot = lds + 2048;
        bf16_t* QK = (bf16_t*)(C.ws + WS_QK); bf16_t* QKF = (bf16_t*)(C.ws + WS_QKF);
        const float* GDT = (const float*)(C.ws + WS_GDT); float* GLAD = (float*)(C.ws + WS_GLAD);
        const int c = C.tid & 127, tg = C.tid >> 7;
        for (int item = C.bid; item < 272 * 4; item += C.G) {
            const int rc = item >> 2, h = item & 3, row0 = rc * 64;
            __syncthreads();
            for (int i = C.tid; i < 64 * 32; i += NTHREADS) gs[i] = GDT[(size_t)(row0 + (i >> 5)) * 64 + (i & 31)];
            float wf[16], wb[16];
#pragma unroll
            for (int r = 0; r < 16; ++r) { wf[r] = C.in[I_GWUP][r * 512 + h * 128 + c]; wb[r] = C.in[I_GWUP][(16 + r) * 512 + h * 128 + c]; }
            const float bfv = C.in[I_GB][h * 128 + c], bbv = C.in[I_GB][512 + h * 128 + c];
            __syncthreads();
            float pf[16], pb[16];
#pragma unroll
            for (int tt = 0; tt < 16; ++tt) { const float* g = gs + (tg * 16 + tt) * 32; float sf = bfv, sb = bbv;
#pragma unroll
                for (int r = 0; r < 16; ++r) { sf += g[r] * wf[r]; sb += g[16 + r] * wb[r]; }
                pf[tt] = logsigf(sf) * (1.f / 16.f); pb[tt] = logsigf(sb) * (1.f / 16.f); }
#pragma unroll
            for (int tt = 1; tt < 16; ++tt) pf[tt] += pf[tt - 1];
#pragma unroll
            for (int tt = 14; tt >= 0; --tt) pb[tt] += pb[tt + 1];
            tot[(0 * 4 + tg) * 128 + c] = pf[15]; tot[(1 * 4 + tg) * 128 + c] = pb[0];
            __syncthreads();
            float offf = 0.f, offb = 0.f, totf = 0.f, totb = 0.f;
#pragma unroll
            for (int g = 0; g < 4; ++g) { const float a = tot[(0 * 4 + g) * 128 + c], b = tot[(1 * 4 + g) * 128 + c]; if (g < tg) offf += a; if (g > tg) offb += b; totf += a; totb += b; }
            if (tg == 0) { GLAD[((size_t)(rc * 4 + h) * 2 + 0) * 128 + c] = __expf(totf); GLAD[((size_t)(rc * 4 + h) * 2 + 1) * 128 + c] = __expf(totb); }
            const float qscale = 0.08838834764831845f;
#pragma unroll
            for (int tt = 0; tt < 16; ++tt) { const size_t ro = (size_t)(row0 + tg * 16 + tt) * 1024;
                const float q = bf2f(QK[ro + h * 128 + c]) * qscale, k = bf2f(QK[ro + 512 + h * 128 + c]);
                const float ef = pf[tt] + offf, eb = pb[tt] + offb;
                QKF[ro + h * 128 + c] = (bf16_t)f2bf(q * __expf(ef)); QKF[ro + 512 + h * 128 + c] = (bf16_t)f2bf(k * __expf(-ef));
                QK[ro + h * 128 + c] = (bf16_t)f2bf(q * __expf(eb)); QK[ro + 512 + h * 128 + c] = (bf16_t)f2bf(k * __expf(-eb)); }
        }
    }
    {
        const bf16_t* XBC = (const bf16_t*)(C.ws + WS_XBC); bf16_t* XC = (bf16_t*)(C.ws + WS_XC);
        const float* cw = C.in[I_CONVW]; const float* cb = C.in[I_CONVB];
        const long total = (long)T_ALL * 192;
        for (long it = (long)C.bid * NTHREADS + C.tid; it < total; it += (long)C.G * NTHREADS) {
            const int row = (int)(it / 192), c0 = (int)(it % 192) * 8;
            float acc[8];
#pragma unroll
            for (int j = 0; j < 8; ++j) acc[j] = cb[c0 + j];
            int base, y, x, H, W;
            if (row < T_CTX) { base = row & ~255; y = 0; x = row & 255; H = 1; W = 256; }
            else { const int l = row - T_CTX; base = T_CTX + (l & ~4095); const int t = l & 4095; y = t >> 6; x = t & 63; H = 64; W = 64; }
            for (int i = 0; i < 3; ++i) { const int yy = y + i - 1; if (yy < 0 || yy >= H) continue;
                for (int jx = 0; jx < 3; ++jx) { const int xx = x + jx - 1; if (xx < 0 || xx >= W) continue;
                    const u16x8 v = *(const u16x8*)(XBC + (size_t)(base + yy * W + xx) * 1536 + c0);
                    const float* w = cw + (size_t)(i * 3 + jx) * 1536 + c0;
#pragma unroll
                    for (int j = 0; j < 8; ++j) acc[j] += bf2f(v[j]) * w[j]; } }
            u32x4 o; o.x = pk2(siluf(acc[0]), siluf(acc[1])); o.y = pk2(siluf(acc[2]), siluf(acc[3])); o.z = pk2(siluf(acc[4]), siluf(acc[5])); o.w = pk2(siluf(acc[6]), siluf(acc[7]));
            *(u32x4*)(XC + (size_t)row * 1536 + c0) = o;
        }
    }
}

__device__ __forceinline__ int scan_row(int b, int dir, int s) {
    if (s < CTXL) return b * CTXL + (dir ? CTXL - 1 - s : s);
    const int t = s - CTXL; return T_CTX + b * SEQ + (dir ? SEQ - 1 - t : t);
}

__device__ __forceinline__ void phase4_naive(Ctx& C) {
    bf16_t* OF = (bf16_t*)C.out;
    bf16_t* OB = (bf16_t*)(C.ws + WS_OB);
    bf16_t* YB = (bf16_t*)(C.ws + WS_YB);
    const bf16_t* V = (const bf16_t*)(C.ws + WS_V); const bf16_t* XC = (const bf16_t*)(C.ws + WS_XC);
    const float* GDT = (const float*)(C.ws + WS_GDT); const float* GLAD = (const float*)(C.ws + WS_GLAD);
    for (int gt = C.bid * NTHREADS + C.tid; gt < 65536; gt += C.G * NTHREADS) {
        if (gt < 32768) {
            const int chain = gt >> 10, rem = gt & 1023, dv = rem >> 2, dq = rem & 3;
            const int b = chain >> 3, h = (chain >> 1) & 3, dir = chain & 1;
            const bf16_t* QKp = (const bf16_t*)(C.ws + (dir ? WS_QK : WS_QKF));
            float S[32];
#pragma unroll
            for (int i = 0; i < 32; ++i) S[i] = 0.f;
            for (int s = 0; s < CTXL + SEQ; ++s) {
                const int row = scan_row(b, dir, s);
                const float v = bf2f(V[(size_t)row * 1024 + h * 256 + dv]);
                const bf16_t* qp = QKp + (size_t)row * 1024 + h * 128 + dq * 32;
                float o = 0.f;
#pragma unroll
                for (int i8 = 0; i8 < 4; ++i8) { const u16x8 kv = *(const u16x8*)(qp + 512 + i8 * 8), qv = *(const u16x8*)(qp + i8 * 8);
#pragma unroll
                    for (int j = 0; j < 8; ++j) { S[i8 * 8 + j] += bf2f(kv[j]) * v; o += bf2f(qv[j]) * S[i8 * 8 + j]; } }
                o += __shfl_xor(o, 1); o += __shfl_xor(o, 2);
                if (row >= T_CTX && dq == 0) { const size_t l = row - T_CTX; if (dir) OB[l * 1024 + h * 256 + dv] = (bf16_t)f2bf(o); else OF[l * 2048 + h * 256 + dv] = (bf16_t)f2bf(o); }
                if ((s & 63) == 63) { const float* d = GLAD + ((size_t)((row >> 6) * 4 + h) * 2 + dir) * 128 + dq * 32;
#pragma unroll
                    for (int i = 0; i < 32; ++i) S[i] *= d[i]; }
            }
        } else {
            const int g2 = gt - 32768, chain = g2 >> 8, rem = g2 & 255, p = rem >> 2, nq = rem & 3;
            const int b = chain >> 5, head = (chain >> 1) & 15, dir = chain & 1, grp = head >> 3;
            const float Aneg = -__expf(C.in[I_ALOG][dir * 16 + head]), dtb = C.in[I_DTB][dir * 16 + head];
            float S[32];
#pragma unroll
            for (int i = 0; i < 32; ++i) S[i] = 0.f;
            for (int s = 0; s < CTXL + SEQ; ++s) {
                const int row = scan_row(b, dir, s);
                const float dt = softplusf(GDT[(size_t)row * 64 + 32 + dir * 16 + head] + dtb), a = __expf(dt * Aneg);
                const float xd = bf2f(XC[(size_t)row * 1536 + head * 64 + p]) * dt;
                const bf16_t* bp = XC + (size_t)row * 1536 + 1024 + grp * 128 + nq * 32;
                float y = 0.f;
#pragma unroll
                for (int i8 = 0; i8 < 4; ++i8) { const u16x8 bv = *(const u16x8*)(bp + i8 * 8), cv = *(const u16x8*)(bp + 256 + i8 * 8);
#pragma unroll
                    for (int j = 0; j < 8; ++j) { S[i8 * 8 + j] = a * S[i8 * 8 + j] + xd * bf2f(bv[j]); y += S[i8 * 8 + j] * bf2f(cv[j]); } }
                y += __shfl_xor(y, 1); y += __shfl_xor(y, 2);
                if (row >= T_CTX && nq == 0) { const size_t l = row - T_CTX; if (dir) YB[l * 1024 + head * 64 + p] = (bf16_t)f2bf(y); else OF[l * 2048 + 1024 + head * 64 + p] = (bf16_t)f2bf(y); }
            }
        }
    }
}

__device__ __forceinline__ void phase5(Ctx& C) {
    const int gw = C.bid * 8 + C.wave, NGW = C.G * 8;
    const bf16_t* OF = (const bf16_t*)C.out; const bf16_t* OB = (const bf16_t*)(C.ws + WS_OB); const bf16_t* YB = (const bf16_t*)(C.ws + WS_YB);
    const bf16_t* RZ = (const bf16_t*)(C.ws + WS_RZ); const bf16_t* XC = (const bf16_t*)(C.ws + WS_XC); bf16_t* YX = (bf16_t*)(C.ws + WS_YX);
    for (int l = gw; l < T_LAT; l += NGW) {
        const f32x4 gn = *(const f32x4*)(C.in[I_GNORM] + C.lane * 4);
        for (int h = 0; h < 4; ++h) {
            const int c0 = h * 256 + C.lane * 4;
            const u16x4 a = *(const u16x4*)(OF + (size_t)l * 2048 + c0), b = *(const u16x4*)(OB + (size_t)l * 1024 + c0), r = *(const u16x4*)(RZ + (size_t)l * 2048 + c0);
            float o[4], ss = 0.f;
#pragma unroll
            for (int j = 0; j < 4; ++j) { o[j] = bf2f(a[j]) + bf2f(b[j]); ss += o[j] * o[j]; }
            const float rs = rsqrtf(wave_sum(ss) * (1.f / 256.f) + EPS);
            u32x2 w; w.x = pk2(o[0] * rs * gn.x * bf2f(r[0]), o[1] * rs * gn.y * bf2f(r[1])); w.y = pk2(o[2] * rs * gn.z * bf2f(r[2]), o[3] * rs * gn.w * bf2f(r[3]));
            *(u32x2*)(YX + (size_t)l * 2048 + c0) = w;
        }
        for (int g = 0; g < 2; ++g) {
            const int c0 = g * 512 + C.lane * 8, head = c0 >> 6;
            const u16x8 a = *(const u16x8*)(OF + (size_t)l * 2048 + 1024 + c0), b = *(const u16x8*)(YB + (size_t)l * 1024 + c0), z = *(const u16x8*)(RZ + (size_t)l * 2048 + 1024 + c0),
                        xs = *(const u16x8*)(XC + (size_t)(l + T_CTX) * 1536 + c0);
            const float dsk = C.in[I_SSDD][head];
            float y[8], ss = 0.f;
#pragma unroll
            for (int j = 0; j < 8; ++j) { y[j] = (bf2f(a[j]) + bf2f(b[j]) + bf2f(xs[j]) * dsk) * bf2f(z[j]); ss += y[j] * y[j]; }
            const float rs = rsqrtf(wave_sum(ss) * (1.f / 512.f) + EPS);
            const float* nw = C.in[I_SSDN] + c0;
            u32x4 w; w.x = pk2(y[0] * rs * nw[0], y[1] * rs * nw[1]); w.y = pk2(y[2] * rs * nw[2], y[3] * rs * nw[3]); w.z = pk2(y[4] * rs * nw[4], y[5] * rs * nw[5]); w.w = pk2(y[6] * rs * nw[6], y[7] * rs * nw[7]);
            *(u32x4*)(YX + (size_t)l * 2048 + 1024 + c0) = w;
        }
    }
}

__device__ __forceinline__ bf16_t* wgu_ptr(unsigned char* ws, int e) { return (bf16_t*)(ws + (e < 16 ? WS_WGU_LO : WS_WGU_HI)) + (size_t)(e & 15) * 1024 * 1024; }
__device__ __forceinline__ void phase6(Ctx& C) {
    {
        float* scr = (float*)C.lds + 16384 + C.wave * (64 * 33);
        const int gw = C.bid * 8 + C.wave, NGW = C.G * 8;
        bf16_t* WdT = (bf16_t*)(C.ws + WS_WDT);
        for (int it = gw; it < 32 * 768; it += NGW) {
            const int e = it / 768, r = it % 768;
            if (r < 512) { const int up = r >> 8, q = r & 255, kb = q >> 4, nb = q & 15;
                const float* src = C.in[up ? I_EWU : I_EWG] + (size_t)e * 1024 * 512 + (size_t)(kb * 64) * 512 + nb * 32;
                bf16_t* dst = wgu_ptr(C.ws, e) + (size_t)(256 * (nb >> 2) + (nb & 3) * 32 + up * 128) * 1024 + kb * 64;
                transpose_tile(src, 512, dst, 1024, scr, C.lane, false); }
            else { const int q = r - 512, kb = q >> 5, nb = q & 31;
                transpose_tile(C.in[I_EWD] + (size_t)e * 512 * 1024 + (size_t)(kb * 64) * 1024 + nb * 32, 1024, WdT + (size_t)e * 1024 * 512 + (size_t)(nb * 32) * 512 + kb * 64, 512, scr, C.lane, false); }
        }
    }
    __syncthreads();
    const bf16_t* YX = (const bf16_t*)(C.ws + WS_YX); const bf16_t* WoutT = (const bf16_t*)(C.ws + WS_WOUTT);
    const float* MOD = (const float*)(C.ws + WS_MOD); const float* X = C.in[I_X]; float* HL = C.out;
    auto bsel = [=](int, int tn, int& ldb) { ldb = 2048; return WoutT + (size_t)tn * 128 * 2048; };
    auto epi = [=](int row, int tn, int cc, float v, float) { const int col = tn * 128 + cc, b = row >> 12;
        HL[(size_t)row * 1024 + col] = X[(size_t)row * 1024 + col] + MOD[b * 6144 + 2048 + col] * v; };
    gemm_simple<false>(C, YX, 2048, T_LAT / 128, 1024 / 128, 2048, bsel, epi);
}

__device__ __forceinline__ void phase7(Ctx& C) {
    const int gw = C.bid * 8 + C.wave, NGW = C.G * 8;
    const float* MOD = (const float*)(C.ws + WS_MOD); const float* HL = C.out; bf16_t* XN2 = (bf16_t*)(C.ws + WS_XN2);
    int* PE = (int*)(C.ws + WS_PAIR); int* PP = PE + 32768; float* PW = (float*)(PP + 32768);
    unsigned* cnt = (unsigned*)(C.ws + WS_CTL) + CW_CNT;
    const float* wg = C.in[I_RGW]; const float* we = C.in[I_REW];
    for (int l = gw; l < T_LAT; l += NGW) {
        const int b = l >> 12;
        f32x4 v[4]; float ss = 0.f;
#pragma unroll
        for (int j = 0; j < 4; ++j) { v[j] = *(const f32x4*)(HL + (size_t)l * DM + j * 256 + C.lane * 4); ss += v[j].x * v[j].x + v[j].y * v[j].y + v[j].z * v[j].z + v[j].w * v[j].w; }
        const float rs = rsqrtf(wave_sum(ss) * (1.f / DM) + EPS);
        float lg[36];
#pragma unroll
        for (int o = 0; o < 36; ++o) lg[o] = 0.f;
#pragma unroll
        for (int j = 0; j < 4; ++j) { const int c0 = j * 256 + C.lane * 4;
            const f32x4 g = *(const f32x4*)(C.in[I_NFFN] + c0), sh = *(const f32x4*)(MOD + b * 6144 + 3072 + c0), scl = *(const f32x4*)(MOD + b * 6144 + 4096 + c0);
            const f32x4 t = v[j] * rs * g * (1.f + scl) + sh;
            u32x2 o; o.x = pk2(t.x, t.y); o.y = pk2(t.z, t.w); *(u32x2*)(XN2 + (size_t)l * DM + c0) = o;
            const float tf[4] = {t.x, t.y, t.z, t.w};
#pragma unroll
            for (int q = 0; q < 4; ++q) { const f32x4 w4 = *(const f32x4*)(wg + (size_t)(c0 + q) * 4);
                lg[0] += tf[q] * w4.x; lg[1] += tf[q] * w4.y; lg[2] += tf[q] * w4.z; lg[3] += tf[q] * w4.w;
#pragma unroll
                for (int o4 = 0; o4 < 8; ++o4) { const f32x4 e4 = *(const f32x4*)(we + (size_t)(c0 + q) * 32 + o4 * 4);
                    lg[4 + o4 * 4 + 0] += tf[q] * e4.x; lg[4 + o4 * 4 + 1] += tf[q] * e4.y; lg[4 + o4 * 4 + 2] += tf[q] * e4.z; lg[4 + o4 * 4 + 3] += tf[q] * e4.w; } } }
#pragma unroll
        for (int o = 0; o < 36; ++o) lg[o] = wave_sum(lg[o]);
        if (C.lane == 0) {
            float gl[4]; int gs = 0; float gm = -3.4e38f;
#pragma unroll
            for (int o = 0; o < 4; ++o) { gl[o] = lg[o] + C.in[I_RGB][o]; if (gl[o] > gm) { gm = gl[o]; gs = o; } }
            float den = 0.f;
#pragma unroll
            for (int o = 0; o < 4; ++o) den += __expf(gl[o] - gm);
            const float pg = 1.f / den;
            float el[8];
#pragma unroll
            for (int o = 0; o < 8; ++o) { float s = 0.f;
#pragma unroll
                for (int g = 0; g < 4; ++g) s = (g == gs) ? lg[4 + g * 8 + o] : s;
                el[o] = s; }
            int i1 = 0, i2 = 0; float v1 = -3.4e38f, v2 = -3.4e38f;
#pragma unroll
            for (int o = 0; o < 8; ++o) { el[o] += C.in[I_REB][gs * 8 + o]; }
#pragma unroll
            for (int o = 0; o < 8; ++o) { if (el[o] > v1) { v2 = v1; i2 = i1; v1 = el[o]; i1 = o; } else if (el[o] > v2) { v2 = el[o]; i2 = o; } }
            const float e2 = __expf(v2 - v1), w1 = pg / (1.f + e2), w2 = pg * e2 / (1.f + e2);
            const int ex1 = gs * 8 + i1, ex2 = gs * 8 + i2;
            const unsigned p1 = atomicAdd(cnt + ex1, 1u), p2 = atomicAdd(cnt + ex2, 1u);
            PE[l * 2] = ex1; PE[l * 2 + 1] = ex2; PP[l * 2] = (int)p1; PP[l * 2 + 1] = (int)p2; PW[l * 2] = w1; PW[l * 2 + 1] = w2;
        }
    }
}

__device__ __forceinline__ void moe_offsets(Ctx& C, int* off) {
    if (C.tid == 0) { const unsigned* cnt = (const unsigned*)(C.ws + WS_CTL) + CW_CNT; int o = 0;
        for (int e = 0; e < 32; ++e) { off[e] = o; o += (int)((__hip_atomic_load(cnt + e, __ATOMIC_RELAXED, __HIP_MEMORY_SCOPE_AGENT) + 255u) & ~255u); } off[32] = o; }
    __syncthreads();
}

__device__ __forceinline__ void phase8(Ctx& C) {
    int* off = (int*)C.lds; moe_offsets(C, off);
    const int gw = C.bid * 8 + C.wave, NGW = C.G * 8;
    const int* PE = (const int*)(C.ws + WS_PAIR); const int* PP = PE + 32768; const float* PW = (const float*)(PP + 32768); int* SL = (int*)(PW + 32768); float* SW = (float*)(SL + 32768);
    const bf16_t* XN2 = (const bf16_t*)(C.ws + WS_XN2); bf16_t* XS = (bf16_t*)(C.ws + WS_XN2S);
    for (int p = gw; p < 32768; p += NGW) {
        const int slot = off[PE[p]] + PP[p];
        if (C.lane == 0) { SL[p] = slot; SW[slot] = PW[p]; }
        const u32x4* s = (const u32x4*)(XN2 + (size_t)(p >> 1) * DM); u32x4* d = (u32x4*)(XS + (size_t)slot * DM);
        d[C.lane] = s[C.lane]; d[C.lane + 64] = s[C.lane + 64];
    }
}

__device__ __forceinline__ void phase9(Ctx& C) {
    int* off = (int*)(C.lds + 65536); moe_offsets(C, off);
    const bf16_t* XS = (const bf16_t*)(C.ws + WS_XN2S); bf16_t* H = (bf16_t*)(C.ws + WS_H); unsigned char* ws = C.ws;
    auto bsel = [=](int tm, int tn, int& ldb) { int e = 0; const int r0 = tm * 128;
        for (int i = 1; i < 32; ++i) if (off[i] <= r0) e = i;
        ldb = 1024; return (const bf16_t*)wgu_ptr(ws, e) + (size_t)tn * 256 * 1024; };
    auto epi = [=](int row, int tn, int cc, float g, float u) { H[(size_t)row * 512 + tn * 128 + cc] = (bf16_t)f2bf(siluf(g) * u); };
    gemm_simple<true>(C, XS, 1024, off[32] / 128, 4, 1024, bsel, epi);
}

__device__ __forceinline__ void phase10(Ctx& C) {
    int* off = (int*)(C.lds + 65536); moe_offsets(C, off);
    const bf16_t* H = (const bf16_t*)(C.ws + WS_H); bf16_t* Y = (bf16_t*)(C.ws + WS_Y); const bf16_t* WdT = (const bf16_t*)(C.ws + WS_WDT);
    const float* SW = (const float*)(C.ws + WS_PAIR) + 4 * 32768;
    auto bsel = [=](int tm, int tn, int& ldb) { int e = 0; const int r0 = tm * 128;
        for (int i = 1; i < 32; ++i) if (off[i] <= r0) e = i;
        ldb = 512; return WdT + (size_t)e * 1024 * 512 + (size_t)tn * 128 * 512; };
    auto epi = [=](int row, int tn, int cc, float v, float) { Y[(size_t)row * 1024 + tn * 128 + cc] = (bf16_t)f2bf(v * SW[row]); };
    gemm_simple<false>(C, H, 512, off[32] / 128, 8, 512, bsel, epi);
}

__device__ __forceinline__ void phase11(Ctx& C) {
    const int gw = C.bid * 8 + C.wave, NGW = C.G * 8;
    const float* MOD = (const float*)(C.ws + WS_MOD); float* HL = C.out; const bf16_t* Y = (const bf16_t*)(C.ws + WS_Y);
    const int* SL = (const int*)(C.ws + WS_PAIR) + 3 * 32768;
    for (int l = gw; l < T_LAT; l += NGW) {
        const int b = l >> 12, s1 = SL[l * 2], s2 = SL[l * 2 + 1];
        f32x4 v[4]; float ss = 0.f;
#pragma unroll
        for (int j = 0; j < 4; ++j) { const int c0 = j * 256 + C.lane * 4;
            const f32x4 hv = *(const f32x4*)(HL + (size_t)l * DM + c0), g2 = *(const f32x4*)(MOD + b * 6144 + 5120 + c0);
            const u16x4 a = *(const u16x4*)(Y + (size_t)s1 * DM + c0), bb = *(const u16x4*)(Y + (size_t)s2 * DM + c0);
            f32x4 m; m.x = bf2f(a[0]) + bf2f(bb[0]); m.y = bf2f(a[1]) + bf2f(bb[1]); m.z = bf2f(a[2]) + bf2f(bb[2]); m.w = bf2f(a[3]) + bf2f(bb[3]);
            v[j] = hv + g2 * m; ss += v[j].x * v[j].x + v[j].y * v[j].y + v[j].z * v[j].z + v[j].w * v[j].w; }
        const float rs = rsqrtf(wave_sum(ss) * (1.f / DM) + EPS);
#pragma unroll
        for (int j = 0; j < 4; ++j) { const int c0 = j * 256 + C.lane * 4; const f32x4 fn = *(const f32x4*)(C.in[I_FNORM] + c0);
            *(f32x4*)(HL + (size_t)l * DM + c0) = v[j] * rs * fn; }
    }
}

__global__ void __launch_bounds__(NTHREADS, 2) fwd_kernel(Args a) {
    extern __shared__ __attribute__((aligned(16))) unsigned char lds[];
    Ctx C;
#pragma unroll
    for (int i = 0; i < 27; ++i) C.in[i] = a.in[i];
    C.out = a.out; C.ws = a.ws; C.lds = lds;
    C.tid = threadIdx.x; C.lane = C.tid & 63; C.wave = __builtin_amdgcn_readfirstlane(C.tid >> 6); C.bid = blockIdx.x; C.G = gridDim.x;
#if MK_COOP
    cg::grid_group grid = cg::this_grid();
#define SEAM(k) do { if ((k) + 1 < a.ph_hi) grid.sync(); } while (0)
#else
#define SEAM(k) do { } while (0)
#endif
#define IN(k) (a.ph_lo <= (k) && (k) < a.ph_hi)
    if (IN(0)) { phase0(C); SEAM(0); }
    if (IN(1)) { phase1(C); SEAM(1); }
    if (IN(2)) { phase2(C); SEAM(2); }
    if (IN(3)) { phase3(C); SEAM(3); }
    if (IN(4)) { phase4_naive(C); SEAM(4); }
    if (IN(5)) { phase5(C); SEAM(5); }
    if (IN(6)) { phase6(C); SEAM(6); }
    if (IN(7)) { phase7(C); SEAM(7); }
    if (IN(8)) { phase8(C); SEAM(8); }
    if (IN(9)) { phase9(C); SEAM(9); }
    if (IN(10)) { phase10(C); SEAM(10); }
    if (IN(11)) { phase11(C); }
}

extern "C" void kernel_launch(void* const* d_in, const int* in_sizes, int n_in, void* d_out, int out_size, void* d_ws, size_t ws_size, hipStream_t stream) {
    static int grid = 0;
    if (grid == 0) {
        if (n_in != 27 || out_size != T_LAT * DM || ws_size < WS_END) { fprintf(stderr, "kernel_launch: unexpected shapes: n_in %d out %d ws %zu (need %zu)\n", n_in, out_size, ws_size, (size_t)WS_END); grid = -1; return; }
        int dev = 0, cus = 0, per_cu = 0;
        hipGetDevice(&dev); hipDeviceGetAttribute(&cus, hipDeviceAttributeMultiprocessorCount, dev);
        hipFuncSetAttribute((const void*)fwd_kernel, hipFuncAttributeMaxDynamicSharedMemorySize, LDS_BYTES);
        hipOccupancyMaxActiveBlocksPerMultiprocessor(&per_cu, (const void*)fwd_kernel, NTHREADS, LDS_BYTES);
        if (per_cu < 1) { fprintf(stderr, "kernel_launch: occupancy query says %d blocks per CU\n", per_cu); per_cu = 1; }
        (void)hipGetLastError();
        grid = cus;
        fprintf(stderr, "kernel_launch: grid %d, per_cu %d, ws %zu\n", grid, per_cu, ws_size);
    }
    if (grid < 0) return;
    hipMemsetAsync((char*)d_ws + WS_CTL, 0, CTL_BYTES, stream);
    Args a{};
    for (int i = 0; i < 27; ++i) a.in[i] = (const float*)d_in[i];
    a.out = (float*)d_out; a.ws = (unsigned char*)d_ws;
#if MK_COOP
    a.ph_lo = 0; a.ph_hi = NPH;
    void* args[] = {&a};
    hipError_t e = hipLaunchCooperativeKernel((const void*)fwd_kernel, dim3(grid), dim3(NTHREADS), args, LDS_BYTES, stream);
    if (e != hipSuccess) fprintf(stderr, "cooperative launch failed: %s (grid %d)\n", hipGetErrorString(e), grid);
#else
    for (int p = 0; p < NPH; ++p) { a.ph_lo = p; a.ph_hi = p + 1; hipLaunchKernelGGL(fwd_kernel, dim3(grid), dim3(NTHREADS), LDS_BYTES, stream, a); }
#endif
}
```

```cpp
#include <hip/hip_runtime.h>
#include <hip/hip_cooperative_groups.h>
#include <cstdio>
#include <cstdint>
namespace cg = cooperative_groups;

#ifndef MK_COOP
#define MK_COOP 1
#endif

constexpr int NB = 4, SEQ = 4096, DM = 1024, CTXL = 256;
constexpr int T_CTX = NB * CTXL, T_LAT = NB * SEQ, T_ALL = T_CTX + T_LAT;
constexpr float EPS = 1e-6f;
constexpr int NW_IN = 5888;
constexpr int NPH = 12;
constexpr int NTHREADS = 512;
constexpr int LDS_BYTES = 147456;

typedef unsigned short bf16_t;
typedef float f32x4 __attribute__((ext_vector_type(4)));
typedef unsigned u32x4 __attribute__((ext_vector_type(4)));
typedef unsigned u32x2 __attribute__((ext_vector_type(2)));
typedef unsigned short u16x8 __attribute__((ext_vector_type(8)));
typedef unsigned short u16x4 __attribute__((ext_vector_type(4)));

constexpr size_t MiB = 1u << 20;
constexpr size_t WS_QK = 0;
constexpr size_t WS_XBC = 34 * MiB;
constexpr size_t WS_OB = 34 * MiB;
constexpr size_t WS_QKF = 85 * MiB;
constexpr size_t WS_XN = 85 * MiB;
constexpr size_t WS_YX = 85 * MiB;
constexpr size_t WS_V = 119 * MiB;
constexpr size_t WS_XC = 153 * MiB;
constexpr size_t WS_WINT = 153 * MiB;
constexpr size_t WS_RZ = 204 * MiB;
constexpr size_t WS_XN2 = 204 * MiB;
constexpr size_t WS_YB = 268 * MiB;
constexpr size_t WS_GDT = 300 * MiB;
constexpr size_t WS_WOUTT = 305 * MiB;
constexpr size_t WS_MOD = 309 * MiB;
constexpr size_t WS_GLAD = WS_MOD + 256 * 1024;
constexpr size_t WS_CTL = 311 * MiB;
constexpr size_t CTL_BYTES = 64 * 1024;
constexpr size_t WS_PAIR = 312 * MiB;
constexpr size_t WS_END = 313 * MiB;
constexpr size_t WS_WDT = 0;
constexpr size_t WS_WGU_LO = 34 * MiB;
constexpr size_t WS_WGU_HI = 268 * MiB;
constexpr size_t WS_H = 66 * MiB;
constexpr size_t WS_XN2S = 106 * MiB;
constexpr size_t WS_Y = 106 * MiB;
constexpr int MAX_SLOTS = 40960;
constexpr int CW_CNT = 0;

__device__ __forceinline__ float bf2f(bf16_t v) { return __uint_as_float((unsigned)v << 16); }
__device__ __forceinline__ unsigned f2bf(float f) { unsigned u = __float_as_uint(f); return (u + 0x7fffu + ((u >> 16) & 1u)) >> 16; }
__device__ __forceinline__ unsigned pk2(float lo, float hi) { return f2bf(lo) | (f2bf(hi) << 16); }
__device__ __forceinline__ float siluf(float x) { return x / (1.f + __expf(-x)); }
__device__ __forceinline__ float softplusf(float x) { return fmaxf(x, 0.f) + log1pf(__expf(-fabsf(x))); }
__device__ __forceinline__ float logsigf(float x) { return fminf(x, 0.f) - log1pf(__expf(-fabsf(x))); }
__device__ __forceinline__ float wave_sum(float v) {
#pragma unroll
    for (int o = 1; o < 64; o <<= 1) v += __shfl_xor(v, o);
    return v;
}

struct Args { const float* in[27]; float* out; unsigned char* ws; int ph_lo, ph_hi; };
enum { I_X = 0, I_C, I_CTX, I_CCTX, I_WADA, I_BADA, I_NMIX, I_NFFN, I_WIN, I_GWUP, I_GB, I_GNORM, I_CONVW, I_CONVB, I_DTB, I_ALOG, I_SSDD, I_SSDN,
       I_WOUT, I_RGW, I_RGB, I_REW, I_REB, I_EWG, I_EWU, I_EWD, I_FNORM };

struct Ctx {
    const float* in[27]; float* out; unsigned char* ws; unsigned char* lds;
    int tid, lane, wave, bid, G;
};

__device__ __forceinline__ void transpose_tile(const float* src  , int ldw, bf16_t* dst  , int ldt, float* scr, int lane, bool zero) {
#pragma unroll 8
    for (int i = 0; i < 32; ++i) { const int kk = 2 * i + (lane >> 5); scr[kk * 33 + (lane & 31)] = zero ? 0.f : src[(size_t)kk * ldw + (lane & 31)]; }
    asm volatile("s_waitcnt lgkmcnt(0)" ::: "memory");
    const int c = lane & 7;
#pragma unroll
    for (int j = 0; j < 4; ++j) { const int n = (lane >> 3) + 8 * j; const float* s = scr + (8 * c) * 33 + n;
        u32x4 o; o.x = pk2(s[0 * 33], s[1 * 33]); o.y = pk2(s[2 * 33], s[3 * 33]); o.z = pk2(s[4 * 33], s[5 * 33]); o.w = pk2(s[6 * 33], s[7 * 33]);
        *(u32x4*)(dst + (size_t)n * ldt + 8 * c) = o; }
    asm volatile("s_waitcnt lgkmcnt(0)" ::: "memory");
}

__device__ __forceinline__ int win_src_col(int n) {
    if (n < 3072) return n;
    if (n < 4096) return 3104 + (n - 3072);
    if (n < 5632) return 4128 + (n - 4096);
    if (n < 5664) return 3072 + (n - 5632);
    if (n < 5696) return 5664 + (n - 5664);
    return -1;
}

__device__ __forceinline__ void phase0(Ctx& C) {
    float* lds = (float*)C.lds;
    const int gw = C.bid * 8 + C.wave, NGW = C.G * 8;
    {
        float* scr = lds + 8192 + C.wave * (64 * 33);
        bf16_t* WinT = (bf16_t*)(C.ws + WS_WINT); bf16_t* WoutT = (bf16_t*)(C.ws + WS_WOUTT);
        constexpr int IT_IN = 16 * (NW_IN / 32), IT_OUT = 32 * 32;
        for (int it = gw; it < IT_IN + IT_OUT; it += NGW) {
            if (it < IT_IN) { const int kb = it / (NW_IN / 32), nb = it % (NW_IN / 32); const int sc = win_src_col(nb * 32);
                transpose_tile(C.in[I_WIN] + (size_t)(kb * 64) * 5696 + (sc < 0 ? 0 : sc), 5696, WinT + (size_t)(nb * 32) * 1024 + kb * 64, 1024, scr, C.lane, sc < 0); }
            else { const int r = it - IT_IN, kb = r / 32, nb = r % 32;
                transpose_tile(C.in[I_WOUT] + (size_t)(kb * 64) * 1024 + nb * 32, 1024, WoutT + (size_t)(nb * 32) * 2048 + kb * 64, 2048, scr, C.lane, false); }
        }
    }
    __syncthreads();
    float* sc = lds;
    float* red = lds + 5120;
    for (int i = C.tid; i < 5 * 1024; i += NTHREADS) { const int r = i >> 10, k = i & 1023; const float v = r < 4 ? C.in[I_C][r * 1024 + k] : C.in[I_CCTX][k]; sc[i] = siluf(v); }
    __syncthreads();
    float* MOD = (float*)(C.ws + WS_MOD);
    for (int grp = C.bid; grp < 192; grp += C.G) {
        const int col = grp * 32 + (C.tid & 31), kg = C.tid >> 5;
        float acc[5] = {0.f, 0.f, 0.f, 0.f, 0.f};
        for (int k = kg; k < 1024; k += 16) { const float w = C.in[I_WADA][(size_t)k * 6144 + col];
#pragma unroll
            for (int i = 0; i < 5; ++i) acc[i] += sc[i * 1024 + k] * w; }
#pragma unroll
        for (int i = 0; i < 5; ++i) red[(kg * 5 + i) * 32 + (C.tid & 31)] = acc[i];
        __syncthreads();
        if (C.tid < 160) { const int i = C.tid >> 5, c = C.tid & 31; float s = 0.f;
            for (int g = 0; g < 16; ++g) s += red[(g * 5 + i) * 32 + c];
            MOD[i * 6144 + grp * 32 + c] = s + C.in[I_BADA][grp * 32 + c]; }
        __syncthreads();
    }
}

__device__ __forceinline__ const float* tok_row(const Ctx& C, int row, int& mi) {
    if (row < T_CTX) { mi = 4; return C.in[I_CTX] + (size_t)row * DM; }
    mi = (row - T_CTX) >> 12; return C.in[I_X] + (size_t)(row - T_CTX) * DM;
}

__device__ __forceinline__ void phase1(Ctx& C) {
    const int gw = C.bid * 8 + C.wave, NGW = C.G * 8;
    const float* MOD = (const float*)(C.ws + WS_MOD); bf16_t* XN = (bf16_t*)(C.ws + WS_XN);
    for (int row = gw; row < T_ALL; row += NGW) {
        int mi; const float* xr = tok_row(C, row, mi);
        f32x4 v[4]; float ss = 0.f;
#pragma unroll
        for (int j = 0; j < 4; ++j) { v[j] = *(const f32x4*)(xr + j * 256 + C.lane * 4); ss += v[j].x * v[j].x + v[j].y * v[j].y + v[j].z * v[j].z + v[j].w * v[j].w; }
        const float rs = rsqrtf(wave_sum(ss) * (1.f / DM) + EPS);
#pragma unroll
        for (int j = 0; j < 4; ++j) { const int c0 = j * 256 + C.lane * 4;
            const f32x4 g = *(const f32x4*)(C.in[I_NMIX] + c0), sh = *(const f32x4*)(MOD + mi * 6144 + c0), scl = *(const f32x4*)(MOD + mi * 6144 + 1024 + c0);
            const f32x4 y = v[j] * rs * g * (1.f + scl) + sh;
            u32x2 o; o.x = pk2(y.x, y.y); o.y = pk2(y.z, y.w); *(u32x2*)(XN + (size_t)row * DM + c0) = o; }
    }
}

template <bool DUAL, class BSel, class Epi>
__device__ __forceinline__ void gemm_simple(Ctx& C, const bf16_t* A, int lda, int Mtiles, int Ntiles, int K, BSel bsel, Epi epi) {
    float* As = (float*)C.lds;
    float* Bs = As + 32 * 132;
    float* Bs2 = Bs + 32 * 132;
    const int ty = C.tid >> 4, tx = C.tid & 15;
    const int lr = C.tid >> 2, lk = (C.tid & 3) * 8;
    for (int tile = C.bid; tile < Mtiles * Ntiles; tile += C.G) {
        const int tm = tile / Ntiles, tn = tile % Ntiles;
        int ldb; const bf16_t* Bt = bsel(tm, tn, ldb);
        float acc[4][8], acc2[DUAL ? 4 : 1][8];
#pragma unroll
        for (int i = 0; i < 4; ++i)
#pragma unroll
            for (int j = 0; j < 8; ++j) { acc[i][j] = 0.f; if constexpr (DUAL) acc2[i][j] = 0.f; }
        const bf16_t* ap = A + (size_t)(tm * 128 + lr) * lda + lk;
        const bf16_t* bp = Bt + (size_t)lr * ldb + lk;
        for (int k0 = 0; k0 < K; k0 += 32) {
            const u16x8 av = *(const u16x8*)(ap + k0), bv = *(const u16x8*)(bp + k0);
            u16x8 bv2 = bv; if constexpr (DUAL) bv2 = *(const u16x8*)(bp + (size_t)128 * ldb + k0);
            __syncthreads();
#pragma unroll
            for (int j = 0; j < 8; ++j) { As[(lk + j) * 132 + lr] = bf2f(av[j]); Bs[(lk + j) * 132 + lr] = bf2f(bv[j]); if constexpr (DUAL) Bs2[(lk + j) * 132 + lr] = bf2f(bv2[j]); }
            __syncthreads();
#pragma unroll 8
            for (int k = 0; k < 32; ++k) {
                const f32x4 a = *(const f32x4*)(As + k * 132 + ty * 4);
                const f32x4 b0 = *(const f32x4*)(Bs + k * 132 + tx * 8), b1 = *(const f32x4*)(Bs + k * 132 + tx * 8 + 4);
                const float af[4] = {a.x, a.y, a.z, a.w}; const float bf[8] = {b0.x, b0.y, b0.z, b0.w, b1.x, b1.y, b1.z, b1.w};
#pragma unroll
                for (int i = 0; i < 4; ++i)
#pragma unroll
                    for (int j = 0; j < 8; ++j) acc[i][j] += af[i] * bf[j];
                if constexpr (DUAL) {
                    const f32x4 c0 = *(const f32x4*)(Bs2 + k * 132 + tx * 8), c1 = *(const f32x4*)(Bs2 + k * 132 + tx * 8 + 4);
                    const float cf[8] = {c0.x, c0.y, c0.z, c0.w, c1.x, c1.y, c1.z, c1.w};
#pragma unroll
                    for (int i = 0; i < 4; ++i)
#pragma unroll
                        for (int j = 0; j < 8; ++j) acc2[i][j] += af[i] * cf[j];
                }
            }
        }
#pragma unroll
        for (int i = 0; i < 4; ++i)
#pragma unroll
            for (int j = 0; j < 8; ++j) { float a2 = 0.f; if constexpr (DUAL) a2 = acc2[i][j]; epi(tm * 128 + ty * 4 + i, tn, tx * 8 + j, acc[i][j], a2); }
        __syncthreads();
    }
}

__device__ __forceinline__ void phase2(Ctx& C) {
    const bf16_t* XN = (const bf16_t*)(C.ws + WS_XN); const bf16_t* WinT = (const bf16_t*)(C.ws + WS_WINT);
    bf16_t* QK = (bf16_t*)(C.ws + WS_QK); bf16_t* V = (bf16_t*)(C.ws + WS_V); bf16_t* RZ = (bf16_t*)(C.ws + WS_RZ); bf16_t* XBC = (bf16_t*)(C.ws + WS_XBC);
    float* GDT = (float*)(C.ws + WS_GDT);
    auto bsel = [=](int, int tn, int& ldb) { ldb = 1024; return WinT + (size_t)tn * 128 * 1024; };
    auto epi = [=](int row, int tn, int cc, float v, float) {
        const int col = tn * 128 + cc;
        if (col < 1024) QK[(size_t)row * 1024 + col] = (bf16_t)f2bf(v);
        else if (col < 2048) V[(size_t)row * 1024 + col - 1024] = (bf16_t)f2bf(v);
        else if (col < 4096) { if (row >= T_CTX) RZ[(size_t)(row - T_CTX) * 2048 + col - 2048] = (bf16_t)f2bf(siluf(v)); }
        else if (col < 5632) XBC[(size_t)row * 1536 + col - 4096] = (bf16_t)f2bf(v);
        else if (col < 5696) GDT[(size_t)row * 64 + col - 5632] = v;
    };
    gemm_simple<false>(C, XN, 1024, T_ALL / 128, NW_IN / 128, 1024, bsel, epi);
}

__device__ __forceinline__ void phase3(Ctx& C) {
    float* lds = (float*)C.lds;
    {
        float* gs = lds;
        float* tot = lds + 2048;
        bf16_t* QK = (bf16_t*)(C.ws + WS_QK); bf16_t* QKF = (bf16_t*)(C.ws + WS_QKF);
        const float* GDT = (const float*)(C.ws + WS_GDT); float* GLAD = (float*)(C.ws + WS_GLAD);
        const int c = C.tid & 127, tg = C.tid >> 7;
        for (int item = C.bid; item < 272 * 4; item += C.G) {
            const int rc = item >> 2, h = item & 3, row0 = rc * 64;
            __syncthreads();
            for (int i = C.tid; i < 64 * 32; i += NTHREADS) gs[i] = GDT[(size_t)(row0 + (i >> 5)) * 64 + (i & 31)];
            float wf[16], wb[16];
#pragma unroll
            for (int r = 0; r < 16; ++r) { wf[r] = C.in[I_GWUP][r * 512 + h * 128 + c]; wb[r] = C.in[I_GWUP][(16 + r) * 512 + h * 128 + c]; }
            const float bfv = C.in[I_GB][h * 128 + c], bbv = C.in[I_GB][512 + h * 128 + c];
            __syncthreads();
            float pf[16], pb[16];
#pragma unroll
            for (int tt = 0; tt < 16; ++tt) { const float* g = gs + (tg * 16 + tt) * 32; float sf = bfv, sb = bbv;
#pragma unroll
                for (int r = 0; r < 16; ++r) { sf += g[r] * wf[r]; sb += g[16 + r] * wb[r]; }
                pf[tt] = logsigf(sf) * (1.f / 16.f); pb[tt] = logsigf(sb) * (1.f / 16.f); }
#pragma unroll
            for (int tt = 1; tt < 16; ++tt) pf[tt] += pf[tt - 1];
#pragma unroll
            for (int tt = 14; tt >= 0; --tt) pb[tt] += pb[tt + 1];
            tot[(0 * 4 + tg) * 128 + c] = pf[15]; tot[(1 * 4 + tg) * 128 + c] = pb[0];
            __syncthreads();
            float offf = 0.f, offb = 0.f, totf = 0.f, totb = 0.f;
#pragma unroll
            for (int g = 0; g < 4; ++g) { const float a = tot[(0 * 4 + g) * 128 + c], b = tot[(1 * 4 + g) * 128 + c]; if (g < tg) offf += a; if (g > tg) offb += b; totf += a; totb += b; }
            if (tg == 0) { GLAD[((size_t)(rc * 4 + h) * 2 + 0) * 128 + c] = __expf(totf); GLAD[((size_t)(rc * 4 + h) * 2 + 1) * 128 + c] = __expf(totb); }
            const float qscale = 0.08838834764831845f;
#pragma unroll
            for (int tt = 0; tt < 16; ++tt) { const size_t ro = (size_t)(row0 + tg * 16 + tt) * 1024;
                const float q = bf2f(QK[ro + h * 128 + c]) * qscale, k = bf2f(QK[ro + 512 + h * 128 + c]);
                const float ef = pf[tt] + offf, eb = pb[tt] + offb;
                QKF[ro + h * 128 + c] = (bf16_t)f2bf(q * __expf(ef)); QKF[ro + 512 + h * 128 + c] = (bf16_t)f2bf(k * __expf(-ef));
                QK[ro + h * 128 + c] = (bf16_t)f2bf(q * __expf(eb)); QK[ro + 512 + h * 128 + c] = (bf16_t)f2bf(k * __expf(-eb)); }
        }
    }
    {
        const bf16_t* XBC = (const bf16_t*)(C.ws + WS_XBC); bf16_t* XC = (bf16_t*)(C.ws + WS_XC);
        const float* cw = C.in[I_CONVW]; const float* cb = C.in[I_CONVB];
        const long total = (long)T_ALL * 192;
        for (long it = (long)C.bid * NTHREADS + C.tid; it < total; it += (long)C.G * NTHREADS) {
            const int row = (int)(it / 192), c0 = (int)(it % 192) * 8;
            float acc[8];
#pragma unroll
            for (int j = 0; j < 8; ++j) acc[j] = cb[c0 + j];
            int base, y, x, H, W;
            if (row < T_CTX) { base = row & ~255; y = 0; x = row & 255; H = 1; W = 256; }
            else { const int l = row - T_CTX; base = T_CTX + (l & ~4095); const int t = l & 4095; y = t >> 6; x = t & 63; H = 64; W = 64; }
            for (int i = 0; i < 3; ++i) { const int yy = y + i - 1; if (yy < 0 || yy >= H) continue;
                for (int jx = 0; jx < 3; ++jx) { const int xx = x + jx - 1; if (xx < 0 || xx >= W) continue;
                    const u16x8 v = *(const u16x8*)(XBC + (size_t)(base + yy * W + xx) * 1536 + c0);
                    const float* w = cw + (size_t)(i * 3 + jx) * 1536 + c0;
#pragma unroll
                    for (int j = 0; j < 8; ++j) acc[j] += bf2f(v[j]) * w[j]; } }
            u32x4 o; o.x = pk2(siluf(acc[0]), siluf(acc[1])); o.y = pk2(siluf(acc[2]), siluf(acc[3])); o.z = pk2(siluf(acc[4]), siluf(acc[5])); o.w = pk2(siluf(acc[6]), siluf(acc[7]));
            *(u32x4*)(XC + (size_t)row * 1536 + c0) = o;
        }
    }
}

__device__ __forceinline__ int scan_row(int b, int dir, int s) {
    if (s < CTXL) return b * CTXL + (dir ? CTXL - 1 - s : s);
    const int t = s - CTXL; return T_CTX + b * SEQ + (dir ? SEQ - 1 - t : t);
}

__device__ __forceinline__ void phase4_naive(Ctx& C) {
    bf16_t* OF = (bf16_t*)C.out;
    bf16_t* OB = (bf16_t*)(C.ws + WS_OB);
    bf16_t* YB = (bf16_t*)(C.ws + WS_YB);
    const bf16_t* V = (const bf16_t*)(C.ws + WS_V); const bf16_t* XC = (const bf16_t*)(C.ws + WS_XC);
    const float* GDT = (const float*)(C.ws + WS_GDT); const float* GLAD = (const float*)(C.ws + WS_GLAD);
    for (int gt = C.bid * NTHREADS + C.tid; gt < 65536; gt += C.G * NTHREADS) {
        if (gt < 32768) {
            const int chain = gt >> 10, rem = gt & 1023, dv = rem >> 2, dq = rem & 3;
            const int b = chain >> 3, h = (chain >> 1) & 3, dir = chain & 1;
            const bf16_t* QKp = (const bf16_t*)(C.ws + (dir ? WS_QK : WS_QKF));
            float S[32];
#pragma unroll
            for (int i = 0; i < 32; ++i) S[i] = 0.f;
            for (int s = 0; s < CTXL + SEQ; ++s) {
                const int row = scan_row(b, dir, s);
                const float v = bf2f(V[(size_t)row * 1024 + h * 256 + dv]);
                const bf16_t* qp = QKp + (size_t)row * 1024 + h * 128 + dq * 32;
                float o = 0.f;
#pragma unroll
                for (int i8 = 0; i8 < 4; ++i8) { const u16x8 kv = *(const u16x8*)(qp + 512 + i8 * 8), qv = *(const u16x8*)(qp + i8 * 8);
#pragma unroll
                    for (int j = 0; j < 8; ++j) { S[i8 * 8 + j] += bf2f(kv[j]) * v; o += bf2f(qv[j]) * S[i8 * 8 + j]; } }
                o += __shfl_xor(o, 1); o += __shfl_xor(o, 2);
                if (row >= T_CTX && dq == 0) { const size_t l = row - T_CTX; if (dir) OB[l * 1024 + h * 256 + dv] = (bf16_t)f2bf(o); else OF[l * 2048 + h * 256 + dv] = (bf16_t)f2bf(o); }
                if ((s & 63) == 63) { const float* d = GLAD + ((size_t)((row >> 6) * 4 + h) * 2 + dir) * 128 + dq * 32;
#pragma unroll
                    for (int i = 0; i < 32; ++i) S[i] *= d[i]; }
            }
        } else {
            const int g2 = gt - 32768, chain = g2 >> 8, rem = g2 & 255, p = rem >> 2, nq = rem & 3;
            const int b = chain >> 5, head = (chain >> 1) & 15, dir = chain & 1, grp = head >> 3;
            const float Aneg = -__expf(C.in[I_ALOG][dir * 16 + head]), dtb = C.in[I_DTB][dir * 16 + head];
            float S[32];
#pragma unroll
            for (int i = 0; i < 32; ++i) S[i] = 0.f;
            for (int s = 0; s < CTXL + SEQ; ++s) {
                const int row = scan_row(b, dir, s);
                const float dt = softplusf(GDT[(size_t)row * 64 + 32 + dir * 16 + head] + dtb), a = __expf(dt * Aneg);
                const float xd = bf2f(XC[(size_t)row * 1536 + head * 64 + p]) * dt;
                const bf16_t* bp = XC + (size_t)row * 1536 + 1024 + grp * 128 + nq * 32;
                float y = 0.f;
#pragma unroll
                for (int i8 = 0; i8 < 4; ++i8) { const u16x8 bv = *(const u16x8*)(bp + i8 * 8), cv = *(const u16x8*)(bp + 256 + i8 * 8);
#pragma unroll
                    for (int j = 0; j < 8; ++j) { S[i8 * 8 + j] = a * S[i8 * 8 + j] + xd * bf2f(bv[j]); y += S[i8 * 8 + j] * bf2f(cv[j]); } }
                y += __shfl_xor(y, 1); y += __shfl_xor(y, 2);
                if (row >= T_CTX && nq == 0) { const size_t l = row - T_CTX; if (dir) YB[l * 1024 + head * 64 + p] = (bf16_t)f2bf(y); else OF[l * 2048 + 1024 + head * 64 + p] = (bf16_t)f2bf(y); }
            }
        }
    }
}

__device__ __forceinline__ void phase5(Ctx& C) {
    const int gw = C.bid * 8 + C.wave, NGW = C.G * 8;
    const bf16_t* OF = (const bf16_t*)C.out; const bf16_t* OB = (const bf16_t*)(C.ws + WS_OB); const bf16_t* YB = (const bf16_t*)(C.ws + WS_YB);
    const bf16_t* RZ = (const bf16_t*)(C.ws + WS_RZ); const bf16_t* XC = (const bf16_t*)(C.ws + WS_XC); bf16_t* YX = (bf16_t*)(C.ws + WS_YX);
    for (int l = gw; l < T_LAT; l += NGW) {
        const f32x4 gn = *(const f32x4*)(C.in[I_GNORM] + C.lane * 4);
        for (int h = 0; h < 4; ++h) {
            const int c0 = h * 256 + C.lane * 4;
            const u16x4 a = *(const u16x4*)(OF + (size_t)l * 2048 + c0), b = *(const u16x4*)(OB + (size_t)l * 1024 + c0), r = *(const u16x4*)(RZ + (size_t)l * 2048 + c0);
            float o[4], ss = 0.f;
#pragma unroll
            for (int j = 0; j < 4; ++j) { o[j] = bf2f(a[j]) + bf2f(b[j]); ss += o[j] * o[j]; }
            const float rs = rsqrtf(wave_sum(ss) * (1.f / 256.f) + EPS);
            u32x2 w; w.x = pk2(o[0] * rs * gn.x * bf2f(r[0]), o[1] * rs * gn.y * bf2f(r[1])); w.y = pk2(o[2] * rs * gn.z * bf2f(r[2]), o[3] * rs * gn.w * bf2f(r[3]));
            *(u32x2*)(YX + (size_t)l * 2048 + c0) = w;
        }
        for (int g = 0; g < 2; ++g) {
            const int c0 = g * 512 + C.lane * 8, head = c0 >> 6;
            const u16x8 a = *(const u16x8*)(OF + (size_t)l * 2048 + 1024 + c0), b = *(const u16x8*)(YB + (size_t)l * 1024 + c0), z = *(const u16x8*)(RZ + (size_t)l * 2048 + 1024 + c0),
                        xs = *(const u16x8*)(XC + (size_t)(l + T_CTX) * 1536 + c0);
            const float dsk = C.in[I_SSDD][head];
            float y[8], ss = 0.f;
#pragma unroll
            for (int j = 0; j < 8; ++j) { y[j] = (bf2f(a[j]) + bf2f(b[j]) + bf2f(xs[j]) * dsk) * bf2f(z[j]); ss += y[j] * y[j]; }
            const float rs = rsqrtf(wave_sum(ss) * (1.f / 512.f) + EPS);
            const float* nw = C.in[I_SSDN] + c0;
            u32x4 w; w.x = pk2(y[0] * rs * nw[0], y[1] * rs * nw[1]); w.y = pk2(y[2] * rs * nw[2], y[3] * rs * nw[3]); w.z = pk2(y[4] * rs * nw[4], y[5] * rs * nw[5]); w.w = pk2(y[6] * rs * nw[6], y[7] * rs * nw[7]);
            *(u32x4*)(YX + (size_t)l * 2048 + 1024 + c0) = w;
        }
    }
}

__device__ __forceinline__ bf16_t* wgu_ptr(unsigned char* ws, int e) { return (bf16_t*)(ws + (e < 16 ? WS_WGU_LO : WS_WGU_HI)) + (size_t)(e & 15) * 1024 * 1024; }
__device__ __forceinline__ void phase6(Ctx& C) {
    {
        float* scr = (float*)C.lds + 16384 + C.wave * (64 * 33);
        const int gw = C.bid * 8 + C.wave, NGW = C.G * 8;
        bf16_t* WdT = (bf16_t*)(C.ws + WS_WDT);
        for (int it = gw; it < 32 * 768; it += NGW) {
            const int e = it / 768, r = it % 768;
            if (r < 512) { const int up = r >> 8, q = r & 255, kb = q >> 4, nb = q & 15;
                const float* src = C.in[up ? I_EWU : I_EWG] + (size_t)e * 1024 * 512 + (size_t)(kb * 64) * 512 + nb * 32;
                bf16_t* dst = wgu_ptr(C.ws, e) + (size_t)(256 * (nb >> 2) + (nb & 3) * 32 + up * 128) * 1024 + kb * 64;
                transpose_tile(src, 512, dst, 1024, scr, C.lane, false); }
            else { const int q = r - 512, kb = q >> 5, nb = q & 31;
                transpose_tile(C.in[I_EWD] + (size_t)e * 512 * 1024 + (size_t)(kb * 64) * 1024 + nb * 32, 1024, WdT + (size_t)e * 1024 * 512 + (size_t)(nb * 32) * 512 + kb * 64, 512, scr, C.lane, false); }
        }
    }
    __syncthreads();
    const bf16_t* YX = (const bf16_t*)(C.ws + WS_YX); const bf16_t* WoutT = (const bf16_t*)(C.ws + WS_WOUTT);
    const float* MOD = (const float*)(C.ws + WS_MOD); const float* X = C.in[I_X]; float* HL = C.out;
    auto bsel = [=](int, int tn, int& ldb) { ldb = 2048; return WoutT + (size_t)tn * 128 * 2048; };
    auto epi = [=](int row, int tn, int cc, float v, float) { const int col = tn * 128 + cc, b = row >> 12;
        HL[(size_t)row * 1024 + col] = X[(size_t)row * 1024 + col] + MOD[b * 6144 + 2048 + col] * v; };
    gemm_simple<false>(C, YX, 2048, T_LAT / 128, 1024 / 128, 2048, bsel, epi);
}

__device__ __forceinline__ void phase7(Ctx& C) {
    const int gw = C.bid * 8 + C.wave, NGW = C.G * 8;
    const float* MOD = (const float*)(C.ws + WS_MOD); const float* HL = C.out; bf16_t* XN2 = (bf16_t*)(C.ws + WS_XN2);
    int* PE = (int*)(C.ws + WS_PAIR); int* PP = PE + 32768; float* PW = (float*)(PP + 32768);
    unsigned* cnt = (unsigned*)(C.ws + WS_CTL) + CW_CNT;
    const float* wg = C.in[I_RGW]; const float* we = C.in[I_REW];
    for (int l = gw; l < T_LAT; l += NGW) {
        const int b = l >> 12;
        f32x4 v[4]; float ss = 0.f;
#pragma unroll
        for (int j = 0; j < 4; ++j) { v[j] = *(const f32x4*)(HL + (size_t)l * DM + j * 256 + C.lane * 4); ss += v[j].x * v[j].x + v[j].y * v[j].y + v[j].z * v[j].z + v[j].w * v[j].w; }
        const float rs = rsqrtf(wave_sum(ss) * (1.f / DM) + EPS);
        float lg[36];
#pragma unroll
        for (int o = 0; o < 36; ++o) lg[o] = 0.f;
#pragma unroll
        for (int j = 0; j < 4; ++j) { const int c0 = j * 256 + C.lane * 4;
            const f32x4 g = *(const f32x4*)(C.in[I_NFFN] + c0), sh = *(const f32x4*)(MOD + b * 6144 + 3072 + c0), scl = *(const f32x4*)(MOD + b * 6144 + 4096 + c0);
            const f32x4 t = v[j] * rs * g * (1.f + scl) + sh;
            u32x2 o; o.x = pk2(t.x, t.y); o.y = pk2(t.z, t.w); *(u32x2*)(XN2 + (size_t)l * DM + c0) = o;
            const float tf[4] = {t.x, t.y, t.z, t.w};
#pragma unroll
            for (int q = 0; q < 4; ++q) { const f32x4 w4 = *(const f32x4*)(wg + (size_t)(c0 + q) * 4);
                lg[0] += tf[q] * w4.x; lg[1] += tf[q] * w4.y; lg[2] += tf[q] * w4.z; lg[3] += tf[q] * w4.w;
#pragma unroll
                for (int o4 = 0; o4 < 8; ++o4) { const f32x4 e4 = *(const f32x4*)(we + (size_t)(c0 + q) * 32 + o4 * 4);
                    lg[4 + o4 * 4 + 0] += tf[q] * e4.x; lg[4 + o4 * 4 + 1] += tf[q] * e4.y; lg[4 + o4 * 4 + 2] += tf[q] * e4.z; lg[4 + o4 * 4 + 3] += tf[q] * e4.w; } } }
#pragma unroll
        for (int o = 0; o < 36; ++o) lg[o] = wave_sum(lg[o]);
        if (C.lane == 0) {
            float gl[4]; int gs = 0; float gm = -3.4e38f;
#pragma unroll
            for (int o = 0; o < 4; ++o) { gl[o] = lg[o] + C.in[I_RGB][o]; if (gl[o] > gm) { gm = gl[o]; gs = o; } }
            float den = 0.f;
#pragma unroll
            for (int o = 0; o < 4; ++o) den += __expf(gl[o] - gm);
            const float pg = 1.f / den;
            float el[8];
#pragma unroll
            for (int o = 0; o < 8; ++o) { float s = 0.f;
#pragma unroll
                for (int g = 0; g < 4; ++g) s = (g == gs) ? lg[4 + g * 8 + o] : s;
                el[o] = s; }
            int i1 = 0, i2 = 0; float v1 = -3.4e38f, v2 = -3.4e38f;
#pragma unroll
            for (int o = 0; o < 8; ++o) { el[o] += C.in[I_REB][gs * 8 + o]; }
#pragma unroll
            for (int o = 0; o < 8; ++o) { if (el[o] > v1) { v2 = v1; i2 = i1; v1 = el[o]; i1 = o; } else if (el[o] > v2) { v2 = el[o]; i2 = o; } }
            const float e2 = __expf(v2 - v1), w1 = pg / (1.f + e2), w2 = pg * e2 / (1.f + e2);
            const int ex1 = gs * 8 + i1, ex2 = gs * 8 + i2;
            const unsigned p1 = atomicAdd(cnt + ex1, 1u), p2 = atomicAdd(cnt + ex2, 1u);
            PE[l * 2] = ex1; PE[l * 2 + 1] = ex2; PP[l * 2] = (int)p1; PP[l * 2 + 1] = (int)p2; PW[l * 2] = w1; PW[l * 2 + 1] = w2;
        }
    }
}

__device__ __forceinline__ void moe_offsets(Ctx& C, int* off) {
    if (C.tid == 0) { const unsigned* cnt = (const unsigned*)(C.ws + WS_CTL) + CW_CNT; int o = 0;
        for (int e = 0; e < 32; ++e) { off[e] = o; o += (int)((__hip_atomic_load(cnt + e, __ATOMIC_RELAXED, __HIP_MEMORY_SCOPE_AGENT) + 255u) & ~255u); } off[32] = o; }
    __syncthreads();
}

__device__ __forceinline__ void phase8(Ctx& C) {
    int* off = (int*)C.lds; moe_offsets(C, off);
    const int gw = C.bid * 8 + C.wave, NGW = C.G * 8;
    const int* PE = (const int*)(C.ws + WS_PAIR); const int* PP = PE + 32768; const float* PW = (const float*)(PP + 32768); int* SL = (int*)(PW + 32768); float* SW = (float*)(SL + 32768);
    const bf16_t* XN2 = (const bf16_t*)(C.ws + WS_XN2); bf16_t* XS = (bf16_t*)(C.ws + WS_XN2S);
    for (int p = gw; p < 32768; p += NGW) {
        const int slot = off[PE[p]] + PP[p];
        if (C.lane == 0) { SL[p] = slot; SW[slot] = PW[p]; }
        const u32x4* s = (const u32x4*)(XN2 + (size_t)(p >> 1) * DM); u32x4* d = (u32x4*)(XS + (size_t)slot * DM);
        d[C.lane] = s[C.lane]; d[C.lane + 64] = s[C.lane + 64];
    }
}

__device__ __forceinline__ void phase9(Ctx& C) {
    int* off = (int*)(C.lds + 65536); moe_offsets(C, off);
    const bf16_t* XS = (const bf16_t*)(C.ws + WS_XN2S); bf16_t* H = (bf16_t*)(C.ws + WS_H); unsigned char* ws = C.ws;
    auto bsel = [=](int tm, int tn, int& ldb) { int e = 0; const int r0 = tm * 128;
        for (int i = 1; i < 32; ++i) if (off[i] <= r0) e = i;
        ldb = 1024; return (const bf16_t*)wgu_ptr(ws, e) + (size_t)tn * 256 * 1024; };
    auto epi = [=](int row, int tn, int cc, float g, float u) { H[(size_t)row * 512 + tn * 128 + cc] = (bf16_t)f2bf(siluf(g) * u); };
    gemm_simple<true>(C, XS, 1024, off[32] / 128, 4, 1024, bsel, epi);
}

__device__ __forceinline__ void phase10(Ctx& C) {
    int* off = (int*)(C.lds + 65536); moe_offsets(C, off);
    const bf16_t* H = (const bf16_t*)(C.ws + WS_H); bf16_t* Y = (bf16_t*)(C.ws + WS_Y); const bf16_t* WdT = (const bf16_t*)(C.ws + WS_WDT);
    const float* SW = (const float*)(C.ws + WS_PAIR) + 4 * 32768;
    auto bsel = [=](int tm, int tn, int& ldb) { int e = 0; const int r0 = tm * 128;
        for (int i = 1; i < 32; ++i) if (off[i] <= r0) e = i;
        ldb = 512; return WdT + (size_t)e * 1024 * 512 + (size_t)tn * 128 * 512; };
    auto epi = [=](int row, int tn, int cc, float v, float) { Y[(size_t)row * 1024 + tn * 128 + cc] = (bf16_t)f2bf(v * SW[row]); };
    gemm_simple<false>(C, H, 512, off[32] / 128, 8, 512, bsel, epi);
}

__device__ __forceinline__ void phase11(Ctx& C) {
    const int gw = C.bid * 8 + C.wave, NGW = C.G * 8;
    const float* MOD = (const float*)(C.ws + WS_MOD); float* HL = C.out; const bf16_t* Y = (const bf16_t*)(C.ws + WS_Y);
    const int* SL = (const int*)(C.ws + WS_PAIR) + 3 * 32768;
    for (int l = gw; l < T_LAT; l += NGW) {
        const int b = l >> 12, s1 = SL[l * 2], s2 = SL[l * 2 + 1];
        f32x4 v[4]; float ss = 0.f;
#pragma unroll
        for (int j = 0; j < 4; ++j) { const int c0 = j * 256 + C.lane * 4;
            const f32x4 hv = *(const f32x4*)(HL + (size_t)l * DM + c0), g2 = *(const f32x4*)(MOD + b * 6144 + 5120 + c0);
            const u16x4 a = *(const u16x4*)(Y + (size_t)s1 * DM + c0), bb = *(const u16x4*)(Y + (size_t)s2 * DM + c0);
            f32x4 m; m.x = bf2f(a[0]) + bf2f(bb[0]); m.y = bf2f(a[1]) + bf2f(bb[1]); m.z = bf2f(a[2]) + bf2f(bb[2]); m.w = bf2f(a[3]) + bf2f(bb[3]);
            v[j] = hv + g2 * m; ss += v[j].x * v[j].x + v[j].y * v[j].y + v[j].z * v[j].z + v[j].w * v[j].w; }
        const float rs = rsqrtf(wave_sum(ss) * (1.f / DM) + EPS);
#pragma unroll
        for (int j = 0; j < 4; ++j) { const int c0 = j * 256 + C.lane * 4; const f32x4 fn = *(const f32x4*)(C.in[I_FNORM] + c0);
            *(f32x4*)(HL + (size_t)l * DM + c0) = v[j] * rs * fn; }
    }
}

__global__ void __launch_bounds__(NTHREADS, 2) fwd_kernel(Args a) {
    extern __shared__ __attribute__((aligned(16))) unsigned char lds[];
    Ctx C;
#pragma unroll
    for (int i = 0; i < 27; ++i) C.in[i] = a.in[i];
    C.out = a.out; C.ws = a.ws; C.lds = lds;
    C.tid = threadIdx.x; C.lane = C.tid & 63; C.wave = __builtin_amdgcn_readfirstlane(C.tid >> 6); C.bid = blockIdx.x; C.G = gridDim.x;
#if MK_COOP
    cg::grid_group grid = cg::this_grid();
#define SEAM(k) do { if ((k) + 1 < a.ph_hi) grid.sync(); } while (0)
#else
#define SEAM(k) do { } while (0)
#endif
#define IN(k) (a.ph_lo <= (k) && (k) < a.ph_hi)
    if (IN(0)) { phase0(C); SEAM(0); }
    if (IN(1)) { phase1(C); SEAM(1); }
    if (IN(2)) { phase2(C); SEAM(2); }
    if (IN(3)) { phase3(C); SEAM(3); }
    if (IN(4)) { phase4_naive(C); SEAM(4); }
    if (IN(5)) { phase5(C); SEAM(5); }
    if (IN(6)) { phase6(C); SEAM(6); }
    if (IN(7)) { phase7(C); SEAM(7); }
    if (IN(8)) { phase8(C); SEAM(8); }
    if (IN(9)) { phase9(C); SEAM(9); }
    if (IN(10)) { phase10(C); SEAM(10); }
    if (IN(11)) { phase11(C); }
}

extern "C" void kernel_launch(void* const* d_in, const int* in_sizes, int n_in, void* d_out, int out_size, void* d_ws, size_t ws_size, hipStream_t stream) {
    static int grid = 0;
    if (grid == 0) {
        if (n_in != 27 || out_size != T_LAT * DM || ws_size < WS_END) { fprintf(stderr, "kernel_launch: unexpected shapes: n_in %d out %d ws %zu (need %zu)\n", n_in, out_size, ws_size, (size_t)WS_END); grid = -1; return; }
        int dev = 0, cus = 0, per_cu = 0;
        hipGetDevice(&dev); hipDeviceGetAttribute(&cus, hipDeviceAttributeMultiprocessorCount, dev);
        hipFuncSetAttribute((const void*)fwd_kernel, hipFuncAttributeMaxDynamicSharedMemorySize, LDS_BYTES);
        hipOccupancyMaxActiveBlocksPerMultiprocessor(&per_cu, (const void*)fwd_kernel, NTHREADS, LDS_BYTES);
        if (per_cu < 1) { fprintf(stderr, "kernel_launch: occupancy query says %d blocks per CU\n", per_cu); per_cu = 1; }
        (void)hipGetLastError();
        grid = cus;
        fprintf(stderr, "kernel_launch: grid %d, per_cu %d, ws %zu\n", grid, per_cu, ws_size);
    }
    if (grid < 0) return;
    hipMemsetAsync((char*)d_ws + WS_CTL, 0, CTL_BYTES, stream);
    Args a{};
    for (int i = 0; i < 27; ++i) a.in[i] = (const float*)d_in[i];
    a.out = (float*)d_out; a.ws = (unsigned char*)d_ws;
#if MK_COOP
    a.ph_lo = 0; a.ph_hi = NPH;
    void* args[] = {&a};
    hipError_t e = hipLaunchCooperativeKernel((const void*)fwd_kernel, dim3(grid), dim3(NTHREADS), args, LDS_BYTES, stream);
    if (e != hipSuccess) fprintf(stderr, "cooperative launch failed: %s (grid %d)\n", hipGetErrorString(e), grid);
#else
    for (int p = 0; p < NPH; ++p) { a.ph_lo = p; a.ph_hi = p + 1; hipLaunchKernelGGL(fwd_kernel, dim3(grid), dim3(NTHREADS), LDS_BYTES, stream, a); }
#endif
}
```

```cpp
#include <hip/hip_runtime.h>
#include <hip/hip_cooperative_groups.h>
#include <cstdio>
#include <cstdint>
namespace cg = cooperative_groups;

#ifndef MK_COOP
#define MK_COOP 1
#endif

constexpr int NB = 4, SEQ = 4096, DM = 1024, CTXL = 256;
constexpr int T_CTX = NB * CTXL, T_LAT = NB * SEQ, T_ALL = T_CTX + T_LAT;
constexpr float EPS = 1e-6f;
constexpr int NW_IN = 5888;
constexpr int NPH = 12;
constexpr int NTHREADS = 512;
constexpr int LDS_BYTES = 147456;

typedef unsigned short bf16_t;
typedef float f32x4 __attribute__((ext_vector_type(4)));
typedef unsigned u32x4 __attribute__((ext_vector_type(4)));
typedef unsigned u32x2 __attribute__((ext_vector_type(2)));
typedef unsigned short u16x8 __attribute__((ext_vector_type(8)));
typedef unsigned short u16x4 __attribute__((ext_vector_type(4)));

constexpr size_t MiB = 1u << 20;
constexpr size_t WS_QK = 0;
constexpr size_t WS_XBC = 34 * MiB;
constexpr size_t WS_OB = 34 * MiB;
constexpr size_t WS_QKF = 85 * MiB;
constexpr size_t WS_XN = 85 * MiB;
constexpr size_t WS_YX = 85 * MiB;
constexpr size_t WS_V = 119 * MiB;
constexpr size_t WS_XC = 153 * MiB;
constexpr size_t WS_WINT = 153 * MiB;
constexpr size_t WS_RZ = 204 * MiB;
constexpr size_t WS_XN2 = 204 * MiB;
constexpr size_t WS_YB = 268 * MiB;
constexpr size_t WS_GDT = 300 * MiB;
constexpr size_t WS_WOUTT = 305 * MiB;
constexpr size_t WS_MOD = 309 * MiB;
constexpr size_t WS_GLAD = WS_MOD + 256 * 1024;
constexpr size_t WS_CTL = 311 * MiB;
constexpr size_t CTL_BYTES = 64 * 1024;
constexpr size_t WS_PAIR = 312 * MiB;
constexpr size_t WS_END = 313 * MiB;
constexpr size_t WS_WDT = 0;
constexpr size_t WS_WGU_LO = 34 * MiB;
constexpr size_t WS_WGU_HI = 268 * MiB;
constexpr size_t WS_H = 66 * MiB;
constexpr size_t WS_XN2S = 106 * MiB;
constexpr size_t WS_Y = 106 * MiB;
constexpr int MAX_SLOTS = 40960;
constexpr int CW_CNT = 0;

__device__ __forceinline__ float bf2f(bf16_t v) { return __uint_as_float((unsigned)v << 16); }
__device__ __forceinline__ unsigned f2bf(float f) { unsigned u = __float_as_uint(f); return (u + 0x7fffu + ((u >> 16) & 1u)) >> 16; }
__device__ __forceinline__ unsigned pk2(float lo, float hi) { return f2bf(lo) | (f2bf(hi) << 16); }
__device__ __forceinline__ float siluf(float x) { return x / (1.f + __expf(-x)); }
__device__ __forceinline__ float softplusf(float x) { return fmaxf(x, 0.f) + log1pf(__expf(-fabsf(x))); }
__device__ __forceinline__ float logsigf(float x) { return fminf(x, 0.f) - log1pf(__expf(-fabsf(x))); }
__device__ __forceinline__ float wave_sum(float v) {
#pragma unroll
    for (int o = 1; o < 64; o <<= 1) v += __shfl_xor(v, o);
    return v;
}

struct Args { const float* in[27]; float* out; unsigned char* ws; int ph_lo, ph_hi; };
enum { I_X = 0, I_C, I_CTX, I_CCTX, I_WADA, I_BADA, I_NMIX, I_NFFN, I_WIN, I_GWUP, I_GB, I_GNORM, I_CONVW, I_CONVB, I_DTB, I_ALOG, I_SSDD, I_SSDN,
       I_WOUT, I_RGW, I_RGB, I_REW, I_REB, I_EWG, I_EWU, I_EWD, I_FNORM };

struct Ctx {
    const float* in[27]; float* out; unsigned char* ws; unsigned char* lds;
    int tid, lane, wave, bid, G;
};

__device__ __forceinline__ void transpose_tile(const float* src  , int ldw, bf16_t* dst  , int ldt, float* scr, int lane, bool zero) {
#pragma unroll 8
    for (int i = 0; i < 32; ++i) { const int kk = 2 * i + (lane >> 5); scr[kk * 33 + (lane & 31)] = zero ? 0.f : src[(size_t)kk * ldw + (lane & 31)]; }
    asm volatile("s_waitcnt lgkmcnt(0)" ::: "memory");
    const int c = lane & 7;
#pragma unroll
    for (int j = 0; j < 4; ++j) { const int n = (lane >> 3) + 8 * j; const float* s = scr + (8 * c) * 33 + n;
        u32x4 o; o.x = pk2(s[0 * 33], s[1 * 33]); o.y = pk2(s[2 * 33], s[3 * 33]); o.z = pk2(s[4 * 33], s[5 * 33]); o.w = pk2(s[6 * 33], s[7 * 33]);
        *(u32x4*)(dst + (size_t)n * ldt + 8 * c) = o; }
    asm volatile("s_waitcnt lgkmcnt(0)" ::: "memory");
}

__device__ __forceinline__ int win_src_col(int n) {
    if (n < 3072) return n;
    if (n < 4096) return 3104 + (n - 3072);
    if (n < 5632) return 4128 + (n - 4096);
    if (n < 5664) return 3072 + (n - 5632);
    if (n < 5696) return 5664 + (n - 5664);
    return -1;
}

__device__ __forceinline__ void phase0(Ctx& C) {
    float* lds = (float*)C.lds;
    const int gw = C.bid * 8 + C.wave, NGW = C.G * 8;
    {
        float* scr = lds + 8192 + C.wave * (64 * 33);
        bf16_t* WinT = (bf16_t*)(C.ws + WS_WINT); bf16_t* WoutT = (bf16_t*)(C.ws + WS_WOUTT);
        constexpr int IT_IN = 16 * (NW_IN / 32), IT_OUT = 32 * 32;
        for (int it = gw; it < IT_IN + IT_OUT; it += NGW) {
            if (it < IT_IN) { const int kb = it / (NW_IN / 32), nb = it % (NW_IN / 32); const int sc = win_src_col(nb * 32);
                transpose_tile(C.in[I_WIN] + (size_t)(kb * 64) * 5696 + (sc < 0 ? 0 : sc), 5696, WinT + (size_t)(nb * 32) * 1024 + kb * 64, 1024, scr, C.lane, sc < 0); }
            else { const int r = it - IT_IN, kb = r / 32, nb = r % 32;
                transpose_tile(C.in[I_WOUT] + (size_t)(kb * 64) * 1024 + nb * 32, 1024, WoutT + (size_t)(nb * 32) * 2048 + kb * 64, 2048, scr, C.lane, false); }
        }
    }
    __syncthreads();
    float* sc = lds;
    float* red = lds + 5120;
    for (int i = C.tid; i < 5 * 1024; i += NTHREADS) { const int r = i >> 10, k = i & 1023; const float v = r < 4 ? C.in[I_C][r * 1024 + k] : C.in[I_CCTX][k]; sc[i] = siluf(v); }
    __syncthreads();
    float* MOD = (float*)(C.ws + WS_MOD);
    for (int grp = C.bid; grp < 192; grp += C.G) {
        const int col = grp * 32 + (C.tid & 31), kg = C.tid >> 5;
        float acc[5] = {0.f, 0.f, 0.f, 0.f, 0.f};
        for (int k = kg; k < 1024; k += 16) { const float w = C.in[I_WADA][(size_t)k * 6144 + col];
#pragma unroll
            for (int i = 0; i < 5; ++i) acc[i] += sc[i * 1024 + k] * w; }
#pragma unroll
        for (int i = 0; i < 5; ++i) red[(kg * 5 + i) * 32 + (C.tid & 31)] = acc[i];
        __syncthreads();
        if (C.tid < 160) { const int i = C.tid >> 5, c = C.tid & 31; float s = 0.f;
            for (int g = 0; g < 16; ++g) s += red[(g * 5 + i) * 32 + c];
            MOD[i * 6144 + grp * 32 + c] = s + C.in[I_BADA][grp * 32 + c]; }
        __syncthreads();
    }
}

__device__ __forceinline__ const float* tok_row(const Ctx& C, int row, int& mi) {
    if (row < T_CTX) { mi = 4; return C.in[I_CTX] + (size_t)row * DM; }
    mi = (row - T_CTX) >> 12; return C.in[I_X] + (size_t)(row - T_CTX) * DM;
}

__device__ __forceinline__ void phase1(Ctx& C) {
    const int gw = C.bid * 8 + C.wave, NGW = C.G * 8;
    const float* MOD = (const float*)(C.ws + WS_MOD); bf16_t* XN = (bf16_t*)(C.ws + WS_XN);
    for (int row = gw; row < T_ALL; row += NGW) {
        int mi; const float* xr = tok_row(C, row, mi);
        f32x4 v[4]; float ss = 0.f;
#pragma unroll
        for (int j = 0; j < 4; ++j) { v[j] = *(const f32x4*)(xr + j * 256 + C.lane * 4); ss += v[j].x * v[j].x + v[j].y * v[j].y + v[j].z * v[j].z + v[j].w * v[j].w; }
        const float rs = rsqrtf(wave_sum(ss) * (1.f / DM) + EPS);
#pragma unroll
        for (int j = 0; j < 4; ++j) { const int c0 = j * 256 + C.lane * 4;
            const f32x4 g = *(const f32x4*)(C.in[I_NMIX] + c0), sh = *(const f32x4*)(MOD + mi * 6144 + c0), scl = *(const f32x4*)(MOD + mi * 6144 + 1024 + c0);
            const f32x4 y = v[j] * rs * g * (1.f + scl) + sh;
            u32x2 o; o.x = pk2(y.x, y.y); o.y = pk2(y.z, y.w); *(u32x2*)(XN + (size_t)row * DM + c0) = o; }
    }
}

template <bool DUAL, class BSel, class Epi>
__device__ __forceinline__ void gemm_simple(Ctx& C, const bf16_t* A, int lda, int Mtiles, int Ntiles, int K, BSel bsel, Epi epi) {
    float* As = (float*)C.lds;
    float* Bs = As + 32 * 132;
    float* Bs2 = Bs + 32 * 132;
    const int ty = C.tid >> 4, tx = C.tid & 15;
    const int lr = C.tid >> 2, lk = (C.tid & 3) * 8;
    for (int tile = C.bid; tile < Mtiles * Ntiles; tile += C.G) {
        const int tm = tile / Ntiles, tn = tile % Ntiles;
        int ldb; const bf16_t* Bt = bsel(tm, tn, ldb);
        float acc[4][8], acc2[DUAL ? 4 : 1][8];
#pragma unroll
        for (int i = 0; i < 4; ++i)
#pragma unroll
            for (int j = 0; j < 8; ++j) { acc[i][j] = 0.f; if constexpr (DUAL) acc2[i][j] = 0.f; }
        const bf16_t* ap = A + (size_t)(tm * 128 + lr) * lda + lk;
        const bf16_t* bp = Bt + (size_t)lr * ldb + lk;
        for (int k0 = 0; k0 < K; k0 += 32) {
            const u16x8 av = *(const u16x8*)(ap + k0), bv = *(const u16x8*)(bp + k0);
            u16x8 bv2 = bv; if constexpr (DUAL) bv2 = *(const u16x8*)(bp + (size_t)128 * ldb + k0);
            __syncthreads();
#pragma unroll
            for (int j = 0; j < 8; ++j) { As[(lk + j) * 132 + lr] = bf2f(av[j]); Bs[(lk + j) * 132 + lr] = bf2f(bv[j]); if constexpr (DUAL) Bs2[(lk + j) * 132 + lr] = bf2f(bv2[j]); }
            __syncthreads();
#pragma unroll 8
            for (int k = 0; k < 32; ++k) {
                const f32x4 a = *(const f32x4*)(As + k * 132 + ty * 4);
                const f32x4 b0 = *(const f32x4*)(Bs + k * 132 + tx * 8), b1 = *(const f32x4*)(Bs + k * 132 + tx * 8 + 4);
                const float af[4] = {a.x, a.y, a.z, a.w}; const float bf[8] = {b0.x, b0.y, b0.z, b0.w, b1.x, b1.y, b1.z, b1.w};
#pragma unroll
                for (int i = 0; i < 4; ++i)
#pragma unroll
                    for (int j = 0; j < 8; ++j) acc[i][j] += af[i] * bf[j];
                if constexpr (DUAL) {
                    const f32x4 c0 = *(const f32x4*)(Bs2 + k * 132 + tx * 8), c1 = *(const f32x4*)(Bs2 + k * 132 + tx * 8 + 4);
                    const float cf[8] = {c0.x, c0.y, c0.z, c0.w, c1.x, c1.y, c1.z, c1.w};
#pragma unroll
                    for (int i = 0; i < 4; ++i)
#pragma unroll
                        for (int j = 0; j < 8; ++j) acc2[i][j] += af[i] * cf[j];
                }
            }
        }
#pragma unroll
        for (int i = 0; i < 4; ++i)
#pragma unroll
            for (int j = 0; j < 8; ++j) { float a2 = 0.f; if constexpr (DUAL) a2 = acc2[i][j]; epi(tm * 128 + ty * 4 + i, tn, tx * 8 + j, acc[i][j], a2); }
        __syncthreads();
    }
}


namespace pg8 {
#define PG8_LAS __attribute__((address_space(3)))
typedef short bf16x8 __attribute__((ext_vector_type(8)));
constexpr int BM = 256, BK = 64, HALF = 128, HTB = HALF * BK * 2  , STAGE_BYTES = 8 * HTB, NXCD = 8, WGM = 8;
__host__ __device__ __forceinline__ int lds_byte(int r, int c) { const int st = (r >> 4) * 2 + (c >> 5), rr = r & 15, cc = c & 31, ob = rr * 64 + cc * 2; return st * 1024 + (ob ^ (((ob >> 9) & 1) << 5)); }
__host__ __device__ __forceinline__ void stage_rc(int b, int& R, int& C) { const int st = b / 1024, sb = b % 1024, swz = sb ^ (((sb >> 9) & 1) << 5); R = (st >> 1) * 16 + swz / 64; C = (st & 1) * 32 + (swz % 64) / 2; }
__host__ __device__ __forceinline__ int perm32(int rho) { const int n = rho >> 4, i = rho & 15; return 8 * (i >> 2) + 4 * n + (i & 3); }
struct Unit { int pm, pn; };
__device__ __forceinline__ unsigned cvt_pk_bf16(float lo, float hi) { unsigned r; asm volatile("v_cvt_pk_bf16_f32 %0, %1, %2" : "=v"(r) : "v"(lo), "v"(hi)); return r; }
__device__ __forceinline__ int xcd_remap(int L, int nwg) { const int q = nwg / NXCD, r = nwg % NXCD, xcd = L % NXCD, off = L / NXCD; return (xcd < r ? xcd * (q + 1) : r * (q + 1) + (xcd - r) * q) + off; }
template <class Epi, class Sched, bool ALIGN_EPI = false, bool SP2 = false>
__device__ __forceinline__ void gemm_phase(PG8_LAS unsigned char* lds, const int K_, const Sched& S, const Epi& E) {
    const int tid = threadIdx.x, wid = __builtin_amdgcn_readfirstlane(tid >> 6), lane = tid & 63, wr = wid >> 2, wc = wid & 3, fr = lane & 15, fq = lane >> 4;
    const int K = K_, nt = K / BK;
    unsigned voffA[2], voffB[2];
#pragma unroll
    for (int i = 0; i < 2; ++i) { int R, C; stage_rc(tid * 16 + i * 8192, R, C); const int Rb = Epi::PERM ? ((R & ~31) + perm32(R & 31)) : R;
        voffA[i] = (unsigned)(R * K + C) * 2u; voffB[i] = (unsigned)(Rb * K + C) * 2u; }
    const size_t kstep = (size_t)(BK * 2);
    const size_t hstep = (size_t)HALF * K * 2;
    const unsigned ldsw = (unsigned)wid * 1024u;
    const int aoff = lds_byte(wr * 64 + fr, fq * 8), boff = lds_byte(wc * 32 + fr, fq * 8);
#define PG8_SA(b, h) (((b) * 2 + (h)) * HTB)
#define PG8_SB(b, h) ((4 + (b) * 2 + (h)) * HTB)
#define PG8_STAGE(bufoff, gbase, voff) do { _Pragma("unroll") for (int _i = 0; _i < 2; ++_i) \
        __builtin_amdgcn_global_load_lds((const unsigned*)((const char*)(gbase) + (voff)[_i]), (PG8_LAS unsigned*)(lds + (bufoff) + ldsw + _i * 8192), 16, 0, 0); } while (0)
#define PG8_LDA(dst, b, h) do { _Pragma("unroll") for (int m = 0; m < 4; ++m) _Pragma("unroll") for (int k = 0; k < 2; ++k) dst[m][k] = *(const PG8_LAS bf16x8*)(lds + PG8_SA(b, h) + aoff + m * 2048 + k * 1024); } while (0)
#define PG8_LDB(dst, b, h) do { _Pragma("unroll") for (int n = 0; n < 2; ++n) _Pragma("unroll") for (int k = 0; k < 2; ++k) dst[n][k] = *(const PG8_LAS bf16x8*)(lds + PG8_SB(b, h) + boff + n * 2048 + k * 1024); } while (0)
#define PG8_MMA(ai, bj, At, Bt) do { __builtin_amdgcn_s_setprio(1); _Pragma("unroll") for (int m = 0; m < 4; ++m) _Pragma("unroll") for (int n = 0; n < 2; ++n) _Pragma("unroll") for (int k = 0; k < 2; ++k) \
        acc[ai][bj][m][n] = __builtin_amdgcn_mfma_f32_16x16x32_bf16(Bt[n][k], At[m][k], acc[ai][bj][m][n], 0, 0, 0); __builtin_amdgcn_s_setprio(0); } while (0)
#define PG8_WAIT_V(n) asm volatile("s_waitcnt vmcnt(" #n ")" ::: "memory")
#define PG8_WAIT_L(n) asm volatile("s_waitcnt lgkmcnt(" #n ")" ::: "memory")
#define PG8_BAR __builtin_amdgcn_s_barrier()
#define PG8_SCHED __builtin_amdgcn_sched_barrier(0)
    Unit cur, nxt; int ui = 0;
    if (!S.next(0, cur)) return;
    f32x4 acc[2][2][4][2];
#pragma unroll
    for (int a = 0; a < 2; ++a)
#pragma unroll
        for (int b = 0; b < 2; ++b)
#pragma unroll
            for (int m = 0; m < 4; ++m)
#pragma unroll
                for (int n = 0; n < 2; ++n) acc[a][b][m][n] = (f32x4){0.f, 0.f, 0.f, 0.f};
    bf16x8 At[4][2], B0[2][2], B1[2][2];
    const char* cA = S.a_ptr(cur); const char* cB = S.b_ptr(cur);
    S.a_ready(cur);
    if constexpr (SP2) {
        PG8_STAGE(PG8_SB(0, 0), cB, voffB); PG8_STAGE(PG8_SB(0, 1), cB + hstep, voffB); PG8_STAGE(PG8_SA(0, 0), cA, voffA); PG8_STAGE(PG8_SA(0, 1), cA + hstep, voffA);
        if (wr == 1) PG8_BAR;
        PG8_WAIT_V(2); PG8_BAR;
        PG8_STAGE(PG8_SB(1, 0), cB + kstep, voffB); PG8_STAGE(PG8_SA(1, 0), cA + kstep, voffA); PG8_STAGE(PG8_SB(1, 1), cB + hstep + kstep, voffB);
        PG8_WAIT_V(6); PG8_BAR;
    } else {
        PG8_STAGE(PG8_SB(0, 0), cB, voffB); PG8_STAGE(PG8_SA(0, 0), cA, voffA); PG8_STAGE(PG8_SB(0, 1), cB + hstep, voffB); PG8_STAGE(PG8_SA(0, 1), cA + hstep, voffA);
        if (wr == 1) PG8_BAR;
        PG8_WAIT_V(4); PG8_BAR;
        PG8_STAGE(PG8_SB(1, 0), cB + kstep, voffB); PG8_STAGE(PG8_SA(1, 0), cA + kstep, voffA); PG8_STAGE(PG8_SB(1, 1), cB + hstep + kstep, voffB);
        PG8_WAIT_V(6); PG8_BAR;
    }
    for (;;) {
        const bool has_next = S.next(ui + 1, nxt);
        const char* nA = has_next ? S.a_ptr(nxt) : cA; const char* nB = has_next ? S.b_ptr(nxt) : cB;
        for (int t = 0; t < nt; t += 2) {
            const bool last = (t == nt - 2);
            const char* a1 = cA + (size_t)(t + 1) * kstep;
            const char* a2 = last ? nA : cA + (size_t)(t + 2) * kstep; const char* b2 = last ? nB : cB + (size_t)(t + 2) * kstep;
            const char* a3 = a2 + kstep; const char* b3 = b2 + kstep;
            if (last && has_next) S.a_ready(nxt);
            if constexpr (SP2) {
            PG8_LDB(B0, 0, 0); PG8_LDB(B1, 0, 1); PG8_SCHED; PG8_LDA(At, 0, 0); PG8_STAGE(PG8_SA(1, 1), a1 + hstep, voffA);
            PG8_WAIT_V(8); PG8_WAIT_L(0); PG8_BAR; PG8_MMA(0, 0, At, B0); PG8_MMA(0, 1, At, B1); PG8_BAR; PG8_SCHED;
            PG8_LDA(At, 0, 1); PG8_STAGE(PG8_SB(0, 0), b2, voffB); PG8_STAGE(PG8_SB(0, 1), b2 + hstep, voffB); PG8_STAGE(PG8_SA(0, 0), a2, voffA);
            PG8_WAIT_V(8); PG8_WAIT_L(0); PG8_BAR; PG8_MMA(1, 0, At, B0); PG8_MMA(1, 1, At, B1); PG8_BAR; PG8_SCHED;
            PG8_LDB(B0, 1, 0); PG8_LDB(B1, 1, 1); PG8_SCHED; PG8_LDA(At, 1, 0); PG8_STAGE(PG8_SA(0, 1), a2 + hstep, voffA);
            PG8_WAIT_V(8); PG8_WAIT_L(0); PG8_BAR; PG8_MMA(0, 0, At, B0); PG8_MMA(0, 1, At, B1); PG8_BAR; PG8_SCHED;
            PG8_LDA(At, 1, 1); PG8_STAGE(PG8_SB(1, 0), b3, voffB); PG8_STAGE(PG8_SB(1, 1), b3 + hstep, voffB); PG8_STAGE(PG8_SA(1, 0), a3, voffA);
            PG8_WAIT_V(8); PG8_WAIT_L(0); PG8_BAR; PG8_MMA(1, 0, At, B0); PG8_MMA(1, 1, At, B1); PG8_BAR; PG8_SCHED;
            } else {
            PG8_LDB(B0, 0, 0); PG8_SCHED; PG8_LDA(At, 0, 0); PG8_STAGE(PG8_SA(1, 1), a1 + hstep, voffA);
            PG8_WAIT_L(8); PG8_BAR; PG8_WAIT_L(0); PG8_MMA(0, 0, At, B0); PG8_BAR; PG8_SCHED;
            PG8_LDB(B1, 0, 1); PG8_STAGE(PG8_SB(0, 0), b2, voffB);
            PG8_BAR; PG8_WAIT_L(0); PG8_MMA(0, 1, At, B1); PG8_BAR;
            PG8_LDA(At, 0, 1); PG8_STAGE(PG8_SA(0, 0), a2, voffA);
            PG8_BAR; PG8_WAIT_L(0); PG8_MMA(1, 0, At, B0); PG8_BAR; PG8_SCHED;
            PG8_STAGE(PG8_SB(0, 1), b2 + hstep, voffB);
            PG8_WAIT_V(6); PG8_BAR; PG8_MMA(1, 1, At, B1); PG8_BAR;
            PG8_LDB(B0, 1, 0); PG8_SCHED; PG8_LDA(At, 1, 0); PG8_STAGE(PG8_SA(0, 1), a2 + hstep, voffA);
            PG8_WAIT_L(8); PG8_BAR; PG8_WAIT_L(0); PG8_MMA(0, 0, At, B0); PG8_BAR; PG8_SCHED;
            PG8_LDB(B1, 1, 1); PG8_STAGE(PG8_SB(1, 0), b3, voffB);
            PG8_BAR; PG8_WAIT_L(0); PG8_MMA(0, 1, At, B1); PG8_BAR;
            PG8_LDA(At, 1, 1); PG8_STAGE(PG8_SA(1, 0), a3, voffA);
            PG8_BAR; PG8_WAIT_L(0); PG8_MMA(1, 0, At, B0); PG8_BAR; PG8_SCHED;
            PG8_STAGE(PG8_SB(1, 1), b3 + hstep, voffB);
            PG8_WAIT_V(6); PG8_BAR; PG8_MMA(1, 1, At, B1); PG8_BAR;
            }
        }
        if constexpr (ALIGN_EPI) { if (wr == 0) PG8_BAR; }
        if constexpr (!Epi::AFTER_DRAIN) { E(acc, cur, wr, wc, fr, fq); S.done(cur); }
        if (!has_next) break;
#pragma unroll
        for (int a = 0; a < 2; ++a)
#pragma unroll
            for (int b = 0; b < 2; ++b)
#pragma unroll
                for (int m = 0; m < 4; ++m)
#pragma unroll
                    for (int n = 0; n < 2; ++n) acc[a][b][m][n] = (f32x4){0.f, 0.f, 0.f, 0.f};
        cur = nxt; cA = nA; cB = nB; ++ui;
        if constexpr (ALIGN_EPI) { if (wr == 1) PG8_BAR; }
    }
    PG8_WAIT_V(0);
    if constexpr (!ALIGN_EPI) { if (wr == 0) PG8_BAR; }
    PG8_BAR;
    if constexpr (Epi::AFTER_DRAIN) { E.fused(acc, cur, wr, wc, fr, fq, lds, wid, lane); S.done(cur); }
#undef PG8_SA
#undef PG8_SB
#undef PG8_STAGE
#undef PG8_LDA
#undef PG8_LDB
#undef PG8_MMA
#undef PG8_WAIT_V
#undef PG8_WAIT_L
#undef PG8_BAR
#undef PG8_SCHED
}
}

__device__ __forceinline__ bf16_t* wgu_ptr(unsigned char* ws, int e) { return (bf16_t*)(ws + (e < 16 ? WS_WGU_LO : WS_WGU_HI)) + (size_t)(e & 15) * 1024 * 1024; }

#ifndef PG8_MASK
#define PG8_MASK 15
#endif
typedef __attribute__((address_space(3))) unsigned char* lds_ptr_t;

struct SchedIn {
    const char* A; const char* Bt; int G, c;
    __device__ __forceinline__ bool next(int i, pg8::Unit& u) const {
        const int L0 = i * G + c; if (L0 >= 1532) return false;
        const int L = pg8::xcd_remap(L0, 1532);
        if (L < 60) { const int pi = L >> 2; u.pm = L & 3; u.pn = pi < 8 ? pi : pi + 8; }
        else { const int l2 = L - 60, g = l2 / 184, r = l2 % 184; u.pn = r >> 3; u.pm = 4 + 8 * g + (r & 7); }
        return true;
    }
    __device__ __forceinline__ const char* a_ptr(const pg8::Unit& u) const { return A + (size_t)u.pm * (256 * 1024 * 2); }
    __device__ __forceinline__ const char* b_ptr(const pg8::Unit& u) const { return Bt + (size_t)u.pn * (256 * 1024 * 2); }
    __device__ __forceinline__ void a_ready(const pg8::Unit&) const {}
    __device__ __forceinline__ void done(const pg8::Unit&) const {}
};
struct SchedOut {
    const char* A; const char* Bt; int G, c;
    __device__ __forceinline__ bool next(int i, pg8::Unit& u) const {
        const int L0 = i * G + c; if (L0 >= 256) return false;
        const int w = pg8::xcd_remap(L0, 256), gid = w >> 5, r = w & 31;
        u.pm = gid * 8 + (r & 7); u.pn = r >> 3;
        return true;
    }
    __device__ __forceinline__ const char* a_ptr(const pg8::Unit& u) const { return A + (size_t)u.pm * (256 * 2048 * 2); }
    __device__ __forceinline__ const char* b_ptr(const pg8::Unit& u) const { return Bt + (size_t)u.pn * (256 * 2048 * 2); }
    __device__ __forceinline__ void a_ready(const pg8::Unit&) const {}
    __device__ __forceinline__ void done(const pg8::Unit&) const {}
};
struct SchedMoe {
    const char* A; unsigned char* ws; const int* tile_e; int NT, G, c, K, down;
    __device__ __forceinline__ bool next(int i, pg8::Unit& u) const {
        const int nwg = NT * 4; const int L0 = i * G + c; if (L0 >= nwg) return false;
        const int w = pg8::xcd_remap(L0, nwg);
        u.pm = w >> 2; u.pn = w & 3;
        return true;
    }
    __device__ __forceinline__ const char* a_ptr(const pg8::Unit& u) const { return A + (size_t)u.pm * 256 * K * 2; }
    __device__ __forceinline__ const char* b_ptr(const pg8::Unit& u) const {
        const int e = __builtin_amdgcn_readfirstlane(tile_e[u.pm]);
        return down ? (const char*)(ws + WS_WDT) + ((size_t)e * 1024 * 512 + (size_t)u.pn * 256 * 512) * 2
                    : (const char*)wgu_ptr(ws, e) + (size_t)u.pn * 256 * 1024 * 2;
    }
    __device__ __forceinline__ void a_ready(const pg8::Unit&) const {}
    __device__ __forceinline__ void done(const pg8::Unit&) const {}
};

struct EpiIn {
    static constexpr bool PERM = true, AFTER_DRAIN = false;
    unsigned char* ws;
    __device__ __forceinline__ void operator()(const f32x4 (&acc)[2][2][4][2], const pg8::Unit& u, int wr, int wc, int fr, int fq) const {
        const int pn = u.pn; const int row0 = u.pm * 256 + wr * 64 + fr; const int ct = wc * 32 + 8 * fq;
        if (pn == 22) {
            if (wc < 2) { float* GDT = (float*)(ws + WS_GDT);
#pragma unroll
                for (int ai = 0; ai < 2; ++ai)
#pragma unroll
                    for (int m = 0; m < 4; ++m) { float* p = GDT + (size_t)(row0 + ai * 128 + m * 16) * 64 + ct; *(f32x4*)p = acc[ai][0][m][0]; *(f32x4*)(p + 4) = acc[ai][0][m][1]; } }
            return;
        }
        bf16_t* base; int ld; int roff = 0; bool act = false;
        if (pn < 4) { base = (bf16_t*)(ws + WS_QK) + pn * 256; ld = 1024; }
        else if (pn < 8) { base = (bf16_t*)(ws + WS_V) + (pn - 4) * 256; ld = 1024; }
        else if (pn < 16) { base = (bf16_t*)(ws + WS_RZ) + (pn - 8) * 256; ld = 2048; roff = T_CTX; act = true; }
        else { base = (bf16_t*)(ws + WS_XBC) + (pn - 16) * 256; ld = 1536; }
#pragma unroll
        for (int ai = 0; ai < 2; ++ai)
#pragma unroll
            for (int m = 0; m < 4; ++m) { bf16_t* rowp = base + (size_t)(row0 - roff + ai * 128 + m * 16) * ld + ct;
#pragma unroll
                for (int bj = 0; bj < 2; ++bj) { f32x4 v0 = acc[ai][bj][m][0], v1 = acc[ai][bj][m][1];
                    if (act) { v0.x = siluf(v0.x); v0.y = siluf(v0.y); v0.z = siluf(v0.z); v0.w = siluf(v0.w); v1.x = siluf(v1.x); v1.y = siluf(v1.y); v1.z = siluf(v1.z); v1.w = siluf(v1.w); }
                    u32x4 w; w.x = pg8::cvt_pk_bf16(v0.x, v0.y); w.y = pg8::cvt_pk_bf16(v0.z, v0.w); w.z = pg8::cvt_pk_bf16(v1.x, v1.y); w.w = pg8::cvt_pk_bf16(v1.z, v1.w);
                    *(u32x4*)(rowp + bj * 128) = w; } }
    }
};
struct EpiOut {
    static constexpr bool PERM = false, AFTER_DRAIN = false;
    const float* X; const float* MOD; float* HL;
    __device__ __forceinline__ void operator()(const f32x4 (&acc)[2][2][4][2], const pg8::Unit& u, int wr, int wc, int fr, int fq) const {
        const int b = u.pm >> 4; const int col0 = u.pn * 256 + wc * 32 + 4 * fq;
        f32x4 g1[2][2];
#pragma unroll
        for (int bj = 0; bj < 2; ++bj)
#pragma unroll
            for (int n = 0; n < 2; ++n) g1[bj][n] = *(const f32x4*)(MOD + b * 6144 + 2048 + col0 + bj * 128 + n * 16);
#pragma unroll
        for (int ai = 0; ai < 2; ++ai)
#pragma unroll
            for (int m = 0; m < 4; ++m) { const size_t off = (size_t)(u.pm * 256 + ai * 128 + wr * 64 + m * 16 + fr) * 1024 + col0;
#pragma unroll
                for (int bj = 0; bj < 2; ++bj)
#pragma unroll
                    for (int n = 0; n < 2; ++n) { const f32x4 xv = *(const f32x4*)(X + off + bj * 128 + n * 16); *(f32x4*)(HL + off + bj * 128 + n * 16) = xv + g1[bj][n] * acc[ai][bj][m][n]; }
                if (m & 1) asm volatile("" ::: "memory"); }
    }
};
struct EpiUp {
    static constexpr bool PERM = true, AFTER_DRAIN = false;
    bf16_t* H;
    __device__ __forceinline__ void operator()(const f32x4 (&acc)[2][2][4][2], const pg8::Unit& u, int wr, int wc, int fr, int fq) const {
        const int row0 = u.pm * 256 + wr * 64 + fr; const int col = u.pn * 128 + wc * 32 + 8 * fq;
#pragma unroll
        for (int ai = 0; ai < 2; ++ai)
#pragma unroll
            for (int m = 0; m < 4; ++m) { const f32x4 g0 = acc[ai][0][m][0], g1 = acc[ai][0][m][1], u0 = acc[ai][1][m][0], u1 = acc[ai][1][m][1];
                u32x4 w; w.x = pg8::cvt_pk_bf16(siluf(g0.x) * u0.x, siluf(g0.y) * u0.y); w.y = pg8::cvt_pk_bf16(siluf(g0.z) * u0.z, siluf(g0.w) * u0.w);
                w.z = pg8::cvt_pk_bf16(siluf(g1.x) * u1.x, siluf(g1.y) * u1.y); w.w = pg8::cvt_pk_bf16(siluf(g1.z) * u1.z, siluf(g1.w) * u1.w);
                *(u32x4*)(H + (size_t)(row0 + ai * 128 + m * 16) * 512 + col) = w; }
    }
};
struct EpiDown {
    static constexpr bool PERM = true, AFTER_DRAIN = false;
    bf16_t* Y; const float* SW;
    __device__ __forceinline__ void operator()(const f32x4 (&acc)[2][2][4][2], const pg8::Unit& u, int wr, int wc, int fr, int fq) const {
        const int row0 = u.pm * 256 + wr * 64 + fr; const int col = u.pn * 256 + wc * 32 + 8 * fq;
#pragma unroll
        for (int ai = 0; ai < 2; ++ai)
#pragma unroll
            for (int m = 0; m < 4; ++m) { const int row = row0 + ai * 128 + m * 16; const float sw = SW[row];
#pragma unroll
                for (int bj = 0; bj < 2; ++bj) { const f32x4 v0 = acc[ai][bj][m][0] * sw, v1 = acc[ai][bj][m][1] * sw;
                    u32x4 w; w.x = pg8::cvt_pk_bf16(v0.x, v0.y); w.y = pg8::cvt_pk_bf16(v0.z, v0.w); w.z = pg8::cvt_pk_bf16(v1.x, v1.y); w.w = pg8::cvt_pk_bf16(v1.z, v1.w);
                    *(u32x4*)(Y + (size_t)row * 1024 + col + bj * 128) = w; } }
    }
};

__device__ __forceinline__ void phase2(Ctx& C) {
    const bf16_t* XN = (const bf16_t*)(C.ws + WS_XN); const bf16_t* WinT = (const bf16_t*)(C.ws + WS_WINT);
    bf16_t* QK = (bf16_t*)(C.ws + WS_QK); bf16_t* V = (bf16_t*)(C.ws + WS_V); bf16_t* RZ = (bf16_t*)(C.ws + WS_RZ); bf16_t* XBC = (bf16_t*)(C.ws + WS_XBC);
    float* GDT = (float*)(C.ws + WS_GDT);
    auto bsel = [=](int, int tn, int& ldb) { ldb = 1024; return WinT + (size_t)tn * 128 * 1024; };
    auto epi = [=](int row, int tn, int cc, float v, float) {
        const int col = tn * 128 + cc;
        if (col < 1024) QK[(size_t)row * 1024 + col] = (bf16_t)f2bf(v);
        else if (col < 2048) V[(size_t)row * 1024 + col - 1024] = (bf16_t)f2bf(v);
        else if (col < 4096) { if (row >= T_CTX) RZ[(size_t)(row - T_CTX) * 2048 + col - 2048] = (bf16_t)f2bf(siluf(v)); }
        else if (col < 5632) XBC[(size_t)row * 1536 + col - 4096] = (bf16_t)f2bf(v);
        else if (col < 5696) GDT[(size_t)row * 64 + col - 5632] = v;
    };
#if PG8_MASK & 1
    (void)bsel; (void)epi;
    SchedIn S{(const char*)XN, (const char*)WinT, C.G, C.bid}; EpiIn E{C.ws};
    pg8::gemm_phase<EpiIn, SchedIn, true, true>((lds_ptr_t)C.lds, 1024, S, E);
#else
    gemm_simple<false>(C, XN, 1024, T_ALL / 128, NW_IN / 128, 1024, bsel, epi);
#endif
}

__device__ __forceinline__ void phase3(Ctx& C) {
    float* lds = (float*)C.lds;
    {
        float* gs = lds;
        float* tot = lds + 2048;
        bf16_t* QK = (bf16_t*)(C.ws + WS_QK); bf16_t* QKF = (bf16_t*)(C.ws + WS_QKF);
        const float* GDT = (const float*)(C.ws + WS_GDT); float* GLAD = (float*)(C.ws + WS_GLAD);
        const int c = C.tid & 127, tg = C.tid >> 7;
        for (int item = C.bid; item < 272 * 4; item += C.G) {
            const int rc = item >> 2, h = item & 3, row0 = rc * 64;
            __syncthreads();
            for (int i = C.tid; i < 64 * 32; i += NTHREADS) gs[i] = GDT[(size_t)(row0 + (i >> 5)) * 64 + (i & 31)];
            float wf[16], wb[16];
#pragma unroll
            for (int r = 0; r < 16; ++r) { wf[r] = C.in[I_GWUP][r * 512 + h * 128 + c]; wb[r] = C.in[I_GWUP][(16 + r) * 512 + h * 128 + c]; }
            const float bfv = C.in[I_GB][h * 128 + c], bbv = C.in[I_GB][512 + h * 128 + c];
            __syncthreads();
            float pf[16], pb[16];
#pragma unroll
            for (int tt = 0; tt < 16; ++tt) { const float* g = gs + (tg * 16 + tt) * 32; float sf = bfv, sb = bbv;
#pragma unroll
                for (int r = 0; r < 16; ++r) { sf += g[r] * wf[r]; sb += g[16 + r] * wb[r]; }
                pf[tt] = logsigf(sf) * (1.f / 16.f); pb[tt] = logsigf(sb) * (1.f / 16.f); }
#pragma unroll
            for (int tt = 1; tt < 16; ++tt) pf[tt] += pf[tt - 1];
#pragma unroll
            for (int tt = 14; tt >= 0; --tt) pb[tt] += pb[tt + 1];
            tot[(0 * 4 + tg) * 128 + c] = pf[15]; tot[(1 * 4 + tg) * 128 + c] = pb[0];
            __syncthreads();
            float offf = 0.f, offb = 0.f, totf = 0.f, totb = 0.f;
#pragma unroll
            for (int g = 0; g < 4; ++g) { const float a = tot[(0 * 4 + g) * 128 + c], b = tot[(1 * 4 + g) * 128 + c]; if (g < tg) offf += a; if (g > tg) offb += b; totf += a; totb += b; }
            if (tg == 0) { GLAD[((size_t)(rc * 4 + h) * 2 + 0) * 128 + c] = __expf(totf); GLAD[((size_t)(rc * 4 + h) * 2 + 1) * 128 + c] = __expf(totb); }
            const float qscale = 0.08838834764831845f;
#pragma unroll
            for (int tt = 0; tt < 16; ++tt) { const size_t ro = (size_t)(row0 + tg * 16 + tt) * 1024;
                const float q = bf2f(QK[ro + h * 128 + c]) * qscale, k = bf2f(QK[ro + 512 + h * 128 + c]);
                const float ef = pf[tt] + offf, eb = pb[tt] + offb;
                QKF[ro + h * 128 + c] = (bf16_t)f2bf(q * __expf(ef)); QKF[ro + 512 + h * 128 + c] = (bf16_t)f2bf(k * __expf(-ef));
                QK[ro + h * 128 + c] = (bf16_t)f2bf(q * __expf(eb)); QK[ro + 512 + h * 128 + c] = (bf16_t)f2bf(k * __expf(-eb)); }
        }
    }
    {
        const bf16_t* XBC = (const bf16_t*)(C.ws + WS_XBC); bf16_t* XC = (bf16_t*)(C.ws + WS_XC);
        const float* cw = C.in[I_CONVW]; const float* cb = C.in[I_CONVB];
        const long total = (long)T_ALL * 192;
        for (long it = (long)C.bid * NTHREADS + C.tid; it < total; it += (long)C.G * NTHREADS) {
            const int row = (int)(it / 192), c0 = (int)(it % 192) * 8;
            float acc[8];
#pragma unroll
            for (int j = 0; j < 8; ++j) acc[j] = cb[c0 + j];
            int base, y, x, H, W;
            if (row < T_CTX) { base = row & ~255; y = 0; x = row & 255; H = 1; W = 256; }
            else { const int l = row - T_CTX; base = T_CTX + (l & ~4095); const int t = l & 4095; y = t >> 6; x = t & 63; H = 64; W = 64; }
            for (int i = 0; i < 3; ++i) { const int yy = y + i - 1; if (yy < 0 || yy >= H) continue;
                for (int jx = 0; jx < 3; ++jx) { const int xx = x + jx - 1; if (xx < 0 || xx >= W) continue;
                    const u16x8 v = *(const u16x8*)(XBC + (size_t)(base + yy * W + xx) * 1536 + c0);
                    const float* w = cw + (size_t)(i * 3 + jx) * 1536 + c0;
#pragma unroll
                    for (int j = 0; j < 8; ++j) acc[j] += bf2f(v[j]) * w[j]; } }
            u32x4 o; o.x = pk2(siluf(acc[0]), siluf(acc[1])); o.y = pk2(siluf(acc[2]), siluf(acc[3])); o.z = pk2(siluf(acc[4]), siluf(acc[5])); o.w = pk2(siluf(acc[6]), siluf(acc[7]));
            *(u32x4*)(XC + (size_t)row * 1536 + c0) = o;
        }
    }
}

__device__ __forceinline__ int scan_row(int b, int dir, int s) {
    if (s < CTXL) return b * CTXL + (dir ? CTXL - 1 - s : s);
    const int t = s - CTXL; return T_CTX + b * SEQ + (dir ? SEQ - 1 - t : t);
}

__device__ __forceinline__ void phase4_naive(Ctx& C) {
    bf16_t* OF = (bf16_t*)C.out;
    bf16_t* OB = (bf16_t*)(C.ws + WS_OB);
    bf16_t* YB = (bf16_t*)(C.ws + WS_YB);
    const bf16_t* V = (const bf16_t*)(C.ws + WS_V); const bf16_t* XC = (const bf16_t*)(C.ws + WS_XC);
    const float* GDT = (const float*)(C.ws + WS_GDT); const float* GLAD = (const float*)(C.ws + WS_GLAD);
    for (int gt = C.bid * NTHREADS + C.tid; gt < 65536; gt += C.G * NTHREADS) {
        if (gt < 32768) {
            const int chain = gt >> 10, rem = gt & 1023, dv = rem >> 2, dq = rem & 3;
            const int b = chain >> 3, h = (chain >> 1) & 3, dir = chain & 1;
            const bf16_t* QKp = (const bf16_t*)(C.ws + (dir ? WS_QK : WS_QKF));
            float S[32];
#pragma unroll
            for (int i = 0; i < 32; ++i) S[i] = 0.f;
            for (int s = 0; s < CTXL + SEQ; ++s) {
                const int row = scan_row(b, dir, s);
                const float v = bf2f(V[(size_t)row * 1024 + h * 256 + dv]);
                const bf16_t* qp = QKp + (size_t)row * 1024 + h * 128 + dq * 32;
                float o = 0.f;
#pragma unroll
                for (int i8 = 0; i8 < 4; ++i8) { const u16x8 kv = *(const u16x8*)(qp + 512 + i8 * 8), qv = *(const u16x8*)(qp + i8 * 8);
#pragma unroll
                    for (int j = 0; j < 8; ++j) { S[i8 * 8 + j] += bf2f(kv[j]) * v; o += bf2f(qv[j]) * S[i8 * 8 + j]; } }
                o += __shfl_xor(o, 1); o += __shfl_xor(o, 2);
                if (row >= T_CTX && dq == 0) { const size_t l = row - T_CTX; if (dir) OB[l * 1024 + h * 256 + dv] = (bf16_t)f2bf(o); else OF[l * 2048 + h * 256 + dv] = (bf16_t)f2bf(o); }
                if ((s & 63) == 63) { const float* d = GLAD + ((size_t)((row >> 6) * 4 + h) * 2 + dir) * 128 + dq * 32;
#pragma unroll
                    for (int i = 0; i < 32; ++i) S[i] *= d[i]; }
            }
        } else {
            const int g2 = gt - 32768, chain = g2 >> 8, rem = g2 & 255, p = rem >> 2, nq = rem & 3;
            const int b = chain >> 5, head = (chain >> 1) & 15, dir = chain & 1, grp = head >> 3;
            const float Aneg = -__expf(C.in[I_ALOG][dir * 16 + head]), dtb = C.in[I_DTB][dir * 16 + head];
            float S[32];
#pragma unroll
            for (int i = 0; i < 32; ++i) S[i] = 0.f;
            for (int s = 0; s < CTXL + SEQ; ++s) {
                const int row = scan_row(b, dir, s);
                const float dt = softplusf(GDT[(size_t)row * 64 + 32 + dir * 16 + head] + dtb), a = __expf(dt * Aneg);
                const float xd = bf2f(XC[(size_t)row * 1536 + head * 64 + p]) * dt;
                const bf16_t* bp = XC + (size_t)row * 1536 + 1024 + grp * 128 + nq * 32;
                float y = 0.f;
#pragma unroll
                for (int i8 = 0; i8 < 4; ++i8) { const u16x8 bv = *(const u16x8*)(bp + i8 * 8), cv = *(const u16x8*)(bp + 256 + i8 * 8);
#pragma unroll
                    for (int j = 0; j < 8; ++j) { S[i8 * 8 + j] = a * S[i8 * 8 + j] + xd * bf2f(bv[j]); y += S[i8 * 8 + j] * bf2f(cv[j]); } }
                y += __shfl_xor(y, 1); y += __shfl_xor(y, 2);
                if (row >= T_CTX && nq == 0) { const size_t l = row - T_CTX; if (dir) YB[l * 1024 + head * 64 + p] = (bf16_t)f2bf(y); else OF[l * 2048 + 1024 + head * 64 + p] = (bf16_t)f2bf(y); }
            }
        }
    }
}

__device__ __forceinline__ void phase5(Ctx& C) {
    const int gw = C.bid * 8 + C.wave, NGW = C.G * 8;
    const bf16_t* OF = (const bf16_t*)C.out; const bf16_t* OB = (const bf16_t*)(C.ws + WS_OB); const bf16_t* YB = (const bf16_t*)(C.ws + WS_YB);
    const bf16_t* RZ = (const bf16_t*)(C.ws + WS_RZ); const bf16_t* XC = (const bf16_t*)(C.ws + WS_XC); bf16_t* YX = (bf16_t*)(C.ws + WS_YX);
    for (int l = gw; l < T_LAT; l += NGW) {
        const f32x4 gn = *(const f32x4*)(C.in[I_GNORM] + C.lane * 4);
        for (int h = 0; h < 4; ++h) {
            const int c0 = h * 256 + C.lane * 4;
            const u16x4 a = *(const u16x4*)(OF + (size_t)l * 2048 + c0), b = *(const u16x4*)(OB + (size_t)l * 1024 + c0), r = *(const u16x4*)(RZ + (size_t)l * 2048 + c0);
            float o[4], ss = 0.f;
#pragma unroll
            for (int j = 0; j < 4; ++j) { o[j] = bf2f(a[j]) + bf2f(b[j]); ss += o[j] * o[j]; }
            const float rs = rsqrtf(wave_sum(ss) * (1.f / 256.f) + EPS);
            u32x2 w; w.x = pk2(o[0] * rs * gn.x * bf2f(r[0]), o[1] * rs * gn.y * bf2f(r[1])); w.y = pk2(o[2] * rs * gn.z * bf2f(r[2]), o[3] * rs * gn.w * bf2f(r[3]));
            *(u32x2*)(YX + (size_t)l * 2048 + c0) = w;
        }
        for (int g = 0; g < 2; ++g) {
            const int c0 = g * 512 + C.lane * 8, head = c0 >> 6;
            const u16x8 a = *(const u16x8*)(OF + (size_t)l * 2048 + 1024 + c0), b = *(const u16x8*)(YB + (size_t)l * 1024 + c0), z = *(const u16x8*)(RZ + (size_t)l * 2048 + 1024 + c0),
                        xs = *(const u16x8*)(XC + (size_t)(l + T_CTX) * 1536 + c0);
            const float dsk = C.in[I_SSDD][head];
            float y[8], ss = 0.f;
#pragma unroll
            for (int j = 0; j < 8; ++j) { y[j] = (bf2f(a[j]) + bf2f(b[j]) + bf2f(xs[j]) * dsk) * bf2f(z[j]); ss += y[j] * y[j]; }
            const float rs = rsqrtf(wave_sum(ss) * (1.f / 512.f) + EPS);
            const float* nw = C.in[I_SSDN] + c0;
            u32x4 w; w.x = pk2(y[0] * rs * nw[0], y[1] * rs * nw[1]); w.y = pk2(y[2] * rs * nw[2], y[3] * rs * nw[3]); w.z = pk2(y[4] * rs * nw[4], y[5] * rs * nw[5]); w.w = pk2(y[6] * rs * nw[6], y[7] * rs * nw[7]);
            *(u32x4*)(YX + (size_t)l * 2048 + 1024 + c0) = w;
        }
    }
}

__device__ __forceinline__ void phase6(Ctx& C) {
    {
        float* scr = (float*)C.lds + 16384 + C.wave * (64 * 33);
        const int gw = C.bid * 8 + C.wave, NGW = C.G * 8;
        bf16_t* WdT = (bf16_t*)(C.ws + WS_WDT);
        for (int it = gw; it < 32 * 768; it += NGW) {
            const int e = it / 768, r = it % 768;
            if (r < 512) { const int up = r >> 8, q = r & 255, kb = q >> 4, nb = q & 15;
                const float* src = C.in[up ? I_EWU : I_EWG] + (size_t)e * 1024 * 512 + (size_t)(kb * 64) * 512 + nb * 32;
                bf16_t* dst = wgu_ptr(C.ws, e) + (size_t)(256 * (nb >> 2) + (nb & 3) * 32 + up * 128) * 1024 + kb * 64;
                transpose_tile(src, 512, dst, 1024, scr, C.lane, false); }
            else { const int q = r - 512, kb = q >> 5, nb = q & 31;
                transpose_tile(C.in[I_EWD] + (size_t)e * 512 * 1024 + (size_t)(kb * 64) * 1024 + nb * 32, 1024, WdT + (size_t)e * 1024 * 512 + (size_t)(nb * 32) * 512 + kb * 64, 512, scr, C.lane, false); }
        }
    }
    __syncthreads();
    const bf16_t* YX = (const bf16_t*)(C.ws + WS_YX); const bf16_t* WoutT = (const bf16_t*)(C.ws + WS_WOUTT);
    const float* MOD = (const float*)(C.ws + WS_MOD); const float* X = C.in[I_X]; float* HL = C.out;
    auto bsel = [=](int, int tn, int& ldb) { ldb = 2048; return WoutT + (size_t)tn * 128 * 2048; };
    auto epi = [=](int row, int tn, int cc, float v, float) { const int col = tn * 128 + cc, b = row >> 12;
        HL[(size_t)row * 1024 + col] = X[(size_t)row * 1024 + col] + MOD[b * 6144 + 2048 + col] * v; };
#if PG8_MASK & 2
    (void)bsel; (void)epi;
    SchedOut S{(const char*)YX, (const char*)WoutT, C.G, C.bid}; EpiOut E{X, MOD, HL};
    pg8::gemm_phase<EpiOut, SchedOut, false, true>((lds_ptr_t)C.lds, 2048, S, E);
#else
    gemm_simple<false>(C, YX, 2048, T_LAT / 128, 1024 / 128, 2048, bsel, epi);
#endif
}

__device__ __forceinline__ void phase7(Ctx& C) {
    const int gw = C.bid * 8 + C.wave, NGW = C.G * 8;
    const float* MOD = (const float*)(C.ws + WS_MOD); const float* HL = C.out; bf16_t* XN2 = (bf16_t*)(C.ws + WS_XN2);
    int* PE = (int*)(C.ws + WS_PAIR); int* PP = PE + 32768; float* PW = (float*)(PP + 32768);
    unsigned* cnt = (unsigned*)(C.ws + WS_CTL) + CW_CNT;
    const float* wg = C.in[I_RGW]; const float* we = C.in[I_REW];
    float* tw = (float*)C.lds + C.wave * 1024;
    const int oe = C.lane & 31, kh = C.lane >> 5, og = C.lane & 3, kp = C.lane >> 2;
    for (int l = gw; l < T_LAT; l += NGW) {
        const int b = l >> 12;
        f32x4 v[4]; float ss = 0.f;
#pragma unroll
        for (int j = 0; j < 4; ++j) { v[j] = *(const f32x4*)(HL + (size_t)l * DM + j * 256 + C.lane * 4); ss += v[j].x * v[j].x + v[j].y * v[j].y + v[j].z * v[j].z + v[j].w * v[j].w; }
        const float rs = rsqrtf(wave_sum(ss) * (1.f / DM) + EPS);
#pragma unroll
        for (int j = 0; j < 4; ++j) { const int c0 = j * 256 + C.lane * 4;
            const f32x4 g = *(const f32x4*)(C.in[I_NFFN] + c0), sh = *(const f32x4*)(MOD + b * 6144 + 3072 + c0), scl = *(const f32x4*)(MOD + b * 6144 + 4096 + c0);
            const f32x4 t = v[j] * rs * g * (1.f + scl) + sh;
            u32x2 o; o.x = pk2(t.x, t.y); o.y = pk2(t.z, t.w); *(u32x2*)(XN2 + (size_t)l * DM + c0) = o;
            *(f32x4*)(tw + c0) = t; }
        asm volatile("s_waitcnt lgkmcnt(0)" ::: "memory");
        float ae = 0.f, ag = 0.f;
        { const float* wp = we + (size_t)(kh * 512) * 32 + oe; const float* tp = tw + kh * 512;
#pragma unroll 8
            for (int k = 0; k < 512; ++k) ae += tp[k] * wp[(size_t)k * 32]; }
        { const float* wp = wg + (size_t)(kp * 64) * 4 + og; const float* tp = tw + kp * 64;
#pragma unroll 8
            for (int k = 0; k < 64; ++k) ag += tp[k] * wp[k * 4]; }
        ae += __shfl_xor(ae, 32);
        ag += __shfl_xor(ag, 4); ag += __shfl_xor(ag, 8); ag += __shfl_xor(ag, 16); ag += __shfl_xor(ag, 32);
        asm volatile("" ::: "memory");
        float gl[4]; int gs = 0; float gm = -3.4e38f;
#pragma unroll
        for (int o = 0; o < 4; ++o) { gl[o] = __shfl(ag, o) + C.in[I_RGB][o]; if (gl[o] > gm) { gm = gl[o]; gs = o; } }
        float den = 0.f;
#pragma unroll
        for (int o = 0; o < 4; ++o) den += __expf(gl[o] - gm);
        const float pg = 1.f / den;
        int i1 = 0, i2 = 0; float v1 = -3.4e38f, v2 = -3.4e38f;
#pragma unroll
        for (int o = 0; o < 8; ++o) { const float e = __shfl(ae, gs * 8 + o) + C.in[I_REB][gs * 8 + o];
            if (e > v1) { v2 = v1; i2 = i1; v1 = e; i1 = o; } else if (e > v2) { v2 = e; i2 = o; } }
        if (C.lane == 0) {
            const float e2 = __expf(v2 - v1), w1 = pg / (1.f + e2), w2 = pg * e2 / (1.f + e2);
            const int ex1 = gs * 8 + i1, ex2 = gs * 8 + i2;
            const unsigned p1 = atomicAdd(cnt + ex1, 1u), p2 = atomicAdd(cnt + ex2, 1u);
            PE[l * 2] = ex1; PE[l * 2 + 1] = ex2; PP[l * 2] = (int)p1; PP[l * 2 + 1] = (int)p2; PW[l * 2] = w1; PW[l * 2 + 1] = w2;
        }
    }
}

__device__ __forceinline__ void moe_offsets(Ctx& C, int* off) {
    if (C.tid == 0) { const unsigned* cnt = (const unsigned*)(C.ws + WS_CTL) + CW_CNT; int o = 0;
        for (int e = 0; e < 32; ++e) { off[e] = o; o += (int)((__hip_atomic_load(cnt + e, __ATOMIC_RELAXED, __HIP_MEMORY_SCOPE_AGENT) + 255u) & ~255u); } off[32] = o; }
    __syncthreads();
}


__device__ __forceinline__ void moe_tile_table(Ctx& C, const int* off, int* tile_e) {
    const int NT = off[32] >> 8;
    for (int t = C.tid; t < NT; t += NTHREADS) { int e = 0; for (int i = 1; i < 32; ++i) if (off[i] <= t * 256) e = i; tile_e[t] = e; }
    __syncthreads();
}
__device__ __forceinline__ void phase8(Ctx& C) {
    int* off = (int*)C.lds; moe_offsets(C, off);
    const int gw = C.bid * 8 + C.wave, NGW = C.G * 8;
    const int* PE = (const int*)(C.ws + WS_PAIR); const int* PP = PE + 32768; const float* PW = (const float*)(PP + 32768); int* SL = (int*)(PW + 32768); float* SW = (float*)(SL + 32768);
    const bf16_t* XN2 = (const bf16_t*)(C.ws + WS_XN2); bf16_t* XS = (bf16_t*)(C.ws + WS_XN2S);
    for (int p = gw; p < 32768; p += NGW) {
        const int slot = off[PE[p]] + PP[p];
        if (C.lane == 0) { SL[p] = slot; SW[slot] = PW[p]; }
        const u32x4* s = (const u32x4*)(XN2 + (size_t)(p >> 1) * DM); u32x4* d = (u32x4*)(XS + (size_t)slot * DM);
        d[C.lane] = s[C.lane]; d[C.lane + 64] = s[C.lane + 64];
    }
}

__device__ __forceinline__ void phase9(Ctx& C) {
    int* off = (int*)(C.lds + 131072 + 1024); moe_offsets(C, off);
    const bf16_t* XS = (const bf16_t*)(C.ws + WS_XN2S); bf16_t* H = (bf16_t*)(C.ws + WS_H); unsigned char* ws = C.ws;
    auto bsel = [=](int tm, int tn, int& ldb) { int e = 0; const int r0 = tm * 128;
        for (int i = 1; i < 32; ++i) if (off[i] <= r0) e = i;
        ldb = 1024; return (const bf16_t*)wgu_ptr(ws, e) + (size_t)tn * 256 * 1024; };
    auto epi = [=](int row, int tn, int cc, float g, float u) { H[(size_t)row * 512 + tn * 128 + cc] = (bf16_t)f2bf(siluf(g) * u); };
#if PG8_MASK & 4
    (void)bsel; (void)epi;
    int* tile_e = off + 64; moe_tile_table(C, off, tile_e);
    SchedMoe S{(const char*)XS, C.ws, tile_e, off[32] >> 8, C.G, C.bid, 1024, 0}; EpiUp E{H};
    pg8::gemm_phase<EpiUp, SchedMoe, true, true>((lds_ptr_t)C.lds, 1024, S, E);
#else
    gemm_simple<true>(C, XS, 1024, off[32] / 128, 4, 1024, bsel, epi);
#endif
}

__device__ __forceinline__ void phase10(Ctx& C) {
    int* off = (int*)(C.lds + 131072 + 1024); moe_offsets(C, off);
    const bf16_t* H = (const bf16_t*)(C.ws + WS_H); bf16_t* Y = (bf16_t*)(C.ws + WS_Y); const bf16_t* WdT = (const bf16_t*)(C.ws + WS_WDT);
    const float* SW = (const float*)(C.ws + WS_PAIR) + 4 * 32768;
    auto bsel = [=](int tm, int tn, int& ldb) { int e = 0; const int r0 = tm * 128;
        for (int i = 1; i < 32; ++i) if (off[i] <= r0) e = i;
        ldb = 512; return WdT + (size_t)e * 1024 * 512 + (size_t)tn * 128 * 512; };
    auto epi = [=](int row, int tn, int cc, float v, float) { Y[(size_t)row * 1024 + tn * 128 + cc] = (bf16_t)f2bf(v * SW[row]); };
#if PG8_MASK & 8
    (void)bsel; (void)epi;
    int* tile_e = off + 64; moe_tile_table(C, off, tile_e);
    SchedMoe S{(const char*)H, C.ws, tile_e, off[32] >> 8, C.G, C.bid, 512, 1}; EpiDown E{Y, SW};
    pg8::gemm_phase<EpiDown, SchedMoe, true, true>((lds_ptr_t)C.lds, 512, S, E);
#else
    gemm_simple<false>(C, H, 512, off[32] / 128, 8, 512, bsel, epi);
#endif
}

__device__ __forceinline__ void phase11(Ctx& C) {
    const int gw = C.bid * 8 + C.wave, NGW = C.G * 8;
    const float* MOD = (const float*)(C.ws + WS_MOD); float* HL = C.out; const bf16_t* Y = (const bf16_t*)(C.ws + WS_Y);
    const int* SL = (const int*)(C.ws + WS_PAIR) + 3 * 32768;
    for (int l = gw; l < T_LAT; l += NGW) {
        const int b = l >> 12, s1 = SL[l * 2], s2 = SL[l * 2 + 1];
        f32x4 v[4]; float ss = 0.f;
#pragma unroll
        for (int j = 0; j < 4; ++j) { const int c0 = j * 256 + C.lane * 4;
            const f32x4 hv = *(const f32x4*)(HL + (size_t)l * DM + c0), g2 = *(const f32x4*)(MOD + b * 6144 + 5120 + c0);
            const u16x4 a = *(const u16x4*)(Y + (size_t)s1 * DM + c0), bb = *(const u16x4*)(Y + (size_t)s2 * DM + c0);
            f32x4 m; m.x = bf2f(a[0]) + bf2f(bb[0]); m.y = bf2f(a[1]) + bf2f(bb[1]); m.z = bf2f(a[2]) + bf2f(bb[2]); m.w = bf2f(a[3]) + bf2f(bb[3]);
            v[j] = hv + g2 * m; ss += v[j].x * v[j].x + v[j].y * v[j].y + v[j].z * v[j].z + v[j].w * v[j].w; }
        const float rs = rsqrtf(wave_sum(ss) * (1.f / DM) + EPS);
#pragma unroll
        for (int j = 0; j < 4; ++j) { const int c0 = j * 256 + C.lane * 4; const f32x4 fn = *(const f32x4*)(C.in[I_FNORM] + c0);
            *(f32x4*)(HL + (size_t)l * DM + c0) = v[j] * rs * fn; }
    }
}

__global__ void __launch_bounds__(NTHREADS, 2) fwd_kernel(Args a) {
    extern __shared__ __attribute__((aligned(16))) unsigned char lds[];
    Ctx C;
#pragma unroll
    for (int i = 0; i < 27; ++i) C.in[i] = a.in[i];
    C.out = a.out; C.ws = a.ws; C.lds = lds;
    C.tid = threadIdx.x; C.lane = C.tid & 63; C.wave = __builtin_amdgcn_readfirstlane(C.tid >> 6); C.bid = blockIdx.x; C.G = gridDim.x;
#if MK_COOP
    cg::grid_group grid = cg::this_grid();
#define SEAM(k) do { if ((k) + 1 < a.ph_hi) grid.sync(); } while (0)
#else
#define SEAM(k) do { } while (0)
#endif
#define IN(k) (a.ph_lo <= (k) && (k) < a.ph_hi)
    if (IN(0)) { phase0(C); SEAM(0); }
    if (IN(1)) { phase1(C); SEAM(1); }
    if (IN(2)) { phase2(C); SEAM(2); }
    if (IN(3)) { phase3(C); SEAM(3); }
    if (IN(4)) { phase4_naive(C); SEAM(4); }
    if (IN(5)) { phase5(C); SEAM(5); }
    if (IN(6)) { phase6(C); SEAM(6); }
    if (IN(7)) { phase7(C); SEAM(7); }
    if (IN(8)) { phase8(C); SEAM(8); }
    if (IN(9)) { phase9(C); SEAM(9); }
    if (IN(10)) { phase10(C); SEAM(10); }
    if (IN(11)) { phase11(C); }
}

extern "C" void kernel_launch(void* const* d_in, const int* in_sizes, int n_in, void* d_out, int out_size, void* d_ws, size_t ws_size, hipStream_t stream) {
    static int grid = 0;
    if (grid == 0) {
        if (n_in != 27 || out_size != T_LAT * DM || ws_size < WS_END) { fprintf(stderr, "kernel_launch: unexpected shapes: n_in %d out %d ws %zu (need %zu)\n", n_in, out_size, ws_size, (size_t)WS_END); grid = -1; return; }
        int dev = 0, cus = 0, per_cu = 0;
        hipGetDevice(&dev); hipDeviceGetAttribute(&cus, hipDeviceAttributeMultiprocessorCount, dev);
        hipFuncSetAttribute((const void*)fwd_kernel, hipFuncAttributeMaxDynamicSharedMemorySize, LDS_BYTES);
        hipOccupancyMaxActiveBlocksPerMultiprocessor(&per_cu, (const void*)fwd_kernel, NTHREADS, LDS_BYTES);
        if (per_cu < 1) { fprintf(stderr, "kernel_launch: occupancy query says %d blocks per CU\n", per_cu); per_cu = 1; }
        (void)hipGetLastError();
        grid = cus;
        fprintf(stderr, "kernel_launch: grid %d, per_cu %d, ws %zu\n", grid, per_cu, ws_size);
    }
    if (grid < 0) return;
    hipMemsetAsync((char*)d_ws + WS_CTL, 0, CTL_BYTES, stream);
    Args a{};
    for (int i = 0; i < 27; ++i) a.in[i] = (const float*)d_in[i];
    a.out = (float*)d_out; a.ws = (unsigned char*)d_ws;
#if MK_COOP
    a.ph_lo = 0; a.ph_hi = NPH;
    void* args[] = {&a};
    hipError_t e = hipLaunchCooperativeKernel((const void*)fwd_kernel, dim3(grid), dim3(NTHREADS), args, LDS_BYTES, stream);
    if (e != hipSuccess) fprintf(stderr, "cooperative launch failed: %s (grid %d)\n", hipGetErrorString(e), grid);
#else
    for (int p = 0; p < NPH; ++p) { a.ph_lo = p; a.ph_hi = p + 1; hipLaunchKernelGGL(fwd_kernel, dim3(grid), dim3(NTHREADS), LDS_BYTES, stream, a); }
#endif
}
```

```cpp
#include <hip/hip_runtime.h>
#include <hip/hip_cooperative_groups.h>
#include <cstdio>
#include <cstdint>
namespace cg = cooperative_groups;

#ifndef MK_COOP
#define MK_COOP 1
#endif

constexpr int NB = 4, SEQ = 4096, DM = 1024, CTXL = 256;
constexpr int T_CTX = NB * CTXL, T_LAT = NB * SEQ, T_ALL = T_CTX + T_LAT;
constexpr float EPS = 1e-6f;
constexpr int NW_IN = 5888;
constexpr int NPH = 12;
constexpr int NTHREADS = 512;
constexpr int LDS_BYTES = 147456;

typedef unsigned short bf16_t;
typedef float f32x4 __attribute__((ext_vector_type(4)));
typedef unsigned u32x4 __attribute__((ext_vector_type(4)));
typedef unsigned u32x2 __attribute__((ext_vector_type(2)));
typedef unsigned short u16x8 __attribute__((ext_vector_type(8)));
typedef unsigned short u16x4 __attribute__((ext_vector_type(4)));

constexpr size_t MiB = 1u << 20;
constexpr size_t WS_QK = 0;
constexpr size_t WS_XBC = 34 * MiB;
constexpr size_t WS_OB = 34 * MiB;
constexpr size_t WS_QKF = 85 * MiB;
constexpr size_t WS_XN = 85 * MiB;
constexpr size_t WS_YX = 85 * MiB;
constexpr size_t WS_V = 119 * MiB;
constexpr size_t WS_XC = 153 * MiB;
constexpr size_t WS_WINT = 153 * MiB;
constexpr size_t WS_RZ = 204 * MiB;
constexpr size_t WS_XN2 = 204 * MiB;
constexpr size_t WS_YB = 268 * MiB;
constexpr size_t WS_GDT = 300 * MiB;
constexpr size_t WS_WOUTT = 305 * MiB;
constexpr size_t WS_MOD = 309 * MiB;
constexpr size_t WS_GLAD = WS_MOD + 256 * 1024;
constexpr size_t WS_CTL = 311 * MiB;
constexpr size_t CTL_BYTES = 64 * 1024;
constexpr size_t WS_PAIR = 312 * MiB;
constexpr size_t WS_END = 313 * MiB;
constexpr size_t WS_WDT = 0;
constexpr size_t WS_WGU_LO = 34 * MiB;
constexpr size_t WS_WGU_HI = 268 * MiB;
constexpr size_t WS_H = 66 * MiB;
constexpr size_t WS_XN2S = 106 * MiB;
constexpr size_t WS_Y = 106 * MiB;
constexpr int MAX_SLOTS = 40960;
constexpr int CW_CNT = 0;

__device__ __forceinline__ float bf2f(bf16_t v) { return __uint_as_float((unsigned)v << 16); }
__device__ __forceinline__ unsigned f2bf(float f) { unsigned u = __float_as_uint(f); return (u + 0x7fffu + ((u >> 16) & 1u)) >> 16; }
__device__ __forceinline__ unsigned pk2(float lo, float hi) { return f2bf(lo) | (f2bf(hi) << 16); }
__device__ __forceinline__ float siluf(float x) { return x / (1.f + __expf(-x)); }
__device__ __forceinline__ float softplusf(float x) { return fmaxf(x, 0.f) + log1pf(__expf(-fabsf(x))); }
__device__ __forceinline__ float logsigf(float x) { return fminf(x, 0.f) - log1pf(__expf(-fabsf(x))); }
__device__ __forceinline__ float wave_sum(float v) {
#pragma unroll
    for (int o = 1; o < 64; o <<= 1) v += __shfl_xor(v, o);
    return v;
}

struct Args { const float* in[27]; float* out; unsigned char* ws; int ph_lo, ph_hi; };
enum { I_X = 0, I_C, I_CTX, I_CCTX, I_WADA, I_BADA, I_NMIX, I_NFFN, I_WIN, I_GWUP, I_GB, I_GNORM, I_CONVW, I_CONVB, I_DTB, I_ALOG, I_SSDD, I_SSDN,
       I_WOUT, I_RGW, I_RGB, I_REW, I_REB, I_EWG, I_EWU, I_EWD, I_FNORM };

struct Ctx {
    const float* in[27]; float* out; unsigned char* ws; unsigned char* lds;
    int tid, lane, wave, bid, G;
};

__device__ __forceinline__ void transpose_tile(const float* src  , int ldw, bf16_t* dst  , int ldt, float* scr, int lane, bool zero) {
#pragma unroll 8
    for (int i = 0; i < 32; ++i) { const int kk = 2 * i + (lane >> 5); scr[kk * 33 + (lane & 31)] = zero ? 0.f : src[(size_t)kk * ldw + (lane & 31)]; }
    asm volatile("s_waitcnt lgkmcnt(0)" ::: "memory");
    const int c = lane & 7;
#pragma unroll
    for (int j = 0; j < 4; ++j) { const int n = (lane >> 3) + 8 * j; const float* s = scr + (8 * c) * 33 + n;
        u32x4 o; o.x = pk2(s[0 * 33], s[1 * 33]); o.y = pk2(s[2 * 33], s[3 * 33]); o.z = pk2(s[4 * 33], s[5 * 33]); o.w = pk2(s[6 * 33], s[7 * 33]);
        *(u32x4*)(dst + (size_t)n * ldt + 8 * c) = o; }
    asm volatile("s_waitcnt lgkmcnt(0)" ::: "memory");
}

__device__ __forceinline__ int win_src_col(int n) {
    if (n < 3072) return n;
    if (n < 4096) return 3104 + (n - 3072);
    if (n < 5632) return 4128 + (n - 4096);
    if (n < 5664) return 3072 + (n - 5632);
    if (n < 5696) return 5664 + (n - 5664);
    return -1;
}

__device__ __forceinline__ void phase0(Ctx& C) {
    float* lds = (float*)C.lds;
    const int gw = C.bid * 8 + C.wave, NGW = C.G * 8;
    {
        float* scr = lds + 8192 + C.wave * (64 * 33);
        bf16_t* WinT = (bf16_t*)(C.ws + WS_WINT); bf16_t* WoutT = (bf16_t*)(C.ws + WS_WOUTT);
        constexpr int IT_IN = 16 * (NW_IN / 32), IT_OUT = 32 * 32;
        for (int it = gw; it < IT_IN + IT_OUT; it += NGW) {
            if (it < IT_IN) { const int kb = it / (NW_IN / 32), nb = it % (NW_IN / 32); const int sc = win_src_col(nb * 32);
                transpose_tile(C.in[I_WIN] + (size_t)(kb * 64) * 5696 + (sc < 0 ? 0 : sc), 5696, WinT + (size_t)(nb * 32) * 1024 + kb * 64, 1024, scr, C.lane, sc < 0); }
            else { const int r = it - IT_IN, kb = r / 32, nb = r % 32;
                transpose_tile(C.in[I_WOUT] + (size_t)(kb * 64) * 1024 + nb * 32, 1024, WoutT + (size_t)(nb * 32) * 2048 + kb * 64, 2048, scr, C.lane, false); }
        }
    }
    __syncthreads();
    float* sc = lds;
    float* red = lds + 5120;
    for (int i = C.tid; i < 5 * 1024; i += NTHREADS) { const int r = i >> 10, k = i & 1023; const float v = r < 4 ? C.in[I_C][r * 1024 + k] : C.in[I_CCTX][k]; sc[i] = siluf(v); }
    __syncthreads();
    float* MOD = (float*)(C.ws + WS_MOD);
    for (int grp = C.bid; grp < 192; grp += C.G) {
        const int col = grp * 32 + (C.tid & 31), kg = C.tid >> 5;
        float acc[5] = {0.f, 0.f, 0.f, 0.f, 0.f};
        for (int k = kg; k < 1024; k += 16) { const float w = C.in[I_WADA][(size_t)k * 6144 + col];
#pragma unroll
            for (int i = 0; i < 5; ++i) acc[i] += sc[i * 1024 + k] * w; }
#pragma unroll
        for (int i = 0; i < 5; ++i) red[(kg * 5 + i) * 32 + (C.tid & 31)] = acc[i];
        __syncthreads();
        if (C.tid < 160) { const int i = C.tid >> 5, c = C.tid & 31; float s = 0.f;
            for (int g = 0; g < 16; ++g) s += red[(g * 5 + i) * 32 + c];
            MOD[i * 6144 + grp * 32 + c] = s + C.in[I_BADA][grp * 32 + c]; }
        __syncthreads();
    }
}

__device__ __forceinline__ const float* tok_row(const Ctx& C, int row, int& mi) {
    if (row < T_CTX) { mi = 4; return C.in[I_CTX] + (size_t)row * DM; }
    mi = (row - T_CTX) >> 12; return C.in[I_X] + (size_t)(row - T_CTX) * DM;
}

__device__ __forceinline__ void phase1(Ctx& C) {
    const int gw = C.bid * 8 + C.wave, NGW = C.G * 8;
    const float* MOD = (const float*)(C.ws + WS_MOD); bf16_t* XN = (bf16_t*)(C.ws + WS_XN);
    for (int row = gw; row < T_ALL; row += NGW) {
        int mi; const float* xr = tok_row(C, row, mi);
        f32x4 v[4]; float ss = 0.f;
#pragma unroll
        for (int j = 0; j < 4; ++j) { v[j] = *(const f32x4*)(xr + j * 256 + C.lane * 4); ss += v[j].x * v[j].x + v[j].y * v[j].y + v[j].z * v[j].z + v[j].w * v[j].w; }
        const float rs = rsqrtf(wave_sum(ss) * (1.f / DM) + EPS);
#pragma unroll
        for (int j = 0; j < 4; ++j) { const int c0 = j * 256 + C.lane * 4;
            const f32x4 g = *(const f32x4*)(C.in[I_NMIX] + c0), sh = *(const f32x4*)(MOD + mi * 6144 + c0), scl = *(const f32x4*)(MOD + mi * 6144 + 1024 + c0);
            const f32x4 y = v[j] * rs * g * (1.f + scl) + sh;
            u32x2 o; o.x = pk2(y.x, y.y); o.y = pk2(y.z, y.w); *(u32x2*)(XN + (size_t)row * DM + c0) = o; }
    }
}

template <bool DUAL, class BSel, class Epi>
__device__ __forceinline__ void gemm_simple(Ctx& C, const bf16_t* A, int lda, int Mtiles, int Ntiles, int K, BSel bsel, Epi epi) {
    float* As = (float*)C.lds;
    float* Bs = As + 32 * 132;
    float* Bs2 = Bs + 32 * 132;
    const int ty = C.tid >> 4, tx = C.tid & 15;
    const int lr = C.tid >> 2, lk = (C.tid & 3) * 8;
    for (int tile = C.bid; tile < Mtiles * Ntiles; tile += C.G) {
        const int tm = tile / Ntiles, tn = tile % Ntiles;
        int ldb; const bf16_t* Bt = bsel(tm, tn, ldb);
        float acc[4][8], acc2[DUAL ? 4 : 1][8];
#pragma unroll
        for (int i = 0; i < 4; ++i)
#pragma unroll
            for (int j = 0; j < 8; ++j) { acc[i][j] = 0.f; if constexpr (DUAL) acc2[i][j] = 0.f; }
        const bf16_t* ap = A + (size_t)(tm * 128 + lr) * lda + lk;
        const bf16_t* bp = Bt + (size_t)lr * ldb + lk;
        for (int k0 = 0; k0 < K; k0 += 32) {
            const u16x8 av = *(const u16x8*)(ap + k0), bv = *(const u16x8*)(bp + k0);
            u16x8 bv2 = bv; if constexpr (DUAL) bv2 = *(const u16x8*)(bp + (size_t)128 * ldb + k0);
            __syncthreads();
#pragma unroll
            for (int j = 0; j < 8; ++j) { As[(lk + j) * 132 + lr] = bf2f(av[j]); Bs[(lk + j) * 132 + lr] = bf2f(bv[j]); if constexpr (DUAL) Bs2[(lk + j) * 132 + lr] = bf2f(bv2[j]); }
            __syncthreads();
#pragma unroll 8
            for (int k = 0; k < 32; ++k) {
                const f32x4 a = *(const f32x4*)(As + k * 132 + ty * 4);
                const f32x4 b0 = *(const f32x4*)(Bs + k * 132 + tx * 8), b1 = *(const f32x4*)(Bs + k * 132 + tx * 8 + 4);
                const float af[4] = {a.x, a.y, a.z, a.w}; const float bf[8] = {b0.x, b0.y, b0.z, b0.w, b1.x, b1.y, b1.z, b1.w};
#pragma unroll
                for (int i = 0; i < 4; ++i)
#pragma unroll
                    for (int j = 0; j < 8; ++j) acc[i][j] += af[i] * bf[j];
                if constexpr (DUAL) {
                    const f32x4 c0 = *(const f32x4*)(Bs2 + k * 132 + tx * 8), c1 = *(const f32x4*)(Bs2 + k * 132 + tx * 8 + 4);
                    const float cf[8] = {c0.x, c0.y, c0.z, c0.w, c1.x, c1.y, c1.z, c1.w};
#pragma unroll
                    for (int i = 0; i < 4; ++i)
#pragma unroll
                        for (int j = 0; j < 8; ++j) acc2[i][j] += af[i] * cf[j];
                }
            }
        }
#pragma unroll
        for (int i = 0; i < 4; ++i)
#pragma unroll
            for (int j = 0; j < 8; ++j) { float a2 = 0.f; if constexpr (DUAL) a2 = acc2[i][j]; epi(tm * 128 + ty * 4 + i, tn, tx * 8 + j, acc[i][j], a2); }
        __syncthreads();
    }
}


namespace pg8 {
#define PG8_LAS __attribute__((address_space(3)))
typedef short bf16x8 __attribute__((ext_vector_type(8)));
constexpr int BM = 256, BK = 64, HALF = 128, HTB = HALF * BK * 2  , STAGE_BYTES = 8 * HTB, NXCD = 8, WGM = 8;
__host__ __device__ __forceinline__ int lds_byte(int r, int c) { const int st = (r >> 4) * 2 + (c >> 5), rr = r & 15, cc = c & 31, ob = rr * 64 + cc * 2; return st * 1024 + (ob ^ (((ob >> 9) & 1) << 5)); }
__host__ __device__ __forceinline__ void stage_rc(int b, int& R, int& C) { const int st = b / 1024, sb = b % 1024, swz = sb ^ (((sb >> 9) & 1) << 5); R = (st >> 1) * 16 + swz / 64; C = (st & 1) * 32 + (swz % 64) / 2; }
__host__ __device__ __forceinline__ int perm32(int rho) { const int n = rho >> 4, i = rho & 15; return 8 * (i >> 2) + 4 * n + (i & 3); }
struct Unit { int pm, pn; };
__device__ __forceinline__ unsigned cvt_pk_bf16(float lo, float hi) { unsigned r; asm volatile("v_cvt_pk_bf16_f32 %0, %1, %2" : "=v"(r) : "v"(lo), "v"(hi)); return r; }
__device__ __forceinline__ int xcd_remap(int L, int nwg) { const int q = nwg / NXCD, r = nwg % NXCD, xcd = L % NXCD, off = L / NXCD; return (xcd < r ? xcd * (q + 1) : r * (q + 1) + (xcd - r) * q) + off; }
template <class Epi, class Sched, bool ALIGN_EPI = false, bool SP2 = false>
__device__ __forceinline__ void gemm_phase(PG8_LAS unsigned char* lds, const int K_, const Sched& S, const Epi& E) {
    const int tid = threadIdx.x, wid = __builtin_amdgcn_readfirstlane(tid >> 6), lane = tid & 63, wr = wid >> 2, wc = wid & 3, fr = lane & 15, fq = lane >> 4;
    const int K = K_, nt = K / BK;
    unsigned voffA[2], voffB[2];
#pragma unroll
    for (int i = 0; i < 2; ++i) { int R, C; stage_rc(tid * 16 + i * 8192, R, C); const int Rb = Epi::PERM ? ((R & ~31) + perm32(R & 31)) : R;
        voffA[i] = (unsigned)(R * K + C) * 2u; voffB[i] = (unsigned)(Rb * K + C) * 2u; }
    const size_t kstep = (size_t)(BK * 2);
    const size_t hstep = (size_t)HALF * K * 2;
    const unsigned ldsw = (unsigned)wid * 1024u;
    const int aoff = lds_byte(wr * 64 + fr, fq * 8), boff = lds_byte(wc * 32 + fr, fq * 8);
#define PG8_SA(b, h) (((b) * 2 + (h)) * HTB)
#define PG8_SB(b, h) ((4 + (b) * 2 + (h)) * HTB)
#define PG8_STAGE(bufoff, gbase, voff) do { _Pragma("unroll") for (int _i = 0; _i < 2; ++_i) \
        __builtin_amdgcn_global_load_lds((const unsigned*)((const char*)(gbase) + (voff)[_i]), (PG8_LAS unsigned*)(lds + (bufoff) + ldsw + _i * 8192), 16, 0, 0); } while (0)
#define PG8_LDA(dst, b, h) do { _Pragma("unroll") for (int m = 0; m < 4; ++m) _Pragma("unroll") for (int k = 0; k < 2; ++k) dst[m][k] = *(const PG8_LAS bf16x8*)(lds + PG8_SA(b, h) + aoff + m * 2048 + k * 1024); } while (0)
#define PG8_LDB(dst, b, h) do { _Pragma("unroll") for (int n = 0; n < 2; ++n) _Pragma("unroll") for (int k = 0; k < 2; ++k) dst[n][k] = *(const PG8_LAS bf16x8*)(lds + PG8_SB(b, h) + boff + n * 2048 + k * 1024); } while (0)
#define PG8_MMA(ai, bj, At, Bt) do { __builtin_amdgcn_s_setprio(1); _Pragma("unroll") for (int m = 0; m < 4; ++m) _Pragma("unroll") for (int n = 0; n < 2; ++n) _Pragma("unroll") for (int k = 0; k < 2; ++k) \
        acc[ai][bj][m][n] = __builtin_amdgcn_mfma_f32_16x16x32_bf16(Bt[n][k], At[m][k], acc[ai][bj][m][n], 0, 0, 0); __builtin_amdgcn_s_setprio(0); } while (0)
#define PG8_WAIT_V(n) asm volatile("s_waitcnt vmcnt(" #n ")" ::: "memory")
#define PG8_WAIT_L(n) asm volatile("s_waitcnt lgkmcnt(" #n ")" ::: "memory")
#define PG8_BAR __builtin_amdgcn_s_barrier()
#define PG8_SCHED __builtin_amdgcn_sched_barrier(0)
    Unit cur, nxt; int ui = 0;
    if (!S.next(0, cur)) return;
    f32x4 acc[2][2][4][2];
#pragma unroll
    for (int a = 0; a < 2; ++a)
#pragma unroll
        for (int b = 0; b < 2; ++b)
#pragma unroll
            for (int m = 0; m < 4; ++m)
#pragma unroll
                for (int n = 0; n < 2; ++n) acc[a][b][m][n] = (f32x4){0.f, 0.f, 0.f, 0.f};
    bf16x8 At[4][2], B0[2][2], B1[2][2];
    const char* cA = S.a_ptr(cur); const char* cB = S.b_ptr(cur);
    S.a_ready(cur);
    if constexpr (SP2) {
        PG8_STAGE(PG8_SB(0, 0), cB, voffB); PG8_STAGE(PG8_SB(0, 1), cB + hstep, voffB); PG8_STAGE(PG8_SA(0, 0), cA, voffA); PG8_STAGE(PG8_SA(0, 1), cA + hstep, voffA);
        if (wr == 1) PG8_BAR;
        PG8_WAIT_V(2); PG8_BAR;
        PG8_STAGE(PG8_SB(1, 0), cB + kstep, voffB); PG8_STAGE(PG8_SA(1, 0), cA + kstep, voffA); PG8_STAGE(PG8_SB(1, 1), cB + hstep + kstep, voffB);
        PG8_WAIT_V(6); PG8_BAR;
    } else {
        PG8_STAGE(PG8_SB(0, 0), cB, voffB); PG8_STAGE(PG8_SA(0, 0), cA, voffA); PG8_STAGE(PG8_SB(0, 1), cB + hstep, voffB); PG8_STAGE(PG8_SA(0, 1), cA + hstep, voffA);
        if (wr == 1) PG8_BAR;
        PG8_WAIT_V(4); PG8_BAR;
        PG8_STAGE(PG8_SB(1, 0), cB + kstep, voffB); PG8_STAGE(PG8_SA(1, 0), cA + kstep, voffA); PG8_STAGE(PG8_SB(1, 1), cB + hstep + kstep, voffB);
        PG8_WAIT_V(6); PG8_BAR;
    }
    for (;;) {
        const bool has_next = S.next(ui + 1, nxt);
        const char* nA = has_next ? S.a_ptr(nxt) : cA; const char* nB = has_next ? S.b_ptr(nxt) : cB;
        for (int t = 0; t < nt; t += 2) {
            const bool last = (t == nt - 2);
            const char* a1 = cA + (size_t)(t + 1) * kstep;
            const char* a2 = last ? nA : cA + (size_t)(t + 2) * kstep; const char* b2 = last ? nB : cB + (size_t)(t + 2) * kstep;
            const char* a3 = a2 + kstep; const char* b3 = b2 + kstep;
            if (last && has_next) S.a_ready(nxt);
            if constexpr (SP2) {
            PG8_LDB(B0, 0, 0); PG8_LDB(B1, 0, 1); PG8_SCHED; PG8_LDA(At, 0, 0); PG8_STAGE(PG8_SA(1, 1), a1 + hstep, voffA);
            PG8_WAIT_V(8); PG8_WAIT_L(0); PG8_BAR; PG8_MMA(0, 0, At, B0); PG8_MMA(0, 1, At, B1); PG8_BAR; PG8_SCHED;
            PG8_LDA(At, 0, 1); PG8_STAGE(PG8_SB(0, 0), b2, voffB); PG8_STAGE(PG8_SB(0, 1), b2 + hstep, voffB); PG8_STAGE(PG8_SA(0, 0), a2, voffA);
            PG8_WAIT_V(8); PG8_WAIT_L(0); PG8_BAR; PG8_MMA(1, 0, At, B0); PG8_MMA(1, 1, At, B1); PG8_BAR; PG8_SCHED;
            PG8_LDB(B0, 1, 0); PG8_LDB(B1, 1, 1); PG8_SCHED; PG8_LDA(At, 1, 0); PG8_STAGE(PG8_SA(0, 1), a2 + hstep, voffA);
            PG8_WAIT_V(8); PG8_WAIT_L(0); PG8_BAR; PG8_MMA(0, 0, At, B0); PG8_MMA(0, 1, At, B1); PG8_BAR; PG8_SCHED;
            PG8_LDA(At, 1, 1); PG8_STAGE(PG8_SB(1, 0), b3, voffB); PG8_STAGE(PG8_SB(1, 1), b3 + hstep, voffB); PG8_STAGE(PG8_SA(1, 0), a3, voffA);
            PG8_WAIT_V(8); PG8_WAIT_L(0); PG8_BAR; PG8_MMA(1, 0, At, B0); PG8_MMA(1, 1, At, B1); PG8_BAR; PG8_SCHED;
            } else {
            PG8_LDB(B0, 0, 0); PG8_SCHED; PG8_LDA(At, 0, 0); PG8_STAGE(PG8_SA(1, 1), a1 + hstep, voffA);
            PG8_WAIT_L(8); PG8_BAR; PG8_WAIT_L(0); PG8_MMA(0, 0, At, B0); PG8_BAR; PG8_SCHED;
            PG8_LDB(B1, 0, 1); PG8_STAGE(PG8_SB(0, 0), b2, voffB);
            PG8_BAR; PG8_WAIT_L(0); PG8_MMA(0, 1, At, B1); PG8_BAR;
            PG8_LDA(At, 0, 1); PG8_STAGE(PG8_SA(0, 0), a2, voffA);
            PG8_BAR; PG8_WAIT_L(0); PG8_MMA(1, 0, At, B0); PG8_BAR; PG8_SCHED;
            PG8_STAGE(PG8_SB(0, 1), b2 + hstep, voffB);
            PG8_WAIT_V(6); PG8_BAR; PG8_MMA(1, 1, At, B1); PG8_BAR;
            PG8_LDB(B0, 1, 0); PG8_SCHED; PG8_LDA(At, 1, 0); PG8_STAGE(PG8_SA(0, 1), a2 + hstep, voffA);
            PG8_WAIT_L(8); PG8_BAR; PG8_WAIT_L(0); PG8_MMA(0, 0, At, B0); PG8_BAR; PG8_SCHED;
            PG8_LDB(B1, 1, 1); PG8_STAGE(PG8_SB(1, 0), b3, voffB);
            PG8_BAR; PG8_WAIT_L(0); PG8_MMA(0, 1, At, B1); PG8_BAR;
            PG8_LDA(At, 1, 1); PG8_STAGE(PG8_SA(1, 0), a3, voffA);
            PG8_BAR; PG8_WAIT_L(0); PG8_MMA(1, 0, At, B0); PG8_BAR; PG8_SCHED;
            PG8_STAGE(PG8_SB(1, 1), b3 + hstep, voffB);
            PG8_WAIT_V(6); PG8_BAR; PG8_MMA(1, 1, At, B1); PG8_BAR;
            }
        }
        if constexpr (ALIGN_EPI) { if (wr == 0) PG8_BAR; }
        if constexpr (!Epi::AFTER_DRAIN) { E(acc, cur, wr, wc, fr, fq); S.done(cur); }
        if (!has_next) break;
#pragma unroll
        for (int a = 0; a < 2; ++a)
#pragma unroll
            for (int b = 0; b < 2; ++b)
#pragma unroll
                for (int m = 0; m < 4; ++m)
#pragma unroll
                    for (int n = 0; n < 2; ++n) acc[a][b][m][n] = (f32x4){0.f, 0.f, 0.f, 0.f};
        cur = nxt; cA = nA; cB = nB; ++ui;
        if constexpr (ALIGN_EPI) { if (wr == 1) PG8_BAR; }
    }
    PG8_WAIT_V(0);
    if constexpr (!ALIGN_EPI) { if (wr == 0) PG8_BAR; }
    PG8_BAR;
    if constexpr (Epi::AFTER_DRAIN) { E.fused(acc, cur, wr, wc, fr, fq, lds, wid, lane); S.done(cur); }
#undef PG8_SA
#undef PG8_SB
#undef PG8_STAGE
#undef PG8_LDA
#undef PG8_LDB
#undef PG8_MMA
#undef PG8_WAIT_V
#undef PG8_WAIT_L
#undef PG8_BAR
#undef PG8_SCHED
}
}

__device__ __forceinline__ bf16_t* wgu_ptr(unsigned char* ws, int e) { return (bf16_t*)(ws + (e < 16 ? WS_WGU_LO : WS_WGU_HI)) + (size_t)(e & 15) * 1024 * 1024; }

#ifndef PG8_MASK
#define PG8_MASK 15
#endif
typedef __attribute__((address_space(3))) unsigned char* lds_ptr_t;

struct SchedIn {
    const char* A; const char* Bt; int G, c;
    __device__ __forceinline__ bool next(int i, pg8::Unit& u) const {
        const int L0 = i * G + c; if (L0 >= 1532) return false;
        const int L = pg8::xcd_remap(L0, 1532);
        if (L < 60) { const int pi = L >> 2; u.pm = L & 3; u.pn = pi < 8 ? pi : pi + 8; }
        else { const int l2 = L - 60, g = l2 / 184, r = l2 % 184; u.pn = r >> 3; u.pm = 4 + 8 * g + (r & 7); }
        return true;
    }
    __device__ __forceinline__ const char* a_ptr(const pg8::Unit& u) const { return A + (size_t)u.pm * (256 * 1024 * 2); }
    __device__ __forceinline__ const char* b_ptr(const pg8::Unit& u) const { return Bt + (size_t)u.pn * (256 * 1024 * 2); }
    __device__ __forceinline__ void a_ready(const pg8::Unit&) const {}
    __device__ __forceinline__ void done(const pg8::Unit&) const {}
};
struct SchedOut {
    const char* A; const char* Bt; int G, c;
    __device__ __forceinline__ bool next(int i, pg8::Unit& u) const {
        const int L0 = i * G + c; if (L0 >= 256) return false;
        const int w = pg8::xcd_remap(L0, 256), gid = w >> 5, r = w & 31;
        u.pm = gid * 8 + (r & 7); u.pn = r >> 3;
        return true;
    }
    __device__ __forceinline__ const char* a_ptr(const pg8::Unit& u) const { return A + (size_t)u.pm * (256 * 2048 * 2); }
    __device__ __forceinline__ const char* b_ptr(const pg8::Unit& u) const { return Bt + (size_t)u.pn * (256 * 2048 * 2); }
    __device__ __forceinline__ void a_ready(const pg8::Unit&) const {}
    __device__ __forceinline__ void done(const pg8::Unit&) const {}
};
struct SchedMoe {
    const char* A; unsigned char* ws; const int* tile_e; int NT, G, c, K, down;
    __device__ __forceinline__ bool next(int i, pg8::Unit& u) const {
        const int nwg = NT * 4; const int L0 = i * G + c; if (L0 >= nwg) return false;
        const int w = pg8::xcd_remap(L0, nwg);
        u.pm = w >> 2; u.pn = w & 3;
        return true;
    }
    __device__ __forceinline__ const char* a_ptr(const pg8::Unit& u) const { return A + (size_t)u.pm * 256 * K * 2; }
    __device__ __forceinline__ const char* b_ptr(const pg8::Unit& u) const {
        const int e = __builtin_amdgcn_readfirstlane(tile_e[u.pm]);
        return down ? (const char*)(ws + WS_WDT) + ((size_t)e * 1024 * 512 + (size_t)u.pn * 256 * 512) * 2
                    : (const char*)wgu_ptr(ws, e) + (size_t)u.pn * 256 * 1024 * 2;
    }
    __device__ __forceinline__ void a_ready(const pg8::Unit&) const {}
    __device__ __forceinline__ void done(const pg8::Unit&) const {}
};

struct EpiIn {
    static constexpr bool PERM = true, AFTER_DRAIN = false;
    unsigned char* ws;
    __device__ __forceinline__ void operator()(const f32x4 (&acc)[2][2][4][2], const pg8::Unit& u, int wr, int wc, int fr, int fq) const {
        const int pn = u.pn; const int row0 = u.pm * 256 + wr * 64 + fr; const int ct = wc * 32 + 8 * fq;
        if (pn == 22) {
            if (wc < 2) { float* GDT = (float*)(ws + WS_GDT);
#pragma unroll
                for (int ai = 0; ai < 2; ++ai)
#pragma unroll
                    for (int m = 0; m < 4; ++m) { float* p = GDT + (size_t)(row0 + ai * 128 + m * 16) * 64 + ct; *(f32x4*)p = acc[ai][0][m][0]; *(f32x4*)(p + 4) = acc[ai][0][m][1]; } }
            return;
        }
        bf16_t* base; int ld; int roff = 0; bool act = false;
        if (pn < 4) { base = (bf16_t*)(ws + WS_QK) + pn * 256; ld = 1024; }
        else if (pn < 8) { base = (bf16_t*)(ws + WS_V) + (pn - 4) * 256; ld = 1024; }
        else if (pn < 16) { base = (bf16_t*)(ws + WS_RZ) + (pn - 8) * 256; ld = 2048; roff = T_CTX; act = true; }
        else { base = (bf16_t*)(ws + WS_XBC) + (pn - 16) * 256; ld = 1536; }
#pragma unroll
        for (int ai = 0; ai < 2; ++ai)
#pragma unroll
            for (int m = 0; m < 4; ++m) { bf16_t* rowp = base + (size_t)(row0 - roff + ai * 128 + m * 16) * ld + ct;
#pragma unroll
                for (int bj = 0; bj < 2; ++bj) { f32x4 v0 = acc[ai][bj][m][0], v1 = acc[ai][bj][m][1];
                    if (act) { v0.x = siluf(v0.x); v0.y = siluf(v0.y); v0.z = siluf(v0.z); v0.w = siluf(v0.w); v1.x = siluf(v1.x); v1.y = siluf(v1.y); v1.z = siluf(v1.z); v1.w = siluf(v1.w); }
                    u32x4 w; w.x = pg8::cvt_pk_bf16(v0.x, v0.y); w.y = pg8::cvt_pk_bf16(v0.z, v0.w); w.z = pg8::cvt_pk_bf16(v1.x, v1.y); w.w = pg8::cvt_pk_bf16(v1.z, v1.w);
                    *(u32x4*)(rowp + bj * 128) = w; } }
    }
};
struct EpiOut {
    static constexpr bool PERM = false, AFTER_DRAIN = false;
    const float* X; const float* MOD; float* HL;
    __device__ __forceinline__ void operator()(const f32x4 (&acc)[2][2][4][2], const pg8::Unit& u, int wr, int wc, int fr, int fq) const {
        const int b = u.pm >> 4; const int col0 = u.pn * 256 + wc * 32 + 4 * fq;
        f32x4 g1[2][2];
#pragma unroll
        for (int bj = 0; bj < 2; ++bj)
#pragma unroll
            for (int n = 0; n < 2; ++n) g1[bj][n] = *(const f32x4*)(MOD + b * 6144 + 2048 + col0 + bj * 128 + n * 16);
#pragma unroll
        for (int ai = 0; ai < 2; ++ai)
#pragma unroll
            for (int m = 0; m < 4; ++m) { const size_t off = (size_t)(u.pm * 256 + ai * 128 + wr * 64 + m * 16 + fr) * 1024 + col0;
#pragma unroll
                for (int bj = 0; bj < 2; ++bj)
#pragma unroll
                    for (int n = 0; n < 2; ++n) { const f32x4 xv = *(const f32x4*)(X + off + bj * 128 + n * 16); *(f32x4*)(HL + off + bj * 128 + n * 16) = xv + g1[bj][n] * acc[ai][bj][m][n]; }
                if (m & 1) asm volatile("" ::: "memory"); }
    }
};
struct EpiUp {
    static constexpr bool PERM = true, AFTER_DRAIN = false;
    bf16_t* H;
    __device__ __forceinline__ void operator()(const f32x4 (&acc)[2][2][4][2], const pg8::Unit& u, int wr, int wc, int fr, int fq) const {
        const int row0 = u.pm * 256 + wr * 64 + fr; const int col = u.pn * 128 + wc * 32 + 8 * fq;
#pragma unroll
        for (int ai = 0; ai < 2; ++ai)
#pragma unroll
            for (int m = 0; m < 4; ++m) { const f32x4 g0 = acc[ai][0][m][0], g1 = acc[ai][0][m][1], u0 = acc[ai][1][m][0], u1 = acc[ai][1][m][1];
                u32x4 w; w.x = pg8::cvt_pk_bf16(siluf(g0.x) * u0.x, siluf(g0.y) * u0.y); w.y = pg8::cvt_pk_bf16(siluf(g0.z) * u0.z, siluf(g0.w) * u0.w);
                w.z = pg8::cvt_pk_bf16(siluf(g1.x) * u1.x, siluf(g1.y) * u1.y); w.w = pg8::cvt_pk_bf16(siluf(g1.z) * u1.z, siluf(g1.w) * u1.w);
                *(u32x4*)(H + (size_t)(row0 + ai * 128 + m * 16) * 512 + col) = w; }
    }
};
struct EpiDown {
    static constexpr bool PERM = true, AFTER_DRAIN = false;
    bf16_t* Y; const float* SW;
    __device__ __forceinline__ void operator()(const f32x4 (&acc)[2][2][4][2], const pg8::Unit& u, int wr, int wc, int fr, int fq) const {
        const int row0 = u.pm * 256 + wr * 64 + fr; const int col = u.pn * 256 + wc * 32 + 8 * fq;
#pragma unroll
        for (int ai = 0; ai < 2; ++ai)
#pragma unroll
            for (int m = 0; m < 4; ++m) { const int row = row0 + ai * 128 + m * 16; const float sw = SW[row];
#pragma unroll
                for (int bj = 0; bj < 2; ++bj) { const f32x4 v0 = acc[ai][bj][m][0] * sw, v1 = acc[ai][bj][m][1] * sw;
                    u32x4 w; w.x = pg8::cvt_pk_bf16(v0.x, v0.y); w.y = pg8::cvt_pk_bf16(v0.z, v0.w); w.z = pg8::cvt_pk_bf16(v1.x, v1.y); w.w = pg8::cvt_pk_bf16(v1.z, v1.w);
                    *(u32x4*)(Y + (size_t)row * 1024 + col + bj * 128) = w; } }
    }
};

__device__ __forceinline__ void phase2(Ctx& C) {
    const bf16_t* XN = (const bf16_t*)(C.ws + WS_XN); const bf16_t* WinT = (const bf16_t*)(C.ws + WS_WINT);
    bf16_t* QK = (bf16_t*)(C.ws + WS_QK); bf16_t* V = (bf16_t*)(C.ws + WS_V); bf16_t* RZ = (bf16_t*)(C.ws + WS_RZ); bf16_t* XBC = (bf16_t*)(C.ws + WS_XBC);
    float* GDT = (float*)(C.ws + WS_GDT);
    auto bsel = [=](int, int tn, int& ldb) { ldb = 1024; return WinT + (size_t)tn * 128 * 1024; };
    auto epi = [=](int row, int tn, int cc, float v, float) {
        const int col = tn * 128 + cc;
        if (col < 1024) QK[(size_t)row * 1024 + col] = (bf16_t)f2bf(v);
        else if (col < 2048) V[(size_t)row * 1024 + col - 1024] = (bf16_t)f2bf(v);
        else if (col < 4096) { if (row >= T_CTX) RZ[(size_t)(row - T_CTX) * 2048 + col - 2048] = (bf16_t)f2bf(siluf(v)); }
        else if (col < 5632) XBC[(size_t)row * 1536 + col - 4096] = (bf16_t)f2bf(v);
        else if (col < 5696) GDT[(size_t)row * 64 + col - 5632] = v;
    };
#if PG8_MASK & 1
    (void)bsel; (void)epi;
    SchedIn S{(const char*)XN, (const char*)WinT, C.G, C.bid}; EpiIn E{C.ws};
    pg8::gemm_phase<EpiIn, SchedIn, true, true>((lds_ptr_t)C.lds, 1024, S, E);
#else
    gemm_simple<false>(C, XN, 1024, T_ALL / 128, NW_IN / 128, 1024, bsel, epi);
#endif
}

__device__ __forceinline__ void phase3(Ctx& C) {
    float* lds = (float*)C.lds;
    {
        float* gs = lds;
        float* tot = lds + 2048;
        bf16_t* QK = (bf16_t*)(C.ws + WS_QK); bf16_t* QKF = (bf16_t*)(C.ws + WS_QKF);
        const float* GDT = (const float*)(C.ws + WS_GDT); float* GLAD = (float*)(C.ws + WS_GLAD);
        const int c = C.tid & 127, tg = C.tid >> 7;
        for (int item = C.bid; item < 272 * 4; item += C.G) {
            const int rc = item >> 2, h = item & 3, row0 = rc * 64;
            __syncthreads();
            for (int i = C.tid; i < 64 * 32; i += NTHREADS) gs[i] = GDT[(size_t)(row0 + (i >> 5)) * 64 + (i & 31)];
            float wf[16], wb[16];
#pragma unroll
            for (int r = 0; r < 16; ++r) { wf[r] = C.in[I_GWUP][r * 512 + h * 128 + c]; wb[r] = C.in[I_GWUP][(16 + r) * 512 + h * 128 + c]; }
            const float bfv = C.in[I_GB][h * 128 + c], bbv = C.in[I_GB][512 + h * 128 + c];
            __syncthreads();
            float pf[16], pb[16];
#pragma unroll
            for (int tt = 0; tt < 16; ++tt) { const float* g = gs + (tg * 16 + tt) * 32; float sf = bfv, sb = bbv;
#pragma unroll
                for (int r = 0; r < 16; ++r) { sf += g[r] * wf[r]; sb += g[16 + r] * wb[r]; }
                pf[tt] = logsigf(sf) * (1.f / 16.f); pb[tt] = logsigf(sb) * (1.f / 16.f); }
#pragma unroll
            for (int tt = 1; tt < 16; ++tt) pf[tt] += pf[tt - 1];
#pragma unroll
            for (int tt = 14; tt >= 0; --tt) pb[tt] += pb[tt + 1];
            tot[(0 * 4 + tg) * 128 + c] = pf[15]; tot[(1 * 4 + tg) * 128 + c] = pb[0];
            __syncthreads();
            float offf = 0.f, offb = 0.f, totf = 0.f, totb = 0.f;
#pragma unroll
            for (int g = 0; g < 4; ++g) { const float a = tot[(0 * 4 + g) * 128 + c], b = tot[(1 * 4 + g) * 128 + c]; if (g < tg) offf += a; if (g > tg) offb += b; totf += a; totb += b; }
            if (tg == 0) { GLAD[((size_t)(rc * 4 + h) * 2 + 0) * 128 + c] = __expf(totf); GLAD[((size_t)(rc * 4 + h) * 2 + 1) * 128 + c] = __expf(totb); }
            const float qscale = 0.08838834764831845f;
#pragma unroll
            for (int tt = 0; tt < 16; ++tt) { const size_t ro = (size_t)(row0 + tg * 16 + tt) * 1024;
                const float q = bf2f(QK[ro + h * 128 + c]) * qscale, k = bf2f(QK[ro + 512 + h * 128 + c]);
                const float ef = pf[tt] + offf, eb = pb[tt] + offb;
                QKF[ro + h * 128 + c] = (bf16_t)f2bf(q * __expf(ef)); QKF[ro + 512 + h * 128 + c] = (bf16_t)f2bf(k * __expf(-ef));
                QK[ro + h * 128 + c] = (bf16_t)f2bf(q * __expf(eb)); QK[ro + 512 + h * 128 + c] = (bf16_t)f2bf(k * __expf(-eb)); }
        }
    }
    {
        const bf16_t* XBC = (const bf16_t*)(C.ws + WS_XBC); bf16_t* XC = (bf16_t*)(C.ws + WS_XC);
        const float* cw = C.in[I_CONVW]; const float* cb = C.in[I_CONVB];
        const long total = (long)T_ALL * 192;
        for (long it = (long)C.bid * NTHREADS + C.tid; it < total; it += (long)C.G * NTHREADS) {
            const int row = (int)(it / 192), c0 = (int)(it % 192) * 8;
            float acc[8];
#pragma unroll
            for (int j = 0; j < 8; ++j) acc[j] = cb[c0 + j];
            int base, y, x, H, W;
            if (row < T_CTX) { base = row & ~255; y = 0; x = row & 255; H = 1; W = 256; }
            else { const int l = row - T_CTX; base = T_CTX + (l & ~4095); const int t = l & 4095; y = t >> 6; x = t & 63; H = 64; W = 64; }
            for (int i = 0; i < 3; ++i) { const int yy = y + i - 1; if (yy < 0 || yy >= H) continue;
                for (int jx = 0; jx < 3; ++jx) { const int xx = x + jx - 1; if (xx < 0 || xx >= W) continue;
                    const u16x8 v = *(const u16x8*)(XBC + (size_t)(base + yy * W + xx) * 1536 + c0);
                    const float* w = cw + (size_t)(i * 3 + jx) * 1536 + c0;
#pragma unroll
                    for (int j = 0; j < 8; ++j) acc[j] += bf2f(v[j]) * w[j]; } }
            u32x4 o; o.x = pk2(siluf(acc[0]), siluf(acc[1])); o.y = pk2(siluf(acc[2]), siluf(acc[3])); o.z = pk2(siluf(acc[4]), siluf(acc[5])); o.w = pk2(siluf(acc[6]), siluf(acc[7]));
            *(u32x4*)(XC + (size_t)row * 1536 + c0) = o;
        }
    }
}

__device__ __forceinline__ int scan_row(int b, int dir, int s) {
    if (s < CTXL) return b * CTXL + (dir ? CTXL - 1 - s : s);
    const int t = s - CTXL; return T_CTX + b * SEQ + (dir ? SEQ - 1 - t : t);
}

__device__ __forceinline__ void phase4_naive(Ctx& C) {
    bf16_t* OF = (bf16_t*)C.out;
    bf16_t* OB = (bf16_t*)(C.ws + WS_OB);
    bf16_t* YB = (bf16_t*)(C.ws + WS_YB);
    const bf16_t* V = (const bf16_t*)(C.ws + WS_V); const bf16_t* XC = (const bf16_t*)(C.ws + WS_XC);
    const float* GDT = (const float*)(C.ws + WS_GDT); const float* GLAD = (const float*)(C.ws + WS_GLAD);
    for (int gt = C.bid * NTHREADS + C.tid; gt < 65536; gt += C.G * NTHREADS) {
        if (gt < 32768) {
            const int chain = gt >> 10, rem = gt & 1023, dv = rem >> 2, dq = rem & 3;
            const int b = chain >> 3, h = (chain >> 1) & 3, dir = chain & 1;
            const bf16_t* QKp = (const bf16_t*)(C.ws + (dir ? WS_QK : WS_QKF));
            float S[32];
#pragma unroll
            for (int i = 0; i < 32; ++i) S[i] = 0.f;
            for (int s = 0; s < CTXL + SEQ; ++s) {
                const int row = scan_row(b, dir, s);
                const float v = bf2f(V[(size_t)row * 1024 + h * 256 + dv]);
                const bf16_t* qp = QKp + (size_t)row * 1024 + h * 128 + dq * 32;
                float o = 0.f;
#pragma unroll
                for (int i8 = 0; i8 < 4; ++i8) { const u16x8 kv = *(const u16x8*)(qp + 512 + i8 * 8), qv = *(const u16x8*)(qp + i8 * 8);
#pragma unroll
                    for (int j = 0; j < 8; ++j) { S[i8 * 8 + j] += bf2f(kv[j]) * v; o += bf2f(qv[j]) * S[i8 * 8 + j]; } }
                o += __shfl_xor(o, 1); o += __shfl_xor(o, 2);
                if (row >= T_CTX && dq == 0) { const size_t l = row - T_CTX; if (dir) OB[l * 1024 + h * 256 + dv] = (bf16_t)f2bf(o); else OF[l * 2048 + h * 256 + dv] = (bf16_t)f2bf(o); }
                if ((s & 63) == 63) { const float* d = GLAD + ((size_t)((row >> 6) * 4 + h) * 2 + dir) * 128 + dq * 32;
#pragma unroll
                    for (int i = 0; i < 32; ++i) S[i] *= d[i]; }
            }
        } else {
            const int g2 = gt - 32768, chain = g2 >> 8, rem = g2 & 255, p = rem >> 2, nq = rem & 3;
            const int b = chain >> 5, head = (chain >> 1) & 15, dir = chain & 1, grp = head >> 3;
            const float Aneg = -__expf(C.in[I_ALOG][dir * 16 + head]), dtb = C.in[I_DTB][dir * 16 + head];
            float S[32];
#pragma unroll
            for (int i = 0; i < 32; ++i) S[i] = 0.f;
            for (int s = 0; s < CTXL + SEQ; ++s) {
                const int row = scan_row(b, dir, s);
                const float dt = softplusf(GDT[(size_t)row * 64 + 32 + dir * 16 + head] + dtb), a = __expf(dt * Aneg);
                const float xd = bf2f(XC[(size_t)row * 1536 + head * 64 + p]) * dt;
                const bf16_t* bp = XC + (size_t)row * 1536 + 1024 + grp * 128 + nq * 32;
                float y = 0.f;
#pragma unroll
                for (int i8 = 0; i8 < 4; ++i8) { const u16x8 bv = *(const u16x8*)(bp + i8 * 8), cv = *(const u16x8*)(bp + 256 + i8 * 8);
#pragma unroll
                    for (int j = 0; j < 8; ++j) { S[i8 * 8 + j] = a * S[i8 * 8 + j] + xd * bf2f(bv[j]); y += S[i8 * 8 + j] * bf2f(cv[j]); } }
                y += __shfl_xor(y, 1); y += __shfl_xor(y, 2);
                if (row >= T_CTX && nq == 0) { const size_t l = row - T_CTX; if (dir) YB[l * 1024 + head * 64 + p] = (bf16_t)f2bf(y); else OF[l * 2048 + 1024 + head * 64 + p] = (bf16_t)f2bf(y); }
            }
        }
    }
}


typedef short bf16x8 __attribute__((ext_vector_type(8)));
typedef short s16x4 __attribute__((ext_vector_type(4)));
typedef __attribute__((address_space(3))) s16x4* lds_s16x4_p;
#define LASQ __attribute__((address_space(3)))
__device__ __forceinline__ bf16x8 lds_row_frag(lds_ptr_t L, int off, int rs, int r0, int kb, int c, int g) {
    return *(const LASQ bf16x8*)(L + off + (r0 + c) * rs + kb + g * 16);
}
__device__ __forceinline__ bf16x8 lds_tr_frag(lds_ptr_t L, int off, int rs, int k0, int n0, int g, int q, int p) {
    const s16x4 lo = __builtin_amdgcn_ds_read_tr16_b64_v4i16((lds_s16x4_p)(L + off + (k0 + 8 * g + q) * rs + (n0 + 4 * p) * 2));
    const s16x4 hi = __builtin_amdgcn_ds_read_tr16_b64_v4i16((lds_s16x4_p)(L + off + (k0 + 8 * g + 4 + q) * rs + (n0 + 4 * p) * 2));
    bf16x8 r; r[0] = lo[0]; r[1] = lo[1]; r[2] = lo[2]; r[3] = lo[3]; r[4] = hi[0]; r[5] = hi[1]; r[6] = hi[2]; r[7] = hi[3]; return r;
}
template <bool GLA>
__device__ __forceinline__ void scan_unit(Ctx& C, int uid) {
    lds_ptr_t L = (lds_ptr_t)C.lds;
    constexpr int QS_OFF = 0, KS_OFF = 17408, VS_OFF = 34816, PS_OFF = 44032, ST_OFF = 53248, SC_OFF = 70656;
    LASQ float* acum = (LASQ float*)(L + SC_OFF); LASQ float* dtj = acum + 64; LASQ float* ei = acum + 128; LASQ float* uj = acum + 192; LASQ float* Dv = acum + 256;
    const int tid = C.tid, w = C.wave, l = C.lane, g = l >> 4, c = l & 15, q = c >> 2, p = c & 3;
    int b, dir, ldqk, ldv, ldo; const bf16_t *Qg, *Kg, *Vg; bf16_t* Og; const float* Dg = nullptr; const float* dtg = nullptr; float Aneg = 0.f, dtb = 0.f;
    if (GLA) { b = uid >> 5; const int h = (uid >> 3) & 3; dir = (uid >> 2) & 1; const int sl = uid & 3;
        const bf16_t* QKp = (const bf16_t*)(C.ws + (dir ? WS_QK : WS_QKF));
        Qg = QKp + h * 128; Kg = QKp + 512 + h * 128; ldqk = 1024; Vg = (const bf16_t*)(C.ws + WS_V) + h * 256 + sl * 64; ldv = 1024;
        Og = dir ? (bf16_t*)(C.ws + WS_OB) + h * 256 + sl * 64 : (bf16_t*)C.out + h * 256 + sl * 64; ldo = dir ? 1024 : 2048;
        Dg = (const float*)(C.ws + WS_GLAD) + (h * 2 + dir) * 128;
    } else { b = uid >> 5; const int head = (uid >> 1) & 15; dir = uid & 1; const int grp = head >> 3;
        const bf16_t* XC = (const bf16_t*)(C.ws + WS_XC);
        Qg = XC + 1280 + grp * 128; Kg = XC + 1024 + grp * 128; ldqk = 1536; Vg = XC + head * 64; ldv = 1536;
        Og = dir ? (bf16_t*)(C.ws + WS_YB) + head * 64 : (bf16_t*)C.out + 1024 + head * 64; ldo = dir ? 1024 : 2048;
        Aneg = -__expf(C.in[I_ALOG][dir * 16 + head]); dtb = C.in[I_DTB][dir * 16 + head];
        dtg = (const float*)(C.ws + WS_GDT) + 32 + dir * 16 + head;
    }
    f32x4 S[4];
#pragma unroll
    for (int t = 0; t < 4; ++t) S[t] = (f32x4){0.f, 0.f, 0.f, 0.f};
    u32x4 pq0, pq1, pk0, pk1, pv; float ps = 0.f;
    auto chunk_rc = [&](int n) { return n < 4 ? 4 * b + (dir ? 3 - n : n) : 16 + 64 * b + (dir ? 67 - n : n - 4); };
    auto prefetch = [&](int n) {
        const int rc = chunk_rc(n), row0 = rc * 64;
        const bf16_t* qp = Qg + (size_t)(row0 + (tid >> 4)) * ldqk + (tid & 15) * 8; const bf16_t* kp = Kg + (size_t)(row0 + (tid >> 4)) * ldqk + (tid & 15) * 8;
        pq0 = *(const u32x4*)qp; pq1 = *(const u32x4*)(qp + (size_t)32 * ldqk); pk0 = *(const u32x4*)kp; pk1 = *(const u32x4*)(kp + (size_t)32 * ldqk);
        pv = *(const u32x4*)(Vg + (size_t)(row0 + (tid >> 3)) * ldv + (tid & 7) * 8);
        if (GLA) { if (tid < 128) ps = Dg[(size_t)rc * 1024 + tid]; }
        else { if (tid < 64) ps = dtg[(size_t)(row0 + tid) * 64]; }
    };
    prefetch(0);
    for (int n = 0; n < 68; ++n) {
        const int rc = chunk_rc(n); const bool lat = n >= 4;
        *(LASQ u32x4*)(L + QS_OFF + (tid >> 4) * 272 + (tid & 15) * 16) = pq0; *(LASQ u32x4*)(L + QS_OFF + ((tid >> 4) + 32) * 272 + (tid & 15) * 16) = pq1;
        *(LASQ u32x4*)(L + KS_OFF + (tid >> 4) * 272 + (tid & 15) * 16) = pk0; *(LASQ u32x4*)(L + KS_OFF + ((tid >> 4) + 32) * 272 + (tid & 15) * 16) = pk1;
        *(LASQ u32x4*)(L + VS_OFF + (tid >> 3) * 144 + (tid & 7) * 16) = pv;
        if (GLA) { if (tid < 128) Dv[tid] = ps; }
        else if (w == 0) {
            const float dtv = softplusf(ps + dtb); float sa = dtv * Aneg;
#pragma unroll
            for (int o = 1; o < 64; o <<= 1) { const float t = dir ? __shfl_down(sa, o) : __shfl_up(sa, o); if (dir ? (l + o < 64) : (l >= o)) sa += t; }
            const float tot = __shfl(sa, dir ? 0 : 63);
            acum[l] = sa; dtj[l] = dtv; ei[l] = __expf(sa); uj[l] = dtv * __expf(tot - sa); if (l == 0) Dv[0] = __expf(tot);
        }
        if (lat) {
#pragma unroll
            for (int t = 0; t < 4; ++t) { u32x2 o; o.x = pk2(S[t].x, S[t].y); o.y = pk2(S[t].z, S[t].w); *(LASQ u32x2*)(L + ST_OFF + (16 * t + c) * 272 + (16 * w + 4 * g) * 2) = o; }
        }
        if (n + 1 < 68) prefetch(n + 1);
        __syncthreads();
        if (lat) {
            const int tj = w >> 1, ti0 = 2 * (w & 1);
            bf16x8 ka[4];
#pragma unroll
            for (int ks = 0; ks < 4; ++ks) ka[ks] = lds_row_frag(L, KS_OFF, 272, 16 * tj, 64 * ks, c, g);
#pragma unroll
            for (int t2 = 0; t2 < 2; ++t2) { const int ti = ti0 + t2; f32x4 acc = (f32x4){0.f, 0.f, 0.f, 0.f};
#pragma unroll
                for (int ks = 0; ks < 4; ++ks) { const bf16x8 qb = lds_row_frag(L, QS_OFF, 272, 16 * ti, 64 * ks, c, g); acc = __builtin_amdgcn_mfma_f32_16x16x32_bf16(ka[ks], qb, acc, 0, 0, 0); }
                const int i = 16 * ti + c, j0 = 16 * tj + 4 * g; float pvv[4];
                if (GLA) {
#pragma unroll
                    for (int r = 0; r < 4; ++r) { const bool ok = dir ? (j0 + r >= i) : (j0 + r <= i); pvv[r] = ok ? acc[r] : 0.f; }
                } else { const float ai = acum[i]; const f32x4 aj = *(const LASQ f32x4*)(acum + j0), dj = *(const LASQ f32x4*)(dtj + j0);
#pragma unroll
                    for (int r = 0; r < 4; ++r) { const bool ok = dir ? (j0 + r >= i) : (j0 + r <= i); pvv[r] = ok ? acc[r] * __expf(fminf(ai - aj[r], 0.f)) * dj[r] : 0.f; } }
                u32x2 o; o.x = pk2(pvv[0], pvv[1]); o.y = pk2(pvv[2], pvv[3]); *(LASQ u32x2*)(L + PS_OFF + i * 144 + j0 * 2) = o; }
        }
        {
            bf16x8 ka[2];
#pragma unroll
            for (int ks = 0; ks < 2; ++ks) ka[ks] = lds_tr_frag(L, KS_OFF, 272, 32 * ks, 16 * w, g, q, p);
            if (!GLA) {
                const float dtot = Dv[0];
#pragma unroll
                for (int ks = 0; ks < 2; ++ks) { const f32x4 u0 = *(const LASQ f32x4*)(uj + 32 * ks + 8 * g), u1 = *(const LASQ f32x4*)(uj + 32 * ks + 8 * g + 4);
                    const float uu[8] = {u0.x, u0.y, u0.z, u0.w, u1.x, u1.y, u1.z, u1.w};
#pragma unroll
                    for (int e = 0; e < 8; ++e) ka[ks][e] = (short)f2bf(bf2f((bf16_t)ka[ks][e]) * uu[e]); }
#pragma unroll
                for (int t = 0; t < 4; ++t) S[t] = S[t] * dtot;
            }
#pragma unroll
            for (int t = 0; t < 4; ++t)
#pragma unroll
                for (int ks = 0; ks < 2; ++ks) { const bf16x8 vb = lds_tr_frag(L, VS_OFF, 144, 32 * ks, 16 * t, g, q, p); S[t] = __builtin_amdgcn_mfma_f32_16x16x32_bf16(ka[ks], vb, S[t], 0, 0, 0); }
            if (GLA) { const f32x4 d = *(const LASQ f32x4*)(Dv + 16 * w + 4 * g);
#pragma unroll
                for (int t = 0; t < 4; ++t) S[t] = S[t] * d; }
        }
        __syncthreads();
        if (lat) {
            const int tdv = w >> 1, ti0 = 2 * (w & 1);
            bf16x8 va[2], sa[4];
#pragma unroll
            for (int ks = 0; ks < 2; ++ks) va[ks] = lds_tr_frag(L, VS_OFF, 144, 32 * ks, 16 * tdv, g, q, p);
#pragma unroll
            for (int ks = 0; ks < 4; ++ks) sa[ks] = lds_row_frag(L, ST_OFF, 272, 16 * tdv, 64 * ks, c, g);
            const size_t lrow0 = (size_t)(rc * 64 - T_CTX);
#pragma unroll
            for (int t2 = 0; t2 < 2; ++t2) { const int ti = ti0 + t2; f32x4 a1 = (f32x4){0.f, 0.f, 0.f, 0.f}, a2 = (f32x4){0.f, 0.f, 0.f, 0.f};
#pragma unroll
                for (int ks = 0; ks < 2; ++ks) { const bf16x8 pb = lds_row_frag(L, PS_OFF, 144, 16 * ti, 64 * ks, c, g); a1 = __builtin_amdgcn_mfma_f32_16x16x32_bf16(va[ks], pb, a1, 0, 0, 0); }
#pragma unroll
                for (int ks = 0; ks < 4; ++ks) { const bf16x8 qb = lds_row_frag(L, QS_OFF, 272, 16 * ti, 64 * ks, c, g); a2 = __builtin_amdgcn_mfma_f32_16x16x32_bf16(sa[ks], qb, a2, 0, 0, 0); }
                const int i = 16 * ti + c; f32x4 o4;
                if (GLA) o4 = a1 + a2; else o4 = a1 + a2 * ei[i];
                u32x2 o; o.x = pk2(o4.x, o4.y); o.y = pk2(o4.z, o4.w);
                *(u32x2*)(Og + (lrow0 + i) * ldo + 16 * tdv + 4 * g) = o; }
        }
        __syncthreads();
    }
}
__device__ __forceinline__ void phase4(Ctx& C) {
    for (int uid = C.bid; uid < 256; uid += C.G) { if (uid < 128) scan_unit<true>(C, uid); else scan_unit<false>(C, uid - 128); }
}

__device__ __forceinline__ void phase5(Ctx& C) {
    const int gw = C.bid * 8 + C.wave, NGW = C.G * 8;
    const bf16_t* OF = (const bf16_t*)C.out; const bf16_t* OB = (const bf16_t*)(C.ws + WS_OB); const bf16_t* YB = (const bf16_t*)(C.ws + WS_YB);
    const bf16_t* RZ = (const bf16_t*)(C.ws + WS_RZ); const bf16_t* XC = (const bf16_t*)(C.ws + WS_XC); bf16_t* YX = (bf16_t*)(C.ws + WS_YX);
    for (int l = gw; l < T_LAT; l += NGW) {
        const f32x4 gn = *(const f32x4*)(C.in[I_GNORM] + C.lane * 4);
        for (int h = 0; h < 4; ++h) {
            const int c0 = h * 256 + C.lane * 4;
            const u16x4 a = *(const u16x4*)(OF + (size_t)l * 2048 + c0), b = *(const u16x4*)(OB + (size_t)l * 1024 + c0), r = *(const u16x4*)(RZ + (size_t)l * 2048 + c0);
            float o[4], ss = 0.f;
#pragma unroll
            for (int j = 0; j < 4; ++j) { o[j] = bf2f(a[j]) + bf2f(b[j]); ss += o[j] * o[j]; }
            const float rs = rsqrtf(wave_sum(ss) * (1.f / 256.f) + EPS);
            u32x2 w; w.x = pk2(o[0] * rs * gn.x * bf2f(r[0]), o[1] * rs * gn.y * bf2f(r[1])); w.y = pk2(o[2] * rs * gn.z * bf2f(r[2]), o[3] * rs * gn.w * bf2f(r[3]));
            *(u32x2*)(YX + (size_t)l * 2048 + c0) = w;
        }
        for (int g = 0; g < 2; ++g) {
            const int c0 = g * 512 + C.lane * 8, head = c0 >> 6;
            const u16x8 a = *(const u16x8*)(OF + (size_t)l * 2048 + 1024 + c0), b = *(const u16x8*)(YB + (size_t)l * 1024 + c0), z = *(const u16x8*)(RZ + (size_t)l * 2048 + 1024 + c0),
                        xs = *(const u16x8*)(XC + (size_t)(l + T_CTX) * 1536 + c0);
            const float dsk = C.in[I_SSDD][head];
            float y[8], ss = 0.f;
#pragma unroll
            for (int j = 0; j < 8; ++j) { y[j] = (bf2f(a[j]) + bf2f(b[j]) + bf2f(xs[j]) * dsk) * bf2f(z[j]); ss += y[j] * y[j]; }
            const float rs = rsqrtf(wave_sum(ss) * (1.f / 512.f) + EPS);
            const float* nw = C.in[I_SSDN] + c0;
            u32x4 w; w.x = pk2(y[0] * rs * nw[0], y[1] * rs * nw[1]); w.y = pk2(y[2] * rs * nw[2], y[3] * rs * nw[3]); w.z = pk2(y[4] * rs * nw[4], y[5] * rs * nw[5]); w.w = pk2(y[6] * rs * nw[6], y[7] * rs * nw[7]);
            *(u32x4*)(YX + (size_t)l * 2048 + 1024 + c0) = w;
        }
    }
}

__device__ __forceinline__ void phase6(Ctx& C) {
    {
        float* scr = (float*)C.lds + 16384 + C.wave * (64 * 33);
        const int gw = C.bid * 8 + C.wave, NGW = C.G * 8;
        bf16_t* WdT = (bf16_t*)(C.ws + WS_WDT);
        for (int it = gw; it < 32 * 768; it += NGW) {
            const int e = it / 768, r = it % 768;
            if (r < 512) { const int up = r >> 8, q = r & 255, kb = q >> 4, nb = q & 15;
                const float* src = C.in[up ? I_EWU : I_EWG] + (size_t)e * 1024 * 512 + (size_t)(kb * 64) * 512 + nb * 32;
                bf16_t* dst = wgu_ptr(C.ws, e) + (size_t)(256 * (nb >> 2) + (nb & 3) * 32 + up * 128) * 1024 + kb * 64;
                transpose_tile(src, 512, dst, 1024, scr, C.lane, false); }
            else { const int q = r - 512, kb = q >> 5, nb = q & 31;
                transpose_tile(C.in[I_EWD] + (size_t)e * 512 * 1024 + (size_t)(kb * 64) * 1024 + nb * 32, 1024, WdT + (size_t)e * 1024 * 512 + (size_t)(nb * 32) * 512 + kb * 64, 512, scr, C.lane, false); }
        }
    }
    __syncthreads();
    const bf16_t* YX = (const bf16_t*)(C.ws + WS_YX); const bf16_t* WoutT = (const bf16_t*)(C.ws + WS_WOUTT);
    const float* MOD = (const float*)(C.ws + WS_MOD); const float* X = C.in[I_X]; float* HL = C.out;
    auto bsel = [=](int, int tn, int& ldb) { ldb = 2048; return WoutT + (size_t)tn * 128 * 2048; };
    auto epi = [=](int row, int tn, int cc, float v, float) { const int col = tn * 128 + cc, b = row >> 12;
        HL[(size_t)row * 1024 + col] = X[(size_t)row * 1024 + col] + MOD[b * 6144 + 2048 + col] * v; };
#if PG8_MASK & 2
    (void)bsel; (void)epi;
    SchedOut S{(const char*)YX, (const char*)WoutT, C.G, C.bid}; EpiOut E{X, MOD, HL};
    pg8::gemm_phase<EpiOut, SchedOut, false, true>((lds_ptr_t)C.lds, 2048, S, E);
#else
    gemm_simple<false>(C, YX, 2048, T_LAT / 128, 1024 / 128, 2048, bsel, epi);
#endif
}

__device__ __forceinline__ void phase7(Ctx& C) {
    const int gw = C.bid * 8 + C.wave, NGW = C.G * 8;
    const float* MOD = (const float*)(C.ws + WS_MOD); const float* HL = C.out; bf16_t* XN2 = (bf16_t*)(C.ws + WS_XN2);
    int* PE = (int*)(C.ws + WS_PAIR); int* PP = PE + 32768; float* PW = (float*)(PP + 32768);
    unsigned* cnt = (unsigned*)(C.ws + WS_CTL) + CW_CNT;
    const float* wg = C.in[I_RGW]; const float* we = C.in[I_REW];
    float* tw = (float*)C.lds + C.wave * 1024;
    const int oe = C.lane & 31, kh = C.lane >> 5, og = C.lane & 3, kp = C.lane >> 2;
    for (int l = gw; l < T_LAT; l += NGW) {
        const int b = l >> 12;
        f32x4 v[4]; float ss = 0.f;
#pragma unroll
        for (int j = 0; j < 4; ++j) { v[j] = *(const f32x4*)(HL + (size_t)l * DM + j * 256 + C.lane * 4); ss += v[j].x * v[j].x + v[j].y * v[j].y + v[j].z * v[j].z + v[j].w * v[j].w; }
        const float rs = rsqrtf(wave_sum(ss) * (1.f / DM) + EPS);
#pragma unroll
        for (int j = 0; j < 4; ++j) { const int c0 = j * 256 + C.lane * 4;
            const f32x4 g = *(const f32x4*)(C.in[I_NFFN] + c0), sh = *(const f32x4*)(MOD + b * 6144 + 3072 + c0), scl = *(const f32x4*)(MOD + b * 6144 + 4096 + c0);
            const f32x4 t = v[j] * rs * g * (1.f + scl) + sh;
            u32x2 o; o.x = pk2(t.x, t.y); o.y = pk2(t.z, t.w); *(u32x2*)(XN2 + (size_t)l * DM + c0) = o;
            *(f32x4*)(tw + c0) = t; }
        asm volatile("s_waitcnt lgkmcnt(0)" ::: "memory");
        float ae = 0.f, ag = 0.f;
        { const float* wp = we + (size_t)(kh * 512) * 32 + oe; const float* tp = tw + kh * 512;
#pragma unroll 8
            for (int k = 0; k < 512; ++k) ae += tp[k] * wp[(size_t)k * 32]; }
        { const float* wp = wg + (size_t)(kp * 64) * 4 + og; const float* tp = tw + kp * 64;
#pragma unroll 8
            for (int k = 0; k < 64; ++k) ag += tp[k] * wp[k * 4]; }
        ae += __shfl_xor(ae, 32);
        ag += __shfl_xor(ag, 4); ag += __shfl_xor(ag, 8); ag += __shfl_xor(ag, 16); ag += __shfl_xor(ag, 32);
        asm volatile("" ::: "memory");
        float gl[4]; int gs = 0; float gm = -3.4e38f;
#pragma unroll
        for (int o = 0; o < 4; ++o) { gl[o] = __shfl(ag, o) + C.in[I_RGB][o]; if (gl[o] > gm) { gm = gl[o]; gs = o; } }
        float den = 0.f;
#pragma unroll
        for (int o = 0; o < 4; ++o) den += __expf(gl[o] - gm);
        const float pg = 1.f / den;
        int i1 = 0, i2 = 0; float v1 = -3.4e38f, v2 = -3.4e38f;
#pragma unroll
        for (int o = 0; o < 8; ++o) { const float e = __shfl(ae, gs * 8 + o) + C.in[I_REB][gs * 8 + o];
            if (e > v1) { v2 = v1; i2 = i1; v1 = e; i1 = o; } else if (e > v2) { v2 = e; i2 = o; } }
        if (C.lane == 0) {
            const float e2 = __expf(v2 - v1), w1 = pg / (1.f + e2), w2 = pg * e2 / (1.f + e2);
            const int ex1 = gs * 8 + i1, ex2 = gs * 8 + i2;
            const unsigned p1 = atomicAdd(cnt + ex1, 1u), p2 = atomicAdd(cnt + ex2, 1u);
            PE[l * 2] = ex1; PE[l * 2 + 1] = ex2; PP[l * 2] = (int)p1; PP[l * 2 + 1] = (int)p2; PW[l * 2] = w1; PW[l * 2 + 1] = w2;
        }
    }
}

__device__ __forceinline__ void moe_offsets(Ctx& C, int* off) {
    if (C.tid == 0) { const unsigned* cnt = (const unsigned*)(C.ws + WS_CTL) + CW_CNT; int o = 0;
        for (int e = 0; e < 32; ++e) { off[e] = o; o += (int)((__hip_atomic_load(cnt + e, __ATOMIC_RELAXED, __HIP_MEMORY_SCOPE_AGENT) + 255u) & ~255u); } off[32] = o; }
    __syncthreads();
}


__device__ __forceinline__ void moe_tile_table(Ctx& C, const int* off, int* tile_e) {
    const int NT = off[32] >> 8;
    for (int t = C.tid; t < NT; t += NTHREADS) { int e = 0; for (int i = 1; i < 32; ++i) if (off[i] <= t * 256) e = i; tile_e[t] = e; }
    __syncthreads();
}
__device__ __forceinline__ void phase8(Ctx& C) {
    int* off = (int*)C.lds; moe_offsets(C, off);
    const int gw = C.bid * 8 + C.wave, NGW = C.G * 8;
    const int* PE = (const int*)(C.ws + WS_PAIR); const int* PP = PE + 32768; const float* PW = (const float*)(PP + 32768); int* SL = (int*)(PW + 32768); float* SW = (float*)(SL + 32768);
    const bf16_t* XN2 = (const bf16_t*)(C.ws + WS_XN2); bf16_t* XS = (bf16_t*)(C.ws + WS_XN2S);
    for (int p = gw; p < 32768; p += NGW) {
        const int slot = off[PE[p]] + PP[p];
        if (C.lane == 0) { SL[p] = slot; SW[slot] = PW[p]; }
        const u32x4* s = (const u32x4*)(XN2 + (size_t)(p >> 1) * DM); u32x4* d = (u32x4*)(XS + (size_t)slot * DM);
        d[C.lane] = s[C.lane]; d[C.lane + 64] = s[C.lane + 64];
    }
}

__device__ __forceinline__ void phase9(Ctx& C) {
    int* off = (int*)(C.lds + 131072 + 1024); moe_offsets(C, off);
    const bf16_t* XS = (const bf16_t*)(C.ws + WS_XN2S); bf16_t* H = (bf16_t*)(C.ws + WS_H); unsigned char* ws = C.ws;
    auto bsel = [=](int tm, int tn, int& ldb) { int e = 0; const int r0 = tm * 128;
        for (int i = 1; i < 32; ++i) if (off[i] <= r0) e = i;
        ldb = 1024; return (const bf16_t*)wgu_ptr(ws, e) + (size_t)tn * 256 * 1024; };
    auto epi = [=](int row, int tn, int cc, float g, float u) { H[(size_t)row * 512 + tn * 128 + cc] = (bf16_t)f2bf(siluf(g) * u); };
#if PG8_MASK & 4
    (void)bsel; (void)epi;
    int* tile_e = off + 64; moe_tile_table(C, off, tile_e);
    SchedMoe S{(const char*)XS, C.ws, tile_e, off[32] >> 8, C.G, C.bid, 1024, 0}; EpiUp E{H};
    pg8::gemm_phase<EpiUp, SchedMoe, true, true>((lds_ptr_t)C.lds, 1024, S, E);
#else
    gemm_simple<true>(C, XS, 1024, off[32] / 128, 4, 1024, bsel, epi);
#endif
}

__device__ __forceinline__ void phase10(Ctx& C) {
    int* off = (int*)(C.lds + 131072 + 1024); moe_offsets(C, off);
    const bf16_t* H = (const bf16_t*)(C.ws + WS_H); bf16_t* Y = (bf16_t*)(C.ws + WS_Y); const bf16_t* WdT = (const bf16_t*)(C.ws + WS_WDT);
    const float* SW = (const float*)(C.ws + WS_PAIR) + 4 * 32768;
    auto bsel = [=](int tm, int tn, int& ldb) { int e = 0; const int r0 = tm * 128;
        for (int i = 1; i < 32; ++i) if (off[i] <= r0) e = i;
        ldb = 512; return WdT + (size_t)e * 1024 * 512 + (size_t)tn * 128 * 512; };
    auto epi = [=](int row, int tn, int cc, float v, float) { Y[(size_t)row * 1024 + tn * 128 + cc] = (bf16_t)f2bf(v * SW[row]); };
#if PG8_MASK & 8
    (void)bsel; (void)epi;
    int* tile_e = off + 64; moe_tile_table(C, off, tile_e);
    SchedMoe S{(const char*)H, C.ws, tile_e, off[32] >> 8, C.G, C.bid, 512, 1}; EpiDown E{Y, SW};
    pg8::gemm_phase<EpiDown, SchedMoe, true, true>((lds_ptr_t)C.lds, 512, S, E);
#else
    gemm_simple<false>(C, H, 512, off[32] / 128, 8, 512, bsel, epi);
#endif
}

__device__ __forceinline__ void phase11(Ctx& C) {
    const int gw = C.bid * 8 + C.wave, NGW = C.G * 8;
    const float* MOD = (const float*)(C.ws + WS_MOD); float* HL = C.out; const bf16_t* Y = (const bf16_t*)(C.ws + WS_Y);
    const int* SL = (const int*)(C.ws + WS_PAIR) + 3 * 32768;
    for (int l = gw; l < T_LAT; l += NGW) {
        const int b = l >> 12, s1 = SL[l * 2], s2 = SL[l * 2 + 1];
        f32x4 v[4]; float ss = 0.f;
#pragma unroll
        for (int j = 0; j < 4; ++j) { const int c0 = j * 256 + C.lane * 4;
            const f32x4 hv = *(const f32x4*)(HL + (size_t)l * DM + c0), g2 = *(const f32x4*)(MOD + b * 6144 + 5120 + c0);
            const u16x4 a = *(const u16x4*)(Y + (size_t)s1 * DM + c0), bb = *(const u16x4*)(Y + (size_t)s2 * DM + c0);
            f32x4 m; m.x = bf2f(a[0]) + bf2f(bb[0]); m.y = bf2f(a[1]) + bf2f(bb[1]); m.z = bf2f(a[2]) + bf2f(bb[2]); m.w = bf2f(a[3]) + bf2f(bb[3]);
            v[j] = hv + g2 * m; ss += v[j].x * v[j].x + v[j].y * v[j].y + v[j].z * v[j].z + v[j].w * v[j].w; }
        const float rs = rsqrtf(wave_sum(ss) * (1.f / DM) + EPS);
#pragma unroll
        for (int j = 0; j < 4; ++j) { const int c0 = j * 256 + C.lane * 4; const f32x4 fn = *(const f32x4*)(C.in[I_FNORM] + c0);
            *(f32x4*)(HL + (size_t)l * DM + c0) = v[j] * rs * fn; }
    }
}

__global__ void __launch_bounds__(NTHREADS, 2) fwd_kernel(Args a) {
    extern __shared__ __attribute__((aligned(16))) unsigned char lds[];
    Ctx C;
#pragma unroll
    for (int i = 0; i < 27; ++i) C.in[i] = a.in[i];
    C.out = a.out; C.ws = a.ws; C.lds = lds;
    C.tid = threadIdx.x; C.lane = C.tid & 63; C.wave = __builtin_amdgcn_readfirstlane(C.tid >> 6); C.bid = blockIdx.x; C.G = gridDim.x;
#if MK_COOP
    cg::grid_group grid = cg::this_grid();
#define SEAM(k) do { if ((k) + 1 < a.ph_hi) grid.sync(); } while (0)
#else
#define SEAM(k) do { } while (0)
#endif
#define IN(k) (a.ph_lo <= (k) && (k) < a.ph_hi)
    if (IN(0)) { phase0(C); SEAM(0); }
    if (IN(1)) { phase1(C); SEAM(1); }
    if (IN(2)) { phase2(C); SEAM(2); }
    if (IN(3)) { phase3(C); SEAM(3); }
#ifdef SCAN_NAIVE
    if (IN(4)) { phase4_naive(C); SEAM(4); }
#else
    if (IN(4)) { phase4(C); SEAM(4); }
#endif
    if (IN(5)) { phase5(C); SEAM(5); }
    if (IN(6)) { phase6(C); SEAM(6); }
    if (IN(7)) { phase7(C); SEAM(7); }
    if (IN(8)) { phase8(C); SEAM(8); }
    if (IN(9)) { phase9(C); SEAM(9); }
    if (IN(10)) { phase10(C); SEAM(10); }
    if (IN(11)) { phase11(C); }
}

extern "C" void kernel_launch(void* const* d_in, const int* in_sizes, int n_in, void* d_out, int out_size, void* d_ws, size_t ws_size, hipStream_t stream) {
    static int grid = 0;
    if (grid == 0) {
        if (n_in != 27 || out_size != T_LAT * DM || ws_size < WS_END) { fprintf(stderr, "kernel_launch: unexpected shapes: n_in %d out %d ws %zu (need %zu)\n", n_in, out_size, ws_size, (size_t)WS_END); grid = -1; return; }
        int dev = 0, cus = 0, per_cu = 0;
        hipGetDevice(&dev); hipDeviceGetAttribute(&cus, hipDeviceAttributeMultiprocessorCount, dev);
        hipFuncSetAttribute((const void*)fwd_kernel, hipFuncAttributeMaxDynamicSharedMemorySize, LDS_BYTES);
        hipOccupancyMaxActiveBlocksPerMultiprocessor(&per_cu, (const void*)fwd_kernel, NTHREADS, LDS_BYTES);
        if (per_cu < 1) { fprintf(stderr, "kernel_launch: occupancy query says %d blocks per CU\n", per_cu); per_cu = 1; }
        (void)hipGetLastError();
        grid = cus;
        fprintf(stderr, "kernel_launch: grid %d, per_cu %d, ws %zu\n", grid, per_cu, ws_size);
    }
    if (grid < 0) return;
    hipMemsetAsync((char*)d_ws + WS_CTL, 0, CTL_BYTES, stream);
    Args a{};
    for (int i = 0; i < 27; ++i) a.in[i] = (const float*)d_in[i];
    a.out = (float*)d_out; a.ws = (unsigned char*)d_ws;
#if MK_COOP
    a.ph_lo = 0; a.ph_hi = NPH;
    void* args[] = {&a};
    hipError_t e = hipLaunchCooperativeKernel((const void*)fwd_kernel, dim3(grid), dim3(NTHREADS), args, LDS_BYTES, stream);
    if (e != hipSuccess) fprintf(stderr, "cooperative launch failed: %s (grid %d)\n", hipGetErrorString(e), grid);
#else
    for (int p = 0; p < NPH; ++p) { a.ph_lo = p; a.ph_hi = p + 1; hipLaunchKernelGGL(fwd_kernel, dim3(grid), dim3(NTHREADS), LDS_BYTES, stream, a); }
#endif
}
```

```cpp
#include <hip/hip_runtime.h>
#include <hip/hip_cooperative_groups.h>
#include <cstdio>
#include <cstdint>
namespace cg = cooperative_groups;

#ifndef MK_COOP
#define MK_COOP 1
#endif

constexpr int NB = 4, SEQ = 4096, DM = 1024, CTXL = 256;
constexpr int T_CTX = NB * CTXL, T_LAT = NB * SEQ, T_ALL = T_CTX + T_LAT;
constexpr float EPS = 1e-6f;
constexpr int NW_IN = 5888;
constexpr int NPH = 12;
constexpr int NTHREADS = 512;
constexpr int LDS_BYTES = 147456;

typedef unsigned short bf16_t;
typedef float f32x4 __attribute__((ext_vector_type(4)));
typedef unsigned u32x4 __attribute__((ext_vector_type(4)));
typedef unsigned u32x2 __attribute__((ext_vector_type(2)));
typedef unsigned short u16x8 __attribute__((ext_vector_type(8)));
typedef unsigned short u16x4 __attribute__((ext_vector_type(4)));

constexpr size_t MiB = 1u << 20;
constexpr size_t WS_QK = 0;
constexpr size_t WS_XBC = 34 * MiB;
constexpr size_t WS_OB = 34 * MiB;
constexpr size_t WS_QKF = 85 * MiB;
constexpr size_t WS_XN = 85 * MiB;
constexpr size_t WS_YX = 85 * MiB;
constexpr size_t WS_V = 119 * MiB;
constexpr size_t WS_XC = 153 * MiB;
constexpr size_t WS_WINT = 153 * MiB;
constexpr size_t WS_RZ = 204 * MiB;
constexpr size_t WS_XN2 = 204 * MiB;
constexpr size_t WS_YB = 268 * MiB;
constexpr size_t WS_GDT = 300 * MiB;
constexpr size_t WS_WOUTT = 305 * MiB;
constexpr size_t WS_MOD = 309 * MiB;
constexpr size_t WS_GLAD = WS_MOD + 256 * 1024;
constexpr size_t WS_CTL = 311 * MiB;
constexpr size_t CTL_BYTES = 64 * 1024;
constexpr size_t WS_PAIR = 312 * MiB;
constexpr size_t WS_END = 313 * MiB;
constexpr size_t WS_WDT = 0;
constexpr size_t WS_WGU_LO = 34 * MiB;
constexpr size_t WS_WGU_HI = 268 * MiB;
constexpr size_t WS_H = 66 * MiB;
constexpr size_t WS_XN2S = 106 * MiB;
constexpr size_t WS_Y = 106 * MiB;
constexpr int MAX_SLOTS = 40960;
constexpr int CW_CNT = 0;
constexpr int CW_BAR = 1024;

__device__ __forceinline__ float bf2f(bf16_t v) { return __uint_as_float((unsigned)v << 16); }
__device__ __forceinline__ unsigned f2bf(float f) { unsigned u = __float_as_uint(f); return (u + 0x7fffu + ((u >> 16) & 1u)) >> 16; }
__device__ __forceinline__ unsigned pk2(float lo, float hi) { return f2bf(lo) | (f2bf(hi) << 16); }
__device__ __forceinline__ float siluf(float x) { return x / (1.f + __expf(-x)); }
__device__ __forceinline__ float softplusf(float x) { return fmaxf(x, 0.f) + log1pf(__expf(-fabsf(x))); }
__device__ __forceinline__ float logsigf(float x) { return fminf(x, 0.f) - log1pf(__expf(-fabsf(x))); }
__device__ __forceinline__ float wave_sum(float v) {
#pragma unroll
    for (int o = 1; o < 64; o <<= 1) v += __shfl_xor(v, o);
    return v;
}

struct Args { const float* in[27]; float* out; unsigned char* ws; int ph_lo, ph_hi; };
enum { I_X = 0, I_C, I_CTX, I_CCTX, I_WADA, I_BADA, I_NMIX, I_NFFN, I_WIN, I_GWUP, I_GB, I_GNORM, I_CONVW, I_CONVB, I_DTB, I_ALOG, I_SSDD, I_SSDN,
       I_WOUT, I_RGW, I_RGB, I_REW, I_REB, I_EWG, I_EWU, I_EWD, I_FNORM };

struct Ctx {
    const float* in[27]; float* out; unsigned char* ws; unsigned char* lds;
    int tid, lane, wave, bid, G;
};

__device__ __forceinline__ void transpose_tile(const float* src  , int ldw, bf16_t* dst  , int ldt, float* scr, int lane, bool zero) {
#pragma unroll 8
    for (int i = 0; i < 32; ++i) { const int kk = 2 * i + (lane >> 5); scr[kk * 33 + (lane & 31)] = zero ? 0.f : src[(size_t)kk * ldw + (lane & 31)]; }
    asm volatile("s_waitcnt lgkmcnt(0)" ::: "memory");
    const int c = lane & 7;
#pragma unroll
    for (int j = 0; j < 4; ++j) { const int n = (lane >> 3) + 8 * j; const float* s = scr + (8 * c) * 33 + n;
        u32x4 o; o.x = pk2(s[0 * 33], s[1 * 33]); o.y = pk2(s[2 * 33], s[3 * 33]); o.z = pk2(s[4 * 33], s[5 * 33]); o.w = pk2(s[6 * 33], s[7 * 33]);
        *(u32x4*)(dst + (size_t)n * ldt + 8 * c) = o; }
    asm volatile("s_waitcnt lgkmcnt(0)" ::: "memory");
}

__device__ __forceinline__ int win_src_col(int n) {
    if (n < 3072) return n;
    if (n < 4096) return 3104 + (n - 3072);
    if (n < 5632) return 4128 + (n - 4096);
    if (n < 5664) return 3072 + (n - 5632);
    if (n < 5696) return 5664 + (n - 5664);
    return -1;
}

__device__ __forceinline__ void phase0(Ctx& C) {
    float* lds = (float*)C.lds;
    const int gw = C.bid * 8 + C.wave, NGW = C.G * 8;
    {
        float* scr = lds + 8192 + C.wave * (64 * 33);
        bf16_t* WinT = (bf16_t*)(C.ws + WS_WINT); bf16_t* WoutT = (bf16_t*)(C.ws + WS_WOUTT);
        constexpr int IT_IN = 16 * (NW_IN / 32), IT_OUT = 32 * 32;
        for (int it = gw; it < IT_IN + IT_OUT; it += NGW) {
            if (it < IT_IN) { const int kb = it / (NW_IN / 32), nb = it % (NW_IN / 32); const int sc = win_src_col(nb * 32);
                transpose_tile(C.in[I_WIN] + (size_t)(kb * 64) * 5696 + (sc < 0 ? 0 : sc), 5696, WinT + (size_t)(nb * 32) * 1024 + kb * 64, 1024, scr, C.lane, sc < 0); }
            else { const int r = it - IT_IN, kb = r / 32, nb = r % 32;
                transpose_tile(C.in[I_WOUT] + (size_t)(kb * 64) * 1024 + nb * 32, 1024, WoutT + (size_t)(nb * 32) * 2048 + kb * 64, 2048, scr, C.lane, false); }
        }
    }
    __syncthreads();
    float* sc = lds;
    float* red = lds + 5120;
    for (int i = C.tid; i < 5 * 1024; i += NTHREADS) { const int r = i >> 10, k = i & 1023; const float v = r < 4 ? C.in[I_C][r * 1024 + k] : C.in[I_CCTX][k]; sc[i] = siluf(v); }
    __syncthreads();
    float* MOD = (float*)(C.ws + WS_MOD);
    for (int grp = C.bid; grp < 192; grp += C.G) {
        const int col = grp * 32 + (C.tid & 31), kg = C.tid >> 5;
        float acc[5] = {0.f, 0.f, 0.f, 0.f, 0.f};
        for (int k = kg; k < 1024; k += 16) { const float w = C.in[I_WADA][(size_t)k * 6144 + col];
#pragma unroll
            for (int i = 0; i < 5; ++i) acc[i] += sc[i * 1024 + k] * w; }
#pragma unroll
        for (int i = 0; i < 5; ++i) red[(kg * 5 + i) * 32 + (C.tid & 31)] = acc[i];
        __syncthreads();
        if (C.tid < 160) { const int i = C.tid >> 5, c = C.tid & 31; float s = 0.f;
            for (int g = 0; g < 16; ++g) s += red[(g * 5 + i) * 32 + c];
            MOD[i * 6144 + grp * 32 + c] = s + C.in[I_BADA][grp * 32 + c]; }
        __syncthreads();
    }
}

__device__ __forceinline__ const float* tok_row(const Ctx& C, int row, int& mi) {
    if (row < T_CTX) { mi = 4; return C.in[I_CTX] + (size_t)row * DM; }
    mi = (row - T_CTX) >> 12; return C.in[I_X] + (size_t)(row - T_CTX) * DM;
}

__device__ __forceinline__ void phase1(Ctx& C) {
    const int gw = C.bid * 8 + C.wave, NGW = C.G * 8;
    const float* MOD = (const float*)(C.ws + WS_MOD); bf16_t* XN = (bf16_t*)(C.ws + WS_XN);
    for (int row = gw; row < T_ALL; row += NGW) {
        int mi; const float* xr = tok_row(C, row, mi);
        f32x4 v[4]; float ss = 0.f;
#pragma unroll
        for (int j = 0; j < 4; ++j) { v[j] = *(const f32x4*)(xr + j * 256 + C.lane * 4); ss += v[j].x * v[j].x + v[j].y * v[j].y + v[j].z * v[j].z + v[j].w * v[j].w; }
        const float rs = rsqrtf(wave_sum(ss) * (1.f / DM) + EPS);
#pragma unroll
        for (int j = 0; j < 4; ++j) { const int c0 = j * 256 + C.lane * 4;
            const f32x4 g = *(const f32x4*)(C.in[I_NMIX] + c0), sh = *(const f32x4*)(MOD + mi * 6144 + c0), scl = *(const f32x4*)(MOD + mi * 6144 + 1024 + c0);
            const f32x4 y = v[j] * rs * g * (1.f + scl) + sh;
            u32x2 o; o.x = pk2(y.x, y.y); o.y = pk2(y.z, y.w); *(u32x2*)(XN + (size_t)row * DM + c0) = o; }
    }
}

template <bool DUAL, class BSel, class Epi>
__device__ __forceinline__ void gemm_simple(Ctx& C, const bf16_t* A, int lda, int Mtiles, int Ntiles, int K, BSel bsel, Epi epi) {
    float* As = (float*)C.lds;
    float* Bs = As + 32 * 132;
    float* Bs2 = Bs + 32 * 132;
    const int ty = C.tid >> 4, tx = C.tid & 15;
    const int lr = C.tid >> 2, lk = (C.tid & 3) * 8;
    for (int tile = C.bid; tile < Mtiles * Ntiles; tile += C.G) {
        const int tm = tile / Ntiles, tn = tile % Ntiles;
        int ldb; const bf16_t* Bt = bsel(tm, tn, ldb);
        float acc[4][8], acc2[DUAL ? 4 : 1][8];
#pragma unroll
        for (int i = 0; i < 4; ++i)
#pragma unroll
            for (int j = 0; j < 8; ++j) { acc[i][j] = 0.f; if constexpr (DUAL) acc2[i][j] = 0.f; }
        const bf16_t* ap = A + (size_t)(tm * 128 + lr) * lda + lk;
        const bf16_t* bp = Bt + (size_t)lr * ldb + lk;
        for (int k0 = 0; k0 < K; k0 += 32) {
            const u16x8 av = *(const u16x8*)(ap + k0), bv = *(const u16x8*)(bp + k0);
            u16x8 bv2 = bv; if constexpr (DUAL) bv2 = *(const u16x8*)(bp + (size_t)128 * ldb + k0);
            __syncthreads();
#pragma unroll
            for (int j = 0; j < 8; ++j) { As[(lk + j) * 132 + lr] = bf2f(av[j]); Bs[(lk + j) * 132 + lr] = bf2f(bv[j]); if constexpr (DUAL) Bs2[(lk + j) * 132 + lr] = bf2f(bv2[j]); }
            __syncthreads();
#pragma unroll 8
            for (int k = 0; k < 32; ++k) {
                const f32x4 a = *(const f32x4*)(As + k * 132 + ty * 4);
                const f32x4 b0 = *(const f32x4*)(Bs + k * 132 + tx * 8), b1 = *(const f32x4*)(Bs + k * 132 + tx * 8 + 4);
                const float af[4] = {a.x, a.y, a.z, a.w}; const float bf[8] = {b0.x, b0.y, b0.z, b0.w, b1.x, b1.y, b1.z, b1.w};
#pragma unroll
                for (int i = 0; i < 4; ++i)
#pragma unroll
                    for (int j = 0; j < 8; ++j) acc[i][j] += af[i] * bf[j];
                if constexpr (DUAL) {
                    const f32x4 c0 = *(const f32x4*)(Bs2 + k * 132 + tx * 8), c1 = *(const f32x4*)(Bs2 + k * 132 + tx * 8 + 4);
                    const float cf[8] = {c0.x, c0.y, c0.z, c0.w, c1.x, c1.y, c1.z, c1.w};
#pragma unroll
                    for (int i = 0; i < 4; ++i)
#pragma unroll
                        for (int j = 0; j < 8; ++j) acc2[i][j] += af[i] * cf[j];
                }
            }
        }
#pragma unroll
        for (int i = 0; i < 4; ++i)
#pragma unroll
            for (int j = 0; j < 8; ++j) { float a2 = 0.f; if constexpr (DUAL) a2 = acc2[i][j]; epi(tm * 128 + ty * 4 + i, tn, tx * 8 + j, acc[i][j], a2); }
        __syncthreads();
    }
}


namespace pg8 {
#define PG8_LAS __attribute__((address_space(3)))
typedef short bf16x8 __attribute__((ext_vector_type(8)));
constexpr int BM = 256, BK = 64, HALF = 128, HTB = HALF * BK * 2  , STAGE_BYTES = 8 * HTB, NXCD = 8, WGM = 8;
__host__ __device__ __forceinline__ int lds_byte(int r, int c) { const int st = (r >> 4) * 2 + (c >> 5), rr = r & 15, cc = c & 31, ob = rr * 64 + cc * 2; return st * 1024 + (ob ^ (((ob >> 9) & 1) << 5)); }
__host__ __device__ __forceinline__ void stage_rc(int b, int& R, int& C) { const int st = b / 1024, sb = b % 1024, swz = sb ^ (((sb >> 9) & 1) << 5); R = (st >> 1) * 16 + swz / 64; C = (st & 1) * 32 + (swz % 64) / 2; }
__host__ __device__ __forceinline__ int perm32(int rho) { const int n = rho >> 4, i = rho & 15; return 8 * (i >> 2) + 4 * n + (i & 3); }
struct Unit { int pm, pn; };
__device__ __forceinline__ unsigned cvt_pk_bf16(float lo, float hi) { unsigned r; asm volatile("v_cvt_pk_bf16_f32 %0, %1, %2" : "=v"(r) : "v"(lo), "v"(hi)); return r; }
__device__ __forceinline__ int xcd_remap(int L, int nwg) { const int q = nwg / NXCD, r = nwg % NXCD, xcd = L % NXCD, off = L / NXCD; return (xcd < r ? xcd * (q + 1) : r * (q + 1) + (xcd - r) * q) + off; }
template <class Epi, class Sched, bool ALIGN_EPI = false, bool SP2 = false>
__device__ __forceinline__ void gemm_phase(PG8_LAS unsigned char* lds, const int K_, const Sched& S, const Epi& E) {
    const int tid = threadIdx.x, wid = __builtin_amdgcn_readfirstlane(tid >> 6), lane = tid & 63, wr = wid >> 2, wc = wid & 3, fr = lane & 15, fq = lane >> 4;
    const int K = K_, nt = K / BK;
    unsigned voffA[2], voffB[2];
#pragma unroll
    for (int i = 0; i < 2; ++i) { int R, C; stage_rc(tid * 16 + i * 8192, R, C); const int Rb = Epi::PERM ? ((R & ~31) + perm32(R & 31)) : R;
        voffA[i] = (unsigned)(R * K + C) * 2u; voffB[i] = (unsigned)(Rb * K + C) * 2u; }
    const size_t kstep = (size_t)(BK * 2);
    const size_t hstep = (size_t)HALF * K * 2;
    const unsigned ldsw = (unsigned)wid * 1024u;
    const int aoff = lds_byte(wr * 64 + fr, fq * 8), boff = lds_byte(wc * 32 + fr, fq * 8);
#define PG8_SA(b, h) (((b) * 2 + (h)) * HTB)
#define PG8_SB(b, h) ((4 + (b) * 2 + (h)) * HTB)
#define PG8_STAGE(bufoff, gbase, voff) do { _Pragma("unroll") for (int _i = 0; _i < 2; ++_i) \
        __builtin_amdgcn_global_load_lds((const unsigned*)((const char*)(gbase) + (voff)[_i]), (PG8_LAS unsigned*)(lds + (bufoff) + ldsw + _i * 8192), 16, 0, 0); } while (0)
#define PG8_LDA(dst, b, h) do { _Pragma("unroll") for (int m = 0; m < 4; ++m) _Pragma("unroll") for (int k = 0; k < 2; ++k) dst[m][k] = *(const PG8_LAS bf16x8*)(lds + PG8_SA(b, h) + aoff + m * 2048 + k * 1024); } while (0)
#define PG8_LDB(dst, b, h) do { _Pragma("unroll") for (int n = 0; n < 2; ++n) _Pragma("unroll") for (int k = 0; k < 2; ++k) dst[n][k] = *(const PG8_LAS bf16x8*)(lds + PG8_SB(b, h) + boff + n * 2048 + k * 1024); } while (0)
#define PG8_MMA(ai, bj, At, Bt) do { __builtin_amdgcn_s_setprio(1); _Pragma("unroll") for (int m = 0; m < 4; ++m) _Pragma("unroll") for (int n = 0; n < 2; ++n) _Pragma("unroll") for (int k = 0; k < 2; ++k) \
        acc[ai][bj][m][n] = __builtin_amdgcn_mfma_f32_16x16x32_bf16(Bt[n][k], At[m][k], acc[ai][bj][m][n], 0, 0, 0); __builtin_amdgcn_s_setprio(0); } while (0)
#define PG8_WAIT_V(n) asm volatile("s_waitcnt vmcnt(" #n ")" ::: "memory")
#define PG8_WAIT_L(n) asm volatile("s_waitcnt lgkmcnt(" #n ")" ::: "memory")
#define PG8_BAR __builtin_amdgcn_s_barrier()
#define PG8_SCHED __builtin_amdgcn_sched_barrier(0)
    Unit cur, nxt; int ui = 0;
    if (!S.next(0, cur)) return;
    f32x4 acc[2][2][4][2];
#pragma unroll
    for (int a = 0; a < 2; ++a)
#pragma unroll
        for (int b = 0; b < 2; ++b)
#pragma unroll
            for (int m = 0; m < 4; ++m)
#pragma unroll
                for (int n = 0; n < 2; ++n) acc[a][b][m][n] = (f32x4){0.f, 0.f, 0.f, 0.f};
    bf16x8 At[4][2], B0[2][2], B1[2][2];
    const char* cA = S.a_ptr(cur); const char* cB = S.b_ptr(cur);
    S.a_ready(cur);
    if constexpr (SP2) {
        PG8_STAGE(PG8_SB(0, 0), cB, voffB); PG8_STAGE(PG8_SB(0, 1), cB + hstep, voffB); PG8_STAGE(PG8_SA(0, 0), cA, voffA); PG8_STAGE(PG8_SA(0, 1), cA + hstep, voffA);
        if (wr == 1) PG8_BAR;
        PG8_WAIT_V(2); PG8_BAR;
        PG8_STAGE(PG8_SB(1, 0), cB + kstep, voffB); PG8_STAGE(PG8_SA(1, 0), cA + kstep, voffA); PG8_STAGE(PG8_SB(1, 1), cB + hstep + kstep, voffB);
        PG8_WAIT_V(6); PG8_BAR;
    } else {
        PG8_STAGE(PG8_SB(0, 0), cB, voffB); PG8_STAGE(PG8_SA(0, 0), cA, voffA); PG8_STAGE(PG8_SB(0, 1), cB + hstep, voffB); PG8_STAGE(PG8_SA(0, 1), cA + hstep, voffA);
        if (wr == 1) PG8_BAR;
        PG8_WAIT_V(4); PG8_BAR;
        PG8_STAGE(PG8_SB(1, 0), cB + kstep, voffB); PG8_STAGE(PG8_SA(1, 0), cA + kstep, voffA); PG8_STAGE(PG8_SB(1, 1), cB + hstep + kstep, voffB);
        PG8_WAIT_V(6); PG8_BAR;
    }
    for (;;) {
        const bool has_next = S.next(ui + 1, nxt);
        const char* nA = has_next ? S.a_ptr(nxt) : cA; const char* nB = has_next ? S.b_ptr(nxt) : cB;
        for (int t = 0; t < nt; t += 2) {
            const bool last = (t == nt - 2);
            const char* a1 = cA + (size_t)(t + 1) * kstep;
            const char* a2 = last ? nA : cA + (size_t)(t + 2) * kstep; const char* b2 = last ? nB : cB + (size_t)(t + 2) * kstep;
            const char* a3 = a2 + kstep; const char* b3 = b2 + kstep;
            if (last && has_next) S.a_ready(nxt);
            if constexpr (SP2) {
            PG8_LDB(B0, 0, 0); PG8_LDB(B1, 0, 1); PG8_SCHED; PG8_LDA(At, 0, 0); PG8_STAGE(PG8_SA(1, 1), a1 + hstep, voffA);
            PG8_WAIT_V(8); PG8_WAIT_L(0); PG8_BAR; PG8_MMA(0, 0, At, B0); PG8_MMA(0, 1, At, B1); PG8_BAR; PG8_SCHED;
            PG8_LDA(At, 0, 1); PG8_STAGE(PG8_SB(0, 0), b2, voffB); PG8_STAGE(PG8_SB(0, 1), b2 + hstep, voffB); PG8_STAGE(PG8_SA(0, 0), a2, voffA);
            PG8_WAIT_V(8); PG8_WAIT_L(0); PG8_BAR; PG8_MMA(1, 0, At, B0); PG8_MMA(1, 1, At, B1); PG8_BAR; PG8_SCHED;
            PG8_LDB(B0, 1, 0); PG8_LDB(B1, 1, 1); PG8_SCHED; PG8_LDA(At, 1, 0); PG8_STAGE(PG8_SA(0, 1), a2 + hstep, voffA);
            PG8_WAIT_V(8); PG8_WAIT_L(0); PG8_BAR; PG8_MMA(0, 0, At, B0); PG8_MMA(0, 1, At, B1); PG8_BAR; PG8_SCHED;
            PG8_LDA(At, 1, 1); PG8_STAGE(PG8_SB(1, 0), b3, voffB); PG8_STAGE(PG8_SB(1, 1), b3 + hstep, voffB); PG8_STAGE(PG8_SA(1, 0), a3, voffA);
            PG8_WAIT_V(8); PG8_WAIT_L(0); PG8_BAR; PG8_MMA(1, 0, At, B0); PG8_MMA(1, 1, At, B1); PG8_BAR; PG8_SCHED;
            } else {
            PG8_LDB(B0, 0, 0); PG8_SCHED; PG8_LDA(At, 0, 0); PG8_STAGE(PG8_SA(1, 1), a1 + hstep, voffA);
            PG8_WAIT_L(8); PG8_BAR; PG8_WAIT_L(0); PG8_MMA(0, 0, At, B0); PG8_BAR; PG8_SCHED;
            PG8_LDB(B1, 0, 1); PG8_STAGE(PG8_SB(0, 0), b2, voffB);
            PG8_BAR; PG8_WAIT_L(0); PG8_MMA(0, 1, At, B1); PG8_BAR;
            PG8_LDA(At, 0, 1); PG8_STAGE(PG8_SA(0, 0), a2, voffA);
            PG8_BAR; PG8_WAIT_L(0); PG8_MMA(1, 0, At, B0); PG8_BAR; PG8_SCHED;
            PG8_STAGE(PG8_SB(0, 1), b2 + hstep, voffB);
            PG8_WAIT_V(6); PG8_BAR; PG8_MMA(1, 1, At, B1); PG8_BAR;
            PG8_LDB(B0, 1, 0); PG8_SCHED; PG8_LDA(At, 1, 0); PG8_STAGE(PG8_SA(0, 1), a2 + hstep, voffA);
            PG8_WAIT_L(8); PG8_BAR; PG8_WAIT_L(0); PG8_MMA(0, 0, At, B0); PG8_BAR; PG8_SCHED;
            PG8_LDB(B1, 1, 1); PG8_STAGE(PG8_SB(1, 0), b3, voffB);
            PG8_BAR; PG8_WAIT_L(0); PG8_MMA(0, 1, At, B1); PG8_BAR;
            PG8_LDA(At, 1, 1); PG8_STAGE(PG8_SA(1, 0), a3, voffA);
            PG8_BAR; PG8_WAIT_L(0); PG8_MMA(1, 0, At, B0); PG8_BAR; PG8_SCHED;
            PG8_STAGE(PG8_SB(1, 1), b3 + hstep, voffB);
            PG8_WAIT_V(6); PG8_BAR; PG8_MMA(1, 1, At, B1); PG8_BAR;
            }
        }
        if constexpr (ALIGN_EPI) { if (wr == 0) PG8_BAR; }
        if constexpr (!Epi::AFTER_DRAIN) { E(acc, cur, wr, wc, fr, fq); S.done(cur); }
        if (!has_next) break;
#pragma unroll
        for (int a = 0; a < 2; ++a)
#pragma unroll
            for (int b = 0; b < 2; ++b)
#pragma unroll
                for (int m = 0; m < 4; ++m)
#pragma unroll
                    for (int n = 0; n < 2; ++n) acc[a][b][m][n] = (f32x4){0.f, 0.f, 0.f, 0.f};
        cur = nxt; cA = nA; cB = nB; ++ui;
        if constexpr (ALIGN_EPI) { if (wr == 1) PG8_BAR; }
    }
    PG8_WAIT_V(0);
    if constexpr (!ALIGN_EPI) { if (wr == 0) PG8_BAR; }
    PG8_BAR;
    if constexpr (Epi::AFTER_DRAIN) { E.fused(acc, cur, wr, wc, fr, fq, lds, wid, lane); S.done(cur); }
#undef PG8_SA
#undef PG8_SB
#undef PG8_STAGE
#undef PG8_LDA
#undef PG8_LDB
#undef PG8_MMA
#undef PG8_WAIT_V
#undef PG8_WAIT_L
#undef PG8_BAR
#undef PG8_SCHED
}
}

__device__ __forceinline__ bf16_t* wgu_ptr(unsigned char* ws, int e) { return (bf16_t*)(ws + (e < 16 ? WS_WGU_LO : WS_WGU_HI)) + (size_t)(e & 15) * 1024 * 1024; }

#ifndef PG8_MASK
#define PG8_MASK 15
#endif
typedef __attribute__((address_space(3))) unsigned char* lds_ptr_t;

struct SchedIn {
    const char* A; const char* Bt; int G, c;
    __device__ __forceinline__ bool next(int i, pg8::Unit& u) const {
        const int L0 = i * G + c; if (L0 >= 1532) return false;
        const int L = pg8::xcd_remap(L0, 1532);
        if (L < 60) { const int pi = L >> 2; u.pm = L & 3; u.pn = pi < 8 ? pi : pi + 8; }
        else { const int l2 = L - 60, g = l2 / 184, r = l2 % 184; u.pn = r >> 3; u.pm = 4 + 8 * g + (r & 7); }
        return true;
    }
    __device__ __forceinline__ const char* a_ptr(const pg8::Unit& u) const { return A + (size_t)u.pm * (256 * 1024 * 2); }
    __device__ __forceinline__ const char* b_ptr(const pg8::Unit& u) const { return Bt + (size_t)u.pn * (256 * 1024 * 2); }
    __device__ __forceinline__ void a_ready(const pg8::Unit&) const {}
    __device__ __forceinline__ void done(const pg8::Unit&) const {}
};
struct SchedOut {
    const char* A; const char* Bt; int G, c;
    __device__ __forceinline__ bool next(int i, pg8::Unit& u) const {
        const int L0 = i * G + c; if (L0 >= 256) return false;
        const int w = pg8::xcd_remap(L0, 256), gid = w >> 5, r = w & 31;
        u.pm = gid * 8 + (r & 7); u.pn = r >> 3;
        return true;
    }
    __device__ __forceinline__ const char* a_ptr(const pg8::Unit& u) const { return A + (size_t)u.pm * (256 * 2048 * 2); }
    __device__ __forceinline__ const char* b_ptr(const pg8::Unit& u) const { return Bt + (size_t)u.pn * (256 * 2048 * 2); }
    __device__ __forceinline__ void a_ready(const pg8::Unit&) const {}
    __device__ __forceinline__ void done(const pg8::Unit&) const {}
};
struct SchedMoe {
    const char* A; unsigned char* ws; const int* tile_e; int NT, G, c, K, down;
    __device__ __forceinline__ bool next(int i, pg8::Unit& u) const {
        const int nwg = NT * 4; const int L0 = i * G + c; if (L0 >= nwg) return false;
        const int w = pg8::xcd_remap(L0, nwg);
        u.pm = w >> 2; u.pn = w & 3;
        return true;
    }
    __device__ __forceinline__ const char* a_ptr(const pg8::Unit& u) const { return A + (size_t)u.pm * 256 * K * 2; }
    __device__ __forceinline__ const char* b_ptr(const pg8::Unit& u) const {
        const int e = __builtin_amdgcn_readfirstlane(tile_e[u.pm]);
        return down ? (const char*)(ws + WS_WDT) + ((size_t)e * 1024 * 512 + (size_t)u.pn * 256 * 512) * 2
                    : (const char*)wgu_ptr(ws, e) + (size_t)u.pn * 256 * 1024 * 2;
    }
    __device__ __forceinline__ void a_ready(const pg8::Unit&) const {}
    __device__ __forceinline__ void done(const pg8::Unit&) const {}
};

struct EpiIn {
    static constexpr bool PERM = true, AFTER_DRAIN = false;
    unsigned char* ws;
    __device__ __forceinline__ void operator()(const f32x4 (&acc)[2][2][4][2], const pg8::Unit& u, int wr, int wc, int fr, int fq) const {
        const int pn = u.pn; const int row0 = u.pm * 256 + wr * 64 + fr; const int ct = wc * 32 + 8 * fq;
        if (pn == 22) {
            if (wc < 2) { float* GDT = (float*)(ws + WS_GDT);
#pragma unroll
                for (int ai = 0; ai < 2; ++ai)
#pragma unroll
                    for (int m = 0; m < 4; ++m) { float* p = GDT + (size_t)(row0 + ai * 128 + m * 16) * 64 + ct; *(f32x4*)p = acc[ai][0][m][0]; *(f32x4*)(p + 4) = acc[ai][0][m][1]; } }
            return;
        }
        bf16_t* base; int ld; int roff = 0; bool act = false;
        if (pn < 4) { base = (bf16_t*)(ws + WS_QK) + pn * 256; ld = 1024; }
        else if (pn < 8) { base = (bf16_t*)(ws + WS_V) + (pn - 4) * 256; ld = 1024; }
        else if (pn < 16) { base = (bf16_t*)(ws + WS_RZ) + (pn - 8) * 256; ld = 2048; roff = T_CTX; act = true; }
        else { base = (bf16_t*)(ws + WS_XBC) + (pn - 16) * 256; ld = 1536; }
#pragma unroll
        for (int ai = 0; ai < 2; ++ai)
#pragma unroll
            for (int m = 0; m < 4; ++m) { bf16_t* rowp = base + (size_t)(row0 - roff + ai * 128 + m * 16) * ld + ct;
#pragma unroll
                for (int bj = 0; bj < 2; ++bj) { f32x4 v0 = acc[ai][bj][m][0], v1 = acc[ai][bj][m][1];
                    if (act) { v0.x = siluf(v0.x); v0.y = siluf(v0.y); v0.z = siluf(v0.z); v0.w = siluf(v0.w); v1.x = siluf(v1.x); v1.y = siluf(v1.y); v1.z = siluf(v1.z); v1.w = siluf(v1.w); }
                    u32x4 w; w.x = pg8::cvt_pk_bf16(v0.x, v0.y); w.y = pg8::cvt_pk_bf16(v0.z, v0.w); w.z = pg8::cvt_pk_bf16(v1.x, v1.y); w.w = pg8::cvt_pk_bf16(v1.z, v1.w);
                    *(u32x4*)(rowp + bj * 128) = w; } }
    }
};
struct EpiOut {
    static constexpr bool PERM = false, AFTER_DRAIN = false;
    const float* X; const float* MOD; float* HL;
    __device__ __forceinline__ void operator()(const f32x4 (&acc)[2][2][4][2], const pg8::Unit& u, int wr, int wc, int fr, int fq) const {
        const int b = u.pm >> 4; const int col0 = u.pn * 256 + wc * 32 + 4 * fq;
        f32x4 g1[2][2];
#pragma unroll
        for (int bj = 0; bj < 2; ++bj)
#pragma unroll
            for (int n = 0; n < 2; ++n) g1[bj][n] = *(const f32x4*)(MOD + b * 6144 + 2048 + col0 + bj * 128 + n * 16);
#pragma unroll
        for (int ai = 0; ai < 2; ++ai)
#pragma unroll
            for (int m = 0; m < 4; ++m) { const size_t off = (size_t)(u.pm * 256 + ai * 128 + wr * 64 + m * 16 + fr) * 1024 + col0;
#pragma unroll
                for (int bj = 0; bj < 2; ++bj)
#pragma unroll
                    for (int n = 0; n < 2; ++n) { const f32x4 xv = *(const f32x4*)(X + off + bj * 128 + n * 16); *(f32x4*)(HL + off + bj * 128 + n * 16) = xv + g1[bj][n] * acc[ai][bj][m][n]; }
                if (m & 1) asm volatile("" ::: "memory"); }
    }
};
struct EpiUp {
    static constexpr bool PERM = true, AFTER_DRAIN = false;
    bf16_t* H;
    __device__ __forceinline__ void operator()(const f32x4 (&acc)[2][2][4][2], const pg8::Unit& u, int wr, int wc, int fr, int fq) const {
        const int row0 = u.pm * 256 + wr * 64 + fr; const int col = u.pn * 128 + wc * 32 + 8 * fq;
#pragma unroll
        for (int ai = 0; ai < 2; ++ai)
#pragma unroll
            for (int m = 0; m < 4; ++m) { const f32x4 g0 = acc[ai][0][m][0], g1 = acc[ai][0][m][1], u0 = acc[ai][1][m][0], u1 = acc[ai][1][m][1];
                u32x4 w; w.x = pg8::cvt_pk_bf16(siluf(g0.x) * u0.x, siluf(g0.y) * u0.y); w.y = pg8::cvt_pk_bf16(siluf(g0.z) * u0.z, siluf(g0.w) * u0.w);
                w.z = pg8::cvt_pk_bf16(siluf(g1.x) * u1.x, siluf(g1.y) * u1.y); w.w = pg8::cvt_pk_bf16(siluf(g1.z) * u1.z, siluf(g1.w) * u1.w);
                *(u32x4*)(H + (size_t)(row0 + ai * 128 + m * 16) * 512 + col) = w; }
    }
};
struct EpiDown {
    static constexpr bool PERM = true, AFTER_DRAIN = false;
    bf16_t* Y; const float* SW;
    __device__ __forceinline__ void operator()(const f32x4 (&acc)[2][2][4][2], const pg8::Unit& u, int wr, int wc, int fr, int fq) const {
        const int row0 = u.pm * 256 + wr * 64 + fr; const int col = u.pn * 256 + wc * 32 + 8 * fq;
#pragma unroll
        for (int ai = 0; ai < 2; ++ai)
#pragma unroll
            for (int m = 0; m < 4; ++m) { const int row = row0 + ai * 128 + m * 16; const float sw = SW[row];
#pragma unroll
                for (int bj = 0; bj < 2; ++bj) { const f32x4 v0 = acc[ai][bj][m][0] * sw, v1 = acc[ai][bj][m][1] * sw;
                    u32x4 w; w.x = pg8::cvt_pk_bf16(v0.x, v0.y); w.y = pg8::cvt_pk_bf16(v0.z, v0.w); w.z = pg8::cvt_pk_bf16(v1.x, v1.y); w.w = pg8::cvt_pk_bf16(v1.z, v1.w);
                    *(u32x4*)(Y + (size_t)row * 1024 + col + bj * 128) = w; } }
    }
};

__device__ __forceinline__ void phase2(Ctx& C) {
    const bf16_t* XN = (const bf16_t*)(C.ws + WS_XN); const bf16_t* WinT = (const bf16_t*)(C.ws + WS_WINT);
    bf16_t* QK = (bf16_t*)(C.ws + WS_QK); bf16_t* V = (bf16_t*)(C.ws + WS_V); bf16_t* RZ = (bf16_t*)(C.ws + WS_RZ); bf16_t* XBC = (bf16_t*)(C.ws + WS_XBC);
    float* GDT = (float*)(C.ws + WS_GDT);
    auto bsel = [=](int, int tn, int& ldb) { ldb = 1024; return WinT + (size_t)tn * 128 * 1024; };
    auto epi = [=](int row, int tn, int cc, float v, float) {
        const int col = tn * 128 + cc;
        if (col < 1024) QK[(size_t)row * 1024 + col] = (bf16_t)f2bf(v);
        else if (col < 2048) V[(size_t)row * 1024 + col - 1024] = (bf16_t)f2bf(v);
        else if (col < 4096) { if (row >= T_CTX) RZ[(size_t)(row - T_CTX) * 2048 + col - 2048] = (bf16_t)f2bf(siluf(v)); }
        else if (col < 5632) XBC[(size_t)row * 1536 + col - 4096] = (bf16_t)f2bf(v);
        else if (col < 5696) GDT[(size_t)row * 64 + col - 5632] = v;
    };
#if PG8_MASK & 1
    (void)bsel; (void)epi;
    SchedIn S{(const char*)XN, (const char*)WinT, C.G, C.bid}; EpiIn E{C.ws};
    pg8::gemm_phase<EpiIn, SchedIn, true, true>((lds_ptr_t)C.lds, 1024, S, E);
#else
    gemm_simple<false>(C, XN, 1024, T_ALL / 128, NW_IN / 128, 1024, bsel, epi);
#endif
}

__device__ __forceinline__ void phase3(Ctx& C) {
    float* lds = (float*)C.lds;
    {
        float* gs = lds;
        float* tot = lds + 2048;
        bf16_t* QK = (bf16_t*)(C.ws + WS_QK); bf16_t* QKF = (bf16_t*)(C.ws + WS_QKF);
        const float* GDT = (const float*)(C.ws + WS_GDT); float* GLAD = (float*)(C.ws + WS_GLAD);
        const int c = C.tid & 127, tg = C.tid >> 7;
        for (int item = C.bid; item < 272 * 4; item += C.G) {
            const int rc = item >> 2, h = item & 3, row0 = rc * 64;
            __syncthreads();
            for (int i = C.tid; i < 64 * 32; i += NTHREADS) gs[i] = GDT[(size_t)(row0 + (i >> 5)) * 64 + (i & 31)];
            float wf[16], wb[16];
#pragma unroll
            for (int r = 0; r < 16; ++r) { wf[r] = C.in[I_GWUP][r * 512 + h * 128 + c]; wb[r] = C.in[I_GWUP][(16 + r) * 512 + h * 128 + c]; }
            const float bfv = C.in[I_GB][h * 128 + c], bbv = C.in[I_GB][512 + h * 128 + c];
            __syncthreads();
            float pf[16], pb[16];
#pragma unroll
            for (int tt = 0; tt < 16; ++tt) { const float* g = gs + (tg * 16 + tt) * 32; float sf = bfv, sb = bbv;
#pragma unroll
                for (int r = 0; r < 16; ++r) { sf += g[r] * wf[r]; sb += g[16 + r] * wb[r]; }
                pf[tt] = logsigf(sf) * (1.f / 16.f); pb[tt] = logsigf(sb) * (1.f / 16.f); }
#pragma unroll
            for (int tt = 1; tt < 16; ++tt) pf[tt] += pf[tt - 1];
#pragma unroll
            for (int tt = 14; tt >= 0; --tt) pb[tt] += pb[tt + 1];
            tot[(0 * 4 + tg) * 128 + c] = pf[15]; tot[(1 * 4 + tg) * 128 + c] = pb[0];
            __syncthreads();
            float offf = 0.f, offb = 0.f, totf = 0.f, totb = 0.f;
#pragma unroll
            for (int g = 0; g < 4; ++g) { const float a = tot[(0 * 4 + g) * 128 + c], b = tot[(1 * 4 + g) * 128 + c]; if (g < tg) offf += a; if (g > tg) offb += b; totf += a; totb += b; }
            if (tg == 0) { GLAD[((size_t)(rc * 4 + h) * 2 + 0) * 128 + c] = __expf(totf); GLAD[((size_t)(rc * 4 + h) * 2 + 1) * 128 + c] = __expf(totb); }
            const float qscale = 0.08838834764831845f;
#pragma unroll
            for (int tt = 0; tt < 16; ++tt) { const size_t ro = (size_t)(row0 + tg * 16 + tt) * 1024;
                const float q = bf2f(QK[ro + h * 128 + c]) * qscale, k = bf2f(QK[ro + 512 + h * 128 + c]);
                const float ef = pf[tt] + offf, eb = pb[tt] + offb;
                QKF[ro + h * 128 + c] = (bf16_t)f2bf(q * __expf(ef)); QKF[ro + 512 + h * 128 + c] = (bf16_t)f2bf(k * __expf(-ef));
                QK[ro + h * 128 + c] = (bf16_t)f2bf(q * __expf(eb)); QK[ro + 512 + h * 128 + c] = (bf16_t)f2bf(k * __expf(-eb)); }
        }
    }
    {
        const bf16_t* XBC = (const bf16_t*)(C.ws + WS_XBC); bf16_t* XC = (bf16_t*)(C.ws + WS_XC);
        const float* cw = C.in[I_CONVW]; const float* cb = C.in[I_CONVB];
        const long total = (long)T_ALL * 192;
        for (long it = (long)C.bid * NTHREADS + C.tid; it < total; it += (long)C.G * NTHREADS) {
            const int row = (int)(it / 192), c0 = (int)(it % 192) * 8;
            float acc[8];
#pragma unroll
            for (int j = 0; j < 8; ++j) acc[j] = cb[c0 + j];
            int base, y, x, H, W;
            if (row < T_CTX) { base = row & ~255; y = 0; x = row & 255; H = 1; W = 256; }
            else { const int l = row - T_CTX; base = T_CTX + (l & ~4095); const int t = l & 4095; y = t >> 6; x = t & 63; H = 64; W = 64; }
            for (int i = 0; i < 3; ++i) { const int yy = y + i - 1; if (yy < 0 || yy >= H) continue;
                for (int jx = 0; jx < 3; ++jx) { const int xx = x + jx - 1; if (xx < 0 || xx >= W) continue;
                    const u16x8 v = *(const u16x8*)(XBC + (size_t)(base + yy * W + xx) * 1536 + c0);
                    const float* w = cw + (size_t)(i * 3 + jx) * 1536 + c0;
#pragma unroll
                    for (int j = 0; j < 8; ++j) acc[j] += bf2f(v[j]) * w[j]; } }
            u32x4 o; o.x = pk2(siluf(acc[0]), siluf(acc[1])); o.y = pk2(siluf(acc[2]), siluf(acc[3])); o.z = pk2(siluf(acc[4]), siluf(acc[5])); o.w = pk2(siluf(acc[6]), siluf(acc[7]));
            *(u32x4*)(XC + (size_t)row * 1536 + c0) = o;
        }
    }
}

__device__ __forceinline__ int scan_row(int b, int dir, int s) {
    if (s < CTXL) return b * CTXL + (dir ? CTXL - 1 - s : s);
    const int t = s - CTXL; return T_CTX + b * SEQ + (dir ? SEQ - 1 - t : t);
}

__device__ __forceinline__ void phase4_naive(Ctx& C) {
    bf16_t* OF = (bf16_t*)C.out;
    bf16_t* OB = (bf16_t*)(C.ws + WS_OB);
    bf16_t* YB = (bf16_t*)(C.ws + WS_YB);
    const bf16_t* V = (const bf16_t*)(C.ws + WS_V); const bf16_t* XC = (const bf16_t*)(C.ws + WS_XC);
    const float* GDT = (const float*)(C.ws + WS_GDT); const float* GLAD = (const float*)(C.ws + WS_GLAD);
    for (int gt = C.bid * NTHREADS + C.tid; gt < 65536; gt += C.G * NTHREADS) {
        if (gt < 32768) {
            const int chain = gt >> 10, rem = gt & 1023, dv = rem >> 2, dq = rem & 3;
            const int b = chain >> 3, h = (chain >> 1) & 3, dir = chain & 1;
            const bf16_t* QKp = (const bf16_t*)(C.ws + (dir ? WS_QK : WS_QKF));
            float S[32];
#pragma unroll
            for (int i = 0; i < 32; ++i) S[i] = 0.f;
            for (int s = 0; s < CTXL + SEQ; ++s) {
                const int row = scan_row(b, dir, s);
                const float v = bf2f(V[(size_t)row * 1024 + h * 256 + dv]);
                const bf16_t* qp = QKp + (size_t)row * 1024 + h * 128 + dq * 32;
                float o = 0.f;
#pragma unroll
                for (int i8 = 0; i8 < 4; ++i8) { const u16x8 kv = *(const u16x8*)(qp + 512 + i8 * 8), qv = *(const u16x8*)(qp + i8 * 8);
#pragma unroll
                    for (int j = 0; j < 8; ++j) { S[i8 * 8 + j] += bf2f(kv[j]) * v; o += bf2f(qv[j]) * S[i8 * 8 + j]; } }
                o += __shfl_xor(o, 1); o += __shfl_xor(o, 2);
                if (row >= T_CTX && dq == 0) { const size_t l = row - T_CTX; if (dir) OB[l * 1024 + h * 256 + dv] = (bf16_t)f2bf(o); else OF[l * 2048 + h * 256 + dv] = (bf16_t)f2bf(o); }
                if ((s & 63) == 63) { const float* d = GLAD + ((size_t)((row >> 6) * 4 + h) * 2 + dir) * 128 + dq * 32;
#pragma unroll
                    for (int i = 0; i < 32; ++i) S[i] *= d[i]; }
            }
        } else {
            const int g2 = gt - 32768, chain = g2 >> 8, rem = g2 & 255, p = rem >> 2, nq = rem & 3;
            const int b = chain >> 5, head = (chain >> 1) & 15, dir = chain & 1, grp = head >> 3;
            const float Aneg = -__expf(C.in[I_ALOG][dir * 16 + head]), dtb = C.in[I_DTB][dir * 16 + head];
            float S[32];
#pragma unroll
            for (int i = 0; i < 32; ++i) S[i] = 0.f;
            for (int s = 0; s < CTXL + SEQ; ++s) {
                const int row = scan_row(b, dir, s);
                const float dt = softplusf(GDT[(size_t)row * 64 + 32 + dir * 16 + head] + dtb), a = __expf(dt * Aneg);
                const float xd = bf2f(XC[(size_t)row * 1536 + head * 64 + p]) * dt;
                const bf16_t* bp = XC + (size_t)row * 1536 + 1024 + grp * 128 + nq * 32;
                float y = 0.f;
#pragma unroll
                for (int i8 = 0; i8 < 4; ++i8) { const u16x8 bv = *(const u16x8*)(bp + i8 * 8), cv = *(const u16x8*)(bp + 256 + i8 * 8);
#pragma unroll
                    for (int j = 0; j < 8; ++j) { S[i8 * 8 + j] = a * S[i8 * 8 + j] + xd * bf2f(bv[j]); y += S[i8 * 8 + j] * bf2f(cv[j]); } }
                y += __shfl_xor(y, 1); y += __shfl_xor(y, 2);
                if (row >= T_CTX && nq == 0) { const size_t l = row - T_CTX; if (dir) YB[l * 1024 + head * 64 + p] = (bf16_t)f2bf(y); else OF[l * 2048 + 1024 + head * 64 + p] = (bf16_t)f2bf(y); }
            }
        }
    }
}


typedef short bf16x8 __attribute__((ext_vector_type(8)));
typedef short s16x4 __attribute__((ext_vector_type(4)));
typedef __attribute__((address_space(3))) s16x4* lds_s16x4_p;
#define LASQ __attribute__((address_space(3)))
__device__ __forceinline__ bf16x8 lds_row_frag(lds_ptr_t L, int off, int rs, int r0, int kb, int c, int g) {
    return *(const LASQ bf16x8*)(L + off + (r0 + c) * rs + kb + g * 16);
}
__device__ __forceinline__ bf16x8 lds_tr_frag(lds_ptr_t L, int off, int rs, int k0, int n0, int g, int q, int p) {
    const s16x4 lo = __builtin_amdgcn_ds_read_tr16_b64_v4i16((lds_s16x4_p)(L + off + (k0 + 8 * g + q) * rs + (n0 + 4 * p) * 2));
    const s16x4 hi = __builtin_amdgcn_ds_read_tr16_b64_v4i16((lds_s16x4_p)(L + off + (k0 + 8 * g + 4 + q) * rs + (n0 + 4 * p) * 2));
    bf16x8 r; r[0] = lo[0]; r[1] = lo[1]; r[2] = lo[2]; r[3] = lo[3]; r[4] = hi[0]; r[5] = hi[1]; r[6] = hi[2]; r[7] = hi[3]; return r;
}
template <bool GLA>
__device__ __forceinline__ void scan_unit(Ctx& C, int uid) {
    lds_ptr_t L = (lds_ptr_t)C.lds;
    constexpr int QS_OFF = 0, KS_OFF = 17408, VS_OFF = 34816, PS_OFF = 44032, ST_OFF = 53248, SC_OFF = 70656;
    LASQ float* acum = (LASQ float*)(L + SC_OFF); LASQ float* dtj = acum + 64; LASQ float* ei = acum + 128; LASQ float* uj = acum + 192; LASQ float* Dv = acum + 256;
    const int tid = C.tid, w = C.wave, l = C.lane, g = l >> 4, c = l & 15, q = c >> 2, p = c & 3;
    int b, dir, ldqk, ldv, ldo; const bf16_t *Qg, *Kg, *Vg; bf16_t* Og; const float* Dg = nullptr; const float* dtg = nullptr; float Aneg = 0.f, dtb = 0.f;
    if (GLA) { b = uid >> 5; const int h = (uid >> 3) & 3; dir = (uid >> 2) & 1; const int sl = uid & 3;
        const bf16_t* QKp = (const bf16_t*)(C.ws + (dir ? WS_QK : WS_QKF));
        Qg = QKp + h * 128; Kg = QKp + 512 + h * 128; ldqk = 1024; Vg = (const bf16_t*)(C.ws + WS_V) + h * 256 + sl * 64; ldv = 1024;
        Og = dir ? (bf16_t*)(C.ws + WS_OB) + h * 256 + sl * 64 : (bf16_t*)C.out + h * 256 + sl * 64; ldo = dir ? 1024 : 2048;
        Dg = (const float*)(C.ws + WS_GLAD) + (h * 2 + dir) * 128;
    } else { b = uid >> 5; const int head = (uid >> 1) & 15; dir = uid & 1; const int grp = head >> 3;
        const bf16_t* XC = (const bf16_t*)(C.ws + WS_XC);
        Qg = XC + 1280 + grp * 128; Kg = XC + 1024 + grp * 128; ldqk = 1536; Vg = XC + head * 64; ldv = 1536;
        Og = dir ? (bf16_t*)(C.ws + WS_YB) + head * 64 : (bf16_t*)C.out + 1024 + head * 64; ldo = dir ? 1024 : 2048;
        Aneg = -__expf(C.in[I_ALOG][dir * 16 + head]); dtb = C.in[I_DTB][dir * 16 + head];
        dtg = (const float*)(C.ws + WS_GDT) + 32 + dir * 16 + head;
    }
    f32x4 S[4];
#pragma unroll
    for (int t = 0; t < 4; ++t) S[t] = (f32x4){0.f, 0.f, 0.f, 0.f};
    u32x4 pq0, pq1, pk0, pk1, pv; float ps = 0.f;
    auto chunk_rc = [&](int n) { return n < 4 ? 4 * b + (dir ? 3 - n : n) : 16 + 64 * b + (dir ? 67 - n : n - 4); };
    auto prefetch = [&](int n) {
        const int rc = chunk_rc(n), row0 = rc * 64;
        const bf16_t* qp = Qg + (size_t)(row0 + (tid >> 4)) * ldqk + (tid & 15) * 8; const bf16_t* kp = Kg + (size_t)(row0 + (tid >> 4)) * ldqk + (tid & 15) * 8;
        pq0 = *(const u32x4*)qp; pq1 = *(const u32x4*)(qp + (size_t)32 * ldqk); pk0 = *(const u32x4*)kp; pk1 = *(const u32x4*)(kp + (size_t)32 * ldqk);
        pv = *(const u32x4*)(Vg + (size_t)(row0 + (tid >> 3)) * ldv + (tid & 7) * 8);
        if (GLA) { if (tid < 128) ps = Dg[(size_t)rc * 1024 + tid]; }
        else { if (tid < 64) ps = dtg[(size_t)(row0 + tid) * 64]; }
    };
    prefetch(0);
    for (int n = 0; n < 68; ++n) {
        const int rc = chunk_rc(n); const bool lat = n >= 4;
        *(LASQ u32x4*)(L + QS_OFF + (tid >> 4) * 272 + (tid & 15) * 16) = pq0; *(LASQ u32x4*)(L + QS_OFF + ((tid >> 4) + 32) * 272 + (tid & 15) * 16) = pq1;
        *(LASQ u32x4*)(L + KS_OFF + (tid >> 4) * 272 + (tid & 15) * 16) = pk0; *(LASQ u32x4*)(L + KS_OFF + ((tid >> 4) + 32) * 272 + (tid & 15) * 16) = pk1;
        *(LASQ u32x4*)(L + VS_OFF + (tid >> 3) * 144 + (tid & 7) * 16) = pv;
        if (GLA) { if (tid < 128) Dv[tid] = ps; }
        else if (w == 0) {
            const float dtv = softplusf(ps + dtb); float sa = dtv * Aneg;
#pragma unroll
            for (int o = 1; o < 64; o <<= 1) { const float t = dir ? __shfl_down(sa, o) : __shfl_up(sa, o); if (dir ? (l + o < 64) : (l >= o)) sa += t; }
            const float tot = __shfl(sa, dir ? 0 : 63);
            acum[l] = sa; dtj[l] = dtv; ei[l] = __expf(sa); uj[l] = dtv * __expf(tot - sa); if (l == 0) Dv[0] = __expf(tot);
        }
        if (lat) {
#pragma unroll
            for (int t = 0; t < 4; ++t) { u32x2 o; o.x = pk2(S[t].x, S[t].y); o.y = pk2(S[t].z, S[t].w); *(LASQ u32x2*)(L + ST_OFF + (16 * t + c) * 272 + (16 * w + 4 * g) * 2) = o; }
        }
        if (n + 1 < 68) prefetch(n + 1);
        __syncthreads();
        if (lat) {
            const int tj = w >> 1, ti0 = 2 * (w & 1);
            bf16x8 ka[4];
#pragma unroll
            for (int ks = 0; ks < 4; ++ks) ka[ks] = lds_row_frag(L, KS_OFF, 272, 16 * tj, 64 * ks, c, g);
#pragma unroll
            for (int t2 = 0; t2 < 2; ++t2) { const int ti = ti0 + t2; f32x4 acc = (f32x4){0.f, 0.f, 0.f, 0.f};
#pragma unroll
                for (int ks = 0; ks < 4; ++ks) { const bf16x8 qb = lds_row_frag(L, QS_OFF, 272, 16 * ti, 64 * ks, c, g); acc = __builtin_amdgcn_mfma_f32_16x16x32_bf16(ka[ks], qb, acc, 0, 0, 0); }
                const int i = 16 * ti + c, j0 = 16 * tj + 4 * g; float pvv[4];
                if (GLA) {
#pragma unroll
                    for (int r = 0; r < 4; ++r) { const bool ok = dir ? (j0 + r >= i) : (j0 + r <= i); pvv[r] = ok ? acc[r] : 0.f; }
                } else { const float ai = acum[i]; const f32x4 aj = *(const LASQ f32x4*)(acum + j0), dj = *(const LASQ f32x4*)(dtj + j0);
#pragma unroll
                    for (int r = 0; r < 4; ++r) { const bool ok = dir ? (j0 + r >= i) : (j0 + r <= i); pvv[r] = ok ? acc[r] * __expf(fminf(ai - aj[r], 0.f)) * dj[r] : 0.f; } }
                u32x2 o; o.x = pk2(pvv[0], pvv[1]); o.y = pk2(pvv[2], pvv[3]); *(LASQ u32x2*)(L + PS_OFF + i * 144 + j0 * 2) = o; }
        }
        {
            bf16x8 ka[2];
#pragma unroll
            for (int ks = 0; ks < 2; ++ks) ka[ks] = lds_tr_frag(L, KS_OFF, 272, 32 * ks, 16 * w, g, q, p);
            if (!GLA) {
                const float dtot = Dv[0];
#pragma unroll
                for (int ks = 0; ks < 2; ++ks) { const f32x4 u0 = *(const LASQ f32x4*)(uj + 32 * ks + 8 * g), u1 = *(const LASQ f32x4*)(uj + 32 * ks + 8 * g + 4);
                    const float uu[8] = {u0.x, u0.y, u0.z, u0.w, u1.x, u1.y, u1.z, u1.w};
#pragma unroll
                    for (int e = 0; e < 8; ++e) ka[ks][e] = (short)f2bf(bf2f((bf16_t)ka[ks][e]) * uu[e]); }
#pragma unroll
                for (int t = 0; t < 4; ++t) S[t] = S[t] * dtot;
            }
#pragma unroll
            for (int t = 0; t < 4; ++t)
#pragma unroll
                for (int ks = 0; ks < 2; ++ks) { const bf16x8 vb = lds_tr_frag(L, VS_OFF, 144, 32 * ks, 16 * t, g, q, p); S[t] = __builtin_amdgcn_mfma_f32_16x16x32_bf16(ka[ks], vb, S[t], 0, 0, 0); }
            if (GLA) { const f32x4 d = *(const LASQ f32x4*)(Dv + 16 * w + 4 * g);
#pragma unroll
                for (int t = 0; t < 4; ++t) S[t] = S[t] * d; }
        }
        __syncthreads();
        if (lat) {
            const int tdv = w >> 1, ti0 = 2 * (w & 1);
            bf16x8 va[2], sa[4];
#pragma unroll
            for (int ks = 0; ks < 2; ++ks) va[ks] = lds_tr_frag(L, VS_OFF, 144, 32 * ks, 16 * tdv, g, q, p);
#pragma unroll
            for (int ks = 0; ks < 4; ++ks) sa[ks] = lds_row_frag(L, ST_OFF, 272, 16 * tdv, 64 * ks, c, g);
            const size_t lrow0 = (size_t)(rc * 64 - T_CTX);
#pragma unroll
            for (int t2 = 0; t2 < 2; ++t2) { const int ti = ti0 + t2; f32x4 a1 = (f32x4){0.f, 0.f, 0.f, 0.f}, a2 = (f32x4){0.f, 0.f, 0.f, 0.f};
#pragma unroll
                for (int ks = 0; ks < 2; ++ks) { const bf16x8 pb = lds_row_frag(L, PS_OFF, 144, 16 * ti, 64 * ks, c, g); a1 = __builtin_amdgcn_mfma_f32_16x16x32_bf16(va[ks], pb, a1, 0, 0, 0); }
#pragma unroll
                for (int ks = 0; ks < 4; ++ks) { const bf16x8 qb = lds_row_frag(L, QS_OFF, 272, 16 * ti, 64 * ks, c, g); a2 = __builtin_amdgcn_mfma_f32_16x16x32_bf16(sa[ks], qb, a2, 0, 0, 0); }
                const int i = 16 * ti + c; f32x4 o4;
                if (GLA) o4 = a1 + a2; else o4 = a1 + a2 * ei[i];
                u32x2 o; o.x = pk2(o4.x, o4.y); o.y = pk2(o4.z, o4.w);
                *(u32x2*)(Og + (lrow0 + i) * ldo + 16 * tdv + 4 * g) = o; }
        }
        __syncthreads();
    }
}
__device__ __forceinline__ void phase4(Ctx& C) {
    for (int uid = C.bid; uid < 256; uid += C.G) { if (uid < 128) scan_unit<true>(C, uid); else scan_unit<false>(C, uid - 128); }
}

__device__ __forceinline__ void phase5(Ctx& C) {
    const int gw = C.bid * 8 + C.wave, NGW = C.G * 8;
    const bf16_t* OF = (const bf16_t*)C.out; const bf16_t* OB = (const bf16_t*)(C.ws + WS_OB); const bf16_t* YB = (const bf16_t*)(C.ws + WS_YB);
    const bf16_t* RZ = (const bf16_t*)(C.ws + WS_RZ); const bf16_t* XC = (const bf16_t*)(C.ws + WS_XC); bf16_t* YX = (bf16_t*)(C.ws + WS_YX);
    for (int l = gw; l < T_LAT; l += NGW) {
        const f32x4 gn = *(const f32x4*)(C.in[I_GNORM] + C.lane * 4);
        for (int h = 0; h < 4; ++h) {
            const int c0 = h * 256 + C.lane * 4;
            const u16x4 a = *(const u16x4*)(OF + (size_t)l * 2048 + c0), b = *(const u16x4*)(OB + (size_t)l * 1024 + c0), r = *(const u16x4*)(RZ + (size_t)l * 2048 + c0);
            float o[4], ss = 0.f;
#pragma unroll
            for (int j = 0; j < 4; ++j) { o[j] = bf2f(a[j]) + bf2f(b[j]); ss += o[j] * o[j]; }
            const float rs = rsqrtf(wave_sum(ss) * (1.f / 256.f) + EPS);
            u32x2 w; w.x = pk2(o[0] * rs * gn.x * bf2f(r[0]), o[1] * rs * gn.y * bf2f(r[1])); w.y = pk2(o[2] * rs * gn.z * bf2f(r[2]), o[3] * rs * gn.w * bf2f(r[3]));
            *(u32x2*)(YX + (size_t)l * 2048 + c0) = w;
        }
        for (int g = 0; g < 2; ++g) {
            const int c0 = g * 512 + C.lane * 8, head = c0 >> 6;
            const u16x8 a = *(const u16x8*)(OF + (size_t)l * 2048 + 1024 + c0), b = *(const u16x8*)(YB + (size_t)l * 1024 + c0), z = *(const u16x8*)(RZ + (size_t)l * 2048 + 1024 + c0),
                        xs = *(const u16x8*)(XC + (size_t)(l + T_CTX) * 1536 + c0);
            const float dsk = C.in[I_SSDD][head];
            float y[8], ss = 0.f;
#pragma unroll
            for (int j = 0; j < 8; ++j) { y[j] = (bf2f(a[j]) + bf2f(b[j]) + bf2f(xs[j]) * dsk) * bf2f(z[j]); ss += y[j] * y[j]; }
            const float rs = rsqrtf(wave_sum(ss) * (1.f / 512.f) + EPS);
            const float* nw = C.in[I_SSDN] + c0;
            u32x4 w; w.x = pk2(y[0] * rs * nw[0], y[1] * rs * nw[1]); w.y = pk2(y[2] * rs * nw[2], y[3] * rs * nw[3]); w.z = pk2(y[4] * rs * nw[4], y[5] * rs * nw[5]); w.w = pk2(y[6] * rs * nw[6], y[7] * rs * nw[7]);
            *(u32x4*)(YX + (size_t)l * 2048 + 1024 + c0) = w;
        }
    }
}

__device__ __forceinline__ void phase6(Ctx& C) {
    {
        float* scr = (float*)C.lds + 8192 + C.wave * (64 * 33);
        const int gw = C.bid * 8 + C.wave, NGW = C.G * 8;
        bf16_t* WdT = (bf16_t*)(C.ws + WS_WDT);
        for (int it = gw; it < 32 * 768; it += NGW) {
            const int e = it / 768, r = it % 768;
            if (r < 512) { const int up = r >> 8, q = r & 255, kb = q >> 4, nb = q & 15;
                const float* src = C.in[up ? I_EWU : I_EWG] + (size_t)e * 1024 * 512 + (size_t)(kb * 64) * 512 + nb * 32;
                bf16_t* dst = wgu_ptr(C.ws, e) + (size_t)(256 * (nb >> 2) + (nb & 3) * 32 + up * 128) * 1024 + kb * 64;
                transpose_tile(src, 512, dst, 1024, scr, C.lane, false); }
            else { const int q = r - 512, kb = q >> 5, nb = q & 31;
                transpose_tile(C.in[I_EWD] + (size_t)e * 512 * 1024 + (size_t)(kb * 64) * 1024 + nb * 32, 1024, WdT + (size_t)e * 1024 * 512 + (size_t)(nb * 32) * 512 + kb * 64, 512, scr, C.lane, false); }
        }
    }
    __syncthreads();
    const bf16_t* YX = (const bf16_t*)(C.ws + WS_YX); const bf16_t* WoutT = (const bf16_t*)(C.ws + WS_WOUTT);
    const float* MOD = (const float*)(C.ws + WS_MOD); const float* X = C.in[I_X]; float* HL = C.out;
    auto bsel = [=](int, int tn, int& ldb) { ldb = 2048; return WoutT + (size_t)tn * 128 * 2048; };
    auto epi = [=](int row, int tn, int cc, float v, float) { const int col = tn * 128 + cc, b = row >> 12;
        HL[(size_t)row * 1024 + col] = X[(size_t)row * 1024 + col] + MOD[b * 6144 + 2048 + col] * v; };
#if PG8_MASK & 2
    (void)bsel; (void)epi;
    SchedOut S{(const char*)YX, (const char*)WoutT, C.G, C.bid}; EpiOut E{X, MOD, HL};
    pg8::gemm_phase<EpiOut, SchedOut, false, true>((lds_ptr_t)C.lds, 2048, S, E);
#else
    gemm_simple<false>(C, YX, 2048, T_LAT / 128, 1024 / 128, 2048, bsel, epi);
#endif
}

__device__ __forceinline__ void phase7(Ctx& C) {
    const int gw = C.bid * 8 + C.wave, NGW = C.G * 8;
    const float* MOD = (const float*)(C.ws + WS_MOD); const float* HL = C.out; bf16_t* XN2 = (bf16_t*)(C.ws + WS_XN2);
    int* PE = (int*)(C.ws + WS_PAIR); int* PP = PE + 32768; float* PW = (float*)(PP + 32768);
    unsigned* cnt = (unsigned*)(C.ws + WS_CTL) + CW_CNT;
    const float* wg = C.in[I_RGW]; const float* we = C.in[I_REW];
    float* tw = (float*)C.lds + C.wave * 1024;
    const int oe = C.lane & 31, kh = C.lane >> 5, og = C.lane & 3, kp = C.lane >> 2;
    for (int l = gw; l < T_LAT; l += NGW) {
        const int b = l >> 12;
        f32x4 v[4]; float ss = 0.f;
#pragma unroll
        for (int j = 0; j < 4; ++j) { v[j] = *(const f32x4*)(HL + (size_t)l * DM + j * 256 + C.lane * 4); ss += v[j].x * v[j].x + v[j].y * v[j].y + v[j].z * v[j].z + v[j].w * v[j].w; }
        const float rs = rsqrtf(wave_sum(ss) * (1.f / DM) + EPS);
#pragma unroll
        for (int j = 0; j < 4; ++j) { const int c0 = j * 256 + C.lane * 4;
            const f32x4 g = *(const f32x4*)(C.in[I_NFFN] + c0), sh = *(const f32x4*)(MOD + b * 6144 + 3072 + c0), scl = *(const f32x4*)(MOD + b * 6144 + 4096 + c0);
            const f32x4 t = v[j] * rs * g * (1.f + scl) + sh;
            u32x2 o; o.x = pk2(t.x, t.y); o.y = pk2(t.z, t.w); *(u32x2*)(XN2 + (size_t)l * DM + c0) = o;
            *(f32x4*)(tw + c0) = t; }
        asm volatile("s_waitcnt lgkmcnt(0)" ::: "memory");
        float ae = 0.f, ag = 0.f;
        { const float* wp = we + (size_t)(kh * 512) * 32 + oe; const float* tp = tw + kh * 512;
#pragma unroll 8
            for (int k = 0; k < 512; ++k) ae += tp[k] * wp[(size_t)k * 32]; }
        { const float* wp = wg + (size_t)(kp * 64) * 4 + og; const float* tp = tw + kp * 64;
#pragma unroll 8
            for (int k = 0; k < 64; ++k) ag += tp[k] * wp[k * 4]; }
        ae += __shfl_xor(ae, 32);
        ag += __shfl_xor(ag, 4); ag += __shfl_xor(ag, 8); ag += __shfl_xor(ag, 16); ag += __shfl_xor(ag, 32);
        asm volatile("" ::: "memory");
        float gl[4]; int gs = 0; float gm = -3.4e38f;
#pragma unroll
        for (int o = 0; o < 4; ++o) { gl[o] = __shfl(ag, o) + C.in[I_RGB][o]; if (gl[o] > gm) { gm = gl[o]; gs = o; } }
        float den = 0.f;
#pragma unroll
        for (int o = 0; o < 4; ++o) den += __expf(gl[o] - gm);
        const float pg = 1.f / den;
        int i1 = 0, i2 = 0; float v1 = -3.4e38f, v2 = -3.4e38f;
#pragma unroll
        for (int o = 0; o < 8; ++o) { const float e = __shfl(ae, gs * 8 + o) + C.in[I_REB][gs * 8 + o];
            if (e > v1) { v2 = v1; i2 = i1; v1 = e; i1 = o; } else if (e > v2) { v2 = e; i2 = o; } }
        if (C.lane == 0) {
            const float e2 = __expf(v2 - v1), w1 = pg / (1.f + e2), w2 = pg * e2 / (1.f + e2);
            const int ex1 = gs * 8 + i1, ex2 = gs * 8 + i2;
            const unsigned p1 = atomicAdd(cnt + ex1, 1u), p2 = atomicAdd(cnt + ex2, 1u);
            PE[l * 2] = ex1; PE[l * 2 + 1] = ex2; PP[l * 2] = (int)p1; PP[l * 2 + 1] = (int)p2; PW[l * 2] = w1; PW[l * 2 + 1] = w2;
        }
    }
}

__device__ __forceinline__ void moe_offsets(Ctx& C, int* off) {
    if (C.tid == 0) { const unsigned* cnt = (const unsigned*)(C.ws + WS_CTL) + CW_CNT; int o = 0;
        for (int e = 0; e < 32; ++e) { off[e] = o; o += (int)((__hip_atomic_load(cnt + e, __ATOMIC_RELAXED, __HIP_MEMORY_SCOPE_AGENT) + 255u) & ~255u); } off[32] = o; }
    __syncthreads();
}


__device__ __forceinline__ void moe_tile_table(Ctx& C, const int* off, int* tile_e) {
    const int NT = off[32] >> 8;
    for (int t = C.tid; t < NT; t += NTHREADS) { int e = 0; for (int i = 1; i < 32; ++i) if (off[i] <= t * 256) e = i; tile_e[t] = e; }
    __syncthreads();
}
__device__ __forceinline__ void phase8(Ctx& C) {
    int* off = (int*)C.lds; moe_offsets(C, off);
    const int gw = C.bid * 8 + C.wave, NGW = C.G * 8;
    const int* PE = (const int*)(C.ws + WS_PAIR); const int* PP = PE + 32768; const float* PW = (const float*)(PP + 32768); int* SL = (int*)(PW + 32768); float* SW = (float*)(SL + 32768);
    const bf16_t* XN2 = (const bf16_t*)(C.ws + WS_XN2); bf16_t* XS = (bf16_t*)(C.ws + WS_XN2S);
    for (int p = gw; p < 32768; p += NGW) {
        const int slot = off[PE[p]] + PP[p];
        if (C.lane == 0) { SL[p] = slot; SW[slot] = PW[p]; }
        const u32x4* s = (const u32x4*)(XN2 + (size_t)(p >> 1) * DM); u32x4* d = (u32x4*)(XS + (size_t)slot * DM);
        d[C.lane] = s[C.lane]; d[C.lane + 64] = s[C.lane + 64];
    }
}

__device__ __forceinline__ void phase9(Ctx& C) {
    int* off = (int*)(C.lds + 131072 + 1024); moe_offsets(C, off);
    const bf16_t* XS = (const bf16_t*)(C.ws + WS_XN2S); bf16_t* H = (bf16_t*)(C.ws + WS_H); unsigned char* ws = C.ws;
    auto bsel = [=](int tm, int tn, int& ldb) { int e = 0; const int r0 = tm * 128;
        for (int i = 1; i < 32; ++i) if (off[i] <= r0) e = i;
        ldb = 1024; return (const bf16_t*)wgu_ptr(ws, e) + (size_t)tn * 256 * 1024; };
    auto epi = [=](int row, int tn, int cc, float g, float u) { H[(size_t)row * 512 + tn * 128 + cc] = (bf16_t)f2bf(siluf(g) * u); };
#if PG8_MASK & 4
    (void)bsel; (void)epi;
    int* tile_e = off + 64; moe_tile_table(C, off, tile_e);
    SchedMoe S{(const char*)XS, C.ws, tile_e, off[32] >> 8, C.G, C.bid, 1024, 0}; EpiUp E{H};
    pg8::gemm_phase<EpiUp, SchedMoe, true, true>((lds_ptr_t)C.lds, 1024, S, E);
#else
    gemm_simple<true>(C, XS, 1024, off[32] / 128, 4, 1024, bsel, epi);
#endif
}

__device__ __forceinline__ void phase10(Ctx& C) {
    int* off = (int*)(C.lds + 131072 + 1024); moe_offsets(C, off);
    const bf16_t* H = (const bf16_t*)(C.ws + WS_H); bf16_t* Y = (bf16_t*)(C.ws + WS_Y); const bf16_t* WdT = (const bf16_t*)(C.ws + WS_WDT);
    const float* SW = (const float*)(C.ws + WS_PAIR) + 4 * 32768;
    auto bsel = [=](int tm, int tn, int& ldb) { int e = 0; const int r0 = tm * 128;
        for (int i = 1; i < 32; ++i) if (off[i] <= r0) e = i;
        ldb = 512; return WdT + (size_t)e * 1024 * 512 + (size_t)tn * 128 * 512; };
    auto epi = [=](int row, int tn, int cc, float v, float) { Y[(size_t)row * 1024 + tn * 128 + cc] = (bf16_t)f2bf(v * SW[row]); };
#if PG8_MASK & 8
    (void)bsel; (void)epi;
    int* tile_e = off + 64; moe_tile_table(C, off, tile_e);
    SchedMoe S{(const char*)H, C.ws, tile_e, off[32] >> 8, C.G, C.bid, 512, 1}; EpiDown E{Y, SW};
    pg8::gemm_phase<EpiDown, SchedMoe, true, true>((lds_ptr_t)C.lds, 512, S, E);
#else
    gemm_simple<false>(C, H, 512, off[32] / 128, 8, 512, bsel, epi);
#endif
}

__device__ __forceinline__ void phase11(Ctx& C) {
    const int gw = C.bid * 8 + C.wave, NGW = C.G * 8;
    const float* MOD = (const float*)(C.ws + WS_MOD); float* HL = C.out; const bf16_t* Y = (const bf16_t*)(C.ws + WS_Y);
    const int* SL = (const int*)(C.ws + WS_PAIR) + 3 * 32768;
    for (int l = gw; l < T_LAT; l += NGW) {
        const int b = l >> 12, s1 = SL[l * 2], s2 = SL[l * 2 + 1];
        f32x4 v[4]; float ss = 0.f;
#pragma unroll
        for (int j = 0; j < 4; ++j) { const int c0 = j * 256 + C.lane * 4;
            const f32x4 hv = *(const f32x4*)(HL + (size_t)l * DM + c0), g2 = *(const f32x4*)(MOD + b * 6144 + 5120 + c0);
            const u16x4 a = *(const u16x4*)(Y + (size_t)s1 * DM + c0), bb = *(const u16x4*)(Y + (size_t)s2 * DM + c0);
            f32x4 m; m.x = bf2f(a[0]) + bf2f(bb[0]); m.y = bf2f(a[1]) + bf2f(bb[1]); m.z = bf2f(a[2]) + bf2f(bb[2]); m.w = bf2f(a[3]) + bf2f(bb[3]);
            v[j] = hv + g2 * m; ss += v[j].x * v[j].x + v[j].y * v[j].y + v[j].z * v[j].z + v[j].w * v[j].w; }
        const float rs = rsqrtf(wave_sum(ss) * (1.f / DM) + EPS);
#pragma unroll
        for (int j = 0; j < 4; ++j) { const int c0 = j * 256 + C.lane * 4; const f32x4 fn = *(const f32x4*)(C.in[I_FNORM] + c0);
            *(f32x4*)(HL + (size_t)l * DM + c0) = v[j] * rs * fn; }
    }
}


#define LAS __attribute__((address_space(3)))
#define XB_TMO      128
#define XB_XCNT(j)  (256  + 64 * (j))
#define XB_XSUB(j)  (1280 + 64 * (j))
#define XB_XGEN(j)  (2304 + 64 * (j))
#define XB_TOP      3328
#define XB_TOPGEN   3392
#define XCD_BAR_WORDS 3456
#define XB_SPIN_CAP (1u << 18)

__device__ __forceinline__ unsigned xb_ld(unsigned* p)              { return __hip_atomic_load(p, __ATOMIC_RELAXED, __HIP_MEMORY_SCOPE_AGENT); }
__device__ __forceinline__ unsigned xb_add(unsigned* p, unsigned v) { return __hip_atomic_fetch_add(p, v, __ATOMIC_RELAXED, __HIP_MEMORY_SCOPE_AGENT); }
__device__ __forceinline__ unsigned xb_xcc_id() { return (unsigned)__builtin_amdgcn_s_getreg((3 << 11) | 20) & 0xFu; }
#define XB_SPIN(cond, bar) do { unsigned _sp = 0; while (cond) { __builtin_amdgcn_s_sleep(1); \
    if ((++_sp & 255u) == 0u) { if (xb_ld(&(bar)[XB_TMO])) break; if (_sp > XB_SPIN_CAP) { atomicAdd(&(bar)[XB_TMO], 1u); break; } } } } while (0)

struct XcdBarrier {
    unsigned* bar; unsigned x;
    volatile LAS unsigned* st;
};

__device__ __forceinline__ XcdBarrier xcd_barrier_post(unsigned* bar, volatile LAS unsigned* st) {
    XcdBarrier b; b.bar = bar; b.x = xb_xcc_id(); b.st = st;
    if (threadIdx.x == 0) (void)xb_add(&bar[XB_XCNT(b.x)], 1u);
    return b;
}
__device__ __forceinline__ void xcd_barrier_complete(unsigned* bar, unsigned x, unsigned& nloc, unsigned& nx) {
    const unsigned G = gridDim.x * gridDim.y * gridDim.z;
    unsigned sum, cnt, mine, sp = 0u;
    for (;;) {
        sum = 0u; cnt = 0u; mine = 0u;
#pragma unroll
        for (unsigned j = 0; j < 16; ++j) { const unsigned c = xb_ld(&bar[XB_XCNT(j)]); sum += c; cnt += (c > 0u) ? 1u : 0u; mine = (j == x) ? c : mine; }
        if (sum == G) break;
        __builtin_amdgcn_s_sleep(1);
        if ((++sp & 255u) == 0u) { if (xb_ld(&bar[XB_TMO])) break; if (sp > XB_SPIN_CAP) { atomicAdd(&bar[XB_TMO], 1u); break; } }
    }
    nloc = mine > 0u ? mine : 1u; nx = cnt > 0u ? cnt : 1u;
}

__device__ __forceinline__ void xcd_barrier(const XcdBarrier& b) {
    asm volatile("s_waitcnt vmcnt(0)" ::: "memory");
    __syncthreads();
    if (threadIdx.x == 0) {
        unsigned* bar = b.bar;
        __builtin_amdgcn_s_waitcnt(0);
        unsigned nloc = b.st[0], nx = b.st[1];
        if (nloc == 0u) { xcd_barrier_complete(bar, b.x, nloc, nx); b.st[0] = nloc; b.st[1] = nx; }
        const unsigned old = xb_add(&bar[XB_XSUB(b.x)], 1u);
        const unsigned gen = old / nloc;
        if (old + 1u == (gen + 1u) * nloc) {
            __builtin_amdgcn_fence(__ATOMIC_RELEASE, "agent");
            asm volatile("s_waitcnt vmcnt(0)" ::: "memory");
            const unsigned og = xb_add(&bar[XB_TOP], 1u);
            const unsigned tg = og / nx;
            if (og + 1u == (tg + 1u) * nx) xb_add(&bar[XB_TOPGEN], 1u);
            else XB_SPIN(xb_ld(&bar[XB_TOPGEN]) == tg, bar);
            __builtin_amdgcn_fence(__ATOMIC_ACQUIRE, "agent");
            xb_add(&bar[XB_XGEN(b.x)], 1u);
            asm volatile("s_waitcnt vmcnt(0)" ::: "memory");
        } else {
            XB_SPIN(xb_ld(&bar[XB_XGEN(b.x)]) == gen, bar);
            __builtin_amdgcn_fence(__ATOMIC_ACQUIRE, "agent");
            asm volatile("s_waitcnt vmcnt(0)" ::: "memory");
        }
    }
    __syncthreads();
}

__global__ void __launch_bounds__(NTHREADS, 2) fwd_kernel(Args a) {
    extern __shared__ __attribute__((aligned(16))) unsigned char lds[];
    Ctx C;
#pragma unroll
    for (int i = 0; i < 27; ++i) C.in[i] = a.in[i];
    C.out = a.out; C.ws = a.ws; C.lds = lds;
    C.tid = threadIdx.x; C.lane = C.tid & 63; C.wave = __builtin_amdgcn_readfirstlane(C.tid >> 6); C.bid = blockIdx.x; C.G = gridDim.x;
#if MK_COOP
    cg::grid_group grid = cg::this_grid();
    if (C.tid < 2) ((LAS unsigned*)(lds + 131072 + 64))[C.tid] = 0u;
    __syncthreads();
    XcdBarrier xbar = xcd_barrier_post((unsigned*)(C.ws + WS_CTL) + CW_BAR, (volatile LAS unsigned*)(lds + 131072 + 64));
#define SEAM(k) do { if ((k) + 1 < a.ph_hi) { if ((k) == 0) grid.sync(); else xcd_barrier(xbar); } } while (0)
#else
#define SEAM(k) do { } while (0)
#endif
#define IN(k) (a.ph_lo <= (k) && (k) < a.ph_hi)
    if (IN(0)) { phase0(C); SEAM(0); }
    if (IN(1)) { phase1(C); SEAM(1); }
    if (IN(2)) { phase2(C); SEAM(2); }
    if (IN(3)) { phase3(C); SEAM(3); }
#ifdef SCAN_NAIVE
    if (IN(4)) { phase4_naive(C); SEAM(4); }
#else
    if (IN(4)) { phase4(C); SEAM(4); }
#endif
    if (IN(5)) { phase5(C); SEAM(5); }
    if (IN(6)) { phase6(C); SEAM(6); }
    if (IN(7)) { phase7(C); SEAM(7); }
    if (IN(8)) { phase8(C); SEAM(8); }
    if (IN(9)) { phase9(C); SEAM(9); }
    if (IN(10)) { phase10(C); SEAM(10); }
    if (IN(11)) { phase11(C); }
}

extern "C" void kernel_launch(void* const* d_in, const int* in_sizes, int n_in, void* d_out, int out_size, void* d_ws, size_t ws_size, hipStream_t stream) {
    static int grid = 0;
    if (grid == 0) {
        if (n_in != 27 || out_size != T_LAT * DM || ws_size < WS_END) { fprintf(stderr, "kernel_launch: unexpected shapes: n_in %d out %d ws %zu (need %zu)\n", n_in, out_size, ws_size, (size_t)WS_END); grid = -1; return; }
        int dev = 0, cus = 0, per_cu = 0;
        hipGetDevice(&dev); hipDeviceGetAttribute(&cus, hipDeviceAttributeMultiprocessorCount, dev);
        hipFuncSetAttribute((const void*)fwd_kernel, hipFuncAttributeMaxDynamicSharedMemorySize, LDS_BYTES);
        hipOccupancyMaxActiveBlocksPerMultiprocessor(&per_cu, (const void*)fwd_kernel, NTHREADS, LDS_BYTES);
        if (per_cu < 1) { fprintf(stderr, "kernel_launch: occupancy query says %d blocks per CU\n", per_cu); per_cu = 1; }
        (void)hipGetLastError();
        grid = cus;
        fprintf(stderr, "kernel_launch: grid %d, per_cu %d, ws %zu\n", grid, per_cu, ws_size);
    }
    if (grid < 0) return;
    hipMemsetAsync((char*)d_ws + WS_CTL, 0, CTL_BYTES, stream);
    Args a{};
    for (int i = 0; i < 27; ++i) a.in[i] = (const float*)d_in[i];
    a.out = (float*)d_out; a.ws = (unsigned char*)d_ws;
#if MK_COOP
    a.ph_lo = 0; a.ph_hi = NPH;
    void* args[] = {&a};
    hipError_t e = hipLaunchCooperativeKernel((const void*)fwd_kernel, dim3(grid), dim3(NTHREADS), args, LDS_BYTES, stream);
    if (e != hipSuccess) fprintf(stderr, "cooperative launch failed: %s (grid %d)\n", hipGetErrorString(e), grid);
#else
    for (int p = 0; p < NPH; ++p) { a.ph_lo = p; a.ph_hi = p + 1; hipLaunchKernelGGL(fwd_kernel, dim3(grid), dim3(NTHREADS), LDS_BYTES, stream, a); }
#endif
}
```

```cpp
#include <hip/hip_runtime.h>
#include <hip/hip_cooperative_groups.h>
#include <cstdio>
#include <cstdint>
namespace cg = cooperative_groups;

#ifndef MK_COOP
#define MK_COOP 1
#endif

constexpr int NB = 4, SEQ = 4096, DM = 1024, CTXL = 256;
constexpr int T_CTX = NB * CTXL, T_LAT = NB * SEQ, T_ALL = T_CTX + T_LAT;
constexpr float EPS = 1e-6f;
constexpr int NW_IN = 5888;
constexpr int NPH = 12;
constexpr int NTHREADS = 512;
constexpr int LDS_BYTES = 147456;

typedef unsigned short bf16_t;
typedef float f32x4 __attribute__((ext_vector_type(4)));
typedef unsigned u32x4 __attribute__((ext_vector_type(4)));
typedef unsigned u32x2 __attribute__((ext_vector_type(2)));
typedef unsigned short u16x8 __attribute__((ext_vector_type(8)));
typedef unsigned short u16x4 __attribute__((ext_vector_type(4)));
#define LASQ __attribute__((address_space(3)))
typedef __attribute__((address_space(3))) unsigned char* lds_ptr_t;

constexpr size_t MiB = 1u << 20;
constexpr size_t WS_QK = 0;
constexpr size_t WS_XBC = 34 * MiB;
constexpr size_t WS_OB = 34 * MiB;
constexpr size_t WS_QKF = 85 * MiB;
constexpr size_t WS_XN = 85 * MiB;
constexpr size_t WS_YX = 85 * MiB;
constexpr size_t WS_V = 119 * MiB;
constexpr size_t WS_XC = 153 * MiB;
constexpr size_t WS_WINT = 153 * MiB;
constexpr size_t WS_RZ = 204 * MiB;
constexpr size_t WS_XN2 = 204 * MiB;
constexpr size_t WS_YB = 268 * MiB;
constexpr size_t WS_GDT = 300 * MiB;
constexpr size_t WS_WOUTT = 305 * MiB;
constexpr size_t WS_MOD = 309 * MiB;
constexpr size_t WS_GLAD = WS_MOD + 256 * 1024;
constexpr size_t WS_CTL = 311 * MiB;
constexpr size_t CTL_BYTES = 64 * 1024;
constexpr size_t WS_PAIR = WS_GLAD + 1088 * 1024;
constexpr size_t WS_ACUM = 311 * MiB + 64 * 1024;
constexpr size_t WS_END = WS_ACUM + (size_t)T_ALL * 32 * 4;
constexpr size_t WS_WDT = 0;
constexpr size_t WS_WGU_LO = 34 * MiB;
constexpr size_t WS_WGU_HI = 268 * MiB;
constexpr size_t WS_H = 66 * MiB;
constexpr size_t WS_XN2S = 106 * MiB;
constexpr size_t WS_Y = 106 * MiB;
constexpr int MAX_SLOTS = 40960;
constexpr int CW_CNT = 0;
constexpr int CW_BAR = 1024;

__device__ __forceinline__ float bf2f(bf16_t v) { return __uint_as_float((unsigned)v << 16); }
__device__ __forceinline__ unsigned f2bf(float f) { unsigned u = __float_as_uint(f); return (u + 0x7fffu + ((u >> 16) & 1u)) >> 16; }
typedef float f32x2 __attribute__((ext_vector_type(2)));
typedef __bf16 bf16x2_t __attribute__((ext_vector_type(2)));
__device__ __forceinline__ unsigned pk2(float lo, float hi) { const f32x2 v = {lo, hi}; return __builtin_bit_cast(unsigned, __builtin_convertvector(v, bf16x2_t)); }
__device__ __forceinline__ float siluf(float x) { return x / (1.f + __expf(-x)); }
__device__ __forceinline__ float softplusf(float x) { return fmaxf(x, 0.f) + log1pf(__expf(-fabsf(x))); }
__device__ __forceinline__ float logsigf(float x) { return fminf(x, 0.f) - log1pf(__expf(-fabsf(x))); }
__device__ __forceinline__ float wave_sum(float v) {
#pragma unroll
    for (int o = 1; o < 64; o <<= 1) v += __shfl_xor(v, o);
    return v;
}

struct Args { const float* in[27]; float* out; unsigned char* ws; int ph_lo, ph_hi; };
enum { I_X = 0, I_C, I_CTX, I_CCTX, I_WADA, I_BADA, I_NMIX, I_NFFN, I_WIN, I_GWUP, I_GB, I_GNORM, I_CONVW, I_CONVB, I_DTB, I_ALOG, I_SSDD, I_SSDN,
       I_WOUT, I_RGW, I_RGB, I_REW, I_REB, I_EWG, I_EWU, I_EWD, I_FNORM };

constexpr int CTRL_OFF = LDS_BYTES - 4096;
constexpr int PTAB_OFF = CTRL_OFF + 128;
struct InTab {
    unsigned char* lds;
    __device__ __forceinline__ const float* operator[](int i) const {
        const unsigned long long v = *(const __attribute__((address_space(3))) unsigned long long*)((__attribute__((address_space(3))) unsigned char*)lds + PTAB_OFF + 8 * i);
        const unsigned lo = __builtin_amdgcn_readfirstlane((unsigned)v), hi = __builtin_amdgcn_readfirstlane((unsigned)(v >> 32));
        return (const float*)(const __attribute__((address_space(1))) float*)(((unsigned long long)hi << 32) | lo);
    }
};
struct Ctx {
    InTab in; float* out; unsigned char* ws; unsigned char* lds;
    int tid, lane, wave, bid, G;
};

__device__ __forceinline__ void transpose_tile(const float* src  , int ldw, bf16_t* dst  , int ldt, float* scr, int lane, bool zero) {
#pragma unroll 8
    for (int i = 0; i < 32; ++i) { const int kk = 2 * i + (lane >> 5); scr[kk * 33 + (lane & 31)] = zero ? 0.f : src[(size_t)kk * ldw + (lane & 31)]; }
    asm volatile("s_waitcnt lgkmcnt(0)" ::: "memory");
    const int c = lane & 7;
#pragma unroll
    for (int j = 0; j < 4; ++j) { const int n = (lane >> 3) + 8 * j; const float* s = scr + (8 * c) * 33 + n;
        u32x4 o; o.x = pk2(s[0 * 33], s[1 * 33]); o.y = pk2(s[2 * 33], s[3 * 33]); o.z = pk2(s[4 * 33], s[5 * 33]); o.w = pk2(s[6 * 33], s[7 * 33]);
        *(u32x4*)(dst + (size_t)n * ldt + 8 * c) = o; }
    asm volatile("s_waitcnt lgkmcnt(0)" ::: "memory");
}

__device__ __forceinline__ int win_src_col(int n) {
    if (n < 3072) return n;
    if (n < 4096) return 3104 + (n - 3072);
    if (n < 5632) return 4128 + (n - 4096);
    if (n < 5664) return 3072 + (n - 5632);
    if (n < 5696) return 5664 + (n - 5664);
    return -1;
}

__device__ __forceinline__ void phase0(Ctx& C) {
    float* lds = (float*)C.lds;
    const int gw = C.bid * 8 + C.wave, NGW = C.G * 8;
    {
        float* scr = lds + 8192 + C.wave * (64 * 33);
        bf16_t* WinT = (bf16_t*)(C.ws + WS_WINT); bf16_t* WoutT = (bf16_t*)(C.ws + WS_WOUTT);
        constexpr int IT_IN = 16 * (NW_IN / 32), IT_OUT = 32 * 32;
        for (int it = gw; it < IT_IN + IT_OUT; it += NGW) {
            if (it < IT_IN) { const int kb = it / (NW_IN / 32), nb = it % (NW_IN / 32); const int sc = win_src_col(nb * 32);
                transpose_tile(C.in[I_WIN] + (size_t)(kb * 64) * 5696 + (sc < 0 ? 0 : sc), 5696, WinT + (size_t)(nb * 32) * 1024 + kb * 64, 1024, scr, C.lane, sc < 0); }
            else { const int r = it - IT_IN, kb = r / 32, nb = r % 32;
                transpose_tile(C.in[I_WOUT] + (size_t)(kb * 64) * 1024 + nb * 32, 1024, WoutT + (size_t)(nb * 32) * 2048 + kb * 64, 2048, scr, C.lane, false); }
        }
    }
    __syncthreads();
    float* sc = lds;
    float* red = lds + 5120;
    for (int i = C.tid; i < 5 * 1024; i += NTHREADS) { const int r = i >> 10, k = i & 1023; const float v = r < 4 ? C.in[I_C][r * 1024 + k] : C.in[I_CCTX][k]; sc[i] = siluf(v); }
    __syncthreads();
    float* MOD = (float*)(C.ws + WS_MOD); const float* wada = C.in[I_WADA]; const float* bada = C.in[I_BADA];
    for (int grp = C.bid; grp < 192; grp += C.G) {
        const int col = grp * 32 + (C.tid & 31), kg = C.tid >> 5;
        float acc[5] = {0.f, 0.f, 0.f, 0.f, 0.f};
        for (int k = kg; k < 1024; k += 16) { const float w = wada[(size_t)k * 6144 + col];
#pragma unroll
            for (int i = 0; i < 5; ++i) acc[i] += sc[i * 1024 + k] * w; }
#pragma unroll
        for (int i = 0; i < 5; ++i) red[(kg * 5 + i) * 32 + (C.tid & 31)] = acc[i];
        __syncthreads();
        if (C.tid < 160) { const int i = C.tid >> 5, c = C.tid & 31; float s = 0.f;
            for (int g = 0; g < 16; ++g) s += red[(g * 5 + i) * 32 + c];
            MOD[i * 6144 + grp * 32 + c] = s + bada[grp * 32 + c]; }
        __syncthreads();
    }
}

__device__ __forceinline__ const float* tok_row(const float* xin, const float* cin, int row, int& mi) {
    if (row < T_CTX) { mi = 4; return cin + (size_t)row * DM; }
    mi = (row - T_CTX) >> 12; return xin + (size_t)(row - T_CTX) * DM;
}

__device__ __forceinline__ void phase1(Ctx& C) {
    const int gw = C.bid * 8 + C.wave, NGW = C.G * 8;
    const float* MOD = (const float*)(C.ws + WS_MOD); bf16_t* XN = (bf16_t*)(C.ws + WS_XN);
    const float* xin = C.in[I_X]; const float* cin = C.in[I_CTX]; const float* nmix = C.in[I_NMIX];
    for (int row = gw; row < T_ALL; row += NGW) {
        int mi; const float* xr = tok_row(xin, cin, row, mi);
        f32x4 v[4]; float ss = 0.f;
#pragma unroll
        for (int j = 0; j < 4; ++j) { v[j] = *(const f32x4*)(xr + j * 256 + C.lane * 4); ss += v[j].x * v[j].x + v[j].y * v[j].y + v[j].z * v[j].z + v[j].w * v[j].w; }
        const float rs = rsqrtf(wave_sum(ss) * (1.f / DM) + EPS);
#pragma unroll
        for (int j = 0; j < 4; ++j) { const int c0 = j * 256 + C.lane * 4;
            const f32x4 g = *(const f32x4*)(nmix + c0), sh = *(const f32x4*)(MOD + mi * 6144 + c0), scl = *(const f32x4*)(MOD + mi * 6144 + 1024 + c0);
            const f32x4 y = v[j] * rs * g * (1.f + scl) + sh;
            u32x2 o; o.x = pk2(y.x, y.y); o.y = pk2(y.z, y.w); *(u32x2*)(XN + (size_t)row * DM + c0) = o; }
    }
}

template <bool DUAL, class BSel, class Epi>
__device__ __forceinline__ void gemm_simple(Ctx& C, const bf16_t* A, int lda, int Mtiles, int Ntiles, int K, BSel bsel, Epi epi) {
    float* As = (float*)C.lds;
    float* Bs = As + 32 * 132;
    float* Bs2 = Bs + 32 * 132;
    const int ty = C.tid >> 4, tx = C.tid & 15;
    const int lr = C.tid >> 2, lk = (C.tid & 3) * 8;
    for (int tile = C.bid; tile < Mtiles * Ntiles; tile += C.G) {
        const int tm = tile / Ntiles, tn = tile % Ntiles;
        int ldb; const bf16_t* Bt = bsel(tm, tn, ldb);
        float acc[4][8], acc2[DUAL ? 4 : 1][8];
#pragma unroll
        for (int i = 0; i < 4; ++i)
#pragma unroll
            for (int j = 0; j < 8; ++j) { acc[i][j] = 0.f; if constexpr (DUAL) acc2[i][j] = 0.f; }
        const bf16_t* ap = A + (size_t)(tm * 128 + lr) * lda + lk;
        const bf16_t* bp = Bt + (size_t)lr * ldb + lk;
        for (int k0 = 0; k0 < K; k0 += 32) {
            const u16x8 av = *(const u16x8*)(ap + k0), bv = *(const u16x8*)(bp + k0);
            u16x8 bv2 = bv; if constexpr (DUAL) bv2 = *(const u16x8*)(bp + (size_t)128 * ldb + k0);
            __syncthreads();
#pragma unroll
            for (int j = 0; j < 8; ++j) { As[(lk + j) * 132 + lr] = bf2f(av[j]); Bs[(lk + j) * 132 + lr] = bf2f(bv[j]); if constexpr (DUAL) Bs2[(lk + j) * 132 + lr] = bf2f(bv2[j]); }
            __syncthreads();
#pragma unroll 8
            for (int k = 0; k < 32; ++k) {
                const f32x4 a = *(const f32x4*)(As + k * 132 + ty * 4);
                const f32x4 b0 = *(const f32x4*)(Bs + k * 132 + tx * 8), b1 = *(const f32x4*)(Bs + k * 132 + tx * 8 + 4);
                const float af[4] = {a.x, a.y, a.z, a.w}; const float bf[8] = {b0.x, b0.y, b0.z, b0.w, b1.x, b1.y, b1.z, b1.w};
#pragma unroll
                for (int i = 0; i < 4; ++i)
#pragma unroll
                    for (int j = 0; j < 8; ++j) acc[i][j] += af[i] * bf[j];
                if constexpr (DUAL) {
                    const f32x4 c0 = *(const f32x4*)(Bs2 + k * 132 + tx * 8), c1 = *(const f32x4*)(Bs2 + k * 132 + tx * 8 + 4);
                    const float cf[8] = {c0.x, c0.y, c0.z, c0.w, c1.x, c1.y, c1.z, c1.w};
#pragma unroll
                    for (int i = 0; i < 4; ++i)
#pragma unroll
                        for (int j = 0; j < 8; ++j) acc2[i][j] += af[i] * cf[j];
                }
            }
        }
#pragma unroll
        for (int i = 0; i < 4; ++i)
#pragma unroll
            for (int j = 0; j < 8; ++j) { float a2 = 0.f; if constexpr (DUAL) a2 = acc2[i][j]; epi(tm * 128 + ty * 4 + i, tn, tx * 8 + j, acc[i][j], a2); }
        __syncthreads();
    }
}


namespace pg8 {
#define PG8_LAS __attribute__((address_space(3)))
typedef short bf16x8 __attribute__((ext_vector_type(8)));
constexpr int BM = 256, BK = 64, HALF = 128, HTB = HALF * BK * 2  , STAGE_BYTES = 8 * HTB, NXCD = 8, WGM = 8;
__host__ __device__ __forceinline__ int lds_byte(int r, int c) { const int st = (r >> 4) * 2 + (c >> 5), rr = r & 15, cc = c & 31, ob = rr * 64 + cc * 2; return st * 1024 + (ob ^ (((ob >> 9) & 1) << 5)); }
__host__ __device__ __forceinline__ void stage_rc(int b, int& R, int& C) { const int st = b / 1024, sb = b % 1024, swz = sb ^ (((sb >> 9) & 1) << 5); R = (st >> 1) * 16 + swz / 64; C = (st & 1) * 32 + (swz % 64) / 2; }
__host__ __device__ __forceinline__ int perm32(int rho) { const int n = rho >> 4, i = rho & 15; return 8 * (i >> 2) + 4 * n + (i & 3); }
struct Unit { int pm, pn; };
__device__ __forceinline__ unsigned cvt_pk_bf16(float lo, float hi) { unsigned r; asm volatile("v_cvt_pk_bf16_f32 %0, %1, %2" : "=v"(r) : "v"(lo), "v"(hi)); return r; }
__device__ __forceinline__ int xcd_remap(int L, int nwg) { const int q = nwg / NXCD, r = nwg % NXCD, xcd = L % NXCD, off = L / NXCD; return (xcd < r ? xcd * (q + 1) : r * (q + 1) + (xcd - r) * q) + off; }
template <class Epi, class Sched, bool ALIGN_EPI = false, bool SP2 = false>
__device__ __forceinline__ void gemm_phase(PG8_LAS unsigned char* lds, const int K_, const Sched& S, const Epi& E) {
    const int tid = threadIdx.x, wid = __builtin_amdgcn_readfirstlane(tid >> 6), lane = tid & 63, wr = wid >> 2, wc = wid & 3, fr = lane & 15, fq = lane >> 4;
    const int K = K_, nt = K / BK;
    unsigned voffA[2], voffB[2];
#pragma unroll
    for (int i = 0; i < 2; ++i) { int R, C; stage_rc(tid * 16 + i * 8192, R, C); const int Rb = Epi::PERM ? ((R & ~31) + perm32(R & 31)) : R;
        voffA[i] = (unsigned)(R * K + C) * 2u; voffB[i] = (unsigned)(Rb * K + C) * 2u; }
    const size_t kstep = (size_t)(BK * 2);
    const size_t hstep = (size_t)HALF * K * 2;
    const unsigned ldsw = (unsigned)wid * 1024u;
    const int aoff = lds_byte(wr * 64 + fr, fq * 8), boff = lds_byte(wc * 32 + fr, fq * 8);
#define PG8_SA(b, h) (((b) * 2 + (h)) * HTB)
#define PG8_SB(b, h) ((4 + (b) * 2 + (h)) * HTB)
#define PG8_STAGE(bufoff, gbase, voff) do { _Pragma("unroll") for (int _i = 0; _i < 2; ++_i) \
        __builtin_amdgcn_global_load_lds((const unsigned*)((const char*)(gbase) + (voff)[_i]), (PG8_LAS unsigned*)(lds + (bufoff) + ldsw + _i * 8192), 16, 0, 0); } while (0)
#define PG8_LDA(dst, b, h) do { _Pragma("unroll") for (int m = 0; m < 4; ++m) _Pragma("unroll") for (int k = 0; k < 2; ++k) dst[m][k] = *(const PG8_LAS bf16x8*)(lds + PG8_SA(b, h) + aoff + m * 2048 + k * 1024); } while (0)
#define PG8_LDB(dst, b, h) do { _Pragma("unroll") for (int n = 0; n < 2; ++n) _Pragma("unroll") for (int k = 0; k < 2; ++k) dst[n][k] = *(const PG8_LAS bf16x8*)(lds + PG8_SB(b, h) + boff + n * 2048 + k * 1024); } while (0)
#define PG8_MMA(ai, bj, At, Bt) do { __builtin_amdgcn_s_setprio(1); _Pragma("unroll") for (int m = 0; m < 4; ++m) _Pragma("unroll") for (int n = 0; n < 2; ++n) _Pragma("unroll") for (int k = 0; k < 2; ++k) \
        acc[ai][bj][m][n] = __builtin_amdgcn_mfma_f32_16x16x32_bf16(Bt[n][k], At[m][k], acc[ai][bj][m][n], 0, 0, 0); __builtin_amdgcn_s_setprio(0); } while (0)
#define PG8_WAIT_V(n) asm volatile("s_waitcnt vmcnt(" #n ")" ::: "memory")
#define PG8_WAIT_L(n) asm volatile("s_waitcnt lgkmcnt(" #n ")" ::: "memory")
#define PG8_BAR __builtin_amdgcn_s_barrier()
#define PG8_SCHED __builtin_amdgcn_sched_barrier(0)
    Unit cur, nxt; int ui = 0;
    if (!S.next(0, cur)) return;
    f32x4 acc[2][2][4][2];
#pragma unroll
    for (int a = 0; a < 2; ++a)
#pragma unroll
        for (int b = 0; b < 2; ++b)
#pragma unroll
            for (int m = 0; m < 4; ++m)
#pragma unroll
                for (int n = 0; n < 2; ++n) acc[a][b][m][n] = (f32x4){0.f, 0.f, 0.f, 0.f};
    bf16x8 At[4][2], B0[2][2], B1[2][2];
    const char* cA = S.a_ptr(cur); const char* cB = S.b_ptr(cur);
    S.a_ready(cur);
    if constexpr (SP2) {
        PG8_STAGE(PG8_SB(0, 0), cB, voffB); PG8_STAGE(PG8_SB(0, 1), cB + hstep, voffB); PG8_STAGE(PG8_SA(0, 0), cA, voffA); PG8_STAGE(PG8_SA(0, 1), cA + hstep, voffA);
        if (wr == 1) PG8_BAR;
        PG8_WAIT_V(2); PG8_BAR;
        PG8_STAGE(PG8_SB(1, 0), cB + kstep, voffB); PG8_STAGE(PG8_SA(1, 0), cA + kstep, voffA); PG8_STAGE(PG8_SB(1, 1), cB + hstep + kstep, voffB);
        PG8_WAIT_V(6); PG8_BAR;
    } else {
        PG8_STAGE(PG8_SB(0, 0), cB, voffB); PG8_STAGE(PG8_SA(0, 0), cA, voffA); PG8_STAGE(PG8_SB(0, 1), cB + hstep, voffB); PG8_STAGE(PG8_SA(0, 1), cA + hstep, voffA);
        if (wr == 1) PG8_BAR;
        PG8_WAIT_V(4); PG8_BAR;
        PG8_STAGE(PG8_SB(1, 0), cB + kstep, voffB); PG8_STAGE(PG8_SA(1, 0), cA + kstep, voffA); PG8_STAGE(PG8_SB(1, 1), cB + hstep + kstep, voffB);
        PG8_WAIT_V(6); PG8_BAR;
    }
    for (;;) {
        const bool has_next = S.next(ui + 1, nxt);
        const char* nA = has_next ? S.a_ptr(nxt) : cA; const char* nB = has_next ? S.b_ptr(nxt) : cB;
        for (int t = 0; t < nt; t += 2) {
            const bool last = (t == nt - 2);
            const char* a1 = cA + (size_t)(t + 1) * kstep;
            const char* a2 = last ? nA : cA + (size_t)(t + 2) * kstep; const char* b2 = last ? nB : cB + (size_t)(t + 2) * kstep;
            const char* a3 = a2 + kstep; const char* b3 = b2 + kstep;
            if (last && has_next) S.a_ready(nxt);
            if constexpr (SP2) {
            PG8_LDB(B0, 0, 0); PG8_LDB(B1, 0, 1); PG8_SCHED; PG8_LDA(At, 0, 0); PG8_STAGE(PG8_SA(1, 1), a1 + hstep, voffA);
            PG8_WAIT_V(8); PG8_WAIT_L(0); PG8_BAR; PG8_MMA(0, 0, At, B0); PG8_MMA(0, 1, At, B1); PG8_BAR; PG8_SCHED;
            PG8_LDA(At, 0, 1); PG8_STAGE(PG8_SB(0, 0), b2, voffB); PG8_STAGE(PG8_SB(0, 1), b2 + hstep, voffB); PG8_STAGE(PG8_SA(0, 0), a2, voffA);
            PG8_WAIT_V(8); PG8_WAIT_L(0); PG8_BAR; PG8_MMA(1, 0, At, B0); PG8_MMA(1, 1, At, B1); PG8_BAR; PG8_SCHED;
            PG8_LDB(B0, 1, 0); PG8_LDB(B1, 1, 1); PG8_SCHED; PG8_LDA(At, 1, 0); PG8_STAGE(PG8_SA(0, 1), a2 + hstep, voffA);
            PG8_WAIT_V(8); PG8_WAIT_L(0); PG8_BAR; PG8_MMA(0, 0, At, B0); PG8_MMA(0, 1, At, B1); PG8_BAR; PG8_SCHED;
            PG8_LDA(At, 1, 1); PG8_STAGE(PG8_SB(1, 0), b3, voffB); PG8_STAGE(PG8_SB(1, 1), b3 + hstep, voffB); PG8_STAGE(PG8_SA(1, 0), a3, voffA);
            PG8_WAIT_V(8); PG8_WAIT_L(0); PG8_BAR; PG8_MMA(1, 0, At, B0); PG8_MMA(1, 1, At, B1); PG8_BAR; PG8_SCHED;
            } else {
            PG8_LDB(B0, 0, 0); PG8_SCHED; PG8_LDA(At, 0, 0); PG8_STAGE(PG8_SA(1, 1), a1 + hstep, voffA);
            PG8_WAIT_L(8); PG8_BAR; PG8_WAIT_L(0); PG8_MMA(0, 0, At, B0); PG8_BAR; PG8_SCHED;
            PG8_LDB(B1, 0, 1); PG8_STAGE(PG8_SB(0, 0), b2, voffB);
            PG8_BAR; PG8_WAIT_L(0); PG8_MMA(0, 1, At, B1); PG8_BAR;
            PG8_LDA(At, 0, 1); PG8_STAGE(PG8_SA(0, 0), a2, voffA);
            PG8_BAR; PG8_WAIT_L(0); PG8_MMA(1, 0, At, B0); PG8_BAR; PG8_SCHED;
            PG8_STAGE(PG8_SB(0, 1), b2 + hstep, voffB);
            PG8_WAIT_V(6); PG8_BAR; PG8_MMA(1, 1, At, B1); PG8_BAR;
            PG8_LDB(B0, 1, 0); PG8_SCHED; PG8_LDA(At, 1, 0); PG8_STAGE(PG8_SA(0, 1), a2 + hstep, voffA);
            PG8_WAIT_L(8); PG8_BAR; PG8_WAIT_L(0); PG8_MMA(0, 0, At, B0); PG8_BAR; PG8_SCHED;
            PG8_LDB(B1, 1, 1); PG8_STAGE(PG8_SB(1, 0), b3, voffB);
            PG8_BAR; PG8_WAIT_L(0); PG8_MMA(0, 1, At, B1); PG8_BAR;
            PG8_LDA(At, 1, 1); PG8_STAGE(PG8_SA(1, 0), a3, voffA);
            PG8_BAR; PG8_WAIT_L(0); PG8_MMA(1, 0, At, B0); PG8_BAR; PG8_SCHED;
            PG8_STAGE(PG8_SB(1, 1), b3 + hstep, voffB);
            PG8_WAIT_V(6); PG8_BAR; PG8_MMA(1, 1, At, B1); PG8_BAR;
            }
        }
        if constexpr (ALIGN_EPI) { if (wr == 0) PG8_BAR; }
        if constexpr (!Epi::AFTER_DRAIN) { E(acc, cur, wr, wc, fr, fq); S.done(cur); }
        if (!has_next) break;
#pragma unroll
        for (int a = 0; a < 2; ++a)
#pragma unroll
            for (int b = 0; b < 2; ++b)
#pragma unroll
                for (int m = 0; m < 4; ++m)
#pragma unroll
                    for (int n = 0; n < 2; ++n) acc[a][b][m][n] = (f32x4){0.f, 0.f, 0.f, 0.f};
        cur = nxt; cA = nA; cB = nB; ++ui;
        if constexpr (ALIGN_EPI) { if (wr == 1) PG8_BAR; }
    }
    PG8_WAIT_V(0);
    if constexpr (!ALIGN_EPI) { if (wr == 0) PG8_BAR; }
    PG8_BAR;
    if constexpr (Epi::AFTER_DRAIN) { E.fused(acc, cur, wr, wc, fr, fq, lds, wid, lane); S.done(cur); }
#undef PG8_SA
#undef PG8_SB
#undef PG8_STAGE
#undef PG8_LDA
#undef PG8_LDB
#undef PG8_MMA
#undef PG8_WAIT_V
#undef PG8_WAIT_L
#undef PG8_BAR
#undef PG8_SCHED
}
}

__device__ __forceinline__ bf16_t* wgu_ptr(unsigned char* ws, int e) { return (bf16_t*)(ws + (e < 16 ? WS_WGU_LO : WS_WGU_HI)) + (size_t)(e & 15) * 1024 * 1024; }

#ifndef PG8_MASK
#define PG8_MASK 15
#endif

struct SchedIn {
    const char* A; const char* Bt; int G, c;
    __device__ __forceinline__ bool next(int i, pg8::Unit& u) const {
        const int L0 = i * G + c; if (L0 >= 1532) return false;
        const int L = pg8::xcd_remap(L0, 1532);
        if (L < 60) { const int pi = L >> 2; u.pm = L & 3; u.pn = pi < 8 ? pi : pi + 8; }
        else { const int l2 = L - 60, g = l2 / 184, r = l2 % 184; u.pn = r >> 3; u.pm = 4 + 8 * g + (r & 7); }
        return true;
    }
    __device__ __forceinline__ const char* a_ptr(const pg8::Unit& u) const { return A + (size_t)u.pm * (256 * 1024 * 2); }
    __device__ __forceinline__ const char* b_ptr(const pg8::Unit& u) const { return Bt + (size_t)u.pn * (256 * 1024 * 2); }
    __device__ __forceinline__ void a_ready(const pg8::Unit&) const {}
    __device__ __forceinline__ void done(const pg8::Unit&) const {}
};
struct SchedOut {
    const char* A; const char* Bt; int G, c;
    __device__ __forceinline__ bool next(int i, pg8::Unit& u) const {
        const int L0 = i * G + c; if (L0 >= 256) return false;
        const int w = pg8::xcd_remap(L0, 256), gid = w >> 5, r = w & 31;
        u.pm = gid * 8 + (r & 7); u.pn = r >> 3;
        return true;
    }
    __device__ __forceinline__ const char* a_ptr(const pg8::Unit& u) const { return A + (size_t)u.pm * (256 * 2048 * 2); }
    __device__ __forceinline__ const char* b_ptr(const pg8::Unit& u) const { return Bt + (size_t)u.pn * (256 * 2048 * 2); }
    __device__ __forceinline__ void a_ready(const pg8::Unit&) const {}
    __device__ __forceinline__ void done(const pg8::Unit&) const {}
};
struct SchedMoe {
    const char* A; unsigned char* ws; const int* tile_e; int NT, G, c, K, down;
    __device__ __forceinline__ bool next(int i, pg8::Unit& u) const {
        const int nwg = NT * 4; const int L0 = i * G + c; if (L0 >= nwg) return false;
        const int w = pg8::xcd_remap(L0, nwg);
        u.pm = w >> 2; u.pn = w & 3;
        return true;
    }
    __device__ __forceinline__ const char* a_ptr(const pg8::Unit& u) const { return A + (size_t)u.pm * 256 * K * 2; }
    __device__ __forceinline__ const char* b_ptr(const pg8::Unit& u) const {
        const int e = __builtin_amdgcn_readfirstlane(tile_e[u.pm]);
        return down ? (const char*)(ws + WS_WDT) + ((size_t)e * 1024 * 512 + (size_t)u.pn * 256 * 512) * 2
                    : (const char*)wgu_ptr(ws, e) + (size_t)u.pn * 256 * 1024 * 2;
    }
    __device__ __forceinline__ void a_ready(const pg8::Unit&) const {}
    __device__ __forceinline__ void done(const pg8::Unit&) const {}
};

struct EpiIn {
    static constexpr bool PERM = true, AFTER_DRAIN = false;
    unsigned char* ws;
    __device__ __forceinline__ void operator()(const f32x4 (&acc)[2][2][4][2], const pg8::Unit& u, int wr, int wc, int fr, int fq) const {
        const int pn = u.pn; const int row0 = u.pm * 256 + wr * 64 + fr; const int ct = wc * 32 + 8 * fq;
        if (pn == 22) {
            if (wc < 2) { float* GDT = (float*)(ws + WS_GDT);
#pragma unroll
                for (int ai = 0; ai < 2; ++ai)
#pragma unroll
                    for (int m = 0; m < 4; ++m) { float* p = GDT + (size_t)(row0 + ai * 128 + m * 16) * 64 + ct; *(f32x4*)p = acc[ai][0][m][0]; *(f32x4*)(p + 4) = acc[ai][0][m][1]; } }
            return;
        }
        bf16_t* base; int ld; int roff = 0; bool act = false;
        if (pn < 4) { base = (bf16_t*)(ws + WS_QK) + pn * 256; ld = 1024; }
        else if (pn < 8) { base = (bf16_t*)(ws + WS_V) + (pn - 4) * 256; ld = 1024; }
        else if (pn < 16) { base = (bf16_t*)(ws + WS_RZ) + (pn - 8) * 256; ld = 2048; roff = T_CTX; act = true; }
        else { base = (bf16_t*)(ws + WS_XBC) + (pn - 16) * 256; ld = 1536; }
#pragma unroll
        for (int ai = 0; ai < 2; ++ai)
#pragma unroll
            for (int m = 0; m < 4; ++m) { bf16_t* rowp = base + (size_t)(row0 - roff + ai * 128 + m * 16) * ld + ct;
#pragma unroll
                for (int bj = 0; bj < 2; ++bj) { f32x4 v0 = acc[ai][bj][m][0], v1 = acc[ai][bj][m][1];
                    if (act) { v0.x = siluf(v0.x); v0.y = siluf(v0.y); v0.z = siluf(v0.z); v0.w = siluf(v0.w); v1.x = siluf(v1.x); v1.y = siluf(v1.y); v1.z = siluf(v1.z); v1.w = siluf(v1.w); }
                    u32x4 w; w.x = pg8::cvt_pk_bf16(v0.x, v0.y); w.y = pg8::cvt_pk_bf16(v0.z, v0.w); w.z = pg8::cvt_pk_bf16(v1.x, v1.y); w.w = pg8::cvt_pk_bf16(v1.z, v1.w);
                    *(u32x4*)(rowp + bj * 128) = w; } }
    }
};
struct EpiOut {
    static constexpr bool PERM = false, AFTER_DRAIN = false;
    const float* X; const float* MOD; float* HL;
    __device__ __forceinline__ void operator()(const f32x4 (&acc)[2][2][4][2], const pg8::Unit& u, int wr, int wc, int fr, int fq) const {
        const int b = u.pm >> 4; const int col0 = u.pn * 256 + wc * 32 + 4 * fq;
        f32x4 g1[2][2];
#pragma unroll
        for (int bj = 0; bj < 2; ++bj)
#pragma unroll
            for (int n = 0; n < 2; ++n) g1[bj][n] = *(const f32x4*)(MOD + b * 6144 + 2048 + col0 + bj * 128 + n * 16);
#pragma unroll
        for (int ai = 0; ai < 2; ++ai)
#pragma unroll
            for (int m = 0; m < 4; ++m) { const size_t off = (size_t)(u.pm * 256 + ai * 128 + wr * 64 + m * 16 + fr) * 1024 + col0;
#pragma unroll
                for (int bj = 0; bj < 2; ++bj)
#pragma unroll
                    for (int n = 0; n < 2; ++n) { const f32x4 xv = *(const f32x4*)(X + off + bj * 128 + n * 16); *(f32x4*)(HL + off + bj * 128 + n * 16) = xv + g1[bj][n] * acc[ai][bj][m][n]; }
                if (m & 1) asm volatile("" ::: "memory"); }
    }
};
struct EpiUp {
    static constexpr bool PERM = true, AFTER_DRAIN = false;
    bf16_t* H;
    __device__ __forceinline__ void operator()(const f32x4 (&acc)[2][2][4][2], const pg8::Unit& u, int wr, int wc, int fr, int fq) const {
        const int row0 = u.pm * 256 + wr * 64 + fr; const int col = u.pn * 128 + wc * 32 + 8 * fq;
#pragma unroll
        for (int ai = 0; ai < 2; ++ai)
#pragma unroll
            for (int m = 0; m < 4; ++m) { const f32x4 g0 = acc[ai][0][m][0], g1 = acc[ai][0][m][1], u0 = acc[ai][1][m][0], u1 = acc[ai][1][m][1];
                u32x4 w; w.x = pg8::cvt_pk_bf16(siluf(g0.x) * u0.x, siluf(g0.y) * u0.y); w.y = pg8::cvt_pk_bf16(siluf(g0.z) * u0.z, siluf(g0.w) * u0.w);
                w.z = pg8::cvt_pk_bf16(siluf(g1.x) * u1.x, siluf(g1.y) * u1.y); w.w = pg8::cvt_pk_bf16(siluf(g1.z) * u1.z, siluf(g1.w) * u1.w);
                *(u32x4*)(H + (size_t)(row0 + ai * 128 + m * 16) * 512 + col) = w; }
    }
};
struct EpiDown {
    static constexpr bool PERM = true, AFTER_DRAIN = false;
    bf16_t* Y; const float* SW;
    __device__ __forceinline__ void operator()(const f32x4 (&acc)[2][2][4][2], const pg8::Unit& u, int wr, int wc, int fr, int fq) const {
        const int row0 = u.pm * 256 + wr * 64 + fr; const int col = u.pn * 256 + wc * 32 + 8 * fq;
#pragma unroll
        for (int ai = 0; ai < 2; ++ai)
#pragma unroll
            for (int m = 0; m < 4; ++m) { const int row = row0 + ai * 128 + m * 16; const float sw = SW[row];
#pragma unroll
                for (int bj = 0; bj < 2; ++bj) { const f32x4 v0 = acc[ai][bj][m][0] * sw, v1 = acc[ai][bj][m][1] * sw;
                    u32x4 w; w.x = pg8::cvt_pk_bf16(v0.x, v0.y); w.y = pg8::cvt_pk_bf16(v0.z, v0.w); w.z = pg8::cvt_pk_bf16(v1.x, v1.y); w.w = pg8::cvt_pk_bf16(v1.z, v1.w);
                    *(u32x4*)(Y + (size_t)row * 1024 + col + bj * 128) = w; } }
    }
};

__device__ __forceinline__ void phase2(Ctx& C) {
    const bf16_t* XN = (const bf16_t*)(C.ws + WS_XN); const bf16_t* WinT = (const bf16_t*)(C.ws + WS_WINT);
    bf16_t* QK = (bf16_t*)(C.ws + WS_QK); bf16_t* V = (bf16_t*)(C.ws + WS_V); bf16_t* RZ = (bf16_t*)(C.ws + WS_RZ); bf16_t* XBC = (bf16_t*)(C.ws + WS_XBC);
    float* GDT = (float*)(C.ws + WS_GDT);
    auto bsel = [=](int, int tn, int& ldb) { ldb = 1024; return WinT + (size_t)tn * 128 * 1024; };
    auto epi = [=](int row, int tn, int cc, float v, float) {
        const int col = tn * 128 + cc;
        if (col < 1024) QK[(size_t)row * 1024 + col] = (bf16_t)f2bf(v);
        else if (col < 2048) V[(size_t)row * 1024 + col - 1024] = (bf16_t)f2bf(v);
        else if (col < 4096) { if (row >= T_CTX) RZ[(size_t)(row - T_CTX) * 2048 + col - 2048] = (bf16_t)f2bf(siluf(v)); }
        else if (col < 5632) XBC[(size_t)row * 1536 + col - 4096] = (bf16_t)f2bf(v);
        else if (col < 5696) GDT[(size_t)row * 64 + col - 5632] = v;
    };
#if PG8_MASK & 1
    (void)bsel; (void)epi;
    SchedIn S{(const char*)XN, (const char*)WinT, C.G, C.bid}; EpiIn E{C.ws};
    pg8::gemm_phase<EpiIn, SchedIn, true, true>((lds_ptr_t)C.lds, 1024, S, E);
#else
    gemm_simple<false>(C, XN, 1024, T_ALL / 128, NW_IN / 128, 1024, bsel, epi);
#endif
}

__device__ __forceinline__ void phase3(Ctx& C) {
    float* lds = (float*)C.lds;
    {
        lds_ptr_t L = (lds_ptr_t)C.lds;
        constexpr int IN_O = 0, OUT_O = 32768, GS_O = 98304, TOT_O = 106496;
        LASQ float* gs = (LASQ float*)(L + GS_O); LASQ float* tot = (LASQ float*)(L + TOT_O);
        bf16_t* QK = (bf16_t*)(C.ws + WS_QK); bf16_t* QKF = (bf16_t*)(C.ws + WS_QKF);
        const float* GDT = (const float*)(C.ws + WS_GDT); float* GLAD = (float*)(C.ws + WS_GLAD);
        const float* gwup = C.in[I_GWUP]; const float* gbias = C.in[I_GB];
        const int tid = C.tid, c = tid & 127, tg = tid >> 7;
        for (int item = C.bid; item < 272 * 4; item += C.G) {
            const int rc = item >> 2, h = item & 3, row0 = rc * 64;
            __syncthreads();
#pragma unroll
            for (int i = 0; i < 4; ++i) { const int id = tid + 512 * i, arr = id >> 10, r = (id >> 4) & 63, ch = id & 15;
                *(LASQ u32x4*)(L + IN_O + arr * 16384 + r * 256 + ch * 16) = *(const u32x4*)(QK + (size_t)(row0 + r) * 1024 + arr * 512 + h * 128 + ch * 8); }
            *(LASQ f32x4*)(gs + (tid >> 3) * 32 + (tid & 7) * 4) = *(const f32x4*)(GDT + (size_t)(row0 + (tid >> 3)) * 64 + (tid & 7) * 4);
            float wf[16], wb[16];
#pragma unroll
            for (int r = 0; r < 16; ++r) { wf[r] = gwup[r * 512 + h * 128 + c]; wb[r] = gwup[(16 + r) * 512 + h * 128 + c]; }
            const float bfv = gbias[h * 128 + c], bbv = gbias[512 + h * 128 + c];
            __syncthreads();
            float pf[16], pb[16];
#pragma unroll
            for (int tt = 0; tt < 16; ++tt) { const LASQ float* g = gs + (tg * 16 + tt) * 32; float sf = bfv, sb = bbv;
#pragma unroll
                for (int r = 0; r < 16; ++r) { sf += g[r] * wf[r]; sb += g[16 + r] * wb[r]; }
                pf[tt] = logsigf(sf) * (1.f / 16.f); pb[tt] = logsigf(sb) * (1.f / 16.f); }
#pragma unroll
            for (int tt = 1; tt < 16; ++tt) pf[tt] += pf[tt - 1];
#pragma unroll
            for (int tt = 14; tt >= 0; --tt) pb[tt] += pb[tt + 1];
            tot[(0 * 4 + tg) * 128 + c] = pf[15]; tot[(1 * 4 + tg) * 128 + c] = pb[0];
            __syncthreads();
            float offf = 0.f, offb = 0.f, totf = 0.f, totb = 0.f;
#pragma unroll
            for (int g = 0; g < 4; ++g) { const float a = tot[(0 * 4 + g) * 128 + c], bq = tot[(1 * 4 + g) * 128 + c]; if (g < tg) offf += a; if (g > tg) offb += bq; totf += a; totb += bq; }
            if (tg == 0) { GLAD[((size_t)(rc * 4 + h) * 2 + 0) * 128 + c] = __expf(totf); GLAD[((size_t)(rc * 4 + h) * 2 + 1) * 128 + c] = __expf(totb); }
            const float qscale = 0.08838834764831845f;
#pragma unroll
            for (int tt = 0; tt < 16; ++tt) { const int r = tg * 16 + tt;
                const float q = bf2f(*(const LASQ bf16_t*)(L + IN_O + r * 256 + c * 2)) * qscale, k = bf2f(*(const LASQ bf16_t*)(L + IN_O + 16384 + r * 256 + c * 2));
                const float ef = pf[tt] + offf, eb = pb[tt] + offb;
                *(LASQ bf16_t*)(L + OUT_O + 0 * 16384 + r * 256 + c * 2) = (bf16_t)f2bf(q * __expf(ef));
                *(LASQ bf16_t*)(L + OUT_O + 1 * 16384 + r * 256 + c * 2) = (bf16_t)f2bf(k * __expf(-ef));
                *(LASQ bf16_t*)(L + OUT_O + 2 * 16384 + r * 256 + c * 2) = (bf16_t)f2bf(q * __expf(eb));
                *(LASQ bf16_t*)(L + OUT_O + 3 * 16384 + r * 256 + c * 2) = (bf16_t)f2bf(k * __expf(-eb)); }
            __syncthreads();
#pragma unroll
            for (int i = 0; i < 8; ++i) { const int id = tid + 512 * i, arr = id >> 10, r = (id >> 4) & 63, ch = id & 15;
                bf16_t* dst = (arr < 2 ? QKF : QK) + (size_t)(row0 + r) * 1024 + (arr & 1) * 512 + h * 128 + ch * 8;
                *(u32x4*)dst = *(const LASQ u32x4*)(L + OUT_O + arr * 16384 + r * 256 + ch * 16); }
        }
        __syncthreads();
    }
    {
        const bf16_t* XBC = (const bf16_t*)(C.ws + WS_XBC); bf16_t* XC = (bf16_t*)(C.ws + WS_XC);
        const float* cw = C.in[I_CONVW]; const float* cb = C.in[I_CONVB];
        const int total = 272 * 4 * 192;
        for (int it = C.bid * NTHREADS + C.tid; it < total; it += C.G * NTHREADS) {
            const int cg8 = it % 192, st = it / 192, rc = st >> 2, x0 = (st & 3) * 16, c0 = cg8 * 8;
            int base, y, xb, H, W;
            if (rc < 16) { base = (rc >> 2) * 256; y = 0; xb = (rc & 3) * 64; H = 1; W = 256; }
            else { const int lr = rc - 16; base = T_CTX + (lr >> 6) * 4096; y = lr & 63; xb = 0; H = 64; W = 64; }
            float wt[9][8], bias[8];
#pragma unroll
            for (int t = 0; t < 9; ++t) { const f32x4 a = *(const f32x4*)(cw + (size_t)t * 1536 + c0), bq = *(const f32x4*)(cw + (size_t)t * 1536 + c0 + 4);
                wt[t][0] = a.x; wt[t][1] = a.y; wt[t][2] = a.z; wt[t][3] = a.w; wt[t][4] = bq.x; wt[t][5] = bq.y; wt[t][6] = bq.z; wt[t][7] = bq.w; }
            { const f32x4 a = *(const f32x4*)(cb + c0), bq = *(const f32x4*)(cb + c0 + 4); bias[0] = a.x; bias[1] = a.y; bias[2] = a.z; bias[3] = a.w; bias[4] = bq.x; bias[5] = bq.y; bias[6] = bq.z; bias[7] = bq.w; }
            const bool vy[3] = {y - 1 >= 0, true, y + 1 < H};
            u16x8 win[3][3];
            auto ldcol = [&](int i, int xx) -> u16x8 { u16x8 z = {0, 0, 0, 0, 0, 0, 0, 0};
                if (!vy[i] || xx < 0 || xx >= W) return z;
                return *(const u16x8*)(XBC + (size_t)(base + (y + i - 1) * W + xx) * 1536 + c0); };
            const int xs = xb + x0;
#pragma unroll
            for (int i = 0; i < 3; ++i) { win[i][0] = ldcol(i, xs - 1); win[i][1] = ldcol(i, xs); }
            for (int dx = 0; dx < 16; ++dx) { const int x = xs + dx;
#pragma unroll
                for (int i = 0; i < 3; ++i) win[i][2] = ldcol(i, x + 1);
                float acc[8];
#pragma unroll
                for (int j = 0; j < 8; ++j) acc[j] = bias[j];
#pragma unroll
                for (int i = 0; i < 3; ++i)
#pragma unroll
                    for (int jx = 0; jx < 3; ++jx)
#pragma unroll
                        for (int j = 0; j < 8; ++j) acc[j] += bf2f(win[i][jx][j]) * wt[i * 3 + jx][j];
                u32x4 o; o.x = pk2(siluf(acc[0]), siluf(acc[1])); o.y = pk2(siluf(acc[2]), siluf(acc[3])); o.z = pk2(siluf(acc[4]), siluf(acc[5])); o.w = pk2(siluf(acc[6]), siluf(acc[7]));
                *(u32x4*)(XC + (size_t)(base + y * W + x) * 1536 + c0) = o;
#pragma unroll
                for (int i = 0; i < 3; ++i) { win[i][0] = win[i][1]; win[i][1] = win[i][2]; }
            }
        }
    }
    {
        float* GDT = (float*)(C.ws + WS_GDT); float* ACUM = (float*)(C.ws + WS_ACUM);
        const float* alog = C.in[I_ALOG]; const float* dtbias = C.in[I_DTB];
        const int gw = C.bid * 8 + C.wave, NGW = C.G * 8, l = C.lane;
        for (int it = gw; it < 272 * 32; it += NGW) {
            const int rc = it >> 5, dh = it & 31, dir = dh >> 4; const size_t row = (size_t)rc * 64 + l;
            const float dtv = softplusf(GDT[row * 64 + 32 + dh] + dtbias[dh]);
            float sa = dtv * (-__expf(alog[dh])) * 1.4426950408889634f;
#pragma unroll
            for (int o = 1; o < 64; o <<= 1) { const float t = dir ? __shfl_down(sa, o) : __shfl_up(sa, o); if (dir ? (l + o < 64) : (l >= o)) sa += t; }
            GDT[row * 64 + 32 + dh] = dtv; ACUM[row * 32 + dh] = sa;
        }
    }
}

__device__ __forceinline__ int scan_row(int b, int dir, int s) {
    if (s < CTXL) return b * CTXL + (dir ? CTXL - 1 - s : s);
    const int t = s - CTXL; return T_CTX + b * SEQ + (dir ? SEQ - 1 - t : t);
}

__device__ __forceinline__ void phase4_naive(Ctx& C) {
    bf16_t* OF = (bf16_t*)C.out;
    bf16_t* OB = (bf16_t*)(C.ws + WS_OB);
    bf16_t* YB = (bf16_t*)(C.ws + WS_YB);
    const bf16_t* V = (const bf16_t*)(C.ws + WS_V); const bf16_t* XC = (const bf16_t*)(C.ws + WS_XC);
    const float* GDT = (const float*)(C.ws + WS_GDT); const float* GLAD = (const float*)(C.ws + WS_GLAD);
    for (int gt = C.bid * NTHREADS + C.tid; gt < 65536; gt += C.G * NTHREADS) {
        if (gt < 32768) {
            const int chain = gt >> 10, rem = gt & 1023, dv = rem >> 2, dq = rem & 3;
            const int b = chain >> 3, h = (chain >> 1) & 3, dir = chain & 1;
            const bf16_t* QKp = (const bf16_t*)(C.ws + (dir ? WS_QK : WS_QKF));
            float S[32];
#pragma unroll
            for (int i = 0; i < 32; ++i) S[i] = 0.f;
            for (int s = 0; s < CTXL + SEQ; ++s) {
                const int row = scan_row(b, dir, s);
                const float v = bf2f(V[(size_t)row * 1024 + h * 256 + dv]);
                const bf16_t* qp = QKp + (size_t)row * 1024 + h * 128 + dq * 32;
                float o = 0.f;
#pragma unroll
                for (int i8 = 0; i8 < 4; ++i8) { const u16x8 kv = *(const u16x8*)(qp + 512 + i8 * 8), qv = *(const u16x8*)(qp + i8 * 8);
#pragma unroll
                    for (int j = 0; j < 8; ++j) { S[i8 * 8 + j] += bf2f(kv[j]) * v; o += bf2f(qv[j]) * S[i8 * 8 + j]; } }
                o += __shfl_xor(o, 1); o += __shfl_xor(o, 2);
                if (row >= T_CTX && dq == 0) { const size_t l = row - T_CTX; if (dir) OB[l * 1024 + h * 256 + dv] = (bf16_t)f2bf(o); else OF[l * 2048 + h * 256 + dv] = (bf16_t)f2bf(o); }
                if ((s & 63) == 63) { const float* d = GLAD + ((size_t)((row >> 6) * 4 + h) * 2 + dir) * 128 + dq * 32;
#pragma unroll
                    for (int i = 0; i < 32; ++i) S[i] *= d[i]; }
            }
        } else {
            const int g2 = gt - 32768, chain = g2 >> 8, rem = g2 & 255, p = rem >> 2, nq = rem & 3;
            const int b = chain >> 5, head = (chain >> 1) & 15, dir = chain & 1, grp = head >> 3;
            const float Aneg = -__expf(C.in[I_ALOG][dir * 16 + head]), dtb = C.in[I_DTB][dir * 16 + head];
            float S[32];
#pragma unroll
            for (int i = 0; i < 32; ++i) S[i] = 0.f;
            for (int s = 0; s < CTXL + SEQ; ++s) {
                const int row = scan_row(b, dir, s);
                const float dt = GDT[(size_t)row * 64 + 32 + dir * 16 + head], a = __expf(dt * Aneg); (void)dtb;
                const float xd = bf2f(XC[(size_t)row * 1536 + head * 64 + p]) * dt;
                const bf16_t* bp = XC + (size_t)row * 1536 + 1024 + grp * 128 + nq * 32;
                float y = 0.f;
#pragma unroll
                for (int i8 = 0; i8 < 4; ++i8) { const u16x8 bv = *(const u16x8*)(bp + i8 * 8), cv = *(const u16x8*)(bp + 256 + i8 * 8);
#pragma unroll
                    for (int j = 0; j < 8; ++j) { S[i8 * 8 + j] = a * S[i8 * 8 + j] + xd * bf2f(bv[j]); y += S[i8 * 8 + j] * bf2f(cv[j]); } }
                y += __shfl_xor(y, 1); y += __shfl_xor(y, 2);
                if (row >= T_CTX && nq == 0) { const size_t l = row - T_CTX; if (dir) YB[l * 1024 + head * 64 + p] = (bf16_t)f2bf(y); else OF[l * 2048 + 1024 + head * 64 + p] = (bf16_t)f2bf(y); }
            }
        }
    }
}


typedef short bf16x8 __attribute__((ext_vector_type(8)));
typedef short s16x4 __attribute__((ext_vector_type(4)));
typedef __attribute__((address_space(3))) s16x4* lds_s16x4_p;
__device__ __forceinline__ bf16x8 lds_row_frag(lds_ptr_t L, int off, int rs, int r0, int kb, int c, int g) {
    return *(const LASQ bf16x8*)(L + off + (r0 + c) * rs + kb + g * 16);
}
__device__ __forceinline__ bf16x8 lds_tr_frag(lds_ptr_t L, int off, int rs, int k0, int n0, int g, int q, int p) {
    const s16x4 lo = __builtin_amdgcn_ds_read_tr16_b64_v4i16((lds_s16x4_p)(L + off + (k0 + 8 * g + q) * rs + (n0 + 4 * p) * 2));
    const s16x4 hi = __builtin_amdgcn_ds_read_tr16_b64_v4i16((lds_s16x4_p)(L + off + (k0 + 8 * g + 4 + q) * rs + (n0 + 4 * p) * 2));
    bf16x8 r; r[0] = lo[0]; r[1] = lo[1]; r[2] = lo[2]; r[3] = lo[3]; r[4] = hi[0]; r[5] = hi[1]; r[6] = hi[2]; r[7] = hi[3]; return r;
}
template <bool GLA>
__device__ __forceinline__ void scan_unit(Ctx& C, int uid) {
    lds_ptr_t L = (lds_ptr_t)C.lds;
    constexpr int INB = 44032, KS_O = 17408, VS_O = 34816, ST_OFF = 88064, STB = 17408, PS_OFF = 122880, SC_OFF = 132096, SCB = 1280;
    const int tid = C.tid, w = C.wave, l = C.lane, g = l >> 4, c = l & 15, q = c >> 2, p = c & 3;
    int b, dir, ldqk, ldv, ldo; const bf16_t *Qg, *Kg, *Vg; bf16_t* Og; const float* Sg; const float* dtg = nullptr;
    if (GLA) { b = uid >> 5; const int h = (uid >> 3) & 3; dir = (uid >> 2) & 1; const int sl = uid & 3;
        const bf16_t* QKp = (const bf16_t*)(C.ws + (dir ? WS_QK : WS_QKF));
        Qg = QKp + h * 128; Kg = QKp + 512 + h * 128; ldqk = 1024; Vg = (const bf16_t*)(C.ws + WS_V) + h * 256 + sl * 64; ldv = 1024;
        Og = dir ? (bf16_t*)(C.ws + WS_OB) + h * 256 + sl * 64 : (bf16_t*)C.out + h * 256 + sl * 64; ldo = dir ? 1024 : 2048;
        Sg = (const float*)(C.ws + WS_GLAD) + (h * 2 + dir) * 128;
    } else { b = uid >> 5; const int head = (uid >> 1) & 15; dir = uid & 1; const int grp = head >> 3;
        const bf16_t* XC = (const bf16_t*)(C.ws + WS_XC);
        Qg = XC + 1280 + grp * 128; Kg = XC + 1024 + grp * 128; ldqk = 1536; Vg = XC + head * 64; ldv = 1536;
        Og = dir ? (bf16_t*)(C.ws + WS_YB) + head * 64 : (bf16_t*)C.out + 1024 + head * 64; ldo = dir ? 1024 : 2048;
        Sg = (const float*)(C.ws + WS_ACUM) + dir * 16 + head;
        dtg = (const float*)(C.ws + WS_GDT) + 32 + dir * 16 + head;
    }
    f32x4 S[4];
#pragma unroll
    for (int t = 0; t < 4; ++t) S[t] = (f32x4){0.f, 0.f, 0.f, 0.f};
    u32x4 pq0, pq1, pk0, pk1, pv; float ps0 = 0.f, ps1 = 0.f, ptot = 0.f;
    auto chunk_rc = [&](int n) { return n < 4 ? 4 * b + (dir ? 3 - n : n) : 16 + 64 * b + (dir ? 67 - n : n - 4); };
    auto prefetch = [&](int n) {
        const int rc = chunk_rc(n), row0 = rc * 64;
        const bf16_t* qp = Qg + (size_t)(row0 + (tid >> 4)) * ldqk + (tid & 15) * 8; const bf16_t* kp = Kg + (size_t)(row0 + (tid >> 4)) * ldqk + (tid & 15) * 8;
        pq0 = *(const u32x4*)qp; pq1 = *(const u32x4*)(qp + (size_t)32 * ldqk); pk0 = *(const u32x4*)kp; pk1 = *(const u32x4*)(kp + (size_t)32 * ldqk);
        pv = *(const u32x4*)(Vg + (size_t)(row0 + (tid >> 3)) * ldv + (tid & 7) * 8);
        if (GLA) { ps0 = Sg[(size_t)rc * 1024 + (tid & 127)]; }
        else { ps0 = Sg[(size_t)(row0 + (tid & 63)) * 32]; ps1 = dtg[(size_t)(row0 + (tid & 63)) * 64]; ptot = Sg[(size_t)(row0 + (dir ? 0 : 63)) * 32]; }
    };
    float dtot = 1.f;
    auto stageW = [&](int n) {
        const int ib = (n & 1) * INB; LASQ float* sc = (LASQ float*)(L + SC_OFF + (n & 1) * SCB);
        *(LASQ u32x4*)(L + ib + (tid >> 4) * 272 + (tid & 15) * 16) = pq0; *(LASQ u32x4*)(L + ib + ((tid >> 4) + 32) * 272 + (tid & 15) * 16) = pq1;
        *(LASQ u32x4*)(L + ib + KS_O + (tid >> 4) * 272 + (tid & 15) * 16) = pk0; *(LASQ u32x4*)(L + ib + KS_O + ((tid >> 4) + 32) * 272 + (tid & 15) * 16) = pk1;
        *(LASQ u32x4*)(L + ib + VS_O + (tid >> 3) * 144 + (tid & 7) * 16) = pv;
        if (GLA) { if (tid < 128) sc[tid] = ps0; }
        else { if (tid < 64) { sc[tid] = ps0; sc[64 + tid] = ps1; sc[128 + tid] = ps1 * __builtin_amdgcn_exp2f(ptot - ps0); } }
    };
    prefetch(0);
    stageW(0);
    float dcur = GLA ? 1.f : __builtin_amdgcn_exp2f(ptot);
    prefetch(1);
    __syncthreads();
    for (int n = 0; n < 68; ++n) {
        const int rc = chunk_rc(n); const bool lat = n >= 4;
        const int ib = (n & 1) * INB; LASQ float* sc = (LASQ float*)(L + SC_OFF + (n & 1) * SCB);
        float dnext = 1.f;
        if (n + 1 < 68) { stageW(n + 1); if (!GLA) dnext = __builtin_amdgcn_exp2f(ptot); if (n + 2 < 68) prefetch(n + 2); }
        if (lat) {
            const int tj = w >> 1, ti0 = 2 * (w & 1);
            bf16x8 ka[4];
#pragma unroll
            for (int ks = 0; ks < 4; ++ks) ka[ks] = lds_row_frag(L, ib + KS_O, 272, 16 * tj, 64 * ks, c, g);
#pragma unroll
            for (int t2 = 0; t2 < 2; ++t2) { const int ti = ti0 + t2; f32x4 acc = (f32x4){0.f, 0.f, 0.f, 0.f};
#pragma unroll
                for (int ks = 0; ks < 4; ++ks) { const bf16x8 qb = lds_row_frag(L, ib, 272, 16 * ti, 64 * ks, c, g); acc = __builtin_amdgcn_mfma_f32_16x16x32_bf16(ka[ks], qb, acc, 0, 0, 0); }
                const int i = 16 * ti + c, j0 = 16 * tj + 4 * g; float pvv[4];
                if (GLA) {
#pragma unroll
                    for (int r = 0; r < 4; ++r) { const bool ok = dir ? (j0 + r >= i) : (j0 + r <= i); pvv[r] = ok ? acc[r] : 0.f; }
                } else { const float ai = sc[i]; const f32x4 aj = *(const LASQ f32x4*)(sc + j0), dj = *(const LASQ f32x4*)(sc + 64 + j0);
#pragma unroll
                    for (int r = 0; r < 4; ++r) { const bool ok = dir ? (j0 + r >= i) : (j0 + r <= i); const float x = ok ? ai - aj[r] : 0.f; pvv[r] = ok ? acc[r] * __builtin_amdgcn_exp2f(x) * dj[r] : 0.f; } }
                u32x2 o; o.x = pk2(pvv[0], pvv[1]); o.y = pk2(pvv[2], pvv[3]); *(LASQ u32x2*)(L + PS_OFF + i * 144 + j0 * 2) = o; }
        }
        {
            bf16x8 ka[2];
#pragma unroll
            for (int ks = 0; ks < 2; ++ks) ka[ks] = lds_tr_frag(L, ib + KS_O, 272, 32 * ks, 16 * w, g, q, p);
            if (!GLA) {
#pragma unroll
                for (int ks = 0; ks < 2; ++ks) { const f32x4 u0 = *(const LASQ f32x4*)(sc + 128 + 32 * ks + 8 * g), u1 = *(const LASQ f32x4*)(sc + 128 + 32 * ks + 8 * g + 4);
                    const float uu[8] = {u0.x, u0.y, u0.z, u0.w, u1.x, u1.y, u1.z, u1.w}; u32x4 pk;
                    pk.x = pk2(bf2f((bf16_t)ka[ks][0]) * uu[0], bf2f((bf16_t)ka[ks][1]) * uu[1]); pk.y = pk2(bf2f((bf16_t)ka[ks][2]) * uu[2], bf2f((bf16_t)ka[ks][3]) * uu[3]);
                    pk.z = pk2(bf2f((bf16_t)ka[ks][4]) * uu[4], bf2f((bf16_t)ka[ks][5]) * uu[5]); pk.w = pk2(bf2f((bf16_t)ka[ks][6]) * uu[6], bf2f((bf16_t)ka[ks][7]) * uu[7]);
                    ka[ks] = __builtin_bit_cast(bf16x8, pk); }
#pragma unroll
                for (int t = 0; t < 4; ++t) S[t] = S[t] * dcur;
            }
#pragma unroll
            for (int t = 0; t < 4; ++t)
#pragma unroll
                for (int ks = 0; ks < 2; ++ks) { const bf16x8 vb = lds_tr_frag(L, ib + VS_O, 144, 32 * ks, 16 * t, g, q, p); S[t] = __builtin_amdgcn_mfma_f32_16x16x32_bf16(ka[ks], vb, S[t], 0, 0, 0); }
            if (GLA) { const f32x4 d = *(const LASQ f32x4*)(sc + 16 * w + 4 * g);
#pragma unroll
                for (int t = 0; t < 4; ++t) S[t] = S[t] * d; }
            if (n + 1 >= 4 && n + 1 < 68) {
                const int so = ST_OFF + ((n + 1) & 1) * STB;
#pragma unroll
                for (int t = 0; t < 4; ++t) { u32x2 o; o.x = pk2(S[t].x, S[t].y); o.y = pk2(S[t].z, S[t].w); *(LASQ u32x2*)(L + so + (16 * t + c) * 272 + (16 * w + 4 * g) * 2) = o; }
            }
        }
        dcur = dnext;
        __syncthreads();
        if (lat) {
            const int tdv = w >> 1, ti0 = 2 * (w & 1), so = ST_OFF + (n & 1) * STB;
            bf16x8 va[2], sa[4];
#pragma unroll
            for (int ks = 0; ks < 2; ++ks) va[ks] = lds_tr_frag(L, ib + VS_O, 144, 32 * ks, 16 * tdv, g, q, p);
#pragma unroll
            for (int ks = 0; ks < 4; ++ks) sa[ks] = lds_row_frag(L, so, 272, 16 * tdv, 64 * ks, c, g);
            const size_t lrow0 = (size_t)(rc * 64 - T_CTX);
#pragma unroll
            for (int t2 = 0; t2 < 2; ++t2) { const int ti = ti0 + t2; f32x4 a1 = (f32x4){0.f, 0.f, 0.f, 0.f}, a2 = (f32x4){0.f, 0.f, 0.f, 0.f};
#pragma unroll
                for (int ks = 0; ks < 2; ++ks) { const bf16x8 pb = lds_row_frag(L, PS_OFF, 144, 16 * ti, 64 * ks, c, g); a1 = __builtin_amdgcn_mfma_f32_16x16x32_bf16(va[ks], pb, a1, 0, 0, 0); }
#pragma unroll
                for (int ks = 0; ks < 4; ++ks) { const bf16x8 qb = lds_row_frag(L, ib, 272, 16 * ti, 64 * ks, c, g); a2 = __builtin_amdgcn_mfma_f32_16x16x32_bf16(sa[ks], qb, a2, 0, 0, 0); }
                const int i = 16 * ti + c; f32x4 o4;
                if (GLA) o4 = a1 + a2; else o4 = a1 + a2 * __builtin_amdgcn_exp2f(sc[i]);
                u32x2 o; o.x = pk2(o4.x, o4.y); o.y = pk2(o4.z, o4.w);
                *(u32x2*)(Og + (lrow0 + i) * ldo + 16 * tdv + 4 * g) = o; }
        }
        __syncthreads();
    }
}
__device__ __forceinline__ void phase4(Ctx& C) {
    for (int uid = C.bid; uid < 256; uid += C.G) { if (uid < 128) scan_unit<true>(C, uid); else scan_unit<false>(C, uid - 128); }
}

__device__ __forceinline__ void phase5(Ctx& C) {
    const int gw = C.bid * 8 + C.wave, NGW = C.G * 8;
    const bf16_t* OF = (const bf16_t*)C.out; const bf16_t* OB = (const bf16_t*)(C.ws + WS_OB); const bf16_t* YB = (const bf16_t*)(C.ws + WS_YB);
    const bf16_t* RZ = (const bf16_t*)(C.ws + WS_RZ); const bf16_t* XC = (const bf16_t*)(C.ws + WS_XC); bf16_t* YX = (bf16_t*)(C.ws + WS_YX);
    const float* ssdd = C.in[I_SSDD]; const float* ssdn = C.in[I_SSDN]; const f32x4 gn = *(const f32x4*)(C.in[I_GNORM] + C.lane * 4);
    for (int l = gw; l < T_LAT; l += NGW) {
        for (int h = 0; h < 4; ++h) {
            const int c0 = h * 256 + C.lane * 4;
            const u16x4 a = *(const u16x4*)(OF + (size_t)l * 2048 + c0), b = *(const u16x4*)(OB + (size_t)l * 1024 + c0), r = *(const u16x4*)(RZ + (size_t)l * 2048 + c0);
            float o[4], ss = 0.f;
#pragma unroll
            for (int j = 0; j < 4; ++j) { o[j] = bf2f(a[j]) + bf2f(b[j]); ss += o[j] * o[j]; }
            const float rs = rsqrtf(wave_sum(ss) * (1.f / 256.f) + EPS);
            u32x2 w; w.x = pk2(o[0] * rs * gn.x * bf2f(r[0]), o[1] * rs * gn.y * bf2f(r[1])); w.y = pk2(o[2] * rs * gn.z * bf2f(r[2]), o[3] * rs * gn.w * bf2f(r[3]));
            *(u32x2*)(YX + (size_t)l * 2048 + c0) = w;
        }
        for (int g = 0; g < 2; ++g) {
            const int c0 = g * 512 + C.lane * 8, head = c0 >> 6;
            const u16x8 a = *(const u16x8*)(OF + (size_t)l * 2048 + 1024 + c0), b = *(const u16x8*)(YB + (size_t)l * 1024 + c0), z = *(const u16x8*)(RZ + (size_t)l * 2048 + 1024 + c0),
                        xs = *(const u16x8*)(XC + (size_t)(l + T_CTX) * 1536 + c0);
            const float dsk = ssdd[head];
            float y[8], ss = 0.f;
#pragma unroll
            for (int j = 0; j < 8; ++j) { y[j] = (bf2f(a[j]) + bf2f(b[j]) + bf2f(xs[j]) * dsk) * bf2f(z[j]); ss += y[j] * y[j]; }
            const float rs = rsqrtf(wave_sum(ss) * (1.f / 512.f) + EPS);
            const float* nw = ssdn + c0;
            u32x4 w; w.x = pk2(y[0] * rs * nw[0], y[1] * rs * nw[1]); w.y = pk2(y[2] * rs * nw[2], y[3] * rs * nw[3]); w.z = pk2(y[4] * rs * nw[4], y[5] * rs * nw[5]); w.w = pk2(y[6] * rs * nw[6], y[7] * rs * nw[7]);
            *(u32x4*)(YX + (size_t)l * 2048 + 1024 + c0) = w;
        }
    }
}

__device__ __forceinline__ void phase6(Ctx& C) {
    {
        float* scr = (float*)C.lds + 8192 + C.wave * (64 * 33);
        const int gw = C.bid * 8 + C.wave, NGW = C.G * 8;
        bf16_t* WdT = (bf16_t*)(C.ws + WS_WDT);
        for (int it = gw; it < 32 * 768; it += NGW) {
            const int e = it / 768, r = it % 768;
            if (r < 512) { const int up = r >> 8, q = r & 255, kb = q >> 4, nb = q & 15;
                const float* src = C.in[up ? I_EWU : I_EWG] + (size_t)e * 1024 * 512 + (size_t)(kb * 64) * 512 + nb * 32;
                bf16_t* dst = wgu_ptr(C.ws, e) + (size_t)(256 * (nb >> 2) + (nb & 3) * 32 + up * 128) * 1024 + kb * 64;
                transpose_tile(src, 512, dst, 1024, scr, C.lane, false); }
            else { const int q = r - 512, kb = q >> 5, nb = q & 31;
                transpose_tile(C.in[I_EWD] + (size_t)e * 512 * 1024 + (size_t)(kb * 64) * 1024 + nb * 32, 1024, WdT + (size_t)e * 1024 * 512 + (size_t)(nb * 32) * 512 + kb * 64, 512, scr, C.lane, false); }
        }
    }
    __syncthreads();
    const bf16_t* YX = (const bf16_t*)(C.ws + WS_YX); const bf16_t* WoutT = (const bf16_t*)(C.ws + WS_WOUTT);
    const float* MOD = (const float*)(C.ws + WS_MOD); const float* X = C.in[I_X]; float* HL = C.out;
    auto bsel = [=](int, int tn, int& ldb) { ldb = 2048; return WoutT + (size_t)tn * 128 * 2048; };
    auto epi = [=](int row, int tn, int cc, float v, float) { const int col = tn * 128 + cc, b = row >> 12;
        HL[(size_t)row * 1024 + col] = X[(size_t)row * 1024 + col] + MOD[b * 6144 + 2048 + col] * v; };
#if PG8_MASK & 2
    (void)bsel; (void)epi;
    SchedOut S{(const char*)YX, (const char*)WoutT, C.G, C.bid}; EpiOut E{X, MOD, HL};
    pg8::gemm_phase<EpiOut, SchedOut, false, true>((lds_ptr_t)C.lds, 2048, S, E);
#else
    gemm_simple<false>(C, YX, 2048, T_LAT / 128, 1024 / 128, 2048, bsel, epi);
#endif
}

__device__ __forceinline__ void phase7(Ctx& C) {
    const int gw = C.bid * 8 + C.wave, NGW = C.G * 8;
    const float* MOD = (const float*)(C.ws + WS_MOD); const float* HL = C.out; bf16_t* XN2 = (bf16_t*)(C.ws + WS_XN2);
    int* PE = (int*)(C.ws + WS_PAIR); int* PP = PE + 32768; float* PW = (float*)(PP + 32768);
    unsigned* cnt = (unsigned*)(C.ws + WS_CTL) + CW_CNT;
    const float* wg = C.in[I_RGW]; const float* we = C.in[I_REW]; const float* nffn = C.in[I_NFFN]; const float* rgb = C.in[I_RGB]; const float* reb = C.in[I_REB];
    float* tw = (float*)C.lds + C.wave * 1024;
    const int oe = C.lane & 31, kh = C.lane >> 5, og = C.lane & 3, kp = C.lane >> 2;
    for (int l = gw; l < T_LAT; l += NGW) {
        const int b = l >> 12;
        f32x4 v[4]; float ss = 0.f;
#pragma unroll
        for (int j = 0; j < 4; ++j) { v[j] = *(const f32x4*)(HL + (size_t)l * DM + j * 256 + C.lane * 4); ss += v[j].x * v[j].x + v[j].y * v[j].y + v[j].z * v[j].z + v[j].w * v[j].w; }
        const float rs = rsqrtf(wave_sum(ss) * (1.f / DM) + EPS);
#pragma unroll
        for (int j = 0; j < 4; ++j) { const int c0 = j * 256 + C.lane * 4;
            const f32x4 g = *(const f32x4*)(nffn + c0), sh = *(const f32x4*)(MOD + b * 6144 + 3072 + c0), scl = *(const f32x4*)(MOD + b * 6144 + 4096 + c0);
            const f32x4 t = v[j] * rs * g * (1.f + scl) + sh;
            u32x2 o; o.x = pk2(t.x, t.y); o.y = pk2(t.z, t.w); *(u32x2*)(XN2 + (size_t)l * DM + c0) = o;
            *(f32x4*)(tw + c0) = t; }
        asm volatile("s_waitcnt lgkmcnt(0)" ::: "memory");
        float ae = 0.f, ag = 0.f;
        { const float* wp = we + (size_t)(kh * 512) * 32 + oe; const float* tp = tw + kh * 512;
#pragma unroll 8
            for (int k = 0; k < 512; ++k) ae += tp[k] * wp[(size_t)k * 32]; }
        { const float* wp = wg + (size_t)(kp * 64) * 4 + og; const float* tp = tw + kp * 64;
#pragma unroll 8
            for (int k = 0; k < 64; ++k) ag += tp[k] * wp[k * 4]; }
        ae += __shfl_xor(ae, 32);
        ag += __shfl_xor(ag, 4); ag += __shfl_xor(ag, 8); ag += __shfl_xor(ag, 16); ag += __shfl_xor(ag, 32);
        asm volatile("" ::: "memory");
        float gl[4]; int gs = 0; float gm = -3.4e38f;
#pragma unroll
        for (int o = 0; o < 4; ++o) { gl[o] = __shfl(ag, o) + rgb[o]; if (gl[o] > gm) { gm = gl[o]; gs = o; } }
        float den = 0.f;
#pragma unroll
        for (int o = 0; o < 4; ++o) den += __expf(gl[o] - gm);
        const float pg = 1.f / den;
        int i1 = 0, i2 = 0; float v1 = -3.4e38f, v2 = -3.4e38f;
#pragma unroll
        for (int o = 0; o < 8; ++o) { const float e = __shfl(ae, gs * 8 + o) + reb[gs * 8 + o];
            if (e > v1) { v2 = v1; i2 = i1; v1 = e; i1 = o; } else if (e > v2) { v2 = e; i2 = o; } }
        if (C.lane == 0) {
            const float e2 = __expf(v2 - v1), w1 = pg / (1.f + e2), w2 = pg * e2 / (1.f + e2);
            const int ex1 = gs * 8 + i1, ex2 = gs * 8 + i2;
            const unsigned p1 = atomicAdd(cnt + ex1, 1u), p2 = atomicAdd(cnt + ex2, 1u);
            PE[l * 2] = ex1; PE[l * 2 + 1] = ex2; PP[l * 2] = (int)p1; PP[l * 2 + 1] = (int)p2; PW[l * 2] = w1; PW[l * 2 + 1] = w2;
        }
    }
}

__device__ __forceinline__ void moe_offsets(Ctx& C, int* off) {
    if (C.tid == 0) { const unsigned* cnt = (const unsigned*)(C.ws + WS_CTL) + CW_CNT; int o = 0;
        for (int e = 0; e < 32; ++e) { off[e] = o; o += (int)((__hip_atomic_load(cnt + e, __ATOMIC_RELAXED, __HIP_MEMORY_SCOPE_AGENT) + 255u) & ~255u); } off[32] = o; }
    __syncthreads();
}


__device__ __forceinline__ void moe_tile_table(Ctx& C, const int* off, int* tile_e) {
    const int NT = off[32] >> 8;
    for (int t = C.tid; t < NT; t += NTHREADS) { int e = 0; for (int i = 1; i < 32; ++i) if (off[i] <= t * 256) e = i; tile_e[t] = e; }
    __syncthreads();
}
__device__ __forceinline__ void phase8(Ctx& C) {
    int* off = (int*)C.lds; moe_offsets(C, off);
    const int gw = C.bid * 8 + C.wave, NGW = C.G * 8;
    const int* PE = (const int*)(C.ws + WS_PAIR); const int* PP = PE + 32768; const float* PW = (const float*)(PP + 32768); int* SL = (int*)(PW + 32768); float* SW = (float*)(SL + 32768);
    const bf16_t* XN2 = (const bf16_t*)(C.ws + WS_XN2); bf16_t* XS = (bf16_t*)(C.ws + WS_XN2S);
    for (int p = gw; p < 32768; p += NGW) {
        const int slot = off[PE[p]] + PP[p];
        if (C.lane == 0) { SL[p] = slot; SW[slot] = PW[p]; }
        const u32x4* s = (const u32x4*)(XN2 + (size_t)(p >> 1) * DM); u32x4* d = (u32x4*)(XS + (size_t)slot * DM);
        d[C.lane] = s[C.lane]; d[C.lane + 64] = s[C.lane + 64];
    }
}

__device__ __forceinline__ void phase9(Ctx& C) {
    int* off = (int*)(C.lds + CTRL_OFF + 1024); moe_offsets(C, off);
    const bf16_t* XS = (const bf16_t*)(C.ws + WS_XN2S); bf16_t* H = (bf16_t*)(C.ws + WS_H); unsigned char* ws = C.ws;
    auto bsel = [=](int tm, int tn, int& ldb) { int e = 0; const int r0 = tm * 128;
        for (int i = 1; i < 32; ++i) if (off[i] <= r0) e = i;
        ldb = 1024; return (const bf16_t*)wgu_ptr(ws, e) + (size_t)tn * 256 * 1024; };
    auto epi = [=](int row, int tn, int cc, float g, float u) { H[(size_t)row * 512 + tn * 128 + cc] = (bf16_t)f2bf(siluf(g) * u); };
#if PG8_MASK & 4
    (void)bsel; (void)epi;
    int* tile_e = off + 64; moe_tile_table(C, off, tile_e);
    SchedMoe S{(const char*)XS, C.ws, tile_e, off[32] >> 8, C.G, C.bid, 1024, 0}; EpiUp E{H};
    pg8::gemm_phase<EpiUp, SchedMoe, true, true>((lds_ptr_t)C.lds, 1024, S, E);
#else
    gemm_simple<true>(C, XS, 1024, off[32] / 128, 4, 1024, bsel, epi);
#endif
}

__device__ __forceinline__ void phase10(Ctx& C) {
    int* off = (int*)(C.lds + CTRL_OFF + 1024); moe_offsets(C, off);
    const bf16_t* H = (const bf16_t*)(C.ws + WS_H); bf16_t* Y = (bf16_t*)(C.ws + WS_Y); const bf16_t* WdT = (const bf16_t*)(C.ws + WS_WDT);
    const float* SW = (const float*)(C.ws + WS_PAIR) + 4 * 32768;
    auto bsel = [=](int tm, int tn, int& ldb) { int e = 0; const int r0 = tm * 128;
        for (int i = 1; i < 32; ++i) if (off[i] <= r0) e = i;
        ldb = 512; return WdT + (size_t)e * 1024 * 512 + (size_t)tn * 128 * 512; };
    auto epi = [=](int row, int tn, int cc, float v, float) { Y[(size_t)row * 1024 + tn * 128 + cc] = (bf16_t)f2bf(v * SW[row]); };
#if PG8_MASK & 8
    (void)bsel; (void)epi;
    int* tile_e = off + 64; moe_tile_table(C, off, tile_e);
    SchedMoe S{(const char*)H, C.ws, tile_e, off[32] >> 8, C.G, C.bid, 512, 1}; EpiDown E{Y, SW};
    pg8::gemm_phase<EpiDown, SchedMoe, true, true>((lds_ptr_t)C.lds, 512, S, E);
#else
    gemm_simple<false>(C, H, 512, off[32] / 128, 8, 512, bsel, epi);
#endif
}

__device__ __forceinline__ void phase11(Ctx& C) {
    const int gw = C.bid * 8 + C.wave, NGW = C.G * 8;
    const float* MOD = (const float*)(C.ws + WS_MOD); float* HL = C.out; const bf16_t* Y = (const bf16_t*)(C.ws + WS_Y);
    const int* SL = (const int*)(C.ws + WS_PAIR) + 3 * 32768; const float* fnorm = C.in[I_FNORM];
    for (int l = gw; l < T_LAT; l += NGW) {
        const int b = l >> 12, s1 = SL[l * 2], s2 = SL[l * 2 + 1];
        f32x4 v[4]; float ss = 0.f;
#pragma unroll
        for (int j = 0; j < 4; ++j) { const int c0 = j * 256 + C.lane * 4;
            const f32x4 hv = *(const f32x4*)(HL + (size_t)l * DM + c0), g2 = *(const f32x4*)(MOD + b * 6144 + 5120 + c0);
            const u16x4 a = *(const u16x4*)(Y + (size_t)s1 * DM + c0), bb = *(const u16x4*)(Y + (size_t)s2 * DM + c0);
            f32x4 m; m.x = bf2f(a[0]) + bf2f(bb[0]); m.y = bf2f(a[1]) + bf2f(bb[1]); m.z = bf2f(a[2]) + bf2f(bb[2]); m.w = bf2f(a[3]) + bf2f(bb[3]);
            v[j] = hv + g2 * m; ss += v[j].x * v[j].x + v[j].y * v[j].y + v[j].z * v[j].z + v[j].w * v[j].w; }
        const float rs = rsqrtf(wave_sum(ss) * (1.f / DM) + EPS);
#pragma unroll
        for (int j = 0; j < 4; ++j) { const int c0 = j * 256 + C.lane * 4; const f32x4 fn = *(const f32x4*)(fnorm + c0);
            *(f32x4*)(HL + (size_t)l * DM + c0) = v[j] * rs * fn; }
    }
}


#define LAS __attribute__((address_space(3)))
#define XB_TMO      128
#define XB_XCNT(j)  (256  + 64 * (j))
#define XB_XSUB(j)  (1280 + 64 * (j))
#define XB_XGEN(j)  (2304 + 64 * (j))
#define XB_TOP      3328
#define XB_TOPGEN   3392
#define XCD_BAR_WORDS 3456
#define XB_SPIN_CAP (1u << 18)

__device__ __forceinline__ unsigned xb_ld(unsigned* p)              { return __hip_atomic_load(p, __ATOMIC_RELAXED, __HIP_MEMORY_SCOPE_AGENT); }
__device__ __forceinline__ unsigned xb_add(unsigned* p, unsigned v) { return __hip_atomic_fetch_add(p, v, __ATOMIC_RELAXED, __HIP_MEMORY_SCOPE_AGENT); }
__device__ __forceinline__ unsigned xb_xcc_id() { return (unsigned)__builtin_amdgcn_s_getreg((3 << 11) | 20) & 0xFu; }
#define XB_SPIN(cond, bar) do { unsigned _sp = 0; while (cond) { __builtin_amdgcn_s_sleep(1); \
    if ((++_sp & 255u) == 0u) { if (xb_ld(&(bar)[XB_TMO])) break; if (_sp > XB_SPIN_CAP) { atomicAdd(&(bar)[XB_TMO], 1u); break; } } } } while (0)

struct XcdBarrier {
    unsigned* bar; unsigned x;
    volatile LAS unsigned* st;
};

__device__ __forceinline__ XcdBarrier xcd_barrier_post(unsigned* bar, volatile LAS unsigned* st) {
    XcdBarrier b; b.bar = bar; b.x = xb_xcc_id(); b.st = st;
    if (threadIdx.x == 0) (void)xb_add(&bar[XB_XCNT(b.x)], 1u);
    return b;
}
__device__ __forceinline__ void xcd_barrier_complete(unsigned* bar, unsigned x, unsigned& nloc, unsigned& nx) {
    const unsigned G = gridDim.x * gridDim.y * gridDim.z;
    unsigned sum, cnt, mine, sp = 0u;
    for (;;) {
        sum = 0u; cnt = 0u; mine = 0u;
#pragma unroll
        for (unsigned j = 0; j < 16; ++j) { const unsigned c = xb_ld(&bar[XB_XCNT(j)]); sum += c; cnt += (c > 0u) ? 1u : 0u; mine = (j == x) ? c : mine; }
        if (sum == G) break;
        __builtin_amdgcn_s_sleep(1);
        if ((++sp & 255u) == 0u) { if (xb_ld(&bar[XB_TMO])) break; if (sp > XB_SPIN_CAP) { atomicAdd(&bar[XB_TMO], 1u); break; } }
    }
    nloc = mine > 0u ? mine : 1u; nx = cnt > 0u ? cnt : 1u;
}

__device__ __forceinline__ void xcd_barrier(const XcdBarrier& b) {
    asm volatile("s_waitcnt vmcnt(0)" ::: "memory");
    __syncthreads();
    if (threadIdx.x == 0) {
        unsigned* bar = b.bar;
        __builtin_amdgcn_s_waitcnt(0);
        unsigned nloc = b.st[0], nx = b.st[1];
        if (nloc == 0u) { xcd_barrier_complete(bar, b.x, nloc, nx); b.st[0] = nloc; b.st[1] = nx; }
        const unsigned old = xb_add(&bar[XB_XSUB(b.x)], 1u);
        const unsigned gen = old / nloc;
        if (old + 1u == (gen + 1u) * nloc) {
            __builtin_amdgcn_fence(__ATOMIC_RELEASE, "agent");
            asm volatile("s_waitcnt vmcnt(0)" ::: "memory");
            const unsigned og = xb_add(&bar[XB_TOP], 1u);
            const unsigned tg = og / nx;
            if (og + 1u == (tg + 1u) * nx) xb_add(&bar[XB_TOPGEN], 1u);
            else XB_SPIN(xb_ld(&bar[XB_TOPGEN]) == tg, bar);
            __builtin_amdgcn_fence(__ATOMIC_ACQUIRE, "agent");
            xb_add(&bar[XB_XGEN(b.x)], 1u);
            asm volatile("s_waitcnt vmcnt(0)" ::: "memory");
        } else {
            XB_SPIN(xb_ld(&bar[XB_XGEN(b.x)]) == gen, bar);
            __builtin_amdgcn_fence(__ATOMIC_ACQUIRE, "agent");
            asm volatile("s_waitcnt vmcnt(0)" ::: "memory");
        }
    }
    __syncthreads();
}

__global__ void __launch_bounds__(NTHREADS, 2) fwd_kernel(Args a) {
    extern __shared__ __attribute__((aligned(16))) unsigned char lds[];
    Ctx C;
    if (threadIdx.x == 0) {
#pragma unroll
        for (int i = 0; i < 27; ++i) *(__attribute__((address_space(3))) unsigned long long*)((__attribute__((address_space(3))) unsigned char*)lds + PTAB_OFF + 8 * i) = (unsigned long long)a.in[i];
    }
    C.in.lds = lds; C.out = a.out; C.ws = a.ws; C.lds = lds;
    __syncthreads();
    C.tid = threadIdx.x; C.lane = C.tid & 63; C.wave = __builtin_amdgcn_readfirstlane(C.tid >> 6); C.bid = blockIdx.x; C.G = gridDim.x;
#if MK_COOP
    cg::grid_group grid = cg::this_grid();
    if (C.tid < 2) ((LAS unsigned*)(lds + CTRL_OFF + 64))[C.tid] = 0u;
    __syncthreads();
    XcdBarrier xbar = xcd_barrier_post((unsigned*)(C.ws + WS_CTL) + CW_BAR, (volatile LAS unsigned*)(lds + CTRL_OFF + 64));
#define SEAM(k) do { if ((k) + 1 < a.ph_hi) { if ((k) == 0) grid.sync(); else xcd_barrier(xbar); } } while (0)
#else
#define SEAM(k) do { } while (0)
#endif
#define IN(k) (a.ph_lo <= (k) && (k) < a.ph_hi)
    if (IN(0)) { phase0(C); SEAM(0); }
    if (IN(1)) { phase1(C); SEAM(1); }
    if (IN(2)) { phase2(C); SEAM(2); }
    if (IN(3)) { phase3(C); SEAM(3); }
#ifdef SCAN_NAIVE
    if (IN(4)) { phase4_naive(C); SEAM(4); }
#else
    if (IN(4)) { phase4(C); SEAM(4); }
#endif
    if (IN(5)) { phase5(C); SEAM(5); }
    if (IN(6)) { phase6(C); SEAM(6); }
    if (IN(7)) { phase7(C); SEAM(7); }
    if (IN(8)) { phase8(C); SEAM(8); }
    if (IN(9)) { phase9(C); SEAM(9); }
    if (IN(10)) { phase10(C); SEAM(10); }
    if (IN(11)) { phase11(C); }
}

extern "C" void kernel_launch(void* const* d_in, const int* in_sizes, int n_in, void* d_out, int out_size, void* d_ws, size_t ws_size, hipStream_t stream) {
    static int grid = 0;
    if (grid == 0) {
        if (n_in != 27 || out_size != T_LAT * DM || ws_size < WS_END) { fprintf(stderr, "kernel_launch: unexpected shapes: n_in %d out %d ws %zu (need %zu)\n", n_in, out_size, ws_size, (size_t)WS_END); grid = -1; return; }
        int dev = 0, cus = 0, per_cu = 0;
        hipGetDevice(&dev); hipDeviceGetAttribute(&cus, hipDeviceAttributeMultiprocessorCount, dev);
        hipFuncSetAttribute((const void*)fwd_kernel, hipFuncAttributeMaxDynamicSharedMemorySize, LDS_BYTES);
        hipOccupancyMaxActiveBlocksPerMultiprocessor(&per_cu, (const void*)fwd_kernel, NTHREADS, LDS_BYTES);
        if (per_cu < 1) { fprintf(stderr, "kernel_launch: occupancy query says %d blocks per CU\n", per_cu); per_cu = 1; }
        (void)hipGetLastError();
        grid = cus;
        fprintf(stderr, "kernel_launch: grid %d, per_cu %d, ws %zu\n", grid, per_cu, ws_size);
    }
    if (grid < 0) return;
    hipMemsetAsync((char*)d_ws + WS_CTL, 0, CTL_BYTES, stream);
    Args a{};
    for (int i = 0; i < 27; ++i) a.in[i] = (const float*)d_in[i];
    a.out = (float*)d_out; a.ws = (unsigned char*)d_ws;
#if MK_COOP
    a.ph_lo = 0; a.ph_hi = NPH;
    void* args[] = {&a};
    hipError_t e = hipLaunchCooperativeKernel((const void*)fwd_kernel, dim3(grid), dim3(NTHREADS), args, LDS_BYTES, stream);
    if (e != hipSuccess) fprintf(stderr, "cooperative launch failed: %s (grid %d)\n", hipGetErrorString(e), grid);
#else
    for (int p = 0; p < NPH; ++p) { a.ph_lo = p; a.ph_hi = p + 1; hipLaunchKernelGGL(fwd_kernel, dim3(grid), dim3(NTHREADS), LDS_BYTES, stream, a); }
#endif
}
```

```cpp
#include <hip/hip_runtime.h>
#include <hip/hip_cooperative_groups.h>
#include <cstdio>
#include <cstdint>
namespace cg = cooperative_groups;

#ifndef MK_COOP
#define MK_COOP 1
#endif

constexpr int NB = 4, SEQ = 4096, DM = 1024, CTXL = 256;
constexpr int T_CTX = NB * CTXL, T_LAT = NB * SEQ, T_ALL = T_CTX + T_LAT;
constexpr float EPS = 1e-6f;
constexpr int NW_IN = 5888;
constexpr int NPH = 12;
constexpr int NTHREADS = 512;
constexpr int LDS_BYTES = 147456;

typedef unsigned short bf16_t;
typedef float f32x4 __attribute__((ext_vector_type(4)));
typedef unsigned u32x4 __attribute__((ext_vector_type(4)));
typedef unsigned u32x2 __attribute__((ext_vector_type(2)));
typedef unsigned short u16x8 __attribute__((ext_vector_type(8)));
typedef unsigned short u16x4 __attribute__((ext_vector_type(4)));
#define LASQ __attribute__((address_space(3)))
typedef __attribute__((address_space(3))) unsigned char* lds_ptr_t;

constexpr size_t MiB = 1u << 20;
constexpr size_t WS_QK = 0;
constexpr size_t WS_XBC = 34 * MiB;
constexpr size_t WS_OB = 34 * MiB;
constexpr size_t WS_QKF = 85 * MiB;
constexpr size_t WS_XN = 85 * MiB;
constexpr size_t WS_YX = 85 * MiB;
constexpr size_t WS_V = 119 * MiB;
constexpr size_t WS_XC = 153 * MiB;
constexpr size_t WS_WINT = 153 * MiB;
constexpr size_t WS_RZ = 204 * MiB;
constexpr size_t WS_XN2 = 204 * MiB;
constexpr size_t WS_YB = 268 * MiB;
constexpr size_t WS_GDT = 300 * MiB;
constexpr size_t WS_WOUTT = 305 * MiB;
constexpr size_t WS_MOD = 309 * MiB;
constexpr size_t WS_GLAD = WS_MOD + 256 * 1024;
constexpr size_t WS_CTL = 311 * MiB;
constexpr size_t CTL_BYTES = 64 * 1024;
constexpr size_t WS_PAIR = WS_GLAD + 1088 * 1024;
constexpr size_t WS_ACUM = 311 * MiB + 64 * 1024;
constexpr size_t WS_END = WS_ACUM + (size_t)T_ALL * 32 * 4;
constexpr size_t WS_WDT = 0;
constexpr size_t WS_WGU_LO = 34 * MiB;
constexpr size_t WS_WGU_HI = 268 * MiB;
constexpr size_t WS_H = 66 * MiB;
constexpr size_t WS_XN2S = 106 * MiB;
constexpr size_t WS_Y = 106 * MiB;
constexpr int MAX_SLOTS = 40960;
constexpr int CW_CNT = 0;
constexpr int CW_BLK = 8192;
constexpr int CW_BAR = 1024;

__device__ __forceinline__ float bf2f(bf16_t v) { return __uint_as_float((unsigned)v << 16); }
__device__ __forceinline__ unsigned f2bf(float f) { unsigned u = __float_as_uint(f); return (u + 0x7fffu + ((u >> 16) & 1u)) >> 16; }
typedef float f32x2 __attribute__((ext_vector_type(2)));
typedef __bf16 bf16x2_t __attribute__((ext_vector_type(2)));
__device__ __forceinline__ unsigned pk2(float lo, float hi) { const f32x2 v = {lo, hi}; return __builtin_bit_cast(unsigned, __builtin_convertvector(v, bf16x2_t)); }
__device__ __forceinline__ float siluf(float x) { return x / (1.f + __expf(-x)); }
__device__ __forceinline__ float softplusf(float x) { return fmaxf(x, 0.f) + log1pf(__expf(-fabsf(x))); }
__device__ __forceinline__ float logsigf(float x) { return fminf(x, 0.f) - log1pf(__expf(-fabsf(x))); }
__device__ __forceinline__ float wave_sum(float v) {
#pragma unroll
    for (int o = 1; o < 64; o <<= 1) v += __shfl_xor(v, o);
    return v;
}

struct Args { const float* in[27]; float* out; unsigned char* ws; int ph_lo, ph_hi; };
enum { I_X = 0, I_C, I_CTX, I_CCTX, I_WADA, I_BADA, I_NMIX, I_NFFN, I_WIN, I_GWUP, I_GB, I_GNORM, I_CONVW, I_CONVB, I_DTB, I_ALOG, I_SSDD, I_SSDN,
       I_WOUT, I_RGW, I_RGB, I_REW, I_REB, I_EWG, I_EWU, I_EWD, I_FNORM };

constexpr int CTRL_OFF = LDS_BYTES - 4096;
constexpr int PTAB_OFF = CTRL_OFF + 128;
struct InTab {
    unsigned char* lds;
    __device__ __forceinline__ const float* operator[](int i) const {
        const unsigned long long v = *(const __attribute__((address_space(3))) unsigned long long*)((__attribute__((address_space(3))) unsigned char*)lds + PTAB_OFF + 8 * i);
        const unsigned lo = __builtin_amdgcn_readfirstlane((unsigned)v), hi = __builtin_amdgcn_readfirstlane((unsigned)(v >> 32));
        return (const float*)(const __attribute__((address_space(1))) float*)(((unsigned long long)hi << 32) | lo);
    }
};
struct Ctx {
    InTab in; float* out; unsigned char* ws; unsigned char* lds;
    int tid, lane, wave, bid, G;
};

__device__ __forceinline__ void transpose_tile(const float* src  , int ldw, bf16_t* dst  , int ldt, float* scr, int lane, bool zero) {
#pragma unroll 8
    for (int i = 0; i < 32; ++i) { const int kk = 2 * i + (lane >> 5); scr[kk * 33 + (lane & 31)] = zero ? 0.f : src[(size_t)kk * ldw + (lane & 31)]; }
    asm volatile("s_waitcnt lgkmcnt(0)" ::: "memory");
    const int c = lane & 7;
#pragma unroll
    for (int j = 0; j < 4; ++j) { const int n = (lane >> 3) + 8 * j; const float* s = scr + (8 * c) * 33 + n;
        u32x4 o; o.x = pk2(s[0 * 33], s[1 * 33]); o.y = pk2(s[2 * 33], s[3 * 33]); o.z = pk2(s[4 * 33], s[5 * 33]); o.w = pk2(s[6 * 33], s[7 * 33]);
        *(u32x4*)(dst + (size_t)n * ldt + 8 * c) = o; }
    asm volatile("s_waitcnt lgkmcnt(0)" ::: "memory");
}

__device__ __forceinline__ int win_src_col(int n) {
    if (n < 3072) return n;
    if (n < 4096) return 3104 + (n - 3072);
    if (n < 5632) return 4128 + (n - 4096);
    if (n < 5664) return 3072 + (n - 5632);
    if (n < 5696) return 5664 + (n - 5664);
    return -1;
}

__device__ __forceinline__ void phase0(Ctx& C) {
    float* lds = (float*)C.lds;
    const int gw = C.bid * 8 + C.wave, NGW = C.G * 8;
    {
        float* scr = lds + 8192 + C.wave * (64 * 33);
        bf16_t* WinT = (bf16_t*)(C.ws + WS_WINT); bf16_t* WoutT = (bf16_t*)(C.ws + WS_WOUTT);
        constexpr int IT_IN = 16 * (NW_IN / 32), IT_OUT = 32 * 32;
        for (int it = gw; it < IT_IN + IT_OUT; it += NGW) {
            if (it < IT_IN) { const int kb = it / (NW_IN / 32), nb = it % (NW_IN / 32); const int sc = win_src_col(nb * 32);
                transpose_tile(C.in[I_WIN] + (size_t)(kb * 64) * 5696 + (sc < 0 ? 0 : sc), 5696, WinT + (size_t)(nb * 32) * 1024 + kb * 64, 1024, scr, C.lane, sc < 0); }
            else { const int r = it - IT_IN, kb = r / 32, nb = r % 32;
                transpose_tile(C.in[I_WOUT] + (size_t)(kb * 64) * 1024 + nb * 32, 1024, WoutT + (size_t)(nb * 32) * 2048 + kb * 64, 2048, scr, C.lane, false); }
        }
    }
    __syncthreads();
    float* sc = lds;
    float* red = lds + 5120;
    for (int i = C.tid; i < 5 * 1024; i += NTHREADS) { const int r = i >> 10, k = i & 1023; const float v = r < 4 ? C.in[I_C][r * 1024 + k] : C.in[I_CCTX][k]; sc[i] = siluf(v); }
    __syncthreads();
    float* MOD = (float*)(C.ws + WS_MOD); const float* wada = C.in[I_WADA]; const float* bada = C.in[I_BADA];
    for (int grp = C.bid; grp < 192; grp += C.G) {
        const int col = grp * 32 + (C.tid & 31), kg = C.tid >> 5;
        float acc[5] = {0.f, 0.f, 0.f, 0.f, 0.f};
#pragma unroll 8
        for (int kk = 0; kk < 64; ++kk) { const int k = kg + 16 * kk; const float w = wada[(size_t)k * 6144 + col];
#pragma unroll
            for (int i = 0; i < 5; ++i) acc[i] += sc[i * 1024 + k] * w; }
#pragma unroll
        for (int i = 0; i < 5; ++i) red[(kg * 5 + i) * 32 + (C.tid & 31)] = acc[i];
        __syncthreads();
        if (C.tid < 160) { const int i = C.tid >> 5, c = C.tid & 31; float s = 0.f;
            for (int g = 0; g < 16; ++g) s += red[(g * 5 + i) * 32 + c];
            MOD[i * 6144 + grp * 32 + c] = s + bada[grp * 32 + c]; }
        __syncthreads();
    }
}

__device__ __forceinline__ const float* tok_row(const float* xin, const float* cin, int row, int& mi) {
    if (row < T_CTX) { mi = 4; return cin + (size_t)row * DM; }
    mi = (row - T_CTX) >> 12; return xin + (size_t)(row - T_CTX) * DM;
}

__device__ __forceinline__ void phase1(Ctx& C) {
    const int gw = C.bid * 8 + C.wave, NGW = C.G * 8;
    const float* MOD = (const float*)(C.ws + WS_MOD); bf16_t* XN = (bf16_t*)(C.ws + WS_XN);
    const float* xin = C.in[I_X]; const float* cin = C.in[I_CTX]; const float* nmix = C.in[I_NMIX];
    constexpr int NR = 4;
    for (int r0 = gw; r0 < T_ALL; r0 += NGW * NR) {
        f32x4 v[NR][4]; float ss[NR]; int mi[NR];
#pragma unroll
        for (int u = 0; u < NR; ++u) { const int row = r0 + u * NGW; ss[u] = 0.f; mi[u] = 0;
            if (row < T_ALL) { const float* xr = tok_row(xin, cin, row, mi[u]);
#pragma unroll
                for (int j = 0; j < 4; ++j) v[u][j] = *(const f32x4*)(xr + j * 256 + C.lane * 4); } }
#pragma unroll
        for (int u = 0; u < NR; ++u) { const int row = r0 + u * NGW;
            if (row < T_ALL) {
#pragma unroll
                for (int j = 0; j < 4; ++j) ss[u] += v[u][j].x * v[u][j].x + v[u][j].y * v[u][j].y + v[u][j].z * v[u][j].z + v[u][j].w * v[u][j].w; } }
#pragma unroll
        for (int o = 1; o < 64; o <<= 1) {
#pragma unroll
            for (int u = 0; u < NR; ++u) ss[u] += __shfl_xor(ss[u], o); }
#pragma unroll
        for (int u = 0; u < NR; ++u) { const int row = r0 + u * NGW;
            if (row < T_ALL) { const float rs = rsqrtf(ss[u] * (1.f / DM) + EPS);
#pragma unroll
                for (int j = 0; j < 4; ++j) { const int c0 = j * 256 + C.lane * 4;
                    const f32x4 g = *(const f32x4*)(nmix + c0), sh = *(const f32x4*)(MOD + mi[u] * 6144 + c0), scl = *(const f32x4*)(MOD + mi[u] * 6144 + 1024 + c0);
                    const f32x4 y = v[u][j] * rs * g * (1.f + scl) + sh;
                    u32x2 o; o.x = pk2(y.x, y.y); o.y = pk2(y.z, y.w); *(u32x2*)(XN + (size_t)row * DM + c0) = o; } } }
    }
}

template <bool DUAL, class BSel, class Epi>
__device__ __forceinline__ void gemm_simple(Ctx& C, const bf16_t* A, int lda, int Mtiles, int Ntiles, int K, BSel bsel, Epi epi) {
    float* As = (float*)C.lds;
    float* Bs = As + 32 * 132;
    float* Bs2 = Bs + 32 * 132;
    const int ty = C.tid >> 4, tx = C.tid & 15;
    const int lr = C.tid >> 2, lk = (C.tid & 3) * 8;
    for (int tile = C.bid; tile < Mtiles * Ntiles; tile += C.G) {
        const int tm = tile / Ntiles, tn = tile % Ntiles;
        int ldb; const bf16_t* Bt = bsel(tm, tn, ldb);
        float acc[4][8], acc2[DUAL ? 4 : 1][8];
#pragma unroll
        for (int i = 0; i < 4; ++i)
#pragma unroll
            for (int j = 0; j < 8; ++j) { acc[i][j] = 0.f; if constexpr (DUAL) acc2[i][j] = 0.f; }
        const bf16_t* ap = A + (size_t)(tm * 128 + lr) * lda + lk;
        const bf16_t* bp = Bt + (size_t)lr * ldb + lk;
        for (int k0 = 0; k0 < K; k0 += 32) {
            const u16x8 av = *(const u16x8*)(ap + k0), bv = *(const u16x8*)(bp + k0);
            u16x8 bv2 = bv; if constexpr (DUAL) bv2 = *(const u16x8*)(bp + (size_t)128 * ldb + k0);
            __syncthreads();
#pragma unroll
            for (int j = 0; j < 8; ++j) { As[(lk + j) * 132 + lr] = bf2f(av[j]); Bs[(lk + j) * 132 + lr] = bf2f(bv[j]); if constexpr (DUAL) Bs2[(lk + j) * 132 + lr] = bf2f(bv2[j]); }
            __syncthreads();
#pragma unroll 8
            for (int k = 0; k < 32; ++k) {
                const f32x4 a = *(const f32x4*)(As + k * 132 + ty * 4);
                const f32x4 b0 = *(const f32x4*)(Bs + k * 132 + tx * 8), b1 = *(const f32x4*)(Bs + k * 132 + tx * 8 + 4);
                const float af[4] = {a.x, a.y, a.z, a.w}; const float bf[8] = {b0.x, b0.y, b0.z, b0.w, b1.x, b1.y, b1.z, b1.w};
#pragma unroll
                for (int i = 0; i < 4; ++i)
#pragma unroll
                    for (int j = 0; j < 8; ++j) acc[i][j] += af[i] * bf[j];
                if constexpr (DUAL) {
                    const f32x4 c0 = *(const f32x4*)(Bs2 + k * 132 + tx * 8), c1 = *(const f32x4*)(Bs2 + k * 132 + tx * 8 + 4);
                    const float cf[8] = {c0.x, c0.y, c0.z, c0.w, c1.x, c1.y, c1.z, c1.w};
#pragma unroll
                    for (int i = 0; i < 4; ++i)
#pragma unroll
                        for (int j = 0; j < 8; ++j) acc2[i][j] += af[i] * cf[j];
                }
            }
        }
#pragma unroll
        for (int i = 0; i < 4; ++i)
#pragma unroll
            for (int j = 0; j < 8; ++j) { float a2 = 0.f; if constexpr (DUAL) a2 = acc2[i][j]; epi(tm * 128 + ty * 4 + i, tn, tx * 8 + j, acc[i][j], a2); }
        __syncthreads();
    }
}


namespace pg8 {
#define PG8_LAS __attribute__((address_space(3)))
typedef short bf16x8 __attribute__((ext_vector_type(8)));
constexpr int BM = 256, BK = 64, HALF = 128, HTB = HALF * BK * 2  , STAGE_BYTES = 8 * HTB, NXCD = 8, WGM = 8;
__host__ __device__ __forceinline__ int lds_byte(int r, int c) { const int st = (r >> 4) * 2 + (c >> 5), rr = r & 15, cc = c & 31, ob = rr * 64 + cc * 2; return st * 1024 + (ob ^ (((ob >> 9) & 1) << 5)); }
__host__ __device__ __forceinline__ void stage_rc(int b, int& R, int& C) { const int st = b / 1024, sb = b % 1024, swz = sb ^ (((sb >> 9) & 1) << 5); R = (st >> 1) * 16 + swz / 64; C = (st & 1) * 32 + (swz % 64) / 2; }
__host__ __device__ __forceinline__ int perm32(int rho) { const int n = rho >> 4, i = rho & 15; return 8 * (i >> 2) + 4 * n + (i & 3); }
struct Unit { int pm, pn; };
__device__ __forceinline__ unsigned cvt_pk_bf16(float lo, float hi) { unsigned r; asm volatile("v_cvt_pk_bf16_f32 %0, %1, %2" : "=v"(r) : "v"(lo), "v"(hi)); return r; }
__device__ __forceinline__ int xcd_remap(int L, int nwg) { const int q = nwg / NXCD, r = nwg % NXCD, xcd = L % NXCD, off = L / NXCD; return (xcd < r ? xcd * (q + 1) : r * (q + 1) + (xcd - r) * q) + off; }
template <class Epi, class Sched, bool ALIGN_EPI = false, bool SP2 = false>
__device__ __forceinline__ void gemm_phase(PG8_LAS unsigned char* lds, const int K_, const Sched& S, const Epi& E) {
    const int tid = threadIdx.x, wid = __builtin_amdgcn_readfirstlane(tid >> 6), lane = tid & 63, wr = wid >> 2, wc = wid & 3, fr = lane & 15, fq = lane >> 4;
    const int K = K_, nt = K / BK;
    unsigned voffA[2], voffB[2];
#pragma unroll
    for (int i = 0; i < 2; ++i) { int R, C; stage_rc(tid * 16 + i * 8192, R, C); const int Rb = Epi::PERM ? ((R & ~31) + perm32(R & 31)) : R;
        voffA[i] = (unsigned)(R * K + C) * 2u; voffB[i] = (unsigned)(Rb * K + C) * 2u; }
    const size_t kstep = (size_t)(BK * 2);
    const size_t hstep = (size_t)HALF * K * 2;
    const unsigned ldsw = (unsigned)wid * 1024u;
    const int aoff = lds_byte(wr * 64 + fr, fq * 8), boff = lds_byte(wc * 32 + fr, fq * 8);
#define PG8_SA(b, h) (((b) * 2 + (h)) * HTB)
#define PG8_SB(b, h) ((4 + (b) * 2 + (h)) * HTB)
#define PG8_STAGE(bufoff, gbase, voff) do { _Pragma("unroll") for (int _i = 0; _i < 2; ++_i) \
        __builtin_amdgcn_global_load_lds((const unsigned*)((const char*)(gbase) + (voff)[_i]), (PG8_LAS unsigned*)(lds + (bufoff) + ldsw + _i * 8192), 16, 0, 0); } while (0)
#define PG8_LDA(dst, b, h) do { _Pragma("unroll") for (int m = 0; m < 4; ++m) _Pragma("unroll") for (int k = 0; k < 2; ++k) dst[m][k] = *(const PG8_LAS bf16x8*)(lds + PG8_SA(b, h) + aoff + m * 2048 + k * 1024); } while (0)
#define PG8_LDB(dst, b, h) do { _Pragma("unroll") for (int n = 0; n < 2; ++n) _Pragma("unroll") for (int k = 0; k < 2; ++k) dst[n][k] = *(const PG8_LAS bf16x8*)(lds + PG8_SB(b, h) + boff + n * 2048 + k * 1024); } while (0)
#define PG8_MMA(ai, bj, At, Bt) do { __builtin_amdgcn_s_setprio(1); _Pragma("unroll") for (int m = 0; m < 4; ++m) _Pragma("unroll") for (int n = 0; n < 2; ++n) _Pragma("unroll") for (int k = 0; k < 2; ++k) \
        acc[ai][bj][m][n] = __builtin_amdgcn_mfma_f32_16x16x32_bf16(Bt[n][k], At[m][k], acc[ai][bj][m][n], 0, 0, 0); __builtin_amdgcn_s_setprio(0); } while (0)
#define PG8_WAIT_V(n) asm volatile("s_waitcnt vmcnt(" #n ")" ::: "memory")
#define PG8_WAIT_L(n) asm volatile("s_waitcnt lgkmcnt(" #n ")" ::: "memory")
#define PG8_BAR __builtin_amdgcn_s_barrier()
#define PG8_SCHED __builtin_amdgcn_sched_barrier(0)
    Unit cur, nxt; int ui = 0;
    if (!S.next(0, cur)) return;
    f32x4 acc[2][2][4][2];
#pragma unroll
    for (int a = 0; a < 2; ++a)
#pragma unroll
        for (int b = 0; b < 2; ++b)
#pragma unroll
            for (int m = 0; m < 4; ++m)
#pragma unroll
                for (int n = 0; n < 2; ++n) acc[a][b][m][n] = (f32x4){0.f, 0.f, 0.f, 0.f};
    bf16x8 At[4][2], B0[2][2], B1[2][2];
    const char* cA = S.a_ptr(cur); const char* cB = S.b_ptr(cur);
    S.a_ready(cur);
    if constexpr (SP2) {
        PG8_STAGE(PG8_SB(0, 0), cB, voffB); PG8_STAGE(PG8_SB(0, 1), cB + hstep, voffB); PG8_STAGE(PG8_SA(0, 0), cA, voffA); PG8_STAGE(PG8_SA(0, 1), cA + hstep, voffA);
        if (wr == 1) PG8_BAR;
        PG8_WAIT_V(2); PG8_BAR;
        PG8_STAGE(PG8_SB(1, 0), cB + kstep, voffB); PG8_STAGE(PG8_SA(1, 0), cA + kstep, voffA); PG8_STAGE(PG8_SB(1, 1), cB + hstep + kstep, voffB);
        PG8_WAIT_V(6); PG8_BAR;
    } else {
        PG8_STAGE(PG8_SB(0, 0), cB, voffB); PG8_STAGE(PG8_SA(0, 0), cA, voffA); PG8_STAGE(PG8_SB(0, 1), cB + hstep, voffB); PG8_STAGE(PG8_SA(0, 1), cA + hstep, voffA);
        if (wr == 1) PG8_BAR;
        PG8_WAIT_V(4); PG8_BAR;
        PG8_STAGE(PG8_SB(1, 0), cB + kstep, voffB); PG8_STAGE(PG8_SA(1, 0), cA + kstep, voffA); PG8_STAGE(PG8_SB(1, 1), cB + hstep + kstep, voffB);
        PG8_WAIT_V(6); PG8_BAR;
    }
    for (;;) {
        const bool has_next = S.next(ui + 1, nxt);
        const char* nA = has_next ? S.a_ptr(nxt) : cA; const char* nB = has_next ? S.b_ptr(nxt) : cB;
        for (int t = 0; t < nt; t += 2) {
            const bool last = (t == nt - 2);
            const char* a1 = cA + (size_t)(t + 1) * kstep;
            const char* a2 = last ? nA : cA + (size_t)(t + 2) * kstep; const char* b2 = last ? nB : cB + (size_t)(t + 2) * kstep;
            const char* a3 = a2 + kstep; const char* b3 = b2 + kstep;
            if (last && has_next) S.a_ready(nxt);
            if constexpr (SP2) {
            PG8_LDB(B0, 0, 0); PG8_LDB(B1, 0, 1); PG8_SCHED; PG8_LDA(At, 0, 0); PG8_STAGE(PG8_SA(1, 1), a1 + hstep, voffA);
            PG8_WAIT_V(8); PG8_WAIT_L(0); PG8_BAR; PG8_MMA(0, 0, At, B0); PG8_MMA(0, 1, At, B1); PG8_BAR; PG8_SCHED;
            PG8_LDA(At, 0, 1); PG8_STAGE(PG8_SB(0, 0), b2, voffB); PG8_STAGE(PG8_SB(0, 1), b2 + hstep, voffB); PG8_STAGE(PG8_SA(0, 0), a2, voffA);
            PG8_WAIT_V(8); PG8_WAIT_L(0); PG8_BAR; PG8_MMA(1, 0, At, B0); PG8_MMA(1, 1, At, B1); PG8_BAR; PG8_SCHED;
            PG8_LDB(B0, 1, 0); PG8_LDB(B1, 1, 1); PG8_SCHED; PG8_LDA(At, 1, 0); PG8_STAGE(PG8_SA(0, 1), a2 + hstep, voffA);
            PG8_WAIT_V(8); PG8_WAIT_L(0); PG8_BAR; PG8_MMA(0, 0, At, B0); PG8_MMA(0, 1, At, B1); PG8_BAR; PG8_SCHED;
            PG8_LDA(At, 1, 1); PG8_STAGE(PG8_SB(1, 0), b3, voffB); PG8_STAGE(PG8_SB(1, 1), b3 + hstep, voffB); PG8_STAGE(PG8_SA(1, 0), a3, voffA);
            PG8_WAIT_V(8); PG8_WAIT_L(0); PG8_BAR; PG8_MMA(1, 0, At, B0); PG8_MMA(1, 1, At, B1); PG8_BAR; PG8_SCHED;
            } else {
            PG8_LDB(B0, 0, 0); PG8_SCHED; PG8_LDA(At, 0, 0); PG8_STAGE(PG8_SA(1, 1), a1 + hstep, voffA);
            PG8_WAIT_L(8); PG8_BAR; PG8_WAIT_L(0); PG8_MMA(0, 0, At, B0); PG8_BAR; PG8_SCHED;
            PG8_LDB(B1, 0, 1); PG8_STAGE(PG8_SB(0, 0), b2, voffB);
            PG8_BAR; PG8_WAIT_L(0); PG8_MMA(0, 1, At, B1); PG8_BAR;
            PG8_LDA(At, 0, 1); PG8_STAGE(PG8_SA(0, 0), a2, voffA);
            PG8_BAR; PG8_WAIT_L(0); PG8_MMA(1, 0, At, B0); PG8_BAR; PG8_SCHED;
            PG8_STAGE(PG8_SB(0, 1), b2 + hstep, voffB);
            PG8_WAIT_V(6); PG8_BAR; PG8_MMA(1, 1, At, B1); PG8_BAR;
            PG8_LDB(B0, 1, 0); PG8_SCHED; PG8_LDA(At, 1, 0); PG8_STAGE(PG8_SA(0, 1), a2 + hstep, voffA);
            PG8_WAIT_L(8); PG8_BAR; PG8_WAIT_L(0); PG8_MMA(0, 0, At, B0); PG8_BAR; PG8_SCHED;
            PG8_LDB(B1, 1, 1); PG8_STAGE(PG8_SB(1, 0), b3, voffB);
            PG8_BAR; PG8_WAIT_L(0); PG8_MMA(0, 1, At, B1); PG8_BAR;
            PG8_LDA(At, 1, 1); PG8_STAGE(PG8_SA(1, 0), a3, voffA);
            PG8_BAR; PG8_WAIT_L(0); PG8_MMA(1, 0, At, B0); PG8_BAR; PG8_SCHED;
            PG8_STAGE(PG8_SB(1, 1), b3 + hstep, voffB);
            PG8_WAIT_V(6); PG8_BAR; PG8_MMA(1, 1, At, B1); PG8_BAR;
            }
        }
        if constexpr (ALIGN_EPI) { if (wr == 0) PG8_BAR; }
        if constexpr (!Epi::AFTER_DRAIN) { E(acc, cur, wr, wc, fr, fq); S.done(cur); }
        if (!has_next) break;
#pragma unroll
        for (int a = 0; a < 2; ++a)
#pragma unroll
            for (int b = 0; b < 2; ++b)
#pragma unroll
                for (int m = 0; m < 4; ++m)
#pragma unroll
                    for (int n = 0; n < 2; ++n) acc[a][b][m][n] = (f32x4){0.f, 0.f, 0.f, 0.f};
        cur = nxt; cA = nA; cB = nB; ++ui;
        if constexpr (ALIGN_EPI) { if (wr == 1) PG8_BAR; }
    }
    PG8_WAIT_V(0);
    if constexpr (!ALIGN_EPI) { if (wr == 0) PG8_BAR; }
    PG8_BAR;
    if constexpr (Epi::AFTER_DRAIN) { E.fused(acc, cur, wr, wc, fr, fq, lds, wid, lane); S.done(cur); }
#undef PG8_SA
#undef PG8_SB
#undef PG8_STAGE
#undef PG8_LDA
#undef PG8_LDB
#undef PG8_MMA
#undef PG8_WAIT_V
#undef PG8_WAIT_L
#undef PG8_BAR
#undef PG8_SCHED
}
}

__device__ __forceinline__ bf16_t* wgu_ptr(unsigned char* ws, int e) { return (bf16_t*)(ws + (e < 16 ? WS_WGU_LO : WS_WGU_HI)) + (size_t)(e & 15) * 1024 * 1024; }

#ifndef PG8_MASK
#define PG8_MASK 15
#endif

struct SchedIn {
    const char* A; const char* Bt; int G, c;
    __device__ __forceinline__ bool next(int i, pg8::Unit& u) const {
        const int L0 = i * G + c; if (L0 >= 1532) return false;
        const int L = pg8::xcd_remap(L0, 1532);
        if (L < 60) { const int pi = L >> 2; u.pm = L & 3; u.pn = pi < 8 ? pi : pi + 8; }
        else { const int l2 = L - 60, g = l2 / 184, r = l2 % 184; u.pn = r >> 3; u.pm = 4 + 8 * g + (r & 7); }
        return true;
    }
    __device__ __forceinline__ const char* a_ptr(const pg8::Unit& u) const { return A + (size_t)u.pm * (256 * 1024 * 2); }
    __device__ __forceinline__ const char* b_ptr(const pg8::Unit& u) const { return Bt + (size_t)u.pn * (256 * 1024 * 2); }
    __device__ __forceinline__ void a_ready(const pg8::Unit&) const {}
    __device__ __forceinline__ void done(const pg8::Unit&) const {}
};
struct SchedOut {
    const char* A; const char* Bt; int G, c;
    __device__ __forceinline__ bool next(int i, pg8::Unit& u) const {
        const int L0 = i * G + c; if (L0 >= 256) return false;
        const int w = pg8::xcd_remap(L0, 256), gid = w >> 5, r = w & 31;
        u.pm = gid * 8 + (r & 7); u.pn = r >> 3;
        return true;
    }
    __device__ __forceinline__ const char* a_ptr(const pg8::Unit& u) const { return A + (size_t)u.pm * (256 * 2048 * 2); }
    __device__ __forceinline__ const char* b_ptr(const pg8::Unit& u) const { return Bt + (size_t)u.pn * (256 * 2048 * 2); }
    __device__ __forceinline__ void a_ready(const pg8::Unit&) const {}
    __device__ __forceinline__ void done(const pg8::Unit&) const {}
};
struct SchedMoe {
    const char* A; unsigned char* ws; const int* tile_e; int NT, G, c, K, down;
    __device__ __forceinline__ bool next(int i, pg8::Unit& u) const {
        const int nwg = NT * 4; const int L0 = i * G + c; if (L0 >= nwg) return false;
        const int w = pg8::xcd_remap(L0, nwg);
        u.pm = w >> 2; u.pn = w & 3;
        return true;
    }
    __device__ __forceinline__ const char* a_ptr(const pg8::Unit& u) const { return A + (size_t)u.pm * 256 * K * 2; }
    __device__ __forceinline__ const char* b_ptr(const pg8::Unit& u) const {
        const int e = __builtin_amdgcn_readfirstlane(tile_e[u.pm]);
        return down ? (const char*)(ws + WS_WDT) + ((size_t)e * 1024 * 512 + (size_t)u.pn * 256 * 512) * 2
                    : (const char*)wgu_ptr(ws, e) + (size_t)u.pn * 256 * 1024 * 2;
    }
    __device__ __forceinline__ void a_ready(const pg8::Unit&) const {}
    __device__ __forceinline__ void done(const pg8::Unit&) const {}
};

struct EpiIn {
    static constexpr bool PERM = true, AFTER_DRAIN = false;
    unsigned char* ws;
    __device__ __forceinline__ void operator()(const f32x4 (&acc)[2][2][4][2], const pg8::Unit& u, int wr, int wc, int fr, int fq) const {
        const int pn = u.pn; const int row0 = u.pm * 256 + wr * 64 + fr; const int ct = wc * 32 + 8 * fq;
        if (pn == 22) {
            if (wc < 2) { float* GDT = (float*)(ws + WS_GDT);
#pragma unroll
                for (int ai = 0; ai < 2; ++ai)
#pragma unroll
                    for (int m = 0; m < 4; ++m) { float* p = GDT + (size_t)(row0 + ai * 128 + m * 16) * 64 + ct; *(f32x4*)p = acc[ai][0][m][0]; *(f32x4*)(p + 4) = acc[ai][0][m][1]; } }
            return;
        }
        bf16_t* base; int ld; int roff = 0; bool act = false;
        if (pn < 4) { base = (bf16_t*)(ws + WS_QK) + pn * 256; ld = 1024; }
        else if (pn < 8) { base = (bf16_t*)(ws + WS_V) + (pn - 4) * 256; ld = 1024; }
        else if (pn < 16) { base = (bf16_t*)(ws + WS_RZ) + (pn - 8) * 256; ld = 2048; roff = T_CTX; act = true; }
        else { base = (bf16_t*)(ws + WS_XBC) + (pn - 16) * 256; ld = 1536; }
#pragma unroll
        for (int ai = 0; ai < 2; ++ai)
#pragma unroll
            for (int m = 0; m < 4; ++m) { bf16_t* rowp = base + (size_t)(row0 - roff + ai * 128 + m * 16) * ld + ct;
#pragma unroll
                for (int bj = 0; bj < 2; ++bj) { f32x4 v0 = acc[ai][bj][m][0], v1 = acc[ai][bj][m][1];
                    if (act) { v0.x = siluf(v0.x); v0.y = siluf(v0.y); v0.z = siluf(v0.z); v0.w = siluf(v0.w); v1.x = siluf(v1.x); v1.y = siluf(v1.y); v1.z = siluf(v1.z); v1.w = siluf(v1.w); }
                    u32x4 w; w.x = pg8::cvt_pk_bf16(v0.x, v0.y); w.y = pg8::cvt_pk_bf16(v0.z, v0.w); w.z = pg8::cvt_pk_bf16(v1.x, v1.y); w.w = pg8::cvt_pk_bf16(v1.z, v1.w);
                    *(u32x4*)(rowp + bj * 128) = w; } }
    }
};
struct EpiOut {
    static constexpr bool PERM = false, AFTER_DRAIN = false;
    const float* X; const float* MOD; float* HL;
    __device__ __forceinline__ void operator()(const f32x4 (&acc)[2][2][4][2], const pg8::Unit& u, int wr, int wc, int fr, int fq) const {
        const int b = u.pm >> 4; const int col0 = u.pn * 256 + wc * 32 + 4 * fq;
        f32x4 g1[2][2];
#pragma unroll
        for (int bj = 0; bj < 2; ++bj)
#pragma unroll
            for (int n = 0; n < 2; ++n) g1[bj][n] = *(const f32x4*)(MOD + b * 6144 + 2048 + col0 + bj * 128 + n * 16);
#pragma unroll
        for (int ai = 0; ai < 2; ++ai)
#pragma unroll
            for (int m = 0; m < 4; ++m) { const size_t off = (size_t)(u.pm * 256 + ai * 128 + wr * 64 + m * 16 + fr) * 1024 + col0;
#pragma unroll
                for (int bj = 0; bj < 2; ++bj)
#pragma unroll
                    for (int n = 0; n < 2; ++n) { const f32x4 xv = *(const f32x4*)(X + off + bj * 128 + n * 16); *(f32x4*)(HL + off + bj * 128 + n * 16) = xv + g1[bj][n] * acc[ai][bj][m][n]; }
                if (m & 1) asm volatile("" ::: "memory"); }
    }
};
struct EpiUp {
    static constexpr bool PERM = true, AFTER_DRAIN = false;
    bf16_t* H;
    __device__ __forceinline__ void operator()(const f32x4 (&acc)[2][2][4][2], const pg8::Unit& u, int wr, int wc, int fr, int fq) const {
        const int row0 = u.pm * 256 + wr * 64 + fr; const int col = u.pn * 128 + wc * 32 + 8 * fq;
#pragma unroll
        for (int ai = 0; ai < 2; ++ai)
#pragma unroll
            for (int m = 0; m < 4; ++m) { const f32x4 g0 = acc[ai][0][m][0], g1 = acc[ai][0][m][1], u0 = acc[ai][1][m][0], u1 = acc[ai][1][m][1];
                u32x4 w; w.x = pg8::cvt_pk_bf16(siluf(g0.x) * u0.x, siluf(g0.y) * u0.y); w.y = pg8::cvt_pk_bf16(siluf(g0.z) * u0.z, siluf(g0.w) * u0.w);
                w.z = pg8::cvt_pk_bf16(siluf(g1.x) * u1.x, siluf(g1.y) * u1.y); w.w = pg8::cvt_pk_bf16(siluf(g1.z) * u1.z, siluf(g1.w) * u1.w);
                *(u32x4*)(H + (size_t)(row0 + ai * 128 + m * 16) * 512 + col) = w; }
    }
};
struct EpiDown {
    static constexpr bool PERM = true, AFTER_DRAIN = false;
    bf16_t* Y; const float* SW;
    __device__ __forceinline__ void operator()(const f32x4 (&acc)[2][2][4][2], const pg8::Unit& u, int wr, int wc, int fr, int fq) const {
        const int row0 = u.pm * 256 + wr * 64 + fr; const int col = u.pn * 256 + wc * 32 + 8 * fq;
#pragma unroll
        for (int ai = 0; ai < 2; ++ai)
#pragma unroll
            for (int m = 0; m < 4; ++m) { const int row = row0 + ai * 128 + m * 16; const float sw = SW[row];
#pragma unroll
                for (int bj = 0; bj < 2; ++bj) { const f32x4 v0 = acc[ai][bj][m][0] * sw, v1 = acc[ai][bj][m][1] * sw;
                    u32x4 w; w.x = pg8::cvt_pk_bf16(v0.x, v0.y); w.y = pg8::cvt_pk_bf16(v0.z, v0.w); w.z = pg8::cvt_pk_bf16(v1.x, v1.y); w.w = pg8::cvt_pk_bf16(v1.z, v1.w);
                    *(u32x4*)(Y + (size_t)row * 1024 + col + bj * 128) = w; } }
    }
};

__device__ __forceinline__ void phase2(Ctx& C) {
    const bf16_t* XN = (const bf16_t*)(C.ws + WS_XN); const bf16_t* WinT = (const bf16_t*)(C.ws + WS_WINT);
    bf16_t* QK = (bf16_t*)(C.ws + WS_QK); bf16_t* V = (bf16_t*)(C.ws + WS_V); bf16_t* RZ = (bf16_t*)(C.ws + WS_RZ); bf16_t* XBC = (bf16_t*)(C.ws + WS_XBC);
    float* GDT = (float*)(C.ws + WS_GDT);
    auto bsel = [=](int, int tn, int& ldb) { ldb = 1024; return WinT + (size_t)tn * 128 * 1024; };
    auto epi = [=](int row, int tn, int cc, float v, float) {
        const int col = tn * 128 + cc;
        if (col < 1024) QK[(size_t)row * 1024 + col] = (bf16_t)f2bf(v);
        else if (col < 2048) V[(size_t)row * 1024 + col - 1024] = (bf16_t)f2bf(v);
        else if (col < 4096) { if (row >= T_CTX) RZ[(size_t)(row - T_CTX) * 2048 + col - 2048] = (bf16_t)f2bf(siluf(v)); }
        else if (col < 5632) XBC[(size_t)row * 1536 + col - 4096] = (bf16_t)f2bf(v);
        else if (col < 5696) GDT[(size_t)row * 64 + col - 5632] = v;
    };
#if PG8_MASK & 1
    (void)bsel; (void)epi;
    SchedIn S{(const char*)XN, (const char*)WinT, C.G, C.bid}; EpiIn E{C.ws};
    pg8::gemm_phase<EpiIn, SchedIn, true, true>((lds_ptr_t)C.lds, 1024, S, E);
#else
    gemm_simple<false>(C, XN, 1024, T_ALL / 128, NW_IN / 128, 1024, bsel, epi);
#endif
}

__device__ __forceinline__ void phase3(Ctx& C) {
    float* lds = (float*)C.lds;
    {
        lds_ptr_t L = (lds_ptr_t)C.lds;
        constexpr int IN_O = 0, OUT_O = 32768, GS_O = 98304, TOT_O = 106496;
        LASQ float* gs = (LASQ float*)(L + GS_O); LASQ float* tot = (LASQ float*)(L + TOT_O);
        bf16_t* QK = (bf16_t*)(C.ws + WS_QK); bf16_t* QKF = (bf16_t*)(C.ws + WS_QKF);
        const float* GDT = (const float*)(C.ws + WS_GDT); float* GLAD = (float*)(C.ws + WS_GLAD);
        const float* gwup = C.in[I_GWUP]; const float* gbias = C.in[I_GB];
        const int tid = C.tid, c = tid & 127, tg = tid >> 7;
        for (int item = C.bid; item < 272 * 4; item += C.G) {
            const int rc = item >> 2, h = item & 3, row0 = rc * 64;
            __syncthreads();
#pragma unroll
            for (int i = 0; i < 4; ++i) { const int id = tid + 512 * i, arr = id >> 10, r = (id >> 4) & 63, ch = id & 15;
                *(LASQ u32x4*)(L + IN_O + arr * 16384 + r * 256 + ch * 16) = *(const u32x4*)(QK + (size_t)(row0 + r) * 1024 + arr * 512 + h * 128 + ch * 8); }
            *(LASQ f32x4*)(gs + (tid >> 3) * 32 + (tid & 7) * 4) = *(const f32x4*)(GDT + (size_t)(row0 + (tid >> 3)) * 64 + (tid & 7) * 4);
            float wf[16], wb[16];
#pragma unroll
            for (int r = 0; r < 16; ++r) { wf[r] = gwup[r * 512 + h * 128 + c]; wb[r] = gwup[(16 + r) * 512 + h * 128 + c]; }
            const float bfv = gbias[h * 128 + c], bbv = gbias[512 + h * 128 + c];
            __syncthreads();
            float pf[16], pb[16];
#pragma unroll
            for (int tt = 0; tt < 16; ++tt) { const LASQ float* g = gs + (tg * 16 + tt) * 32; float sf = bfv, sb = bbv;
#pragma unroll
                for (int r = 0; r < 16; ++r) { sf += g[r] * wf[r]; sb += g[16 + r] * wb[r]; }
                pf[tt] = logsigf(sf) * (1.f / 16.f); pb[tt] = logsigf(sb) * (1.f / 16.f); }
#pragma unroll
            for (int tt = 1; tt < 16; ++tt) pf[tt] += pf[tt - 1];
#pragma unroll
            for (int tt = 14; tt >= 0; --tt) pb[tt] += pb[tt + 1];
            tot[(0 * 4 + tg) * 128 + c] = pf[15]; tot[(1 * 4 + tg) * 128 + c] = pb[0];
            __syncthreads();
            float offf = 0.f, offb = 0.f, totf = 0.f, totb = 0.f;
#pragma unroll
            for (int g = 0; g < 4; ++g) { const float a = tot[(0 * 4 + g) * 128 + c], bq = tot[(1 * 4 + g) * 128 + c]; if (g < tg) offf += a; if (g > tg) offb += bq; totf += a; totb += bq; }
            if (tg == 0) { GLAD[((size_t)(rc * 4 + h) * 2 + 0) * 128 + c] = __expf(totf); GLAD[((size_t)(rc * 4 + h) * 2 + 1) * 128 + c] = __expf(totb); }
            const float qscale = 0.08838834764831845f;
#pragma unroll
            for (int tt = 0; tt < 16; ++tt) { const int r = tg * 16 + tt;
                const float q = bf2f(*(const LASQ bf16_t*)(L + IN_O + r * 256 + c * 2)) * qscale, k = bf2f(*(const LASQ bf16_t*)(L + IN_O + 16384 + r * 256 + c * 2));
                const float ef = pf[tt] + offf, eb = pb[tt] + offb;
                *(LASQ bf16_t*)(L + OUT_O + 0 * 16384 + r * 256 + c * 2) = (bf16_t)f2bf(q * __expf(ef));
                *(LASQ bf16_t*)(L + OUT_O + 1 * 16384 + r * 256 + c * 2) = (bf16_t)f2bf(k * __expf(-ef));
                *(LASQ bf16_t*)(L + OUT_O + 2 * 16384 + r * 256 + c * 2) = (bf16_t)f2bf(q * __expf(eb));
                *(LASQ bf16_t*)(L + OUT_O + 3 * 16384 + r * 256 + c * 2) = (bf16_t)f2bf(k * __expf(-eb)); }
            __syncthreads();
#pragma unroll
            for (int i = 0; i < 8; ++i) { const int id = tid + 512 * i, arr = id >> 10, r = (id >> 4) & 63, ch = id & 15;
                bf16_t* dst = (arr < 2 ? QKF : QK) + (size_t)(row0 + r) * 1024 + (arr & 1) * 512 + h * 128 + ch * 8;
                *(u32x4*)dst = *(const LASQ u32x4*)(L + OUT_O + arr * 16384 + r * 256 + ch * 16); }
        }
        __syncthreads();
    }
    {
        const bf16_t* XBC = (const bf16_t*)(C.ws + WS_XBC); bf16_t* XC = (bf16_t*)(C.ws + WS_XC);
        const float* cw = C.in[I_CONVW]; const float* cb = C.in[I_CONVB];
        const int total = 272 * 4 * 192;
        for (int it = C.bid * NTHREADS + C.tid; it < total; it += C.G * NTHREADS) {
            const int cg8 = it % 192, st = it / 192, rc = st >> 2, x0 = (st & 3) * 16, c0 = cg8 * 8;
            int base, y, xb, H, W;
            if (rc < 16) { base = (rc >> 2) * 256; y = 0; xb = (rc & 3) * 64; H = 1; W = 256; }
            else { const int lr = rc - 16; base = T_CTX + (lr >> 6) * 4096; y = lr & 63; xb = 0; H = 64; W = 64; }
            float wt[9][8], bias[8];
#pragma unroll
            for (int t = 0; t < 9; ++t) { const f32x4 a = *(const f32x4*)(cw + (size_t)t * 1536 + c0), bq = *(const f32x4*)(cw + (size_t)t * 1536 + c0 + 4);
                wt[t][0] = a.x; wt[t][1] = a.y; wt[t][2] = a.z; wt[t][3] = a.w; wt[t][4] = bq.x; wt[t][5] = bq.y; wt[t][6] = bq.z; wt[t][7] = bq.w; }
            { const f32x4 a = *(const f32x4*)(cb + c0), bq = *(const f32x4*)(cb + c0 + 4); bias[0] = a.x; bias[1] = a.y; bias[2] = a.z; bias[3] = a.w; bias[4] = bq.x; bias[5] = bq.y; bias[6] = bq.z; bias[7] = bq.w; }
            const bool vy[3] = {y - 1 >= 0, true, y + 1 < H};
            u16x8 win[3][3];
            auto ldcol = [&](int i, int xx) -> u16x8 { u16x8 z = {0, 0, 0, 0, 0, 0, 0, 0};
                if (!vy[i] || xx < 0 || xx >= W) return z;
                return *(const u16x8*)(XBC + (size_t)(base + (y + i - 1) * W + xx) * 1536 + c0); };
            const int xs = xb + x0;
#pragma unroll
            for (int i = 0; i < 3; ++i) { win[i][0] = ldcol(i, xs - 1); win[i][1] = ldcol(i, xs); }
            for (int dx = 0; dx < 16; ++dx) { const int x = xs + dx;
#pragma unroll
                for (int i = 0; i < 3; ++i) win[i][2] = ldcol(i, x + 1);
                float acc[8];
#pragma unroll
                for (int j = 0; j < 8; ++j) acc[j] = bias[j];
#pragma unroll
                for (int i = 0; i < 3; ++i)
#pragma unroll
                    for (int jx = 0; jx < 3; ++jx)
#pragma unroll
                        for (int j = 0; j < 8; ++j) acc[j] += bf2f(win[i][jx][j]) * wt[i * 3 + jx][j];
                u32x4 o; o.x = pk2(siluf(acc[0]), siluf(acc[1])); o.y = pk2(siluf(acc[2]), siluf(acc[3])); o.z = pk2(siluf(acc[4]), siluf(acc[5])); o.w = pk2(siluf(acc[6]), siluf(acc[7]));
                *(u32x4*)(XC + (size_t)(base + y * W + x) * 1536 + c0) = o;
#pragma unroll
                for (int i = 0; i < 3; ++i) { win[i][0] = win[i][1]; win[i][1] = win[i][2]; }
            }
        }
    }
    {
        float* GDT = (float*)(C.ws + WS_GDT); float* ACUM = (float*)(C.ws + WS_ACUM);
        const float* alog = C.in[I_ALOG]; const float* dtbias = C.in[I_DTB];
        const int gw = C.bid * 8 + C.wave, NGW = C.G * 8, l = C.lane;
        for (int it = gw; it < 272 * 32; it += NGW) {
            const int rc = it >> 5, dh = it & 31, dir = dh >> 4; const size_t row = (size_t)rc * 64 + l;
            const float dtv = softplusf(GDT[row * 64 + 32 + dh] + dtbias[dh]);
            float sa = dtv * (-__expf(alog[dh])) * 1.4426950408889634f;
#pragma unroll
            for (int o = 1; o < 64; o <<= 1) { const float t = dir ? __shfl_down(sa, o) : __shfl_up(sa, o); if (dir ? (l + o < 64) : (l >= o)) sa += t; }
            GDT[row * 64 + 32 + dh] = dtv; ACUM[row * 32 + dh] = sa;
        }
    }
}

__device__ __forceinline__ int scan_row(int b, int dir, int s) {
    if (s < CTXL) return b * CTXL + (dir ? CTXL - 1 - s : s);
    const int t = s - CTXL; return T_CTX + b * SEQ + (dir ? SEQ - 1 - t : t);
}

__device__ __forceinline__ void phase4_naive(Ctx& C) {
    bf16_t* OF = (bf16_t*)C.out;
    bf16_t* OB = (bf16_t*)(C.ws + WS_OB);
    bf16_t* YB = (bf16_t*)(C.ws + WS_YB);
    const bf16_t* V = (const bf16_t*)(C.ws + WS_V); const bf16_t* XC = (const bf16_t*)(C.ws + WS_XC);
    const float* GDT = (const float*)(C.ws + WS_GDT); const float* GLAD = (const float*)(C.ws + WS_GLAD);
    for (int gt = C.bid * NTHREADS + C.tid; gt < 65536; gt += C.G * NTHREADS) {
        if (gt < 32768) {
            const int chain = gt >> 10, rem = gt & 1023, dv = rem >> 2, dq = rem & 3;
            const int b = chain >> 3, h = (chain >> 1) & 3, dir = chain & 1;
            const bf16_t* QKp = (const bf16_t*)(C.ws + (dir ? WS_QK : WS_QKF));
            float S[32];
#pragma unroll
            for (int i = 0; i < 32; ++i) S[i] = 0.f;
            for (int s = 0; s < CTXL + SEQ; ++s) {
                const int row = scan_row(b, dir, s);
                const float v = bf2f(V[(size_t)row * 1024 + h * 256 + dv]);
                const bf16_t* qp = QKp + (size_t)row * 1024 + h * 128 + dq * 32;
                float o = 0.f;
#pragma unroll
                for (int i8 = 0; i8 < 4; ++i8) { const u16x8 kv = *(const u16x8*)(qp + 512 + i8 * 8), qv = *(const u16x8*)(qp + i8 * 8);
#pragma unroll
                    for (int j = 0; j < 8; ++j) { S[i8 * 8 + j] += bf2f(kv[j]) * v; o += bf2f(qv[j]) * S[i8 * 8 + j]; } }
                o += __shfl_xor(o, 1); o += __shfl_xor(o, 2);
                if (row >= T_CTX && dq == 0) { const size_t l = row - T_CTX; if (dir) OB[l * 1024 + h * 256 + dv] = (bf16_t)f2bf(o); else OF[l * 2048 + h * 256 + dv] = (bf16_t)f2bf(o); }
                if ((s & 63) == 63) { const float* d = GLAD + ((size_t)((row >> 6) * 4 + h) * 2 + dir) * 128 + dq * 32;
#pragma unroll
                    for (int i = 0; i < 32; ++i) S[i] *= d[i]; }
            }
        } else {
            const int g2 = gt - 32768, chain = g2 >> 8, rem = g2 & 255, p = rem >> 2, nq = rem & 3;
            const int b = chain >> 5, head = (chain >> 1) & 15, dir = chain & 1, grp = head >> 3;
            const float Aneg = -__expf(C.in[I_ALOG][dir * 16 + head]), dtb = C.in[I_DTB][dir * 16 + head];
            float S[32];
#pragma unroll
            for (int i = 0; i < 32; ++i) S[i] = 0.f;
            for (int s = 0; s < CTXL + SEQ; ++s) {
                const int row = scan_row(b, dir, s);
                const float dt = GDT[(size_t)row * 64 + 32 + dir * 16 + head], a = __expf(dt * Aneg); (void)dtb;
                const float xd = bf2f(XC[(size_t)row * 1536 + head * 64 + p]) * dt;
                const bf16_t* bp = XC + (size_t)row * 1536 + 1024 + grp * 128 + nq * 32;
                float y = 0.f;
#pragma unroll
                for (int i8 = 0; i8 < 4; ++i8) { const u16x8 bv = *(const u16x8*)(bp + i8 * 8), cv = *(const u16x8*)(bp + 256 + i8 * 8);
#pragma unroll
                    for (int j = 0; j < 8; ++j) { S[i8 * 8 + j] = a * S[i8 * 8 + j] + xd * bf2f(bv[j]); y += S[i8 * 8 + j] * bf2f(cv[j]); } }
                y += __shfl_xor(y, 1); y += __shfl_xor(y, 2);
                if (row >= T_CTX && nq == 0) { const size_t l = row - T_CTX; if (dir) YB[l * 1024 + head * 64 + p] = (bf16_t)f2bf(y); else OF[l * 2048 + 1024 + head * 64 + p] = (bf16_t)f2bf(y); }
            }
        }
    }
}


typedef short bf16x8 __attribute__((ext_vector_type(8)));
typedef short s16x4 __attribute__((ext_vector_type(4)));
typedef __attribute__((address_space(3))) s16x4* lds_s16x4_p;
__device__ __forceinline__ bf16x8 lds_row_frag(lds_ptr_t L, int off, int rs, int r0, int kb, int c, int g) {
    return *(const LASQ bf16x8*)(L + off + (r0 + c) * rs + kb + g * 16);
}
__device__ __forceinline__ bf16x8 lds_tr_frag(lds_ptr_t L, int off, int rs, int k0, int n0, int g, int q, int p) {
    const s16x4 lo = __builtin_amdgcn_ds_read_tr16_b64_v4i16((lds_s16x4_p)(L + off + (k0 + 8 * g + q) * rs + (n0 + 4 * p) * 2));
    const s16x4 hi = __builtin_amdgcn_ds_read_tr16_b64_v4i16((lds_s16x4_p)(L + off + (k0 + 8 * g + 4 + q) * rs + (n0 + 4 * p) * 2));
    bf16x8 r; r[0] = lo[0]; r[1] = lo[1]; r[2] = lo[2]; r[3] = lo[3]; r[4] = hi[0]; r[5] = hi[1]; r[6] = hi[2]; r[7] = hi[3]; return r;
}
template <bool GLA>
__device__ __forceinline__ void scan_unit(Ctx& C, int uid) {
    lds_ptr_t L = (lds_ptr_t)C.lds;
    constexpr int INB = 44032, KS_O = 17408, VS_O = 34816, ST_OFF = 88064, STB = 17408, PS_OFF = 122880, SC_OFF = 132096, SCB = 1280;
    const int tid = C.tid, w = C.wave, l = C.lane, g = l >> 4, c = l & 15, q = c >> 2, p = c & 3;
    int b, dir, ldqk, ldv, ldo; const bf16_t *Qg, *Kg, *Vg; bf16_t* Og; const float* Sg; const float* dtg = nullptr;
    if (GLA) { b = uid >> 5; const int h = (uid >> 3) & 3; dir = (uid >> 2) & 1; const int sl = uid & 3;
        const bf16_t* QKp = (const bf16_t*)(C.ws + (dir ? WS_QK : WS_QKF));
        Qg = QKp + h * 128; Kg = QKp + 512 + h * 128; ldqk = 1024; Vg = (const bf16_t*)(C.ws + WS_V) + h * 256 + sl * 64; ldv = 1024;
        Og = dir ? (bf16_t*)(C.ws + WS_OB) + h * 256 + sl * 64 : (bf16_t*)C.out + h * 256 + sl * 64; ldo = dir ? 1024 : 2048;
        Sg = (const float*)(C.ws + WS_GLAD) + (h * 2 + dir) * 128;
    } else { b = uid >> 5; const int head = (uid >> 1) & 15; dir = uid & 1; const int grp = head >> 3;
        const bf16_t* XC = (const bf16_t*)(C.ws + WS_XC);
        Qg = XC + 1280 + grp * 128; Kg = XC + 1024 + grp * 128; ldqk = 1536; Vg = XC + head * 64; ldv = 1536;
        Og = dir ? (bf16_t*)(C.ws + WS_YB) + head * 64 : (bf16_t*)C.out + 1024 + head * 64; ldo = dir ? 1024 : 2048;
        Sg = (const float*)(C.ws + WS_ACUM) + dir * 16 + head;
        dtg = (const float*)(C.ws + WS_GDT) + 32 + dir * 16 + head;
    }
    f32x4 S[4];
#pragma unroll
    for (int t = 0; t < 4; ++t) S[t] = (f32x4){0.f, 0.f, 0.f, 0.f};
    u32x4 pq0, pq1, pk0, pk1, pv; float ps0 = 0.f, ps1 = 0.f, ptot = 0.f;
    auto chunk_rc = [&](int n) { return n < 4 ? 4 * b + (dir ? 3 - n : n) : 16 + 64 * b + (dir ? 67 - n : n - 4); };
    auto prefetch = [&](int n) {
        const int rc = chunk_rc(n), row0 = rc * 64;
        const bf16_t* qp = Qg + (size_t)(row0 + (tid >> 4)) * ldqk + (tid & 15) * 8; const bf16_t* kp = Kg + (size_t)(row0 + (tid >> 4)) * ldqk + (tid & 15) * 8;
        pq0 = *(const u32x4*)qp; pq1 = *(const u32x4*)(qp + (size_t)32 * ldqk); pk0 = *(const u32x4*)kp; pk1 = *(const u32x4*)(kp + (size_t)32 * ldqk);
        pv = *(const u32x4*)(Vg + (size_t)(row0 + (tid >> 3)) * ldv + (tid & 7) * 8);
        if (GLA) { ps0 = Sg[(size_t)rc * 1024 + (tid & 127)]; }
        else { ps0 = Sg[(size_t)(row0 + (tid & 63)) * 32]; ps1 = dtg[(size_t)(row0 + (tid & 63)) * 64]; ptot = Sg[(size_t)(row0 + (dir ? 0 : 63)) * 32]; }
    };
    float dtot = 1.f;
    auto stageW = [&](int n) {
        const int ib = (n & 1) * INB; LASQ float* sc = (LASQ float*)(L + SC_OFF + (n & 1) * SCB);
        *(LASQ u32x4*)(L + ib + (tid >> 4) * 272 + (tid & 15) * 16) = pq0; *(LASQ u32x4*)(L + ib + ((tid >> 4) + 32) * 272 + (tid & 15) * 16) = pq1;
        *(LASQ u32x4*)(L + ib + KS_O + (tid >> 4) * 272 + (tid & 15) * 16) = pk0; *(LASQ u32x4*)(L + ib + KS_O + ((tid >> 4) + 32) * 272 + (tid & 15) * 16) = pk1;
        *(LASQ u32x4*)(L + ib + VS_O + (tid >> 3) * 144 + (tid & 7) * 16) = pv;
        if (GLA) { if (tid < 128) sc[tid] = ps0; }
        else { if (tid < 64) { sc[tid] = ps0; sc[64 + tid] = ps1; sc[128 + tid] = ps1 * __builtin_amdgcn_exp2f(ptot - ps0); } }
    };
    prefetch(0);
    stageW(0);
    float dcur = GLA ? 1.f : __builtin_amdgcn_exp2f(ptot);
    prefetch(1);
    __syncthreads();
    for (int n = 0; n < 68; ++n) {
        const int rc = chunk_rc(n); const bool lat = n >= 4;
        const int ib = (n & 1) * INB; LASQ float* sc = (LASQ float*)(L + SC_OFF + (n & 1) * SCB);
        float dnext = 1.f;
        if (n + 1 < 68) { stageW(n + 1); if (!GLA) dnext = __builtin_amdgcn_exp2f(ptot); if (n + 2 < 68) prefetch(n + 2); }
        if (lat) {
            const int tj = w >> 1, ti0 = 2 * (w & 1);
            bf16x8 ka[4];
#pragma unroll
            for (int ks = 0; ks < 4; ++ks) ka[ks] = lds_row_frag(L, ib + KS_O, 272, 16 * tj, 64 * ks, c, g);
#pragma unroll
            for (int t2 = 0; t2 < 2; ++t2) { const int ti = ti0 + t2; f32x4 acc = (f32x4){0.f, 0.f, 0.f, 0.f};
#pragma unroll
                for (int ks = 0; ks < 4; ++ks) { const bf16x8 qb = lds_row_frag(L, ib, 272, 16 * ti, 64 * ks, c, g); acc = __builtin_amdgcn_mfma_f32_16x16x32_bf16(ka[ks], qb, acc, 0, 0, 0); }
                const int i = 16 * ti + c, j0 = 16 * tj + 4 * g; float pvv[4];
                if (GLA) {
#pragma unroll
                    for (int r = 0; r < 4; ++r) { const bool ok = dir ? (j0 + r >= i) : (j0 + r <= i); pvv[r] = ok ? acc[r] : 0.f; }
                } else { const float ai = sc[i]; const f32x4 aj = *(const LASQ f32x4*)(sc + j0), dj = *(const LASQ f32x4*)(sc + 64 + j0);
#pragma unroll
                    for (int r = 0; r < 4; ++r) { const bool ok = dir ? (j0 + r >= i) : (j0 + r <= i); const float x = ok ? ai - aj[r] : 0.f; pvv[r] = ok ? acc[r] * __builtin_amdgcn_exp2f(x) * dj[r] : 0.f; } }
                u32x2 o; o.x = pk2(pvv[0], pvv[1]); o.y = pk2(pvv[2], pvv[3]); *(LASQ u32x2*)(L + PS_OFF + i * 144 + j0 * 2) = o; }
        }
        {
            bf16x8 ka[2];
#pragma unroll
            for (int ks = 0; ks < 2; ++ks) ka[ks] = lds_tr_frag(L, ib + KS_O, 272, 32 * ks, 16 * w, g, q, p);
            if (!GLA) {
#pragma unroll
                for (int ks = 0; ks < 2; ++ks) { const f32x4 u0 = *(const LASQ f32x4*)(sc + 128 + 32 * ks + 8 * g), u1 = *(const LASQ f32x4*)(sc + 128 + 32 * ks + 8 * g + 4);
                    const float uu[8] = {u0.x, u0.y, u0.z, u0.w, u1.x, u1.y, u1.z, u1.w}; u32x4 pk;
                    pk.x = pk2(bf2f((bf16_t)ka[ks][0]) * uu[0], bf2f((bf16_t)ka[ks][1]) * uu[1]); pk.y = pk2(bf2f((bf16_t)ka[ks][2]) * uu[2], bf2f((bf16_t)ka[ks][3]) * uu[3]);
                    pk.z = pk2(bf2f((bf16_t)ka[ks][4]) * uu[4], bf2f((bf16_t)ka[ks][5]) * uu[5]); pk.w = pk2(bf2f((bf16_t)ka[ks][6]) * uu[6], bf2f((bf16_t)ka[ks][7]) * uu[7]);
                    ka[ks] = __builtin_bit_cast(bf16x8, pk); }
#pragma unroll
                for (int t = 0; t < 4; ++t) S[t] = S[t] * dcur;
            }
#pragma unroll
            for (int t = 0; t < 4; ++t)
#pragma unroll
                for (int ks = 0; ks < 2; ++ks) { const bf16x8 vb = lds_tr_frag(L, ib + VS_O, 144, 32 * ks, 16 * t, g, q, p); S[t] = __builtin_amdgcn_mfma_f32_16x16x32_bf16(ka[ks], vb, S[t], 0, 0, 0); }
            if (GLA) { const f32x4 d = *(const LASQ f32x4*)(sc + 16 * w + 4 * g);
#pragma unroll
                for (int t = 0; t < 4; ++t) S[t] = S[t] * d; }
            if (n + 1 >= 4 && n + 1 < 68) {
                const int so = ST_OFF + ((n + 1) & 1) * STB;
#pragma unroll
                for (int t = 0; t < 4; ++t) { u32x2 o; o.x = pk2(S[t].x, S[t].y); o.y = pk2(S[t].z, S[t].w); *(LASQ u32x2*)(L + so + (16 * t + c) * 272 + (16 * w + 4 * g) * 2) = o; }
            }
        }
        dcur = dnext;
        __syncthreads();
        if (lat) {
            const int tdv = w >> 1, ti0 = 2 * (w & 1), so = ST_OFF + (n & 1) * STB;
            bf16x8 va[2], sa[4];
#pragma unroll
            for (int ks = 0; ks < 2; ++ks) va[ks] = lds_tr_frag(L, ib + VS_O, 144, 32 * ks, 16 * tdv, g, q, p);
#pragma unroll
            for (int ks = 0; ks < 4; ++ks) sa[ks] = lds_row_frag(L, so, 272, 16 * tdv, 64 * ks, c, g);
            const size_t lrow0 = (size_t)(rc * 64 - T_CTX);
#pragma unroll
            for (int t2 = 0; t2 < 2; ++t2) { const int ti = ti0 + t2; f32x4 a1 = (f32x4){0.f, 0.f, 0.f, 0.f}, a2 = (f32x4){0.f, 0.f, 0.f, 0.f};
#pragma unroll
                for (int ks = 0; ks < 2; ++ks) { const bf16x8 pb = lds_row_frag(L, PS_OFF, 144, 16 * ti, 64 * ks, c, g); a1 = __builtin_amdgcn_mfma_f32_16x16x32_bf16(va[ks], pb, a1, 0, 0, 0); }
#pragma unroll
                for (int ks = 0; ks < 4; ++ks) { const bf16x8 qb = lds_row_frag(L, ib, 272, 16 * ti, 64 * ks, c, g); a2 = __builtin_amdgcn_mfma_f32_16x16x32_bf16(sa[ks], qb, a2, 0, 0, 0); }
                const int i = 16 * ti + c; f32x4 o4;
                if (GLA) o4 = a1 + a2; else o4 = a1 + a2 * __builtin_amdgcn_exp2f(sc[i]);
                u32x2 o; o.x = pk2(o4.x, o4.y); o.y = pk2(o4.z, o4.w);
                *(u32x2*)(Og + (lrow0 + i) * ldo + 16 * tdv + 4 * g) = o; }
        }
        __syncthreads();
    }
}
__device__ __forceinline__ void phase4(Ctx& C) {
    for (int uid = C.bid; uid < 256; uid += C.G) { if (uid < 128) scan_unit<true>(C, uid); else scan_unit<false>(C, uid - 128); }
}

__device__ __forceinline__ void phase5(Ctx& C) {
    const int gw = C.bid * 8 + C.wave, NGW = C.G * 8;
    const bf16_t* OF = (const bf16_t*)C.out; const bf16_t* OB = (const bf16_t*)(C.ws + WS_OB); const bf16_t* YB = (const bf16_t*)(C.ws + WS_YB);
    const bf16_t* RZ = (const bf16_t*)(C.ws + WS_RZ); const bf16_t* XC = (const bf16_t*)(C.ws + WS_XC); bf16_t* YX = (bf16_t*)(C.ws + WS_YX);
    const float* ssdd = C.in[I_SSDD]; const float* ssdn = C.in[I_SSDN]; const f32x4 gn = *(const f32x4*)(C.in[I_GNORM] + C.lane * 4);
    const int ln = C.lane;
    float nw[2][8], dsk[2];
#pragma unroll
    for (int g = 0; g < 2; ++g) { const int c0 = g * 512 + ln * 8; dsk[g] = ssdd[c0 >> 6];
        const f32x4 a = *(const f32x4*)(ssdn + c0), bq = *(const f32x4*)(ssdn + c0 + 4);
        nw[g][0] = a.x; nw[g][1] = a.y; nw[g][2] = a.z; nw[g][3] = a.w; nw[g][4] = bq.x; nw[g][5] = bq.y; nw[g][6] = bq.z; nw[g][7] = bq.w; }
    constexpr int NR = 2;
    for (int l0 = gw; l0 < T_LAT; l0 += NGW * NR) {
        u16x4 ga[NR][4], gb[NR][4], gr[NR][4]; u16x8 sa[NR][2], sb[NR][2], sz[NR][2], sx[NR][2];
#pragma unroll
        for (int u = 0; u < NR; ++u) { const int l = l0 + u * NGW; if (l < T_LAT) {
#pragma unroll
            for (int h = 0; h < 4; ++h) { const int c0 = h * 256 + ln * 4;
                ga[u][h] = *(const u16x4*)(OF + (size_t)l * 2048 + c0); gb[u][h] = *(const u16x4*)(OB + (size_t)l * 1024 + c0); gr[u][h] = *(const u16x4*)(RZ + (size_t)l * 2048 + c0); }
#pragma unroll
            for (int g = 0; g < 2; ++g) { const int c0 = g * 512 + ln * 8;
                sa[u][g] = *(const u16x8*)(OF + (size_t)l * 2048 + 1024 + c0); sb[u][g] = *(const u16x8*)(YB + (size_t)l * 1024 + c0);
                sz[u][g] = *(const u16x8*)(RZ + (size_t)l * 2048 + 1024 + c0); sx[u][g] = *(const u16x8*)(XC + (size_t)(l + T_CTX) * 1536 + c0); } } }
        float o[NR][4][4], y[NR][2][8], ss[NR][6];
#pragma unroll
        for (int u = 0; u < NR; ++u) {
#pragma unroll
            for (int h = 0; h < 4; ++h) { float a = 0.f;
#pragma unroll
                for (int j = 0; j < 4; ++j) { o[u][h][j] = bf2f(ga[u][h][j]) + bf2f(gb[u][h][j]); a += o[u][h][j] * o[u][h][j]; }
                ss[u][h] = a; }
#pragma unroll
            for (int g = 0; g < 2; ++g) { float a = 0.f;
#pragma unroll
                for (int j = 0; j < 8; ++j) { y[u][g][j] = (bf2f(sa[u][g][j]) + bf2f(sb[u][g][j]) + bf2f(sx[u][g][j]) * dsk[g]) * bf2f(sz[u][g][j]); a += y[u][g][j] * y[u][g][j]; }
                ss[u][4 + g] = a; } }
#pragma unroll
        for (int of = 1; of < 64; of <<= 1) {
#pragma unroll
            for (int u = 0; u < NR; ++u)
#pragma unroll
                for (int k = 0; k < 6; ++k) ss[u][k] += __shfl_xor(ss[u][k], of); }
#pragma unroll
        for (int u = 0; u < NR; ++u) { const int l = l0 + u * NGW; if (l < T_LAT) {
#pragma unroll
            for (int h = 0; h < 4; ++h) { const int c0 = h * 256 + ln * 4; const float rs = rsqrtf(ss[u][h] * (1.f / 256.f) + EPS);
                u32x2 w; w.x = pk2(o[u][h][0] * rs * gn.x * bf2f(gr[u][h][0]), o[u][h][1] * rs * gn.y * bf2f(gr[u][h][1])); w.y = pk2(o[u][h][2] * rs * gn.z * bf2f(gr[u][h][2]), o[u][h][3] * rs * gn.w * bf2f(gr[u][h][3]));
                *(u32x2*)(YX + (size_t)l * 2048 + c0) = w; }
#pragma unroll
            for (int g = 0; g < 2; ++g) { const int c0 = g * 512 + ln * 8; const float rs = rsqrtf(ss[u][4 + g] * (1.f / 512.f) + EPS);
                u32x4 w; w.x = pk2(y[u][g][0] * rs * nw[g][0], y[u][g][1] * rs * nw[g][1]); w.y = pk2(y[u][g][2] * rs * nw[g][2], y[u][g][3] * rs * nw[g][3]);
                w.z = pk2(y[u][g][4] * rs * nw[g][4], y[u][g][5] * rs * nw[g][5]); w.w = pk2(y[u][g][6] * rs * nw[g][6], y[u][g][7] * rs * nw[g][7]);
                *(u32x4*)(YX + (size_t)l * 2048 + 1024 + c0) = w; } } }
    }
}

__device__ __forceinline__ void phase6(Ctx& C) {
    {
        float* scr = (float*)C.lds + 8192 + C.wave * (64 * 33);
        const int gw = C.bid * 8 + C.wave, NGW = C.G * 8;
        bf16_t* WdT = (bf16_t*)(C.ws + WS_WDT);
        for (int it = gw; it < 32 * 768; it += NGW) {
            const int e = it / 768, r = it % 768;
            if (r < 512) { const int up = r >> 8, q = r & 255, kb = q >> 4, nb = q & 15;
                const float* src = C.in[up ? I_EWU : I_EWG] + (size_t)e * 1024 * 512 + (size_t)(kb * 64) * 512 + nb * 32;
                bf16_t* dst = wgu_ptr(C.ws, e) + (size_t)(256 * (nb >> 2) + (nb & 3) * 32 + up * 128) * 1024 + kb * 64;
                transpose_tile(src, 512, dst, 1024, scr, C.lane, false); }
            else { const int q = r - 512, kb = q >> 5, nb = q & 31;
                transpose_tile(C.in[I_EWD] + (size_t)e * 512 * 1024 + (size_t)(kb * 64) * 1024 + nb * 32, 1024, WdT + (size_t)e * 1024 * 512 + (size_t)(nb * 32) * 512 + kb * 64, 512, scr, C.lane, false); }
        }
    }
    __syncthreads();
    const bf16_t* YX = (const bf16_t*)(C.ws + WS_YX); const bf16_t* WoutT = (const bf16_t*)(C.ws + WS_WOUTT);
    const float* MOD = (const float*)(C.ws + WS_MOD); const float* X = C.in[I_X]; float* HL = C.out;
    auto bsel = [=](int, int tn, int& ldb) { ldb = 2048; return WoutT + (size_t)tn * 128 * 2048; };
    auto epi = [=](int row, int tn, int cc, float v, float) { const int col = tn * 128 + cc, b = row >> 12;
        HL[(size_t)row * 1024 + col] = X[(size_t)row * 1024 + col] + MOD[b * 6144 + 2048 + col] * v; };
#if PG8_MASK & 2
    (void)bsel; (void)epi;
    SchedOut S{(const char*)YX, (const char*)WoutT, C.G, C.bid}; EpiOut E{X, MOD, HL};
    pg8::gemm_phase<EpiOut, SchedOut, false, true>((lds_ptr_t)C.lds, 2048, S, E);
#else
    gemm_simple<false>(C, YX, 2048, T_LAT / 128, 1024 / 128, 2048, bsel, epi);
#endif
}

__device__ __forceinline__ void phase7(Ctx& C) {
    lds_ptr_t L = (lds_ptr_t)C.lds;
    constexpr int TS = 260, WSD = 48;
    constexpr int T_O = 0, W_O = 64 * TS * 4, LG_O = W_O + 256 * WSD * 4, CNT_O = LG_O + 2 * 64 * 48 * 4;
    LASQ float* Ts = (LASQ float*)(L + T_O); LASQ float* Wsm = (LASQ float*)(L + W_O); LASQ float* LG = (LASQ float*)(L + LG_O); LASQ unsigned* lcnt = (LASQ unsigned*)(L + CNT_O);
    const float* MOD = (const float*)(C.ws + WS_MOD); const float* HL = C.out; bf16_t* XN2 = (bf16_t*)(C.ws + WS_XN2);
    int* PE = (int*)(C.ws + WS_PAIR); int* PP = PE + 32768; float* PW = (float*)(PP + 32768);
    const float* wg = C.in[I_RGW]; const float* we = C.in[I_REW]; const float* nffn = C.in[I_NFFN]; const float* rgb = C.in[I_RGB]; const float* reb = C.in[I_REB];
    const int tid = C.tid, w = C.wave, ln = C.lane;
    for (int grp = C.bid; grp < T_LAT / 64; grp += C.G) {
        const int lbase = grp * 64, b = lbase >> 12;
        __syncthreads();
        if (tid < 32) lcnt[tid] = 0u;
        for (int i = tid; i < 256 * 12; i += NTHREADS) Wsm[(i / 12) * WSD + 36 + (i % 12)] = 0.f;
        f32x4 t[8][4];
        {
            float ss[8];
#pragma unroll
            for (int r = 0; r < 8; ++r) { const int l = lbase + w * 8 + r; ss[r] = 0.f;
#pragma unroll
                for (int j = 0; j < 4; ++j) { t[r][j] = *(const f32x4*)(HL + (size_t)l * DM + j * 256 + ln * 4); ss[r] += t[r][j].x * t[r][j].x + t[r][j].y * t[r][j].y + t[r][j].z * t[r][j].z + t[r][j].w * t[r][j].w; } }
#pragma unroll
            for (int o = 1; o < 64; o <<= 1) {
#pragma unroll
                for (int r = 0; r < 8; ++r) ss[r] += __shfl_xor(ss[r], o); }
#pragma unroll
            for (int r = 0; r < 8; ++r) ss[r] = rsqrtf(ss[r] * (1.f / DM) + EPS);
#pragma unroll
            for (int j = 0; j < 4; ++j) { const int c0 = j * 256 + ln * 4;
                const f32x4 gq = *(const f32x4*)(nffn + c0), sh = *(const f32x4*)(MOD + b * 6144 + 3072 + c0); f32x4 scl = *(const f32x4*)(MOD + b * 6144 + 4096 + c0);
                scl = gq * (1.f + scl);
#pragma unroll
                for (int r = 0; r < 8; ++r) { const int l = lbase + w * 8 + r; t[r][j] = t[r][j] * ss[r] * scl + sh;
                    u32x2 o; o.x = pk2(t[r][j].x, t[r][j].y); o.y = pk2(t[r][j].z, t[r][j].w); *(u32x2*)(XN2 + (size_t)l * DM + c0) = o; }
                asm volatile("" ::: "memory"); }
        }
        const int rt = w & 3, kh = w >> 2, ar = ln & 15, kq = ln >> 4;
        f32x4 acc[3];
#pragma unroll
        for (int ct = 0; ct < 3; ++ct) acc[ct] = (f32x4){0.f, 0.f, 0.f, 0.f};
#pragma unroll
        for (int j = 0; j < 4; ++j) {
            __syncthreads();
#pragma unroll
            for (int r = 0; r < 8; ++r) *(LASQ f32x4*)(Ts + (w * 8 + r) * TS + ln * 4) = t[r][j];
            { const int k = tid >> 1, hf = tid & 1; const float* src = we + (size_t)(j * 256 + k) * 32 + hf * 16;
#pragma unroll
                for (int i4 = 0; i4 < 4; ++i4) *(LASQ f32x4*)(Wsm + k * WSD + hf * 16 + i4 * 4) = *(const f32x4*)(src + i4 * 4);
                if (hf == 0) *(LASQ f32x4*)(Wsm + k * WSD + 32) = *(const f32x4*)(wg + (size_t)(j * 256 + k) * 4); }
            __syncthreads();
#pragma unroll 8
            for (int ks = 0; ks < 32; ++ks) { const int k0 = kh * 128 + ks * 4;
                const float av = Ts[(rt * 16 + ar) * TS + k0 + kq];
#pragma unroll
                for (int ct = 0; ct < 3; ++ct) { const float bv = Wsm[(k0 + kq) * WSD + ct * 16 + ar]; acc[ct] = __builtin_amdgcn_mfma_f32_16x16x4f32(av, bv, acc[ct], 0, 0, 0); } }
        }
#pragma unroll
        for (int ct = 0; ct < 3; ++ct)
#pragma unroll
            for (int r = 0; r < 4; ++r) LG[(kh * 64 + rt * 16 + kq * 4 + r) * 48 + ct * 16 + ar] = acc[ct][r];
        __syncthreads();
        if (tid < 64) {
            const int l = lbase + tid; const LASQ float* g0 = LG + tid * 48; const LASQ float* g1 = LG + (64 + tid) * 48;
            float gl[4]; int gs = 0; float gm = -3.4e38f;
#pragma unroll
            for (int o = 0; o < 4; ++o) { gl[o] = g0[32 + o] + g1[32 + o] + rgb[o]; if (gl[o] > gm) { gm = gl[o]; gs = o; } }
            float den = 0.f;
#pragma unroll
            for (int o = 0; o < 4; ++o) den += __expf(gl[o] - gm);
            const float pg = 1.f / den;
            int i1 = 0, i2 = 0; float v1 = -3.4e38f, v2 = -3.4e38f;
#pragma unroll
            for (int o = 0; o < 8; ++o) { const float e = g0[gs * 8 + o] + g1[gs * 8 + o] + reb[gs * 8 + o];
                if (e > v1) { v2 = v1; i2 = i1; v1 = e; i1 = o; } else if (e > v2) { v2 = e; i2 = o; } }
            const float e2 = __expf(v2 - v1), w1 = pg / (1.f + e2), w2 = pg * e2 / (1.f + e2);
            const int ex1 = gs * 8 + i1, ex2 = gs * 8 + i2;
            const unsigned p1 = atomicAdd((unsigned*)(lcnt + ex1), 1u), p2 = atomicAdd((unsigned*)(lcnt + ex2), 1u);
            PE[l * 2] = ex1; PE[l * 2 + 1] = ex2; PP[l * 2] = (int)p1; PP[l * 2 + 1] = (int)p2; PW[l * 2] = w1; PW[l * 2 + 1] = w2;
        }
        __syncthreads();
        if (tid < 32) ((unsigned*)(C.ws + WS_CTL) + CW_BLK)[grp * 32 + tid] = lcnt[tid];
    }
}

__device__ __forceinline__ void moe_offsets(Ctx& C, int* off, int* tmp, int* blkbase) {
    const unsigned* BLK = (const unsigned*)(C.ws + WS_CTL) + CW_BLK;
    const int e = C.tid & 31, ch = C.tid >> 5;
    const int per = 16; int sacc = 0;
    for (int i = 0; i < per; ++i) { const int b = ch * per + i; { const int v = (int)BLK[b * 32 + e]; if (blkbase) blkbase[b * 32 + e] = sacc; sacc += v; } }
    tmp[ch * 32 + e] = sacc;
    __syncthreads();
    if (C.tid < 32) { int run = 0; for (int c2 = 0; c2 < 16; ++c2) { const int v = tmp[c2 * 32 + C.tid]; tmp[c2 * 32 + C.tid] = run; run += v; } off[64 + C.tid] = run; }
    __syncthreads();
    if (C.tid == 0) { int o = 0; for (int x = 0; x < 32; ++x) { const int t = off[64 + x]; off[x] = o; o += (t + 255) & ~255; } off[32] = o; }
    if (blkbase) { const int add = tmp[ch * 32 + e]; for (int i = 0; i < per; ++i) { const int b = ch * per + i; blkbase[b * 32 + e] += add; } }
    __syncthreads();
}

__device__ __forceinline__ void moe_tile_table(Ctx& C, const int* off, int* tile_e) {
    const int NT = off[32] >> 8;
    for (int t = C.tid; t < NT; t += NTHREADS) { int e = 0; for (int i = 1; i < 32; ++i) if (off[i] <= t * 256) e = i; tile_e[t] = e; }
    __syncthreads();
}
__device__ __forceinline__ void phase8(Ctx& C) {
    int* off = (int*)C.lds; int* blkbase = off + 1024; moe_offsets(C, off, off + 256, blkbase);
    const int gw = C.bid * 8 + C.wave, NGW = C.G * 8;
    const int* PE = (const int*)(C.ws + WS_PAIR); const int* PP = PE + 32768; const float* PW = (const float*)(PP + 32768); int* SL = (int*)(PW + 32768); float* SW = (float*)(SL + 32768);
    const bf16_t* XN2 = (const bf16_t*)(C.ws + WS_XN2); bf16_t* XS = (bf16_t*)(C.ws + WS_XN2S);
    constexpr int NP = 8;
    for (int p0 = gw; p0 < 32768; p0 += NGW * NP) {
        u32x4 a[NP], bq[NP]; int slot[NP];
#pragma unroll
        for (int u = 0; u < NP; ++u) { const int p = p0 + u * NGW; slot[u] = 0;
            if (p < 32768) { const u32x4* sp = (const u32x4*)(XN2 + (size_t)(p >> 1) * DM); a[u] = sp[C.lane]; bq[u] = sp[C.lane + 64]; { const int ex = PE[p]; const int blk = p >> 7; slot[u] = off[ex] + blkbase[blk * 32 + ex] + PP[p]; } } }
#pragma unroll
        for (int u = 0; u < NP; ++u) { const int p = p0 + u * NGW;
            if (p < 32768) { if (C.lane == 0) { SL[p] = slot[u]; SW[slot[u]] = PW[p]; }
                u32x4* d = (u32x4*)(XS + (size_t)slot[u] * DM); d[C.lane] = a[u]; d[C.lane + 64] = bq[u]; } }
    }
}

__device__ __forceinline__ void phase9(Ctx& C) {
    int* off = (int*)(C.lds + CTRL_OFF + 1024); moe_offsets(C, off, (int*)C.lds, nullptr);
    const bf16_t* XS = (const bf16_t*)(C.ws + WS_XN2S); bf16_t* H = (bf16_t*)(C.ws + WS_H); unsigned char* ws = C.ws;
    auto bsel = [=](int tm, int tn, int& ldb) { int e = 0; const int r0 = tm * 128;
        for (int i = 1; i < 32; ++i) if (off[i] <= r0) e = i;
        ldb = 1024; return (const bf16_t*)wgu_ptr(ws, e) + (size_t)tn * 256 * 1024; };
    auto epi = [=](int row, int tn, int cc, float g, float u) { H[(size_t)row * 512 + tn * 128 + cc] = (bf16_t)f2bf(siluf(g) * u); };
#if PG8_MASK & 4
    (void)bsel; (void)epi;
    int* tile_e = off + 128; moe_tile_table(C, off, tile_e);
    SchedMoe S{(const char*)XS, C.ws, tile_e, off[32] >> 8, C.G, C.bid, 1024, 0}; EpiUp E{H};
    pg8::gemm_phase<EpiUp, SchedMoe, true, true>((lds_ptr_t)C.lds, 1024, S, E);
#else
    gemm_simple<true>(C, XS, 1024, off[32] / 128, 4, 1024, bsel, epi);
#endif
}

__device__ __forceinline__ void phase10(Ctx& C) {
    int* off = (int*)(C.lds + CTRL_OFF + 1024); moe_offsets(C, off, (int*)C.lds, nullptr);
    const bf16_t* H = (const bf16_t*)(C.ws + WS_H); bf16_t* Y = (bf16_t*)(C.ws + WS_Y); const bf16_t* WdT = (const bf16_t*)(C.ws + WS_WDT);
    const float* SW = (const float*)(C.ws + WS_PAIR) + 4 * 32768;
    auto bsel = [=](int tm, int tn, int& ldb) { int e = 0; const int r0 = tm * 128;
        for (int i = 1; i < 32; ++i) if (off[i] <= r0) e = i;
        ldb = 512; return WdT + (size_t)e * 1024 * 512 + (size_t)tn * 128 * 512; };
    auto epi = [=](int row, int tn, int cc, float v, float) { Y[(size_t)row * 1024 + tn * 128 + cc] = (bf16_t)f2bf(v * SW[row]); };
#if PG8_MASK & 8
    (void)bsel; (void)epi;
    int* tile_e = off + 128; moe_tile_table(C, off, tile_e);
    SchedMoe S{(const char*)H, C.ws, tile_e, off[32] >> 8, C.G, C.bid, 512, 1}; EpiDown E{Y, SW};
    pg8::gemm_phase<EpiDown, SchedMoe, true, true>((lds_ptr_t)C.lds, 512, S, E);
#else
    gemm_simple<false>(C, H, 512, off[32] / 128, 8, 512, bsel, epi);
#endif
}

__device__ __forceinline__ void phase11(Ctx& C) {
    const int gw = C.bid * 8 + C.wave, NGW = C.G * 8;
    const float* MOD = (const float*)(C.ws + WS_MOD); float* HL = C.out; const bf16_t* Y = (const bf16_t*)(C.ws + WS_Y);
    const int* SL = (const int*)(C.ws + WS_PAIR) + 3 * 32768; const float* fnorm = C.in[I_FNORM];
    constexpr int NR = 2;
    for (int l0 = gw; l0 < T_LAT; l0 += NGW * NR) {
        f32x4 hv[NR][4]; u16x4 ya[NR][4], yb[NR][4]; float ss[NR];
#pragma unroll
        for (int u = 0; u < NR; ++u) { const int l = l0 + u * NGW; ss[u] = 0.f; if (l < T_LAT) { const int s1 = SL[l * 2], s2 = SL[l * 2 + 1];
#pragma unroll
            for (int j = 0; j < 4; ++j) { const int c0 = j * 256 + C.lane * 4; hv[u][j] = *(const f32x4*)(HL + (size_t)l * DM + c0);
                ya[u][j] = *(const u16x4*)(Y + (size_t)s1 * DM + c0); yb[u][j] = *(const u16x4*)(Y + (size_t)s2 * DM + c0); } } }
#pragma unroll
        for (int u = 0; u < NR; ++u) { const int l = l0 + u * NGW; if (l < T_LAT) { const int b = l >> 12;
#pragma unroll
            for (int j = 0; j < 4; ++j) { const int c0 = j * 256 + C.lane * 4; const f32x4 g2 = *(const f32x4*)(MOD + b * 6144 + 5120 + c0);
                f32x4 m; m.x = bf2f(ya[u][j][0]) + bf2f(yb[u][j][0]); m.y = bf2f(ya[u][j][1]) + bf2f(yb[u][j][1]); m.z = bf2f(ya[u][j][2]) + bf2f(yb[u][j][2]); m.w = bf2f(ya[u][j][3]) + bf2f(yb[u][j][3]);
                hv[u][j] = hv[u][j] + g2 * m; ss[u] += hv[u][j].x * hv[u][j].x + hv[u][j].y * hv[u][j].y + hv[u][j].z * hv[u][j].z + hv[u][j].w * hv[u][j].w; } } }
#pragma unroll
        for (int o = 1; o < 64; o <<= 1) {
#pragma unroll
            for (int u = 0; u < NR; ++u) ss[u] += __shfl_xor(ss[u], o); }
#pragma unroll
        for (int u = 0; u < NR; ++u) { const int l = l0 + u * NGW; if (l < T_LAT) { const float rs = rsqrtf(ss[u] * (1.f / DM) + EPS);
#pragma unroll
            for (int j = 0; j < 4; ++j) { const int c0 = j * 256 + C.lane * 4; const f32x4 fn = *(const f32x4*)(fnorm + c0);
                *(f32x4*)(HL + (size_t)l * DM + c0) = hv[u][j] * rs * fn; } } }
    }
}

#define LAS __attribute__((address_space(3)))
#define XB_TMO      128
#define XB_XCNT(j)  (256  + 64 * (j))
#define XB_XSUB(j)  (1280 + 64 * (j))
#define XB_XGEN(j)  (2304 + 64 * (j))
#define XB_TOP      3328
#define XB_TOPGEN   3392
#define XCD_BAR_WORDS 3456
#define XB_SPIN_CAP (1u << 18)

__device__ __forceinline__ unsigned xb_ld(unsigned* p)              { return __hip_atomic_load(p, __ATOMIC_RELAXED, __HIP_MEMORY_SCOPE_AGENT); }
__device__ __forceinline__ unsigned xb_add(unsigned* p, unsigned v) { return __hip_atomic_fetch_add(p, v, __ATOMIC_RELAXED, __HIP_MEMORY_SCOPE_AGENT); }
__device__ __forceinline__ unsigned xb_xcc_id() { return (unsigned)__builtin_amdgcn_s_getreg((3 << 11) | 20) & 0xFu; }
#define XB_SPIN(cond, bar) do { unsigned _sp = 0; while (cond) { __builtin_amdgcn_s_sleep(1); \
    if ((++_sp & 255u) == 0u) { if (xb_ld(&(bar)[XB_TMO])) break; if (_sp > XB_SPIN_CAP) { atomicAdd(&(bar)[XB_TMO], 1u); break; } } } } while (0)

struct XcdBarrier {
    unsigned* bar; unsigned x;
    volatile LAS unsigned* st;
};

__device__ __forceinline__ XcdBarrier xcd_barrier_post(unsigned* bar, volatile LAS unsigned* st) {
    XcdBarrier b; b.bar = bar; b.x = xb_xcc_id(); b.st = st;
    if (threadIdx.x == 0) (void)xb_add(&bar[XB_XCNT(b.x)], 1u);
    return b;
}
__device__ __forceinline__ void xcd_barrier_complete(unsigned* bar, unsigned x, unsigned& nloc, unsigned& nx) {
    const unsigned G = gridDim.x * gridDim.y * gridDim.z;
    unsigned sum, cnt, mine, sp = 0u;
    for (;;) {
        sum = 0u; cnt = 0u; mine = 0u;
#pragma unroll
        for (unsigned j = 0; j < 16; ++j) { const unsigned c = xb_ld(&bar[XB_XCNT(j)]); sum += c; cnt += (c > 0u) ? 1u : 0u; mine = (j == x) ? c : mine; }
        if (sum == G) break;
        __builtin_amdgcn_s_sleep(1);
        if ((++sp & 255u) == 0u) { if (xb_ld(&bar[XB_TMO])) break; if (sp > XB_SPIN_CAP) { atomicAdd(&bar[XB_TMO], 1u); break; } }
    }
    nloc = mine > 0u ? mine : 1u; nx = cnt > 0u ? cnt : 1u;
}

__device__ __forceinline__ void xcd_barrier(const XcdBarrier& b) {
    asm volatile("s_waitcnt vmcnt(0)" ::: "memory");
    __syncthreads();
    if (threadIdx.x == 0) {
        unsigned* bar = b.bar;
        __builtin_amdgcn_s_waitcnt(0);
        unsigned nloc = b.st[0], nx = b.st[1];
        if (nloc == 0u) { xcd_barrier_complete(bar, b.x, nloc, nx); b.st[0] = nloc; b.st[1] = nx; }
        const unsigned old = xb_add(&bar[XB_XSUB(b.x)], 1u);
        const unsigned gen = old / nloc;
        if (old + 1u == (gen + 1u) * nloc) {
            __builtin_amdgcn_fence(__ATOMIC_RELEASE, "agent");
            asm volatile("s_waitcnt vmcnt(0)" ::: "memory");
            const unsigned og = xb_add(&bar[XB_TOP], 1u);
            const unsigned tg = og / nx;
            if (og + 1u == (tg + 1u) * nx) xb_add(&bar[XB_TOPGEN], 1u);
            else XB_SPIN(xb_ld(&bar[XB_TOPGEN]) == tg, bar);
            __builtin_amdgcn_fence(__ATOMIC_ACQUIRE, "agent");
            xb_add(&bar[XB_XGEN(b.x)], 1u);
            asm volatile("s_waitcnt vmcnt(0)" ::: "memory");
        } else {
            XB_SPIN(xb_ld(&bar[XB_XGEN(b.x)]) == gen, bar);
            __builtin_amdgcn_fence(__ATOMIC_ACQUIRE, "agent");
            asm volatile("s_waitcnt vmcnt(0)" ::: "memory");
        }
    }
    __syncthreads();
}

__global__ void __launch_bounds__(NTHREADS, 2) fwd_kernel(Args a) {
    extern __shared__ __attribute__((aligned(16))) unsigned char lds[];
    Ctx C;
    if (threadIdx.x == 0) {
#pragma unroll
        for (int i = 0; i < 27; ++i) *(__attribute__((address_space(3))) unsigned long long*)((__attribute__((address_space(3))) unsigned char*)lds + PTAB_OFF + 8 * i) = (unsigned long long)a.in[i];
    }
    C.in.lds = lds; C.out = a.out; C.ws = a.ws; C.lds = lds;
    __syncthreads();
    C.tid = threadIdx.x; C.lane = C.tid & 63; C.wave = __builtin_amdgcn_readfirstlane(C.tid >> 6); C.bid = blockIdx.x; C.G = gridDim.x;
#if MK_COOP
    cg::grid_group grid = cg::this_grid();
    if (C.tid < 2) ((LAS unsigned*)(lds + CTRL_OFF + 64))[C.tid] = 0u;
    __syncthreads();
    XcdBarrier xbar = xcd_barrier_post((unsigned*)(C.ws + WS_CTL) + CW_BAR, (volatile LAS unsigned*)(lds + CTRL_OFF + 64));
#define SEAM(k) do { if ((k) + 1 < a.ph_hi) { if ((k) == 0) grid.sync(); else xcd_barrier(xbar); } } while (0)
#else
#define SEAM(k) do { } while (0)
#endif
#define IN(k) (a.ph_lo <= (k) && (k) < a.ph_hi)
    if (IN(0)) { phase0(C); SEAM(0); }
    if (IN(1)) { phase1(C); SEAM(1); }
    if (IN(2)) { phase2(C); SEAM(2); }
    if (IN(3)) { phase3(C); SEAM(3); }
#ifdef SCAN_NAIVE
    if (IN(4)) { phase4_naive(C); SEAM(4); }
#else
    if (IN(4)) { phase4(C); SEAM(4); }
#endif
    if (IN(5)) { phase5(C); SEAM(5); }
    if (IN(6)) { phase6(C); SEAM(6); }
    if (IN(7)) { phase7(C); SEAM(7); }
    if (IN(8)) { phase8(C); SEAM(8); }
    if (IN(9)) { phase9(C); SEAM(9); }
    if (IN(10)) { phase10(C); SEAM(10); }
    if (IN(11)) { phase11(C); }
}

extern "C" void kernel_launch(void* const* d_in, const int* in_sizes, int n_in, void* d_out, int out_size, void* d_ws, size_t ws_size, hipStream_t stream) {
    static int grid = 0;
    if (grid == 0) {
        if (n_in != 27 || out_size != T_LAT * DM || ws_size < WS_END) { fprintf(stderr, "kernel_launch: unexpected shapes: n_in %d out %d ws %zu (need %zu)\n", n_in, out_size, ws_size, (size_t)WS_END); grid = -1; return; }
        int dev = 0, cus = 0, per_cu = 0;
        hipGetDevice(&dev); hipDeviceGetAttribute(&cus, hipDeviceAttributeMultiprocessorCount, dev);
        hipFuncSetAttribute((const void*)fwd_kernel, hipFuncAttributeMaxDynamicSharedMemorySize, LDS_BYTES);
        hipOccupancyMaxActiveBlocksPerMultiprocessor(&per_cu, (const void*)fwd_kernel, NTHREADS, LDS_BYTES);
        if (per_cu < 1) { fprintf(stderr, "kernel_launch: occupancy query says %d blocks per CU\n", per_cu); per_cu = 1; }
        (void)hipGetLastError();
        grid = cus;
        fprintf(stderr, "kernel_launch: grid %d, per_cu %d, ws %zu\n", grid, per_cu, ws_size);
    }
    if (grid < 0) return;
    hipMemsetAsync((char*)d_ws + WS_CTL, 0, CTL_BYTES, stream);
    Args a{};
    for (int i = 0; i < 27; ++i) a.in[i] = (const float*)d_in[i];
    a.out = (float*)d_out; a.ws = (unsigned char*)d_ws;
#if MK_COOP
    a.ph_lo = 0; a.ph_hi = NPH;
    void* args[] = {&a};
    hipError_t e = hipLaunchCooperativeKernel((const void*)fwd_kernel, dim3(grid), dim3(NTHREADS), args, LDS_BYTES, stream);
    if (e != hipSuccess) fprintf(stderr, "cooperative launch failed: %s (grid %d)\n", hipGetErrorString(e), grid);
#else
    for (int p = 0; p < NPH; ++p) { a.ph_lo = p; a.ph_hi = p + 1; hipLaunchKernelGGL(fwd_kernel, dim3(grid), dim3(NTHREADS), LDS_BYTES, stream, a); }
#endif
}
```

```cpp
#include <hip/hip_runtime.h>
#include <hip/hip_cooperative_groups.h>
#include <cstdio>
#include <cstdint>
namespace cg = cooperative_groups;

#ifndef MK_COOP
#define MK_COOP 1
#endif

constexpr int NB = 4, SEQ = 4096, DM = 1024, CTXL = 256;
constexpr int T_CTX = NB * CTXL, T_LAT = NB * SEQ, T_ALL = T_CTX + T_LAT;
constexpr float EPS = 1e-6f;
constexpr int NW_IN = 5888;
constexpr int NPH = 12;
constexpr int NTHREADS = 512;
constexpr int LDS_BYTES = 147456;

typedef unsigned short bf16_t;
typedef float f32x4 __attribute__((ext_vector_type(4)));
typedef unsigned u32x4 __attribute__((ext_vector_type(4)));
typedef unsigned u32x2 __attribute__((ext_vector_type(2)));
typedef unsigned short u16x8 __attribute__((ext_vector_type(8)));
typedef unsigned short u16x4 __attribute__((ext_vector_type(4)));
#define LASQ __attribute__((address_space(3)))
typedef __attribute__((address_space(3))) unsigned char* lds_ptr_t;

constexpr size_t MiB = 1u << 20;
constexpr size_t WS_QK = 0;
constexpr size_t WS_XBC = 34 * MiB;
constexpr size_t WS_OB = 34 * MiB;
constexpr size_t WS_QKF = 85 * MiB;
constexpr size_t WS_XN = 85 * MiB;
constexpr size_t WS_YX = 85 * MiB;
constexpr size_t WS_V = 119 * MiB;
constexpr size_t WS_XC = 153 * MiB;
constexpr size_t WS_WINT = 153 * MiB;
constexpr size_t WS_RZ = 204 * MiB;
constexpr size_t WS_XN2 = 204 * MiB;
constexpr size_t WS_YB = 268 * MiB;
constexpr size_t WS_GDT = 300 * MiB;
constexpr size_t WS_WOUTT = 305 * MiB;
constexpr size_t WS_MOD = 309 * MiB;
constexpr size_t WS_GLAD = WS_MOD + 256 * 1024;
constexpr size_t WS_CTL = 311 * MiB;
constexpr size_t CTL_BYTES = 64 * 1024;
constexpr size_t WS_PAIR = WS_GLAD + 1088 * 1024;
constexpr size_t WS_ACUM = 311 * MiB + 64 * 1024;
constexpr size_t WS_END = WS_ACUM + (size_t)T_ALL * 32 * 4;
constexpr size_t WS_WDT = 0;
constexpr size_t WS_WGU_LO = 34 * MiB;
constexpr size_t WS_WGU_HI = 268 * MiB;
constexpr size_t WS_H = 66 * MiB;
constexpr size_t WS_XN2S = 106 * MiB;
constexpr size_t WS_Y = 106 * MiB;
constexpr int MAX_SLOTS = 40960;
constexpr int CW_CNT = 0;
constexpr int CW_BLK = 8192;
constexpr int CW_BAR = 1024;

__device__ __forceinline__ float bf2f(bf16_t v) { return __uint_as_float((unsigned)v << 16); }
__device__ __forceinline__ unsigned f2bf(float f) { unsigned u = __float_as_uint(f); return (u + 0x7fffu + ((u >> 16) & 1u)) >> 16; }
typedef float f32x2 __attribute__((ext_vector_type(2)));
typedef __bf16 bf16x2_t __attribute__((ext_vector_type(2)));
__device__ __forceinline__ unsigned pk2(float lo, float hi) { const f32x2 v = {lo, hi}; return __builtin_bit_cast(unsigned, __builtin_convertvector(v, bf16x2_t)); }
__device__ __forceinline__ float siluf(float x) { return x / (1.f + __expf(-x)); }
__device__ __forceinline__ float softplusf(float x) { return fmaxf(x, 0.f) + log1pf(__expf(-fabsf(x))); }
__device__ __forceinline__ float logsigf(float x) { return fminf(x, 0.f) - log1pf(__expf(-fabsf(x))); }
__device__ __forceinline__ float logsig_fast(float x) { return fminf(x, 0.f) - 0.6931471805599453f * __builtin_amdgcn_logf(1.f + __builtin_amdgcn_exp2f(-1.4426950408889634f * fabsf(x))); }
__device__ __forceinline__ float wave_sum(float v) {
#pragma unroll
    for (int o = 1; o < 64; o <<= 1) v += __shfl_xor(v, o);
    return v;
}

struct Args { const float* in[27]; float* out; unsigned char* ws; int ph_lo, ph_hi; };
enum { I_X = 0, I_C, I_CTX, I_CCTX, I_WADA, I_BADA, I_NMIX, I_NFFN, I_WIN, I_GWUP, I_GB, I_GNORM, I_CONVW, I_CONVB, I_DTB, I_ALOG, I_SSDD, I_SSDN,
       I_WOUT, I_RGW, I_RGB, I_REW, I_REB, I_EWG, I_EWU, I_EWD, I_FNORM };

constexpr int CTRL_OFF = LDS_BYTES - 4096;
constexpr int PTAB_OFF = CTRL_OFF + 128;
struct InTab {
    unsigned char* lds;
    __device__ __forceinline__ const float* operator[](int i) const {
        const unsigned long long v = *(const __attribute__((address_space(3))) unsigned long long*)((__attribute__((address_space(3))) unsigned char*)lds + PTAB_OFF + 8 * i);
        const unsigned lo = __builtin_amdgcn_readfirstlane((unsigned)v), hi = __builtin_amdgcn_readfirstlane((unsigned)(v >> 32));
        return (const float*)(const __attribute__((address_space(1))) float*)(((unsigned long long)hi << 32) | lo);
    }
};
struct Ctx {
    InTab in; float* out; unsigned char* ws; unsigned char* lds;
    int tid, lane, wave, bid, G;
};

__device__ __forceinline__ void transpose_tile(const float* src  , int ldw, bf16_t* dst  , int ldt, float* scr, int lane, bool zero) {
#pragma unroll 8
    for (int i = 0; i < 32; ++i) { const int kk = 2 * i + (lane >> 5); scr[kk * 33 + (lane & 31)] = zero ? 0.f : src[(size_t)kk * ldw + (lane & 31)]; }
    asm volatile("s_waitcnt lgkmcnt(0)" ::: "memory");
    const int c = lane & 7;
#pragma unroll
    for (int j = 0; j < 4; ++j) { const int n = (lane >> 3) + 8 * j; const float* s = scr + (8 * c) * 33 + n;
        u32x4 o; o.x = pk2(s[0 * 33], s[1 * 33]); o.y = pk2(s[2 * 33], s[3 * 33]); o.z = pk2(s[4 * 33], s[5 * 33]); o.w = pk2(s[6 * 33], s[7 * 33]);
        *(u32x4*)(dst + (size_t)n * ldt + 8 * c) = o; }
    asm volatile("s_waitcnt lgkmcnt(0)" ::: "memory");
}

__device__ __forceinline__ int win_src_col(int n) {
    if (n < 3072) return n;
    if (n < 4096) return 3104 + (n - 3072);
    if (n < 5632) return 4128 + (n - 4096);
    if (n < 5664) return 3072 + (n - 5632);
    if (n < 5696) return 5664 + (n - 5664);
    return -1;
}

__device__ __forceinline__ void phase0(Ctx& C) {
    float* lds = (float*)C.lds;
    const int gw = C.bid * 8 + C.wave, NGW = C.G * 8;
    {
        float* scr = lds + 8192 + C.wave * (64 * 33);
        bf16_t* WinT = (bf16_t*)(C.ws + WS_WINT); bf16_t* WoutT = (bf16_t*)(C.ws + WS_WOUTT);
        constexpr int IT_IN = 16 * (NW_IN / 32), IT_OUT = 32 * 32;
        for (int it = gw; it < IT_IN + IT_OUT; it += NGW) {
            if (it < IT_IN) { const int kb = it / (NW_IN / 32), nb = it % (NW_IN / 32); const int sc = win_src_col(nb * 32);
                transpose_tile(C.in[I_WIN] + (size_t)(kb * 64) * 5696 + (sc < 0 ? 0 : sc), 5696, WinT + (size_t)(nb * 32) * 1024 + kb * 64, 1024, scr, C.lane, sc < 0); }
            else { const int r = it - IT_IN, kb = r / 32, nb = r % 32;
                transpose_tile(C.in[I_WOUT] + (size_t)(kb * 64) * 1024 + nb * 32, 1024, WoutT + (size_t)(nb * 32) * 2048 + kb * 64, 2048, scr, C.lane, false); }
        }
    }
    __syncthreads();
    float* sc = lds;
    float* red = lds + 5120;
    for (int i = C.tid; i < 5 * 1024; i += NTHREADS) { const int r = i >> 10, k = i & 1023; const float v = r < 4 ? C.in[I_C][r * 1024 + k] : C.in[I_CCTX][k]; sc[i] = siluf(v); }
    __syncthreads();
    float* MOD = (float*)(C.ws + WS_MOD); const float* wada = C.in[I_WADA]; const float* bada = C.in[I_BADA];
    for (int grp = C.bid; grp < 192; grp += C.G) {
        const int col = grp * 32 + (C.tid & 31), kg = C.tid >> 5;
        float acc[5] = {0.f, 0.f, 0.f, 0.f, 0.f};
#pragma unroll 8
        for (int kk = 0; kk < 64; ++kk) { const int k = kg + 16 * kk; const float w = wada[(size_t)k * 6144 + col];
#pragma unroll
            for (int i = 0; i < 5; ++i) acc[i] += sc[i * 1024 + k] * w; }
#pragma unroll
        for (int i = 0; i < 5; ++i) red[(kg * 5 + i) * 32 + (C.tid & 31)] = acc[i];
        __syncthreads();
        if (C.tid < 160) { const int i = C.tid >> 5, c = C.tid & 31; float s = 0.f;
            for (int g = 0; g < 16; ++g) s += red[(g * 5 + i) * 32 + c];
            MOD[i * 6144 + grp * 32 + c] = s + bada[grp * 32 + c]; }
        __syncthreads();
    }
}

__device__ __forceinline__ const float* tok_row(const float* xin, const float* cin, int row, int& mi) {
    if (row < T_CTX) { mi = 4; return cin + (size_t)row * DM; }
    mi = (row - T_CTX) >> 12; return xin + (size_t)(row - T_CTX) * DM;
}

__device__ __forceinline__ void phase1(Ctx& C) {
    const int gw = C.bid * 8 + C.wave, NGW = C.G * 8;
    const float* MOD = (const float*)(C.ws + WS_MOD); bf16_t* XN = (bf16_t*)(C.ws + WS_XN);
    const float* xin = C.in[I_X]; const float* cin = C.in[I_CTX]; const float* nmix = C.in[I_NMIX];
    constexpr int NR = 4;
    for (int r0 = gw; r0 < T_ALL; r0 += NGW * NR) {
        f32x4 v[NR][4]; float ss[NR]; int mi[NR];
#pragma unroll
        for (int u = 0; u < NR; ++u) { const int row = r0 + u * NGW; ss[u] = 0.f; mi[u] = 0;
            if (row < T_ALL) { const float* xr = tok_row(xin, cin, row, mi[u]);
#pragma unroll
                for (int j = 0; j < 4; ++j) v[u][j] = *(const f32x4*)(xr + j * 256 + C.lane * 4); } }
#pragma unroll
        for (int u = 0; u < NR; ++u) { const int row = r0 + u * NGW;
            if (row < T_ALL) {
#pragma unroll
                for (int j = 0; j < 4; ++j) ss[u] += v[u][j].x * v[u][j].x + v[u][j].y * v[u][j].y + v[u][j].z * v[u][j].z + v[u][j].w * v[u][j].w; } }
#pragma unroll
        for (int o = 1; o < 64; o <<= 1) {
#pragma unroll
            for (int u = 0; u < NR; ++u) ss[u] += __shfl_xor(ss[u], o); }
#pragma unroll
        for (int u = 0; u < NR; ++u) { const int row = r0 + u * NGW;
            if (row < T_ALL) { const float rs = rsqrtf(ss[u] * (1.f / DM) + EPS);
#pragma unroll
                for (int j = 0; j < 4; ++j) { const int c0 = j * 256 + C.lane * 4;
                    const f32x4 g = *(const f32x4*)(nmix + c0), sh = *(const f32x4*)(MOD + mi[u] * 6144 + c0), scl = *(const f32x4*)(MOD + mi[u] * 6144 + 1024 + c0);
                    const f32x4 y = v[u][j] * rs * g * (1.f + scl) + sh;
                    u32x2 o; o.x = pk2(y.x, y.y); o.y = pk2(y.z, y.w); *(u32x2*)(XN + (size_t)row * DM + c0) = o; } } }
    }
}

template <bool DUAL, class BSel, class Epi>
__device__ __forceinline__ void gemm_simple(Ctx& C, const bf16_t* A, int lda, int Mtiles, int Ntiles, int K, BSel bsel, Epi epi) {
    float* As = (float*)C.lds;
    float* Bs = As + 32 * 132;
    float* Bs2 = Bs + 32 * 132;
    const int ty = C.tid >> 4, tx = C.tid & 15;
    const int lr = C.tid >> 2, lk = (C.tid & 3) * 8;
    for (int tile = C.bid; tile < Mtiles * Ntiles; tile += C.G) {
        const int tm = tile / Ntiles, tn = tile % Ntiles;
        int ldb; const bf16_t* Bt = bsel(tm, tn, ldb);
        float acc[4][8], acc2[DUAL ? 4 : 1][8];
#pragma unroll
        for (int i = 0; i < 4; ++i)
#pragma unroll
            for (int j = 0; j < 8; ++j) { acc[i][j] = 0.f; if constexpr (DUAL) acc2[i][j] = 0.f; }
        const bf16_t* ap = A + (size_t)(tm * 128 + lr) * lda + lk;
        const bf16_t* bp = Bt + (size_t)lr * ldb + lk;
        for (int k0 = 0; k0 < K; k0 += 32) {
            const u16x8 av = *(const u16x8*)(ap + k0), bv = *(const u16x8*)(bp + k0);
            u16x8 bv2 = bv; if constexpr (DUAL) bv2 = *(const u16x8*)(bp + (size_t)128 * ldb + k0);
            __syncthreads();
#pragma unroll
            for (int j = 0; j < 8; ++j) { As[(lk + j) * 132 + lr] = bf2f(av[j]); Bs[(lk + j) * 132 + lr] = bf2f(bv[j]); if constexpr (DUAL) Bs2[(lk + j) * 132 + lr] = bf2f(bv2[j]); }
            __syncthreads();
#pragma unroll 8
            for (int k = 0; k < 32; ++k) {
                const f32x4 a = *(const f32x4*)(As + k * 132 + ty * 4);
                const f32x4 b0 = *(const f32x4*)(Bs + k * 132 + tx * 8), b1 = *(const f32x4*)(Bs + k * 132 + tx * 8 + 4);
                const float af[4] = {a.x, a.y, a.z, a.w}; const float bf[8] = {b0.x, b0.y, b0.z, b0.w, b1.x, b1.y, b1.z, b1.w};
#pragma unroll
                for (int i = 0; i < 4; ++i)
#pragma unroll
                    for (int j = 0; j < 8; ++j) acc[i][j] += af[i] * bf[j];
                if constexpr (DUAL) {
                    const f32x4 c0 = *(const f32x4*)(Bs2 + k * 132 + tx * 8), c1 = *(const f32x4*)(Bs2 + k * 132 + tx * 8 + 4);
                    const float cf[8] = {c0.x, c0.y, c0.z, c0.w, c1.x, c1.y, c1.z, c1.w};
#pragma unroll
                    for (int i = 0; i < 4; ++i)
#pragma unroll
                        for (int j = 0; j < 8; ++j) acc2[i][j] += af[i] * cf[j];
                }
            }
        }
#pragma unroll
        for (int i = 0; i < 4; ++i)
#pragma unroll
            for (int j = 0; j < 8; ++j) { float a2 = 0.f; if constexpr (DUAL) a2 = acc2[i][j]; epi(tm * 128 + ty * 4 + i, tn, tx * 8 + j, acc[i][j], a2); }
        __syncthreads();
    }
}


namespace pg8 {
#define PG8_LAS __attribute__((address_space(3)))
typedef short bf16x8 __attribute__((ext_vector_type(8)));
constexpr int BM = 256, BK = 64, HALF = 128, HTB = HALF * BK * 2  , STAGE_BYTES = 8 * HTB, NXCD = 8, WGM = 8;
__host__ __device__ __forceinline__ int lds_byte(int r, int c) { const int st = (r >> 4) * 2 + (c >> 5), rr = r & 15, cc = c & 31, ob = rr * 64 + cc * 2; return st * 1024 + (ob ^ (((ob >> 9) & 1) << 5)); }
__host__ __device__ __forceinline__ void stage_rc(int b, int& R, int& C) { const int st = b / 1024, sb = b % 1024, swz = sb ^ (((sb >> 9) & 1) << 5); R = (st >> 1) * 16 + swz / 64; C = (st & 1) * 32 + (swz % 64) / 2; }
__host__ __device__ __forceinline__ int perm32(int rho) { const int n = rho >> 4, i = rho & 15; return 8 * (i >> 2) + 4 * n + (i & 3); }
struct Unit { int pm, pn; };
__device__ __forceinline__ unsigned cvt_pk_bf16(float lo, float hi) { unsigned r; asm volatile("v_cvt_pk_bf16_f32 %0, %1, %2" : "=v"(r) : "v"(lo), "v"(hi)); return r; }
__device__ __forceinline__ int xcd_remap(int L, int nwg) { const int q = nwg / NXCD, r = nwg % NXCD, xcd = L % NXCD, off = L / NXCD; return (xcd < r ? xcd * (q + 1) : r * (q + 1) + (xcd - r) * q) + off; }
template <class Epi, class Sched, bool ALIGN_EPI = false, bool SP2 = false>
__device__ __forceinline__ void gemm_phase(PG8_LAS unsigned char* lds, const int K_, const Sched& S, const Epi& E) {
    const int tid = threadIdx.x, wid = __builtin_amdgcn_readfirstlane(tid >> 6), lane = tid & 63, wr = wid >> 2, wc = wid & 3, fr = lane & 15, fq = lane >> 4;
    const int K = K_, nt = K / BK;
    unsigned voffA[2], voffB[2];
#pragma unroll
    for (int i = 0; i < 2; ++i) { int R, C; stage_rc(tid * 16 + i * 8192, R, C); const int Rb = Epi::PERM ? ((R & ~31) + perm32(R & 31)) : R;
        voffA[i] = (unsigned)(R * K + C) * 2u; voffB[i] = (unsigned)(Rb * K + C) * 2u; }
    const size_t kstep = (size_t)(BK * 2);
    const size_t hstep = (size_t)HALF * K * 2;
    const unsigned ldsw = (unsigned)wid * 1024u;
    const int aoff = lds_byte(wr * 64 + fr, fq * 8), boff = lds_byte(wc * 32 + fr, fq * 8);
#define PG8_SA(b, h) (((b) * 2 + (h)) * HTB)
#define PG8_SB(b, h) ((4 + (b) * 2 + (h)) * HTB)
#define PG8_STAGE(bufoff, gbase, voff) do { _Pragma("unroll") for (int _i = 0; _i < 2; ++_i) \
        __builtin_amdgcn_global_load_lds((const unsigned*)((const char*)(gbase) + (voff)[_i]), (PG8_LAS unsigned*)(lds + (bufoff) + ldsw + _i * 8192), 16, 0, 0); } while (0)
#define PG8_LDA(dst, b, h) do { _Pragma("unroll") for (int m = 0; m < 4; ++m) _Pragma("unroll") for (int k = 0; k < 2; ++k) dst[m][k] = *(const PG8_LAS bf16x8*)(lds + PG8_SA(b, h) + aoff + m * 2048 + k * 1024); } while (0)
#define PG8_LDB(dst, b, h) do { _Pragma("unroll") for (int n = 0; n < 2; ++n) _Pragma("unroll") for (int k = 0; k < 2; ++k) dst[n][k] = *(const PG8_LAS bf16x8*)(lds + PG8_SB(b, h) + boff + n * 2048 + k * 1024); } while (0)
#define PG8_MMA(ai, bj, At, Bt) do { __builtin_amdgcn_s_setprio(1); _Pragma("unroll") for (int m = 0; m < 4; ++m) _Pragma("unroll") for (int n = 0; n < 2; ++n) _Pragma("unroll") for (int k = 0; k < 2; ++k) \
        acc[ai][bj][m][n] = __builtin_amdgcn_mfma_f32_16x16x32_bf16(Bt[n][k], At[m][k], acc[ai][bj][m][n], 0, 0, 0); __builtin_amdgcn_s_setprio(0); } while (0)
#define PG8_WAIT_V(n) asm volatile("s_waitcnt vmcnt(" #n ")" ::: "memory")
#define PG8_WAIT_L(n) asm volatile("s_waitcnt lgkmcnt(" #n ")" ::: "memory")
#define PG8_BAR __builtin_amdgcn_s_barrier()
#define PG8_SCHED __builtin_amdgcn_sched_barrier(0)
    Unit cur, nxt; int ui = 0;
    if (!S.next(0, cur)) return;
    f32x4 acc[2][2][4][2];
#pragma unroll
    for (int a = 0; a < 2; ++a)
#pragma unroll
        for (int b = 0; b < 2; ++b)
#pragma unroll
            for (int m = 0; m < 4; ++m)
#pragma unroll
                for (int n = 0; n < 2; ++n) acc[a][b][m][n] = (f32x4){0.f, 0.f, 0.f, 0.f};
    bf16x8 At[4][2], B0[2][2], B1[2][2];
    const char* cA = S.a_ptr(cur); const char* cB = S.b_ptr(cur);
    S.a_ready(cur);
    if constexpr (SP2) {
        PG8_STAGE(PG8_SB(0, 0), cB, voffB); PG8_STAGE(PG8_SB(0, 1), cB + hstep, voffB); PG8_STAGE(PG8_SA(0, 0), cA, voffA); PG8_STAGE(PG8_SA(0, 1), cA + hstep, voffA);
        if (wr == 1) PG8_BAR;
        PG8_WAIT_V(2); PG8_BAR;
        PG8_STAGE(PG8_SB(1, 0), cB + kstep, voffB); PG8_STAGE(PG8_SA(1, 0), cA + kstep, voffA); PG8_STAGE(PG8_SB(1, 1), cB + hstep + kstep, voffB);
        PG8_WAIT_V(6); PG8_BAR;
    } else {
        PG8_STAGE(PG8_SB(0, 0), cB, voffB); PG8_STAGE(PG8_SA(0, 0), cA, voffA); PG8_STAGE(PG8_SB(0, 1), cB + hstep, voffB); PG8_STAGE(PG8_SA(0, 1), cA + hstep, voffA);
        if (wr == 1) PG8_BAR;
        PG8_WAIT_V(4); PG8_BAR;
        PG8_STAGE(PG8_SB(1, 0), cB + kstep, voffB); PG8_STAGE(PG8_SA(1, 0), cA + kstep, voffA); PG8_STAGE(PG8_SB(1, 1), cB + hstep + kstep, voffB);
        PG8_WAIT_V(6); PG8_BAR;
    }
    for (;;) {
        const bool has_next = S.next(ui + 1, nxt);
        const char* nA = has_next ? S.a_ptr(nxt) : cA; const char* nB = has_next ? S.b_ptr(nxt) : cB;
        for (int t = 0; t < nt; t += 2) {
            const bool last = (t == nt - 2);
            const char* a1 = cA + (size_t)(t + 1) * kstep;
            const char* a2 = last ? nA : cA + (size_t)(t + 2) * kstep; const char* b2 = last ? nB : cB + (size_t)(t + 2) * kstep;
            const char* a3 = a2 + kstep; const char* b3 = b2 + kstep;
            if (last && has_next) S.a_ready(nxt);
            if constexpr (SP2) {
            PG8_LDB(B0, 0, 0); PG8_LDB(B1, 0, 1); PG8_SCHED; PG8_LDA(At, 0, 0); PG8_STAGE(PG8_SA(1, 1), a1 + hstep, voffA);
            PG8_WAIT_V(8); PG8_WAIT_L(0); PG8_BAR; PG8_MMA(0, 0, At, B0); PG8_MMA(0, 1, At, B1); PG8_BAR; PG8_SCHED;
            PG8_LDA(At, 0, 1); PG8_STAGE(PG8_SB(0, 0), b2, voffB); PG8_STAGE(PG8_SB(0, 1), b2 + hstep, voffB); PG8_STAGE(PG8_SA(0, 0), a2, voffA);
            PG8_WAIT_V(8); PG8_WAIT_L(0); PG8_BAR; PG8_MMA(1, 0, At, B0); PG8_MMA(1, 1, At, B1); PG8_BAR; PG8_SCHED;
            PG8_LDB(B0, 1, 0); PG8_LDB(B1, 1, 1); PG8_SCHED; PG8_LDA(At, 1, 0); PG8_STAGE(PG8_SA(0, 1), a2 + hstep, voffA);
            PG8_WAIT_V(8); PG8_WAIT_L(0); PG8_BAR; PG8_MMA(0, 0, At, B0); PG8_MMA(0, 1, At, B1); PG8_BAR; PG8_SCHED;
            PG8_LDA(At, 1, 1); PG8_STAGE(PG8_SB(1, 0), b3, voffB); PG8_STAGE(PG8_SB(1, 1), b3 + hstep, voffB); PG8_STAGE(PG8_SA(1, 0), a3, voffA);
            PG8_WAIT_V(8); PG8_WAIT_L(0); PG8_BAR; PG8_MMA(1, 0, At, B0); PG8_MMA(1, 1, At, B1); PG8_BAR; PG8_SCHED;
            } else {
            PG8_LDB(B0, 0, 0); PG8_SCHED; PG8_LDA(At, 0, 0); PG8_STAGE(PG8_SA(1, 1), a1 + hstep, voffA);
            PG8_WAIT_L(8); PG8_BAR; PG8_WAIT_L(0); PG8_MMA(0, 0, At, B0); PG8_BAR; PG8_SCHED;
            PG8_LDB(B1, 0, 1); PG8_STAGE(PG8_SB(0, 0), b2, voffB);
            PG8_BAR; PG8_WAIT_L(0); PG8_MMA(0, 1, At, B1); PG8_BAR;
            PG8_LDA(At, 0, 1); PG8_STAGE(PG8_SA(0, 0), a2, voffA);
            PG8_BAR; PG8_WAIT_L(0); PG8_MMA(1, 0, At, B0); PG8_BAR; PG8_SCHED;
            PG8_STAGE(PG8_SB(0, 1), b2 + hstep, voffB);
            PG8_WAIT_V(6); PG8_BAR; PG8_MMA(1, 1, At, B1); PG8_BAR;
            PG8_LDB(B0, 1, 0); PG8_SCHED; PG8_LDA(At, 1, 0); PG8_STAGE(PG8_SA(0, 1), a2 + hstep, voffA);
            PG8_WAIT_L(8); PG8_BAR; PG8_WAIT_L(0); PG8_MMA(0, 0, At, B0); PG8_BAR; PG8_SCHED;
            PG8_LDB(B1, 1, 1); PG8_STAGE(PG8_SB(1, 0), b3, voffB);
            PG8_BAR; PG8_WAIT_L(0); PG8_MMA(0, 1, At, B1); PG8_BAR;
            PG8_LDA(At, 1, 1); PG8_STAGE(PG8_SA(1, 0), a3, voffA);
            PG8_BAR; PG8_WAIT_L(0); PG8_MMA(1, 0, At, B0); PG8_BAR; PG8_SCHED;
            PG8_STAGE(PG8_SB(1, 1), b3 + hstep, voffB);
            PG8_WAIT_V(6); PG8_BAR; PG8_MMA(1, 1, At, B1); PG8_BAR;
            }
        }
        if constexpr (ALIGN_EPI) { if (wr == 0) PG8_BAR; }
        if constexpr (!Epi::AFTER_DRAIN) { E(acc, cur, wr, wc, fr, fq); S.done(cur); }
        if (!has_next) break;
#pragma unroll
        for (int a = 0; a < 2; ++a)
#pragma unroll
            for (int b = 0; b < 2; ++b)
#pragma unroll
                for (int m = 0; m < 4; ++m)
#pragma unroll
                    for (int n = 0; n < 2; ++n) acc[a][b][m][n] = (f32x4){0.f, 0.f, 0.f, 0.f};
        cur = nxt; cA = nA; cB = nB; ++ui;
        if constexpr (ALIGN_EPI) { if (wr == 1) PG8_BAR; }
    }
    PG8_WAIT_V(0);
    if constexpr (!ALIGN_EPI) { if (wr == 0) PG8_BAR; }
    PG8_BAR;
    if constexpr (Epi::AFTER_DRAIN) { E.fused(acc, cur, wr, wc, fr, fq, lds, wid, lane); S.done(cur); }
#undef PG8_SA
#undef PG8_SB
#undef PG8_STAGE
#undef PG8_LDA
#undef PG8_LDB
#undef PG8_MMA
#undef PG8_WAIT_V
#undef PG8_WAIT_L
#undef PG8_BAR
#undef PG8_SCHED
}
}

__device__ __forceinline__ bf16_t* wgu_ptr(unsigned char* ws, int e) { return (bf16_t*)(ws + (e < 16 ? WS_WGU_LO : WS_WGU_HI)) + (size_t)(e & 15) * 1024 * 1024; }

#ifndef PG8_MASK
#define PG8_MASK 15
#endif

struct SchedIn {
    const char* A; const char* Bt; int G, c;
    __device__ __forceinline__ bool next(int i, pg8::Unit& u) const {
        const int L0 = i * G + c; if (L0 >= 1532) return false;
        const int L = pg8::xcd_remap(L0, 1532);
        if (L < 60) { const int pi = L >> 2; u.pm = L & 3; u.pn = pi < 8 ? pi : pi + 8; }
        else { const int l2 = L - 60, g = l2 / 184, r = l2 % 184; u.pn = r >> 3; u.pm = 4 + 8 * g + (r & 7); }
        return true;
    }
    __device__ __forceinline__ const char* a_ptr(const pg8::Unit& u) const { return A + (size_t)u.pm * (256 * 1024 * 2); }
    __device__ __forceinline__ const char* b_ptr(const pg8::Unit& u) const { return Bt + (size_t)u.pn * (256 * 1024 * 2); }
    __device__ __forceinline__ void a_ready(const pg8::Unit&) const {}
    __device__ __forceinline__ void done(const pg8::Unit&) const {}
};
struct SchedOut {
    const char* A; const char* Bt; int G, c;
    __device__ __forceinline__ bool next(int i, pg8::Unit& u) const {
        const int L0 = i * G + c; if (L0 >= 256) return false;
        const int w = pg8::xcd_remap(L0, 256), gid = w >> 5, r = w & 31;
        u.pm = gid * 8 + (r & 7); u.pn = r >> 3;
        return true;
    }
    __device__ __forceinline__ const char* a_ptr(const pg8::Unit& u) const { return A + (size_t)u.pm * (256 * 2048 * 2); }
    __device__ __forceinline__ const char* b_ptr(const pg8::Unit& u) const { return Bt + (size_t)u.pn * (256 * 2048 * 2); }
    __device__ __forceinline__ void a_ready(const pg8::Unit&) const {}
    __device__ __forceinline__ void done(const pg8::Unit&) const {}
};
struct SchedMoe {
    const char* A; unsigned char* ws; const int* tile_e; int NT, G, c, K, down;
    __device__ __forceinline__ bool next(int i, pg8::Unit& u) const {
        const int nwg = NT * 4; const int L0 = i * G + c; if (L0 >= nwg) return false;
        const int w = pg8::xcd_remap(L0, nwg);
        u.pm = w >> 2; u.pn = w & 3;
        return true;
    }
    __device__ __forceinline__ const char* a_ptr(const pg8::Unit& u) const { return A + (size_t)u.pm * 256 * K * 2; }
    __device__ __forceinline__ const char* b_ptr(const pg8::Unit& u) const {
        const int e = __builtin_amdgcn_readfirstlane(tile_e[u.pm]);
        return down ? (const char*)(ws + WS_WDT) + ((size_t)e * 1024 * 512 + (size_t)u.pn * 256 * 512) * 2
                    : (const char*)wgu_ptr(ws, e) + (size_t)u.pn * 256 * 1024 * 2;
    }
    __device__ __forceinline__ void a_ready(const pg8::Unit&) const {}
    __device__ __forceinline__ void done(const pg8::Unit&) const {}
};

struct EpiIn {
    static constexpr bool PERM = true, AFTER_DRAIN = false;
    unsigned char* ws;
    __device__ __forceinline__ void operator()(const f32x4 (&acc)[2][2][4][2], const pg8::Unit& u, int wr, int wc, int fr, int fq) const {
        const int pn = u.pn; const int row0 = u.pm * 256 + wr * 64 + fr; const int ct = wc * 32 + 8 * fq;
        if (pn == 22) {
            if (wc < 2) { float* GDT = (float*)(ws + WS_GDT);
#pragma unroll
                for (int ai = 0; ai < 2; ++ai)
#pragma unroll
                    for (int m = 0; m < 4; ++m) { float* p = GDT + (size_t)(row0 + ai * 128 + m * 16) * 64 + ct; *(f32x4*)p = acc[ai][0][m][0]; *(f32x4*)(p + 4) = acc[ai][0][m][1]; } }
            return;
        }
        bf16_t* base; int ld; int roff = 0; bool act = false;
        if (pn < 4) { base = (bf16_t*)(ws + WS_QK) + pn * 256; ld = 1024; }
        else if (pn < 8) { base = (bf16_t*)(ws + WS_V) + (pn - 4) * 256; ld = 1024; }
        else if (pn < 16) { base = (bf16_t*)(ws + WS_RZ) + (pn - 8) * 256; ld = 2048; roff = T_CTX; act = true; }
        else { base = (bf16_t*)(ws + WS_XBC) + (pn - 16) * 256; ld = 1536; }
#pragma unroll
        for (int ai = 0; ai < 2; ++ai)
#pragma unroll
            for (int m = 0; m < 4; ++m) { bf16_t* rowp = base + (size_t)(row0 - roff + ai * 128 + m * 16) * ld + ct;
#pragma unroll
                for (int bj = 0; bj < 2; ++bj) { f32x4 v0 = acc[ai][bj][m][0], v1 = acc[ai][bj][m][1];
                    if (act) { v0.x = siluf(v0.x); v0.y = siluf(v0.y); v0.z = siluf(v0.z); v0.w = siluf(v0.w); v1.x = siluf(v1.x); v1.y = siluf(v1.y); v1.z = siluf(v1.z); v1.w = siluf(v1.w); }
                    u32x4 w; w.x = pg8::cvt_pk_bf16(v0.x, v0.y); w.y = pg8::cvt_pk_bf16(v0.z, v0.w); w.z = pg8::cvt_pk_bf16(v1.x, v1.y); w.w = pg8::cvt_pk_bf16(v1.z, v1.w);
                    *(u32x4*)(rowp + bj * 128) = w; } }
    }
};
struct EpiOut {
    static constexpr bool PERM = false, AFTER_DRAIN = false;
    const float* X; const float* MOD; float* HL;
    __device__ __forceinline__ void operator()(const f32x4 (&acc)[2][2][4][2], const pg8::Unit& u, int wr, int wc, int fr, int fq) const {
        const int b = u.pm >> 4; const int col0 = u.pn * 256 + wc * 32 + 4 * fq;
        f32x4 g1[2][2];
#pragma unroll
        for (int bj = 0; bj < 2; ++bj)
#pragma unroll
            for (int n = 0; n < 2; ++n) g1[bj][n] = *(const f32x4*)(MOD + b * 6144 + 2048 + col0 + bj * 128 + n * 16);
#pragma unroll
        for (int ai = 0; ai < 2; ++ai)
#pragma unroll
            for (int m = 0; m < 4; ++m) { const size_t off = (size_t)(u.pm * 256 + ai * 128 + wr * 64 + m * 16 + fr) * 1024 + col0;
#pragma unroll
                for (int bj = 0; bj < 2; ++bj)
#pragma unroll
                    for (int n = 0; n < 2; ++n) { const f32x4 xv = *(const f32x4*)(X + off + bj * 128 + n * 16); *(f32x4*)(HL + off + bj * 128 + n * 16) = xv + g1[bj][n] * acc[ai][bj][m][n]; }
                if (m & 1) asm volatile("" ::: "memory"); }
    }
};
struct EpiUp {
    static constexpr bool PERM = true, AFTER_DRAIN = false;
    bf16_t* H;
    __device__ __forceinline__ void operator()(const f32x4 (&acc)[2][2][4][2], const pg8::Unit& u, int wr, int wc, int fr, int fq) const {
        const int row0 = u.pm * 256 + wr * 64 + fr; const int col = u.pn * 128 + wc * 32 + 8 * fq;
#pragma unroll
        for (int ai = 0; ai < 2; ++ai)
#pragma unroll
            for (int m = 0; m < 4; ++m) { const f32x4 g0 = acc[ai][0][m][0], g1 = acc[ai][0][m][1], u0 = acc[ai][1][m][0], u1 = acc[ai][1][m][1];
                u32x4 w; w.x = pg8::cvt_pk_bf16(siluf(g0.x) * u0.x, siluf(g0.y) * u0.y); w.y = pg8::cvt_pk_bf16(siluf(g0.z) * u0.z, siluf(g0.w) * u0.w);
                w.z = pg8::cvt_pk_bf16(siluf(g1.x) * u1.x, siluf(g1.y) * u1.y); w.w = pg8::cvt_pk_bf16(siluf(g1.z) * u1.z, siluf(g1.w) * u1.w);
                *(u32x4*)(H + (size_t)(row0 + ai * 128 + m * 16) * 512 + col) = w; }
    }
};
struct EpiDown {
    static constexpr bool PERM = true, AFTER_DRAIN = false;
    bf16_t* Y; const float* SW;
    __device__ __forceinline__ void operator()(const f32x4 (&acc)[2][2][4][2], const pg8::Unit& u, int wr, int wc, int fr, int fq) const {
        const int row0 = u.pm * 256 + wr * 64 + fr; const int col = u.pn * 256 + wc * 32 + 8 * fq;
#pragma unroll
        for (int ai = 0; ai < 2; ++ai)
#pragma unroll
            for (int m = 0; m < 4; ++m) { const int row = row0 + ai * 128 + m * 16; const float sw = SW[row];
#pragma unroll
                for (int bj = 0; bj < 2; ++bj) { const f32x4 v0 = acc[ai][bj][m][0] * sw, v1 = acc[ai][bj][m][1] * sw;
                    u32x4 w; w.x = pg8::cvt_pk_bf16(v0.x, v0.y); w.y = pg8::cvt_pk_bf16(v0.z, v0.w); w.z = pg8::cvt_pk_bf16(v1.x, v1.y); w.w = pg8::cvt_pk_bf16(v1.z, v1.w);
                    *(u32x4*)(Y + (size_t)row * 1024 + col + bj * 128) = w; } }
    }
};

__device__ __forceinline__ void phase2(Ctx& C) {
    const bf16_t* XN = (const bf16_t*)(C.ws + WS_XN); const bf16_t* WinT = (const bf16_t*)(C.ws + WS_WINT);
    bf16_t* QK = (bf16_t*)(C.ws + WS_QK); bf16_t* V = (bf16_t*)(C.ws + WS_V); bf16_t* RZ = (bf16_t*)(C.ws + WS_RZ); bf16_t* XBC = (bf16_t*)(C.ws + WS_XBC);
    float* GDT = (float*)(C.ws + WS_GDT);
    auto bsel = [=](int, int tn, int& ldb) { ldb = 1024; return WinT + (size_t)tn * 128 * 1024; };
    auto epi = [=](int row, int tn, int cc, float v, float) {
        const int col = tn * 128 + cc;
        if (col < 1024) QK[(size_t)row * 1024 + col] = (bf16_t)f2bf(v);
        else if (col < 2048) V[(size_t)row * 1024 + col - 1024] = (bf16_t)f2bf(v);
        else if (col < 4096) { if (row >= T_CTX) RZ[(size_t)(row - T_CTX) * 2048 + col - 2048] = (bf16_t)f2bf(siluf(v)); }
        else if (col < 5632) XBC[(size_t)row * 1536 + col - 4096] = (bf16_t)f2bf(v);
        else if (col < 5696) GDT[(size_t)row * 64 + col - 5632] = v;
    };
#if PG8_MASK & 1
    (void)bsel; (void)epi;
    SchedIn S{(const char*)XN, (const char*)WinT, C.G, C.bid}; EpiIn E{C.ws};
    pg8::gemm_phase<EpiIn, SchedIn, true, true>((lds_ptr_t)C.lds, 1024, S, E);
#else
    gemm_simple<false>(C, XN, 1024, T_ALL / 128, NW_IN / 128, 1024, bsel, epi);
#endif
}

__device__ __forceinline__ void phase3(Ctx& C, int sec) {
    if (sec & 1) {
        lds_ptr_t L = (lds_ptr_t)C.lds;
        constexpr int IN_O = 0, OUT_O = 32768, GS_O = 98304, TOT_O = 106496;
        LASQ float* gs = (LASQ float*)(L + GS_O); LASQ float* tot = (LASQ float*)(L + TOT_O);
        bf16_t* QK = (bf16_t*)(C.ws + WS_QK); bf16_t* QKF = (bf16_t*)(C.ws + WS_QKF);
        const float* GDT = (const float*)(C.ws + WS_GDT); float* GLAD = (float*)(C.ws + WS_GLAD);
        const float* gwup = C.in[I_GWUP]; const float* gbias = C.in[I_GB];
        const int tid = C.tid, c = tid & 127, tg = tid >> 7;
        for (int item = C.bid; item < 272 * 4; item += C.G) {
            const int rc = item >> 2, h = item & 3, row0 = rc * 64;
            __syncthreads();
#pragma unroll
            for (int i = 0; i < 4; ++i) { const int id = tid + 512 * i, arr = id >> 10, r = (id >> 4) & 63, ch = id & 15;
                *(LASQ u32x4*)(L + IN_O + arr * 16384 + r * 256 + ch * 16) = *(const u32x4*)(QK + (size_t)(row0 + r) * 1024 + arr * 512 + h * 128 + ch * 8); }
            *(LASQ f32x4*)(gs + (tid >> 3) * 32 + (tid & 7) * 4) = *(const f32x4*)(GDT + (size_t)(row0 + (tid >> 3)) * 64 + (tid & 7) * 4);
            float wf[16], wb[16];
#pragma unroll
            for (int r = 0; r < 16; ++r) { wf[r] = gwup[r * 512 + h * 128 + c]; wb[r] = gwup[(16 + r) * 512 + h * 128 + c]; }
            const float bfv = gbias[h * 128 + c], bbv = gbias[512 + h * 128 + c];
            __syncthreads();
            float pf[16], pb[16];
#pragma unroll
            for (int tt = 0; tt < 16; ++tt) { const LASQ float* g = gs + (tg * 16 + tt) * 32; float sf = bfv, sb = bbv;
#pragma unroll
                for (int r4 = 0; r4 < 4; ++r4) { const f32x4 gf = *(const LASQ f32x4*)(g + r4 * 4), gb = *(const LASQ f32x4*)(g + 16 + r4 * 4);
                    sf += gf.x * wf[r4 * 4] + gf.y * wf[r4 * 4 + 1] + gf.z * wf[r4 * 4 + 2] + gf.w * wf[r4 * 4 + 3];
                    sb += gb.x * wb[r4 * 4] + gb.y * wb[r4 * 4 + 1] + gb.z * wb[r4 * 4 + 2] + gb.w * wb[r4 * 4 + 3]; }
                pf[tt] = logsig_fast(sf) * (1.f / 16.f); pb[tt] = logsig_fast(sb) * (1.f / 16.f); }
#pragma unroll
            for (int tt = 1; tt < 16; ++tt) pf[tt] += pf[tt - 1];
#pragma unroll
            for (int tt = 14; tt >= 0; --tt) pb[tt] += pb[tt + 1];
            tot[(0 * 4 + tg) * 128 + c] = pf[15]; tot[(1 * 4 + tg) * 128 + c] = pb[0];
            __syncthreads();
            float offf = 0.f, offb = 0.f, totf = 0.f, totb = 0.f;
#pragma unroll
            for (int g = 0; g < 4; ++g) { const float a = tot[(0 * 4 + g) * 128 + c], bq = tot[(1 * 4 + g) * 128 + c]; if (g < tg) offf += a; if (g > tg) offb += bq; totf += a; totb += bq; }
            if (tg == 0) { GLAD[((size_t)(rc * 4 + h) * 2 + 0) * 128 + c] = __expf(totf); GLAD[((size_t)(rc * 4 + h) * 2 + 1) * 128 + c] = __expf(totb); }
            const float qscale = 0.08838834764831845f;
#pragma unroll
            for (int tt = 0; tt < 16; ++tt) { const int r = tg * 16 + tt;
                const float q = bf2f(*(const LASQ bf16_t*)(L + IN_O + r * 256 + c * 2)) * qscale, k = bf2f(*(const LASQ bf16_t*)(L + IN_O + 16384 + r * 256 + c * 2));
                const float ef = pf[tt] + offf, eb = pb[tt] + offb;
                *(LASQ bf16_t*)(L + OUT_O + 0 * 16384 + r * 256 + c * 2) = (bf16_t)f2bf(q * __expf(ef));
                *(LASQ bf16_t*)(L + OUT_O + 1 * 16384 + r * 256 + c * 2) = (bf16_t)f2bf(k * __expf(-ef));
                *(LASQ bf16_t*)(L + OUT_O + 2 * 16384 + r * 256 + c * 2) = (bf16_t)f2bf(q * __expf(eb));
                *(LASQ bf16_t*)(L + OUT_O + 3 * 16384 + r * 256 + c * 2) = (bf16_t)f2bf(k * __expf(-eb)); }
            __syncthreads();
#pragma unroll
            for (int i = 0; i < 8; ++i) { const int id = tid + 512 * i, arr = id >> 10, r = (id >> 4) & 63, ch = id & 15;
                bf16_t* dst = (arr < 2 ? QKF : QK) + (size_t)(row0 + r) * 1024 + (arr & 1) * 512 + h * 128 + ch * 8;
                *(u32x4*)dst = *(const LASQ u32x4*)(L + OUT_O + arr * 16384 + r * 256 + ch * 16); }
        }
        __syncthreads();
    }
    if (sec & 2) {
        const bf16_t* XBC = (const bf16_t*)(C.ws + WS_XBC); bf16_t* XC = (bf16_t*)(C.ws + WS_XC);
        const float* cw = C.in[I_CONVW]; const float* cb = C.in[I_CONVB];
        const int total = 272 * 4 * 192;
        for (int it = C.bid * NTHREADS + C.tid; it < total; it += C.G * NTHREADS) {
            const int cg8 = it % 192, st = it / 192, rc = st >> 2, x0 = (st & 3) * 16, c0 = cg8 * 8;
            int base, y, xb, H, W;
            if (rc < 16) { base = (rc >> 2) * 256; y = 0; xb = (rc & 3) * 64; H = 1; W = 256; }
            else { const int lr = rc - 16; base = T_CTX + (lr >> 6) * 4096; y = lr & 63; xb = 0; H = 64; W = 64; }
            float wt[9][8], bias[8];
#pragma unroll
            for (int t = 0; t < 9; ++t) { const f32x4 a = *(const f32x4*)(cw + (size_t)t * 1536 + c0), bq = *(const f32x4*)(cw + (size_t)t * 1536 + c0 + 4);
                wt[t][0] = a.x; wt[t][1] = a.y; wt[t][2] = a.z; wt[t][3] = a.w; wt[t][4] = bq.x; wt[t][5] = bq.y; wt[t][6] = bq.z; wt[t][7] = bq.w; }
            { const f32x4 a = *(const f32x4*)(cb + c0), bq = *(const f32x4*)(cb + c0 + 4); bias[0] = a.x; bias[1] = a.y; bias[2] = a.z; bias[3] = a.w; bias[4] = bq.x; bias[5] = bq.y; bias[6] = bq.z; bias[7] = bq.w; }
            const bool vy[3] = {y - 1 >= 0, true, y + 1 < H};
            u16x8 win[3][3];
            auto ldcol = [&](int i, int xx) -> u16x8 { u16x8 z = {0, 0, 0, 0, 0, 0, 0, 0};
                if (!vy[i] || xx < 0 || xx >= W) return z;
                return *(const u16x8*)(XBC + (size_t)(base + (y + i - 1) * W + xx) * 1536 + c0); };
            const int xs = xb + x0;
            u16x8 nxt[3];
#pragma unroll
            for (int i = 0; i < 3; ++i) { win[i][0] = ldcol(i, xs - 1); win[i][1] = ldcol(i, xs); nxt[i] = ldcol(i, xs + 1); }
            for (int dx = 0; dx < 16; ++dx) { const int x = xs + dx;
#pragma unroll
                for (int i = 0; i < 3; ++i) { win[i][2] = nxt[i]; nxt[i] = ldcol(i, x + 2 <= xs + 16 ? x + 2 : -1); }
                float acc[8];
#pragma unroll
                for (int j = 0; j < 8; ++j) acc[j] = bias[j];
#pragma unroll
                for (int i = 0; i < 3; ++i)
#pragma unroll
                    for (int jx = 0; jx < 3; ++jx)
#pragma unroll
                        for (int j = 0; j < 8; ++j) acc[j] += bf2f(win[i][jx][j]) * wt[i * 3 + jx][j];
                u32x4 o; o.x = pk2(siluf(acc[0]), siluf(acc[1])); o.y = pk2(siluf(acc[2]), siluf(acc[3])); o.z = pk2(siluf(acc[4]), siluf(acc[5])); o.w = pk2(siluf(acc[6]), siluf(acc[7]));
                *(u32x4*)(XC + (size_t)(base + y * W + x) * 1536 + c0) = o;
#pragma unroll
                for (int i = 0; i < 3; ++i) { win[i][0] = win[i][1]; win[i][1] = win[i][2]; }
            }
        }
    }
    if (sec & 4) {
        float* GDT = (float*)(C.ws + WS_GDT); float* ACUM = (float*)(C.ws + WS_ACUM);
        const float* alog = C.in[I_ALOG]; const float* dtbias = C.in[I_DTB];
        const int gw = C.bid * 8 + C.wave, NGW = C.G * 8, l = C.lane;
        for (int it = gw; it < 272 * 32; it += NGW) {
            const int rc = it >> 5, dh = it & 31, dir = dh >> 4; const size_t row = (size_t)rc * 64 + l;
            const float dtv = softplusf(GDT[row * 64 + 32 + dh] + dtbias[dh]);
            float sa = dtv * (-__expf(alog[dh])) * 1.4426950408889634f;
#pragma unroll
            for (int o = 1; o < 64; o <<= 1) { const float t = dir ? __shfl_down(sa, o) : __shfl_up(sa, o); if (dir ? (l + o < 64) : (l >= o)) sa += t; }
            GDT[row * 64 + 32 + dh] = dtv; ACUM[row * 32 + dh] = sa;
        }
    }
}

__device__ __forceinline__ int scan_row(int b, int dir, int s) {
    if (s < CTXL) return b * CTXL + (dir ? CTXL - 1 - s : s);
    const int t = s - CTXL; return T_CTX + b * SEQ + (dir ? SEQ - 1 - t : t);
}

__device__ __forceinline__ void phase4_naive(Ctx& C) {
    bf16_t* OF = (bf16_t*)C.out;
    bf16_t* OB = (bf16_t*)(C.ws + WS_OB);
    bf16_t* YB = (bf16_t*)(C.ws + WS_YB);
    const bf16_t* V = (const bf16_t*)(C.ws + WS_V); const bf16_t* XC = (const bf16_t*)(C.ws + WS_XC);
    const float* GDT = (const float*)(C.ws + WS_GDT); const float* GLAD = (const float*)(C.ws + WS_GLAD);
    for (int gt = C.bid * NTHREADS + C.tid; gt < 65536; gt += C.G * NTHREADS) {
        if (gt < 32768) {
            const int chain = gt >> 10, rem = gt & 1023, dv = rem >> 2, dq = rem & 3;
            const int b = chain >> 3, h = (chain >> 1) & 3, dir = chain & 1;
            const bf16_t* QKp = (const bf16_t*)(C.ws + (dir ? WS_QK : WS_QKF));
            float S[32];
#pragma unroll
            for (int i = 0; i < 32; ++i) S[i] = 0.f;
            for (int s = 0; s < CTXL + SEQ; ++s) {
                const int row = scan_row(b, dir, s);
                const float v = bf2f(V[(size_t)row * 1024 + h * 256 + dv]);
                const bf16_t* qp = QKp + (size_t)row * 1024 + h * 128 + dq * 32;
                float o = 0.f;
#pragma unroll
                for (int i8 = 0; i8 < 4; ++i8) { const u16x8 kv = *(const u16x8*)(qp + 512 + i8 * 8), qv = *(const u16x8*)(qp + i8 * 8);
#pragma unroll
                    for (int j = 0; j < 8; ++j) { S[i8 * 8 + j] += bf2f(kv[j]) * v; o += bf2f(qv[j]) * S[i8 * 8 + j]; } }
                o += __shfl_xor(o, 1); o += __shfl_xor(o, 2);
                if (row >= T_CTX && dq == 0) { const size_t l = row - T_CTX; if (dir) OB[l * 1024 + h * 256 + dv] = (bf16_t)f2bf(o); else OF[l * 2048 + h * 256 + dv] = (bf16_t)f2bf(o); }
                if ((s & 63) == 63) { const float* d = GLAD + ((size_t)((row >> 6) * 4 + h) * 2 + dir) * 128 + dq * 32;
#pragma unroll
                    for (int i = 0; i < 32; ++i) S[i] *= d[i]; }
            }
        } else {
            const int g2 = gt - 32768, chain = g2 >> 8, rem = g2 & 255, p = rem >> 2, nq = rem & 3;
            const int b = chain >> 5, head = (chain >> 1) & 15, dir = chain & 1, grp = head >> 3;
            const float Aneg = -__expf(C.in[I_ALOG][dir * 16 + head]), dtb = C.in[I_DTB][dir * 16 + head];
            float S[32];
#pragma unroll
            for (int i = 0; i < 32; ++i) S[i] = 0.f;
            for (int s = 0; s < CTXL + SEQ; ++s) {
                const int row = scan_row(b, dir, s);
                const float dt = GDT[(size_t)row * 64 + 32 + dir * 16 + head], a = __expf(dt * Aneg); (void)dtb;
                const float xd = bf2f(XC[(size_t)row * 1536 + head * 64 + p]) * dt;
                const bf16_t* bp = XC + (size_t)row * 1536 + 1024 + grp * 128 + nq * 32;
                float y = 0.f;
#pragma unroll
                for (int i8 = 0; i8 < 4; ++i8) { const u16x8 bv = *(const u16x8*)(bp + i8 * 8), cv = *(const u16x8*)(bp + 256 + i8 * 8);
#pragma unroll
                    for (int j = 0; j < 8; ++j) { S[i8 * 8 + j] = a * S[i8 * 8 + j] + xd * bf2f(bv[j]); y += S[i8 * 8 + j] * bf2f(cv[j]); } }
                y += __shfl_xor(y, 1); y += __shfl_xor(y, 2);
                if (row >= T_CTX && nq == 0) { const size_t l = row - T_CTX; if (dir) YB[l * 1024 + head * 64 + p] = (bf16_t)f2bf(y); else OF[l * 2048 + 1024 + head * 64 + p] = (bf16_t)f2bf(y); }
            }
        }
    }
}


typedef short bf16x8 __attribute__((ext_vector_type(8)));
typedef short s16x4 __attribute__((ext_vector_type(4)));
typedef __attribute__((address_space(3))) s16x4* lds_s16x4_p;
__device__ __forceinline__ bf16x8 lds_row_frag(lds_ptr_t L, int off, int rs, int r0, int kb, int c, int g) {
    return *(const LASQ bf16x8*)(L + off + (r0 + c) * rs + kb + g * 16);
}
__device__ __forceinline__ bf16x8 lds_tr_frag(lds_ptr_t L, int off, int rs, int k0, int n0, int g, int q, int p) {
    const s16x4 lo = __builtin_amdgcn_ds_read_tr16_b64_v4i16((lds_s16x4_p)(L + off + (k0 + 8 * g + q) * rs + (n0 + 4 * p) * 2));
    const s16x4 hi = __builtin_amdgcn_ds_read_tr16_b64_v4i16((lds_s16x4_p)(L + off + (k0 + 8 * g + 4 + q) * rs + (n0 + 4 * p) * 2));
    bf16x8 r; r[0] = lo[0]; r[1] = lo[1]; r[2] = lo[2]; r[3] = lo[3]; r[4] = hi[0]; r[5] = hi[1]; r[6] = hi[2]; r[7] = hi[3]; return r;
}
template <bool GLA>
__device__ __forceinline__ void scan_unit(Ctx& C, int uid) {
    lds_ptr_t L = (lds_ptr_t)C.lds;
    constexpr int INB = 44032, KS_O = 17408, VS_O = 34816, ST_OFF = 88064, STB = 17408, PS_OFF = 122880, SC_OFF = 132096, SCB = 1280;
    const int tid = C.tid, w = C.wave, l = C.lane, g = l >> 4, c = l & 15, q = c >> 2, p = c & 3;
    int b, dir, ldqk, ldv, ldo; const bf16_t *Qg, *Kg, *Vg; bf16_t* Og; const float* Sg; const float* dtg = nullptr;
    if (GLA) { b = uid >> 5; const int h = (uid >> 3) & 3; dir = (uid >> 2) & 1; const int sl = uid & 3;
        const bf16_t* QKp = (const bf16_t*)(C.ws + (dir ? WS_QK : WS_QKF));
        Qg = QKp + h * 128; Kg = QKp + 512 + h * 128; ldqk = 1024; Vg = (const bf16_t*)(C.ws + WS_V) + h * 256 + sl * 64; ldv = 1024;
        Og = dir ? (bf16_t*)(C.ws + WS_OB) + h * 256 + sl * 64 : (bf16_t*)C.out + h * 256 + sl * 64; ldo = dir ? 1024 : 2048;
        Sg = (const float*)(C.ws + WS_GLAD) + (h * 2 + dir) * 128;
    } else { b = uid >> 5; const int head = (uid >> 1) & 15; dir = uid & 1; const int grp = head >> 3;
        const bf16_t* XC = (const bf16_t*)(C.ws + WS_XC);
        Qg = XC + 1280 + grp * 128; Kg = XC + 1024 + grp * 128; ldqk = 1536; Vg = XC + head * 64; ldv = 1536;
        Og = dir ? (bf16_t*)(C.ws + WS_YB) + head * 64 : (bf16_t*)C.out + 1024 + head * 64; ldo = dir ? 1024 : 2048;
        Sg = (const float*)(C.ws + WS_ACUM) + dir * 16 + head;
        dtg = (const float*)(C.ws + WS_GDT) + 32 + dir * 16 + head;
    }
    f32x4 S[4];
#pragma unroll
    for (int t = 0; t < 4; ++t) S[t] = (f32x4){0.f, 0.f, 0.f, 0.f};
    u32x4 pq0, pq1, pk0, pk1, pv; float ps0 = 0.f, ps1 = 0.f, ptot = 0.f;
    auto chunk_rc = [&](int n) { return n < 4 ? 4 * b + (dir ? 3 - n : n) : 16 + 64 * b + (dir ? 67 - n : n - 4); };
    auto prefetch = [&](int n) {
        const int rc = chunk_rc(n), row0 = rc * 64;
        const bf16_t* qp = Qg + (size_t)(row0 + (tid >> 4)) * ldqk + (tid & 15) * 8; const bf16_t* kp = Kg + (size_t)(row0 + (tid >> 4)) * ldqk + (tid & 15) * 8;
        pq0 = *(const u32x4*)qp; pq1 = *(const u32x4*)(qp + (size_t)32 * ldqk); pk0 = *(const u32x4*)kp; pk1 = *(const u32x4*)(kp + (size_t)32 * ldqk);
        pv = *(const u32x4*)(Vg + (size_t)(row0 + (tid >> 3)) * ldv + (tid & 7) * 8);
        if (GLA) { ps0 = Sg[(size_t)rc * 1024 + (tid & 127)]; }
        else { ps0 = Sg[(size_t)(row0 + (tid & 63)) * 32]; ps1 = dtg[(size_t)(row0 + (tid & 63)) * 64]; ptot = Sg[(size_t)(row0 + (dir ? 0 : 63)) * 32]; }
    };
    float dtot = 1.f;
    auto stageW = [&](int n) {
        const int ib = (n & 1) * INB; LASQ float* sc = (LASQ float*)(L + SC_OFF + (n & 1) * SCB);
        *(LASQ u32x4*)(L + ib + (tid >> 4) * 272 + (tid & 15) * 16) = pq0; *(LASQ u32x4*)(L + ib + ((tid >> 4) + 32) * 272 + (tid & 15) * 16) = pq1;
        *(LASQ u32x4*)(L + ib + KS_O + (tid >> 4) * 272 + (tid & 15) * 16) = pk0; *(LASQ u32x4*)(L + ib + KS_O + ((tid >> 4) + 32) * 272 + (tid & 15) * 16) = pk1;
        *(LASQ u32x4*)(L + ib + VS_O + (tid >> 3) * 144 + (tid & 7) * 16) = pv;
        if (GLA) { if (tid < 128) sc[tid] = ps0; }
        else { if (tid < 64) { sc[tid] = ps0; sc[64 + tid] = ps1; sc[128 + tid] = ps1 * __builtin_amdgcn_exp2f(ptot - ps0); } }
    };
    prefetch(0);
    stageW(0);
    float dcur = GLA ? 1.f : __builtin_amdgcn_exp2f(ptot);
    prefetch(1);
    __syncthreads();
    for (int n = 0; n < 68; ++n) {
        const int rc = chunk_rc(n); const bool lat = n >= 4;
        const int ib = (n & 1) * INB; LASQ float* sc = (LASQ float*)(L + SC_OFF + (n & 1) * SCB);
        float dnext = 1.f;
        if (n + 1 < 68) { stageW(n + 1); if (!GLA) dnext = __builtin_amdgcn_exp2f(ptot); if (n + 2 < 68) prefetch(n + 2); }
        if (lat) {
            const int tj = w >> 1, ti0 = 2 * (w & 1);
            bf16x8 ka[4];
#pragma unroll
            for (int ks = 0; ks < 4; ++ks) ka[ks] = lds_row_frag(L, ib + KS_O, 272, 16 * tj, 64 * ks, c, g);
#pragma unroll
            for (int t2 = 0; t2 < 2; ++t2) { const int ti = ti0 + t2; f32x4 acc = (f32x4){0.f, 0.f, 0.f, 0.f};
#pragma unroll
                for (int ks = 0; ks < 4; ++ks) { const bf16x8 qb = lds_row_frag(L, ib, 272, 16 * ti, 64 * ks, c, g); acc = __builtin_amdgcn_mfma_f32_16x16x32_bf16(ka[ks], qb, acc, 0, 0, 0); }
                const int i = 16 * ti + c, j0 = 16 * tj + 4 * g; float pvv[4];
                if (GLA) {
#pragma unroll
                    for (int r = 0; r < 4; ++r) { const bool ok = dir ? (j0 + r >= i) : (j0 + r <= i); pvv[r] = ok ? acc[r] : 0.f; }
                } else { const float ai = sc[i]; const f32x4 aj = *(const LASQ f32x4*)(sc + j0), dj = *(const LASQ f32x4*)(sc + 64 + j0);
#pragma unroll
                    for (int r = 0; r < 4; ++r) { const bool ok = dir ? (j0 + r >= i) : (j0 + r <= i); const float x = ok ? ai - aj[r] : 0.f; pvv[r] = ok ? acc[r] * __builtin_amdgcn_exp2f(x) * dj[r] : 0.f; } }
                u32x2 o; o.x = pk2(pvv[0], pvv[1]); o.y = pk2(pvv[2], pvv[3]); *(LASQ u32x2*)(L + PS_OFF + i * 144 + j0 * 2) = o; }
        }
        {
            bf16x8 ka[2];
#pragma unroll
            for (int ks = 0; ks < 2; ++ks) ka[ks] = lds_tr_frag(L, ib + KS_O, 272, 32 * ks, 16 * w, g, q, p);
            if (!GLA) {
#pragma unroll
                for (int ks = 0; ks < 2; ++ks) { const f32x4 u0 = *(const LASQ f32x4*)(sc + 128 + 32 * ks + 8 * g), u1 = *(const LASQ f32x4*)(sc + 128 + 32 * ks + 8 * g + 4);
                    const float uu[8] = {u0.x, u0.y, u0.z, u0.w, u1.x, u1.y, u1.z, u1.w}; u32x4 pk;
                    pk.x = pk2(bf2f((bf16_t)ka[ks][0]) * uu[0], bf2f((bf16_t)ka[ks][1]) * uu[1]); pk.y = pk2(bf2f((bf16_t)ka[ks][2]) * uu[2], bf2f((bf16_t)ka[ks][3]) * uu[3]);
                    pk.z = pk2(bf2f((bf16_t)ka[ks][4]) * uu[4], bf2f((bf16_t)ka[ks][5]) * uu[5]); pk.w = pk2(bf2f((bf16_t)ka[ks][6]) * uu[6], bf2f((bf16_t)ka[ks][7]) * uu[7]);
                    ka[ks] = __builtin_bit_cast(bf16x8, pk); }
#pragma unroll
                for (int t = 0; t < 4; ++t) S[t] = S[t] * dcur;
            }
#pragma unroll
            for (int t = 0; t < 4; ++t)
#pragma unroll
                for (int ks = 0; ks < 2; ++ks) { const bf16x8 vb = lds_tr_frag(L, ib + VS_O, 144, 32 * ks, 16 * t, g, q, p); S[t] = __builtin_amdgcn_mfma_f32_16x16x32_bf16(ka[ks], vb, S[t], 0, 0, 0); }
            if (GLA) { const f32x4 d = *(const LASQ f32x4*)(sc + 16 * w + 4 * g);
#pragma unroll
                for (int t = 0; t < 4; ++t) S[t] = S[t] * d; }
            if (n + 1 >= 4 && n + 1 < 68) {
                const int so = ST_OFF + ((n + 1) & 1) * STB;
#pragma unroll
                for (int t = 0; t < 4; ++t) { u32x2 o; o.x = pk2(S[t].x, S[t].y); o.y = pk2(S[t].z, S[t].w); *(LASQ u32x2*)(L + so + (16 * t + c) * 272 + (16 * w + 4 * g) * 2) = o; }
            }
        }
        dcur = dnext;
        __syncthreads();
        if (lat) {
            const int tdv = w >> 1, ti0 = 2 * (w & 1), so = ST_OFF + (n & 1) * STB;
            bf16x8 va[2], sa[4];
#pragma unroll
            for (int ks = 0; ks < 2; ++ks) va[ks] = lds_tr_frag(L, ib + VS_O, 144, 32 * ks, 16 * tdv, g, q, p);
#pragma unroll
            for (int ks = 0; ks < 4; ++ks) sa[ks] = lds_row_frag(L, so, 272, 16 * tdv, 64 * ks, c, g);
            const size_t lrow0 = (size_t)(rc * 64 - T_CTX);
#pragma unroll
            for (int t2 = 0; t2 < 2; ++t2) { const int ti = ti0 + t2; f32x4 a1 = (f32x4){0.f, 0.f, 0.f, 0.f}, a2 = (f32x4){0.f, 0.f, 0.f, 0.f};
#pragma unroll
                for (int ks = 0; ks < 2; ++ks) { const bf16x8 pb = lds_row_frag(L, PS_OFF, 144, 16 * ti, 64 * ks, c, g); a1 = __builtin_amdgcn_mfma_f32_16x16x32_bf16(va[ks], pb, a1, 0, 0, 0); }
#pragma unroll
                for (int ks = 0; ks < 4; ++ks) { const bf16x8 qb = lds_row_frag(L, ib, 272, 16 * ti, 64 * ks, c, g); a2 = __builtin_amdgcn_mfma_f32_16x16x32_bf16(sa[ks], qb, a2, 0, 0, 0); }
                const int i = 16 * ti + c; f32x4 o4;
                if (GLA) o4 = a1 + a2; else o4 = a1 + a2 * __builtin_amdgcn_exp2f(sc[i]);
                u32x2 o; o.x = pk2(o4.x, o4.y); o.y = pk2(o4.z, o4.w);
                *(u32x2*)(Og + (lrow0 + i) * ldo + 16 * tdv + 4 * g) = o; }
        }
        __syncthreads();
    }
}
__device__ __forceinline__ void phase4(Ctx& C) {
    for (int uid = C.bid; uid < 256; uid += C.G) { if (uid < 128) scan_unit<true>(C, uid); else scan_unit<false>(C, uid - 128); }
}

__device__ __forceinline__ void phase5(Ctx& C) {
    const int gw = C.bid * 8 + C.wave, NGW = C.G * 8;
    const bf16_t* OF = (const bf16_t*)C.out; const bf16_t* OB = (const bf16_t*)(C.ws + WS_OB); const bf16_t* YB = (const bf16_t*)(C.ws + WS_YB);
    const bf16_t* RZ = (const bf16_t*)(C.ws + WS_RZ); const bf16_t* XC = (const bf16_t*)(C.ws + WS_XC); bf16_t* YX = (bf16_t*)(C.ws + WS_YX);
    const float* ssdd = C.in[I_SSDD]; const float* ssdn = C.in[I_SSDN]; const f32x4 gn = *(const f32x4*)(C.in[I_GNORM] + C.lane * 4);
    const int ln = C.lane;
    float nw[2][8], dsk[2];
#pragma unroll
    for (int g = 0; g < 2; ++g) { const int c0 = g * 512 + ln * 8; dsk[g] = ssdd[c0 >> 6];
        const f32x4 a = *(const f32x4*)(ssdn + c0), bq = *(const f32x4*)(ssdn + c0 + 4);
        nw[g][0] = a.x; nw[g][1] = a.y; nw[g][2] = a.z; nw[g][3] = a.w; nw[g][4] = bq.x; nw[g][5] = bq.y; nw[g][6] = bq.z; nw[g][7] = bq.w; }
    constexpr int NR = 2;
    for (int l0 = gw; l0 < T_LAT; l0 += NGW * NR) {
        u16x4 ga[NR][4], gb[NR][4], gr[NR][4]; u16x8 sa[NR][2], sb[NR][2], sz[NR][2], sx[NR][2];
#pragma unroll
        for (int u = 0; u < NR; ++u) { const int l = l0 + u * NGW; if (l < T_LAT) {
#pragma unroll
            for (int h = 0; h < 4; ++h) { const int c0 = h * 256 + ln * 4;
                ga[u][h] = *(const u16x4*)(OF + (size_t)l * 2048 + c0); gb[u][h] = *(const u16x4*)(OB + (size_t)l * 1024 + c0); gr[u][h] = *(const u16x4*)(RZ + (size_t)l * 2048 + c0); }
#pragma unroll
            for (int g = 0; g < 2; ++g) { const int c0 = g * 512 + ln * 8;
                sa[u][g] = *(const u16x8*)(OF + (size_t)l * 2048 + 1024 + c0); sb[u][g] = *(const u16x8*)(YB + (size_t)l * 1024 + c0);
                sz[u][g] = *(const u16x8*)(RZ + (size_t)l * 2048 + 1024 + c0); sx[u][g] = *(const u16x8*)(XC + (size_t)(l + T_CTX) * 1536 + c0); } } }
        float o[NR][4][4], y[NR][2][8], ss[NR][6];
#pragma unroll
        for (int u = 0; u < NR; ++u) {
#pragma unroll
            for (int h = 0; h < 4; ++h) { float a = 0.f;
#pragma unroll
                for (int j = 0; j < 4; ++j) { o[u][h][j] = bf2f(ga[u][h][j]) + bf2f(gb[u][h][j]); a += o[u][h][j] * o[u][h][j]; }
                ss[u][h] = a; }
#pragma unroll
            for (int g = 0; g < 2; ++g) { float a = 0.f;
#pragma unroll
                for (int j = 0; j < 8; ++j) { y[u][g][j] = (bf2f(sa[u][g][j]) + bf2f(sb[u][g][j]) + bf2f(sx[u][g][j]) * dsk[g]) * bf2f(sz[u][g][j]); a += y[u][g][j] * y[u][g][j]; }
                ss[u][4 + g] = a; } }
#pragma unroll
        for (int of = 1; of < 64; of <<= 1) {
#pragma unroll
            for (int u = 0; u < NR; ++u)
#pragma unroll
                for (int k = 0; k < 6; ++k) ss[u][k] += __shfl_xor(ss[u][k], of); }
#pragma unroll
        for (int u = 0; u < NR; ++u) { const int l = l0 + u * NGW; if (l < T_LAT) {
#pragma unroll
            for (int h = 0; h < 4; ++h) { const int c0 = h * 256 + ln * 4; const float rs = rsqrtf(ss[u][h] * (1.f / 256.f) + EPS);
                u32x2 w; w.x = pk2(o[u][h][0] * rs * gn.x * bf2f(gr[u][h][0]), o[u][h][1] * rs * gn.y * bf2f(gr[u][h][1])); w.y = pk2(o[u][h][2] * rs * gn.z * bf2f(gr[u][h][2]), o[u][h][3] * rs * gn.w * bf2f(gr[u][h][3]));
                *(u32x2*)(YX + (size_t)l * 2048 + c0) = w; }
#pragma unroll
            for (int g = 0; g < 2; ++g) { const int c0 = g * 512 + ln * 8; const float rs = rsqrtf(ss[u][4 + g] * (1.f / 512.f) + EPS);
                u32x4 w; w.x = pk2(y[u][g][0] * rs * nw[g][0], y[u][g][1] * rs * nw[g][1]); w.y = pk2(y[u][g][2] * rs * nw[g][2], y[u][g][3] * rs * nw[g][3]);
                w.z = pk2(y[u][g][4] * rs * nw[g][4], y[u][g][5] * rs * nw[g][5]); w.w = pk2(y[u][g][6] * rs * nw[g][6], y[u][g][7] * rs * nw[g][7]);
                *(u32x4*)(YX + (size_t)l * 2048 + 1024 + c0) = w; } } }
    }
}

__device__ __forceinline__ void phase6(Ctx& C) {
    {
        float* scr = (float*)C.lds + 8192 + C.wave * (64 * 33);
        const int gw = C.bid * 8 + C.wave, NGW = C.G * 8;
        bf16_t* WdT = (bf16_t*)(C.ws + WS_WDT);
        for (int it = gw; it < 32 * 768; it += NGW) {
            const int e = it / 768, r = it % 768;
            if (r < 512) { const int up = r >> 8, q = r & 255, kb = q >> 4, nb = q & 15;
                const float* src = C.in[up ? I_EWU : I_EWG] + (size_t)e * 1024 * 512 + (size_t)(kb * 64) * 512 + nb * 32;
                bf16_t* dst = wgu_ptr(C.ws, e) + (size_t)(256 * (nb >> 2) + (nb & 3) * 32 + up * 128) * 1024 + kb * 64;
                transpose_tile(src, 512, dst, 1024, scr, C.lane, false); }
            else { const int q = r - 512, kb = q >> 5, nb = q & 31;
                transpose_tile(C.in[I_EWD] + (size_t)e * 512 * 1024 + (size_t)(kb * 64) * 1024 + nb * 32, 1024, WdT + (size_t)e * 1024 * 512 + (size_t)(nb * 32) * 512 + kb * 64, 512, scr, C.lane, false); }
        }
    }
    __syncthreads();
    const bf16_t* YX = (const bf16_t*)(C.ws + WS_YX); const bf16_t* WoutT = (const bf16_t*)(C.ws + WS_WOUTT);
    const float* MOD = (const float*)(C.ws + WS_MOD); const float* X = C.in[I_X]; float* HL = C.out;
    auto bsel = [=](int, int tn, int& ldb) { ldb = 2048; return WoutT + (size_t)tn * 128 * 2048; };
    auto epi = [=](int row, int tn, int cc, float v, float) { const int col = tn * 128 + cc, b = row >> 12;
        HL[(size_t)row * 1024 + col] = X[(size_t)row * 1024 + col] + MOD[b * 6144 + 2048 + col] * v; };
#if PG8_MASK & 2
    (void)bsel; (void)epi;
    SchedOut S{(const char*)YX, (const char*)WoutT, C.G, C.bid}; EpiOut E{X, MOD, HL};
    pg8::gemm_phase<EpiOut, SchedOut, false, true>((lds_ptr_t)C.lds, 2048, S, E);
#else
    gemm_simple<false>(C, YX, 2048, T_LAT / 128, 1024 / 128, 2048, bsel, epi);
#endif
}

__device__ __forceinline__ void phase7(Ctx& C) {
    lds_ptr_t L = (lds_ptr_t)C.lds;
    constexpr int TS = 260, WSD = 48;
    constexpr int T_O = 0, W_O = 64 * TS * 4, LG_O = W_O + 256 * WSD * 4, CNT_O = LG_O + 2 * 64 * 48 * 4;
    LASQ float* Ts = (LASQ float*)(L + T_O); LASQ float* Wsm = (LASQ float*)(L + W_O); LASQ float* LG = (LASQ float*)(L + LG_O); LASQ unsigned* lcnt = (LASQ unsigned*)(L + CNT_O);
    const float* MOD = (const float*)(C.ws + WS_MOD); const float* HL = C.out; bf16_t* XN2 = (bf16_t*)(C.ws + WS_XN2);
    int* PE = (int*)(C.ws + WS_PAIR); int* PP = PE + 32768; float* PW = (float*)(PP + 32768);
    const float* wg = C.in[I_RGW]; const float* we = C.in[I_REW]; const float* nffn = C.in[I_NFFN]; const float* rgb = C.in[I_RGB]; const float* reb = C.in[I_REB];
    const int tid = C.tid, w = C.wave, ln = C.lane;
    for (int grp = C.bid; grp < T_LAT / 64; grp += C.G) {
        const int lbase = grp * 64, b = lbase >> 12;
        __syncthreads();
        if (tid < 32) lcnt[tid] = 0u;
        for (int i = tid; i < 256 * 12; i += NTHREADS) Wsm[(i / 12) * WSD + 36 + (i % 12)] = 0.f;
        f32x4 t[8][4];
        {
            float ss[8];
#pragma unroll
            for (int r = 0; r < 8; ++r) { const int l = lbase + w * 8 + r; ss[r] = 0.f;
#pragma unroll
                for (int j = 0; j < 4; ++j) { t[r][j] = *(const f32x4*)(HL + (size_t)l * DM + j * 256 + ln * 4); ss[r] += t[r][j].x * t[r][j].x + t[r][j].y * t[r][j].y + t[r][j].z * t[r][j].z + t[r][j].w * t[r][j].w; } }
#pragma unroll
            for (int o = 1; o < 64; o <<= 1) {
#pragma unroll
                for (int r = 0; r < 8; ++r) ss[r] += __shfl_xor(ss[r], o); }
#pragma unroll
            for (int r = 0; r < 8; ++r) ss[r] = rsqrtf(ss[r] * (1.f / DM) + EPS);
#pragma unroll
            for (int j = 0; j < 4; ++j) { const int c0 = j * 256 + ln * 4;
                const f32x4 gq = *(const f32x4*)(nffn + c0), sh = *(const f32x4*)(MOD + b * 6144 + 3072 + c0); f32x4 scl = *(const f32x4*)(MOD + b * 6144 + 4096 + c0);
                scl = gq * (1.f + scl);
#pragma unroll
                for (int r = 0; r < 8; ++r) { const int l = lbase + w * 8 + r; t[r][j] = t[r][j] * ss[r] * scl + sh;
                    u32x2 o; o.x = pk2(t[r][j].x, t[r][j].y); o.y = pk2(t[r][j].z, t[r][j].w); *(u32x2*)(XN2 + (size_t)l * DM + c0) = o; }
                asm volatile("" ::: "memory"); }
        }
        const int rt = w & 3, kh = w >> 2, ar = ln & 15, kq = ln >> 4;
        f32x4 acc[3];
#pragma unroll
        for (int ct = 0; ct < 3; ++ct) acc[ct] = (f32x4){0.f, 0.f, 0.f, 0.f};
#pragma unroll
        for (int j = 0; j < 4; ++j) {
            __syncthreads();
#pragma unroll
            for (int r = 0; r < 8; ++r) *(LASQ f32x4*)(Ts + (w * 8 + r) * TS + ln * 4) = t[r][j];
            { const int k = tid >> 1, hf = tid & 1; const float* src = we + (size_t)(j * 256 + k) * 32 + hf * 16;
#pragma unroll
                for (int i4 = 0; i4 < 4; ++i4) *(LASQ f32x4*)(Wsm + k * WSD + hf * 16 + i4 * 4) = *(const f32x4*)(src + i4 * 4);
                if (hf == 0) *(LASQ f32x4*)(Wsm + k * WSD + 32) = *(const f32x4*)(wg + (size_t)(j * 256 + k) * 4); }
            __syncthreads();
#pragma unroll 8
            for (int ks = 0; ks < 32; ++ks) { const int k0 = kh * 128 + ks * 4;
                const float av = Ts[(rt * 16 + ar) * TS + k0 + kq];
#pragma unroll
                for (int ct = 0; ct < 3; ++ct) { const float bv = Wsm[(k0 + kq) * WSD + ct * 16 + ar]; acc[ct] = __builtin_amdgcn_mfma_f32_16x16x4f32(av, bv, acc[ct], 0, 0, 0); } }
        }
#pragma unroll
        for (int ct = 0; ct < 3; ++ct)
#pragma unroll
            for (int r = 0; r < 4; ++r) LG[(kh * 64 + rt * 16 + kq * 4 + r) * 48 + ct * 16 + ar] = acc[ct][r];
        __syncthreads();
        if (tid < 64) {
            const int l = lbase + tid; const LASQ float* g0 = LG + tid * 48; const LASQ float* g1 = LG + (64 + tid) * 48;
            float gl[4]; int gs = 0; float gm = -3.4e38f;
#pragma unroll
            for (int o = 0; o < 4; ++o) { gl[o] = g0[32 + o] + g1[32 + o] + rgb[o]; if (gl[o] > gm) { gm = gl[o]; gs = o; } }
            float den = 0.f;
#pragma unroll
            for (int o = 0; o < 4; ++o) den += __expf(gl[o] - gm);
            const float pg = 1.f / den;
            int i1 = 0, i2 = 0; float v1 = -3.4e38f, v2 = -3.4e38f;
#pragma unroll
            for (int o = 0; o < 8; ++o) { const float e = g0[gs * 8 + o] + g1[gs * 8 + o] + reb[gs * 8 + o];
                if (e > v1) { v2 = v1; i2 = i1; v1 = e; i1 = o; } else if (e > v2) { v2 = e; i2 = o; } }
            const float e2 = __expf(v2 - v1), w1 = pg / (1.f + e2), w2 = pg * e2 / (1.f + e2);
            const int ex1 = gs * 8 + i1, ex2 = gs * 8 + i2;
            const unsigned p1 = atomicAdd((unsigned*)(lcnt + ex1), 1u), p2 = atomicAdd((unsigned*)(lcnt + ex2), 1u);
            PE[l * 2] = ex1; PE[l * 2 + 1] = ex2; PP[l * 2] = (int)p1; PP[l * 2 + 1] = (int)p2; PW[l * 2] = w1; PW[l * 2 + 1] = w2;
        }
        __syncthreads();
        if (tid < 32) ((unsigned*)(C.ws + WS_CTL) + CW_BLK)[grp * 32 + tid] = lcnt[tid];
    }
}

__device__ __forceinline__ void moe_offsets(Ctx& C, int* off, int* tmp, int* blkbase) {
    const unsigned* BLK = (const unsigned*)(C.ws + WS_CTL) + CW_BLK;
    const int e = C.tid & 31, ch = C.tid >> 5;
    const int per = 16; int sacc = 0;
    for (int i = 0; i < per; ++i) { const int b = ch * per + i; { const int v = (int)BLK[b * 32 + e]; if (blkbase) blkbase[b * 32 + e] = sacc; sacc += v; } }
    tmp[ch * 32 + e] = sacc;
    __syncthreads();
    if (C.tid < 32) { int run = 0; for (int c2 = 0; c2 < 16; ++c2) { const int v = tmp[c2 * 32 + C.tid]; tmp[c2 * 32 + C.tid] = run; run += v; } off[64 + C.tid] = run; }
    __syncthreads();
    if (C.tid == 0) { int o = 0; for (int x = 0; x < 32; ++x) { const int t = off[64 + x]; off[x] = o; o += (t + 255) & ~255; } off[32] = o; }
    if (blkbase) { const int add = tmp[ch * 32 + e]; for (int i = 0; i < per; ++i) { const int b = ch * per + i; blkbase[b * 32 + e] += add; } }
    __syncthreads();
}

__device__ __forceinline__ void moe_tile_table(Ctx& C, const int* off, int* tile_e) {
    const int NT = off[32] >> 8;
    for (int t = C.tid; t < NT; t += NTHREADS) { int e = 0; for (int i = 1; i < 32; ++i) if (off[i] <= t * 256) e = i; tile_e[t] = e; }
    __syncthreads();
}
__device__ __forceinline__ void phase8(Ctx& C) {
    int* off = (int*)C.lds; int* blkbase = off + 1024; moe_offsets(C, off, off + 256, blkbase);
    const int gw = C.bid * 8 + C.wave, NGW = C.G * 8;
    const int* PE = (const int*)(C.ws + WS_PAIR); const int* PP = PE + 32768; const float* PW = (const float*)(PP + 32768); int* SL = (int*)(PW + 32768); float* SW = (float*)(SL + 32768);
    const bf16_t* XN2 = (const bf16_t*)(C.ws + WS_XN2); bf16_t* XS = (bf16_t*)(C.ws + WS_XN2S);
    constexpr int NP = 8;
    for (int p0 = gw; p0 < 32768; p0 += NGW * NP) {
        u32x4 a[NP], bq[NP]; int slot[NP];
#pragma unroll
        for (int u = 0; u < NP; ++u) { const int p = p0 + u * NGW; slot[u] = 0;
            if (p < 32768) { const u32x4* sp = (const u32x4*)(XN2 + (size_t)(p >> 1) * DM); a[u] = sp[C.lane]; bq[u] = sp[C.lane + 64]; { const int ex = PE[p]; const int blk = p >> 7; slot[u] = off[ex] + blkbase[blk * 32 + ex] + PP[p]; } } }
#pragma unroll
        for (int u = 0; u < NP; ++u) { const int p = p0 + u * NGW;
            if (p < 32768) { if (C.lane == 0) { SL[p] = slot[u]; SW[slot[u]] = PW[p]; }
                u32x4* d = (u32x4*)(XS + (size_t)slot[u] * DM); d[C.lane] = a[u]; d[C.lane + 64] = bq[u]; } }
    }
}

__device__ __forceinline__ void phase9(Ctx& C) {
    int* off = (int*)(C.lds + CTRL_OFF + 1024); moe_offsets(C, off, (int*)C.lds, nullptr);
    const bf16_t* XS = (const bf16_t*)(C.ws + WS_XN2S); bf16_t* H = (bf16_t*)(C.ws + WS_H); unsigned char* ws = C.ws;
    auto bsel = [=](int tm, int tn, int& ldb) { int e = 0; const int r0 = tm * 128;
        for (int i = 1; i < 32; ++i) if (off[i] <= r0) e = i;
        ldb = 1024; return (const bf16_t*)wgu_ptr(ws, e) + (size_t)tn * 256 * 1024; };
    auto epi = [=](int row, int tn, int cc, float g, float u) { H[(size_t)row * 512 + tn * 128 + cc] = (bf16_t)f2bf(siluf(g) * u); };
#if PG8_MASK & 4
    (void)bsel; (void)epi;
    int* tile_e = off + 128; moe_tile_table(C, off, tile_e);
    SchedMoe S{(const char*)XS, C.ws, tile_e, off[32] >> 8, C.G, C.bid, 1024, 0}; EpiUp E{H};
    pg8::gemm_phase<EpiUp, SchedMoe, true, true>((lds_ptr_t)C.lds, 1024, S, E);
#else
    gemm_simple<true>(C, XS, 1024, off[32] / 128, 4, 1024, bsel, epi);
#endif
}

__device__ __forceinline__ void phase10(Ctx& C) {
    int* off = (int*)(C.lds + CTRL_OFF + 1024); moe_offsets(C, off, (int*)C.lds, nullptr);
    const bf16_t* H = (const bf16_t*)(C.ws + WS_H); bf16_t* Y = (bf16_t*)(C.ws + WS_Y); const bf16_t* WdT = (const bf16_t*)(C.ws + WS_WDT);
    const float* SW = (const float*)(C.ws + WS_PAIR) + 4 * 32768;
    auto bsel = [=](int tm, int tn, int& ldb) { int e = 0; const int r0 = tm * 128;
        for (int i = 1; i < 32; ++i) if (off[i] <= r0) e = i;
        ldb = 512; return WdT + (size_t)e * 1024 * 512 + (size_t)tn * 128 * 512; };
    auto epi = [=](int row, int tn, int cc, float v, float) { Y[(size_t)row * 1024 + tn * 128 + cc] = (bf16_t)f2bf(v * SW[row]); };
#if PG8_MASK & 8
    (void)bsel; (void)epi;
    int* tile_e = off + 128; moe_tile_table(C, off, tile_e);
    SchedMoe S{(const char*)H, C.ws, tile_e, off[32] >> 8, C.G, C.bid, 512, 1}; EpiDown E{Y, SW};
    pg8::gemm_phase<EpiDown, SchedMoe, true, true>((lds_ptr_t)C.lds, 512, S, E);
#else
    gemm_simple<false>(C, H, 512, off[32] / 128, 8, 512, bsel, epi);
#endif
}

__device__ __forceinline__ void phase11(Ctx& C) {
    const int gw = C.bid * 8 + C.wave, NGW = C.G * 8;
    const float* MOD = (const float*)(C.ws + WS_MOD); float* HL = C.out; const bf16_t* Y = (const bf16_t*)(C.ws + WS_Y);
    const int* SL = (const int*)(C.ws + WS_PAIR) + 3 * 32768; const float* fnorm = C.in[I_FNORM];
    constexpr int NR = 2;
    for (int l0 = gw; l0 < T_LAT; l0 += NGW * NR) {
        f32x4 hv[NR][4]; u16x4 ya[NR][4], yb[NR][4]; float ss[NR];
#pragma unroll
        for (int u = 0; u < NR; ++u) { const int l = l0 + u * NGW; ss[u] = 0.f; if (l < T_LAT) { const int s1 = SL[l * 2], s2 = SL[l * 2 + 1];
#pragma unroll
            for (int j = 0; j < 4; ++j) { const int c0 = j * 256 + C.lane * 4; hv[u][j] = *(const f32x4*)(HL + (size_t)l * DM + c0);
                ya[u][j] = *(const u16x4*)(Y + (size_t)s1 * DM + c0); yb[u][j] = *(const u16x4*)(Y + (size_t)s2 * DM + c0); } } }
#pragma unroll
        for (int u = 0; u < NR; ++u) { const int l = l0 + u * NGW; if (l < T_LAT) { const int b = l >> 12;
#pragma unroll
            for (int j = 0; j < 4; ++j) { const int c0 = j * 256 + C.lane * 4; const f32x4 g2 = *(const f32x4*)(MOD + b * 6144 + 5120 + c0);
                f32x4 m; m.x = bf2f(ya[u][j][0]) + bf2f(yb[u][j][0]); m.y = bf2f(ya[u][j][1]) + bf2f(yb[u][j][1]); m.z = bf2f(ya[u][j][2]) + bf2f(yb[u][j][2]); m.w = bf2f(ya[u][j][3]) + bf2f(yb[u][j][3]);
                hv[u][j] = hv[u][j] + g2 * m; ss[u] += hv[u][j].x * hv[u][j].x + hv[u][j].y * hv[u][j].y + hv[u][j].z * hv[u][j].z + hv[u][j].w * hv[u][j].w; } } }
#pragma unroll
        for (int o = 1; o < 64; o <<= 1) {
#pragma unroll
            for (int u = 0; u < NR; ++u) ss[u] += __shfl_xor(ss[u], o); }
#pragma unroll
        for (int u = 0; u < NR; ++u) { const int l = l0 + u * NGW; if (l < T_LAT) { const float rs = rsqrtf(ss[u] * (1.f / DM) + EPS);
#pragma unroll
            for (int j = 0; j < 4; ++j) { const int c0 = j * 256 + C.lane * 4; const f32x4 fn = *(const f32x4*)(fnorm + c0);
                *(f32x4*)(HL + (size_t)l * DM + c0) = hv[u][j] * rs * fn; } } }
    }
}

#define LAS __attribute__((address_space(3)))
#define XB_TMO      128
#define XB_XCNT(j)  (256  + 64 * (j))
#define XB_XSUB(j)  (1280 + 64 * (j))
#define XB_XGEN(j)  (2304 + 64 * (j))
#define XB_TOP      3328
#define XB_TOPGEN   3392
#define XCD_BAR_WORDS 3456
#define XB_SPIN_CAP (1u << 18)

__device__ __forceinline__ unsigned xb_ld(unsigned* p)              { return __hip_atomic_load(p, __ATOMIC_RELAXED, __HIP_MEMORY_SCOPE_AGENT); }
__device__ __forceinline__ unsigned xb_add(unsigned* p, unsigned v) { return __hip_atomic_fetch_add(p, v, __ATOMIC_RELAXED, __HIP_MEMORY_SCOPE_AGENT); }
__device__ __forceinline__ unsigned xb_xcc_id() { return (unsigned)__builtin_amdgcn_s_getreg((3 << 11) | 20) & 0xFu; }
#define XB_SPIN(cond, bar) do { unsigned _sp = 0; while (cond) { __builtin_amdgcn_s_sleep(1); \
    if ((++_sp & 255u) == 0u) { if (xb_ld(&(bar)[XB_TMO])) break; if (_sp > XB_SPIN_CAP) { atomicAdd(&(bar)[XB_TMO], 1u); break; } } } } while (0)

struct XcdBarrier {
    unsigned* bar; unsigned x;
    volatile LAS unsigned* st;
};

__device__ __forceinline__ XcdBarrier xcd_barrier_post(unsigned* bar, volatile LAS unsigned* st) {
    XcdBarrier b; b.bar = bar; b.x = xb_xcc_id(); b.st = st;
    if (threadIdx.x == 0) (void)xb_add(&bar[XB_XCNT(b.x)], 1u);
    return b;
}
__device__ __forceinline__ void xcd_barrier_complete(unsigned* bar, unsigned x, unsigned& nloc, unsigned& nx) {
    const unsigned G = gridDim.x * gridDim.y * gridDim.z;
    unsigned sum, cnt, mine, sp = 0u;
    for (;;) {
        sum = 0u; cnt = 0u; mine = 0u;
#pragma unroll
        for (unsigned j = 0; j < 16; ++j) { const unsigned c = xb_ld(&bar[XB_XCNT(j)]); sum += c; cnt += (c > 0u) ? 1u : 0u; mine = (j == x) ? c : mine; }
        if (sum == G) break;
        __builtin_amdgcn_s_sleep(1);
        if ((++sp & 255u) == 0u) { if (xb_ld(&bar[XB_TMO])) break; if (sp > XB_SPIN_CAP) { atomicAdd(&bar[XB_TMO], 1u); break; } }
    }
    nloc = mine > 0u ? mine : 1u; nx = cnt > 0u ? cnt : 1u;
}

__device__ __forceinline__ void xcd_barrier(const XcdBarrier& b) {
    asm volatile("s_waitcnt vmcnt(0)" ::: "memory");
    __syncthreads();
    if (threadIdx.x == 0) {
        unsigned* bar = b.bar;
        __builtin_amdgcn_s_waitcnt(0);
        unsigned nloc = b.st[0], nx = b.st[1];
        if (nloc == 0u) { xcd_barrier_complete(bar, b.x, nloc, nx); b.st[0] = nloc; b.st[1] = nx; }
        const unsigned old = xb_add(&bar[XB_XSUB(b.x)], 1u);
        const unsigned gen = old / nloc;
        if (old + 1u == (gen + 1u) * nloc) {
            __builtin_amdgcn_fence(__ATOMIC_RELEASE, "agent");
            asm volatile("s_waitcnt vmcnt(0)" ::: "memory");
            const unsigned og = xb_add(&bar[XB_TOP], 1u);
            const unsigned tg = og / nx;
            if (og + 1u == (tg + 1u) * nx) xb_add(&bar[XB_TOPGEN], 1u);
            else XB_SPIN(xb_ld(&bar[XB_TOPGEN]) == tg, bar);
            __builtin_amdgcn_fence(__ATOMIC_ACQUIRE, "agent");
            xb_add(&bar[XB_XGEN(b.x)], 1u);
            asm volatile("s_waitcnt vmcnt(0)" ::: "memory");
        } else {
            XB_SPIN(xb_ld(&bar[XB_XGEN(b.x)]) == gen, bar);
            __builtin_amdgcn_fence(__ATOMIC_ACQUIRE, "agent");
            asm volatile("s_waitcnt vmcnt(0)" ::: "memory");
        }
    }
    __syncthreads();
}

__global__ void __launch_bounds__(NTHREADS, 2) fwd_kernel(Args a) {
    extern __shared__ __attribute__((aligned(16))) unsigned char lds[];
    Ctx C;
    if (threadIdx.x == 0) {
#pragma unroll
        for (int i = 0; i < 27; ++i) *(__attribute__((address_space(3))) unsigned long long*)((__attribute__((address_space(3))) unsigned char*)lds + PTAB_OFF + 8 * i) = (unsigned long long)a.in[i];
    }
    C.in.lds = lds; C.out = a.out; C.ws = a.ws; C.lds = lds;
    __syncthreads();
    C.tid = threadIdx.x; C.lane = C.tid & 63; C.wave = __builtin_amdgcn_readfirstlane(C.tid >> 6); C.bid = blockIdx.x; C.G = gridDim.x;
#if MK_COOP
    cg::grid_group grid = cg::this_grid();
    if (C.tid < 2) ((LAS unsigned*)(lds + CTRL_OFF + 64))[C.tid] = 0u;
    __syncthreads();
    XcdBarrier xbar = xcd_barrier_post((unsigned*)(C.ws + WS_CTL) + CW_BAR, (volatile LAS unsigned*)(lds + CTRL_OFF + 64));
#ifndef CG_SEAM0
#define CG_SEAM0 0
#endif
#define SEAM(k) do { if ((k) + 1 < a.ph_hi) { if (CG_SEAM0 && (k) == 0) grid.sync(); else xcd_barrier(xbar); } } while (0)
#else
#define SEAM(k) do { } while (0)
#endif
#define IN(k) (a.ph_lo <= (k) && (k) < a.ph_hi)
#ifndef PROBE_K
#define PROBE_K -1
#endif
    unsigned long long tprev = 0ull; float pdur = 0.f;
    if (PROBE_K >= 0 && blockIdx.x == 0 && threadIdx.x == 0) tprev = __builtin_amdgcn_s_memrealtime();
#define STAMP(k) do { if (PROBE_K >= 0 && blockIdx.x == 0 && threadIdx.x == 0) { const unsigned long long tn = __builtin_amdgcn_s_memrealtime(); if ((k) == PROBE_K) pdur = (float)(tn - tprev) * 0.01f; tprev = tn; } } while (0)
    if (IN(0)) { phase0(C); SEAM(0); STAMP(0); }
    if (IN(1)) { phase1(C); SEAM(1); STAMP(1); }
    if (IN(2)) { phase2(C); SEAM(2); STAMP(2); }
    if (IN(3)) { phase3(C, 1); STAMP(30); phase3(C, 2); STAMP(31); phase3(C, 4); SEAM(3); STAMP(3); }
#ifdef SCAN_NAIVE
    if (IN(4)) { phase4_naive(C); SEAM(4); STAMP(4); }
#else
    if (IN(4)) { phase4(C); SEAM(4); STAMP(4); }
#endif
    if (IN(5)) { phase5(C); SEAM(5); STAMP(5); }
    if (IN(6)) { phase6(C); SEAM(6); STAMP(6); }
    if (IN(7)) { phase7(C); SEAM(7); STAMP(7); }
    if (IN(8)) { phase8(C); SEAM(8); STAMP(8); }
    if (IN(9)) { phase9(C); SEAM(9); STAMP(9); }
    if (IN(10)) { phase10(C); SEAM(10); STAMP(10); }
    if (IN(11)) { phase11(C); STAMP(11); }
    if (PROBE_K >= 0 && blockIdx.x == 0 && threadIdx.x == 0) { asm volatile("s_waitcnt vmcnt(0)" ::: "memory"); a.out[0] += sqrtf(16.78f * pdur); }
}

extern "C" void kernel_launch(void* const* d_in, const int* in_sizes, int n_in, void* d_out, int out_size, void* d_ws, size_t ws_size, hipStream_t stream) {
    static int grid = 0;
    if (grid == 0) {
        if (n_in != 27 || out_size != T_LAT * DM || ws_size < WS_END) { fprintf(stderr, "kernel_launch: unexpected shapes: n_in %d out %d ws %zu (need %zu)\n", n_in, out_size, ws_size, (size_t)WS_END); grid = -1; return; }
        int dev = 0, cus = 0, per_cu = 0;
        hipGetDevice(&dev); hipDeviceGetAttribute(&cus, hipDeviceAttributeMultiprocessorCount, dev);
        hipFuncSetAttribute((const void*)fwd_kernel, hipFuncAttributeMaxDynamicSharedMemorySize, LDS_BYTES);
        hipOccupancyMaxActiveBlocksPerMultiprocessor(&per_cu, (const void*)fwd_kernel, NTHREADS, LDS_BYTES);
        if (per_cu < 1) { fprintf(stderr, "kernel_launch: occupancy query says %d blocks per CU\n", per_cu); per_cu = 1; }
        (void)hipGetLastError();
        grid = cus;
        fprintf(stderr, "kernel_launch: grid %d, per_cu %d, ws %zu\n", grid, per_cu, ws_size);
    }
    if (grid < 0) return;
    hipMemsetAsync((char*)d_ws + WS_CTL, 0, CTL_BYTES, stream);
    Args a{};
    for (int i = 0; i < 27; ++i) a.in[i] = (const float*)d_in[i];
    a.out = (float*)d_out; a.ws = (unsigned char*)d_ws;
#if MK_COOP
    a.ph_lo = 0; a.ph_hi = NPH;
    void* args[] = {&a};
    hipError_t e = hipLaunchCooperativeKernel((const void*)fwd_kernel, dim3(grid), dim3(NTHREADS), args, LDS_BYTES, stream);
    if (e != hipSuccess) fprintf(stderr, "cooperative launch failed: %s (grid %d)\n", hipGetErrorString(e), grid);
#else
    for (int p = 0; p < NPH; ++p) { a.ph_lo = p; a.ph_hi = p + 1; hipLaunchKernelGGL(fwd_kernel, dim3(grid), dim3(NTHREADS), LDS_BYTES, stream, a); }
#endif
}
```

```cpp
#include <hip/hip_runtime.h>
#include <hip/hip_cooperative_groups.h>
#include <cstdio>
#include <cstdint>
namespace cg = cooperative_groups;

#ifndef MK_COOP
#define MK_COOP 1
#endif

constexpr int NB = 4, SEQ = 4096, DM = 1024, CTXL = 256;
constexpr int T_CTX = NB * CTXL, T_LAT = NB * SEQ, T_ALL = T_CTX + T_LAT;
constexpr float EPS = 1e-6f;
constexpr int NW_IN = 5888;
constexpr int NPH = 12;
constexpr int NTHREADS = 512;
constexpr int LDS_BYTES = 147456;

typedef unsigned short bf16_t;
typedef float f32x4 __attribute__((ext_vector_type(4)));
typedef unsigned u32x4 __attribute__((ext_vector_type(4)));
typedef unsigned u32x2 __attribute__((ext_vector_type(2)));
typedef unsigned short u16x8 __attribute__((ext_vector_type(8)));
typedef unsigned short u16x4 __attribute__((ext_vector_type(4)));
#define LASQ __attribute__((address_space(3)))
typedef __attribute__((address_space(3))) unsigned char* lds_ptr_t;

constexpr size_t MiB = 1u << 20;
constexpr size_t WS_QK = 0;
constexpr size_t WS_XBC = 34 * MiB;
constexpr size_t WS_OB = 34 * MiB;
constexpr size_t WS_QKF = 85 * MiB;
constexpr size_t WS_XN = 85 * MiB;
constexpr size_t WS_YX = 85 * MiB;
constexpr size_t WS_V = 119 * MiB;
constexpr size_t WS_XC = 153 * MiB;
constexpr size_t WS_WINT = 153 * MiB;
constexpr size_t WS_RZ = 204 * MiB;
constexpr size_t WS_XN2 = 204 * MiB;
constexpr size_t WS_YB = 268 * MiB;
constexpr size_t WS_GDT = 300 * MiB;
constexpr size_t WS_WOUTT = 305 * MiB;
constexpr size_t WS_MOD = 309 * MiB;
constexpr size_t WS_GLAD = WS_MOD + 256 * 1024;
constexpr size_t WS_CTL = 311 * MiB;
constexpr size_t CTL_BYTES = 64 * 1024;
constexpr size_t WS_PAIR = WS_GLAD + 1088 * 1024;
constexpr size_t WS_ACUM = 311 * MiB + 64 * 1024;
constexpr size_t WS_LIST = WS_ACUM + (size_t)T_ALL * 32 * 4;
constexpr size_t WS_END = WS_LIST + 40960 * 4;
constexpr size_t WS_WDT = 0;
constexpr size_t WS_WGU_LO = 34 * MiB;
constexpr size_t WS_WGU_HI = 268 * MiB;
constexpr size_t WS_H = 66 * MiB;
constexpr size_t WS_XN2S = 106 * MiB;
constexpr size_t WS_Y = 106 * MiB;
constexpr int MAX_SLOTS = 40960;
constexpr size_t WS_GL = 176 * MiB;
constexpr size_t WS_GLW = 178 * MiB;
constexpr int CW_CNT = 0;
constexpr int CW_BLK = 8192;
constexpr int CW_BAR = 1024;

__device__ __forceinline__ float bf2f(bf16_t v) { return __uint_as_float((unsigned)v << 16); }
__device__ __forceinline__ unsigned f2bf(float f) { unsigned u = __float_as_uint(f); return (u + 0x7fffu + ((u >> 16) & 1u)) >> 16; }
typedef float f32x2 __attribute__((ext_vector_type(2)));
typedef __bf16 bf16x2_t __attribute__((ext_vector_type(2)));
__device__ __forceinline__ unsigned pk2(float lo, float hi) { const f32x2 v = {lo, hi}; return __builtin_bit_cast(unsigned, __builtin_convertvector(v, bf16x2_t)); }
__device__ __forceinline__ float siluf(float x) { return x / (1.f + __expf(-x)); }
__device__ __forceinline__ float softplusf(float x) { return fmaxf(x, 0.f) + log1pf(__expf(-fabsf(x))); }
__device__ __forceinline__ float logsigf(float x) { return fminf(x, 0.f) - log1pf(__expf(-fabsf(x))); }
__device__ __forceinline__ float logsig_fast(float x) { return fminf(x, 0.f) - 0.6931471805599453f * __builtin_amdgcn_logf(1.f + __builtin_amdgcn_exp2f(-1.4426950408889634f * fabsf(x))); }
__device__ __forceinline__ float wave_sum(float v) {
#pragma unroll
    for (int o = 1; o < 64; o <<= 1) v += __shfl_xor(v, o);
    return v;
}

struct Args { const float* in[27]; float* out; unsigned char* ws; int ph_lo, ph_hi; };
enum { I_X = 0, I_C, I_CTX, I_CCTX, I_WADA, I_BADA, I_NMIX, I_NFFN, I_WIN, I_GWUP, I_GB, I_GNORM, I_CONVW, I_CONVB, I_DTB, I_ALOG, I_SSDD, I_SSDN,
       I_WOUT, I_RGW, I_RGB, I_REW, I_REB, I_EWG, I_EWU, I_EWD, I_FNORM };

constexpr int CTRL_OFF = LDS_BYTES - 4096;
constexpr int PTAB_OFF = CTRL_OFF + 128;
struct InTab {
    unsigned char* lds;
    __device__ __forceinline__ const float* operator[](int i) const {
        const unsigned long long v = *(const __attribute__((address_space(3))) unsigned long long*)((__attribute__((address_space(3))) unsigned char*)lds + PTAB_OFF + 8 * i);
        const unsigned lo = __builtin_amdgcn_readfirstlane((unsigned)v), hi = __builtin_amdgcn_readfirstlane((unsigned)(v >> 32));
        return (const float*)(const __attribute__((address_space(1))) float*)(((unsigned long long)hi << 32) | lo);
    }
};
struct Ctx {
    InTab in; float* out; unsigned char* ws; unsigned char* lds;
    int tid, lane, wave, bid, G;
};

__device__ __forceinline__ void transpose_tile(const float* src  , int ldw, bf16_t* dst  , int ldt, float* scr, int lane, bool zero) {
#pragma unroll 8
    for (int i = 0; i < 32; ++i) { const int kk = 2 * i + (lane >> 5); scr[kk * 33 + (lane & 31)] = zero ? 0.f : src[(size_t)kk * ldw + (lane & 31)]; }
    asm volatile("s_waitcnt lgkmcnt(0)" ::: "memory");
    const int c = lane & 7;
#pragma unroll
    for (int j = 0; j < 4; ++j) { const int n = (lane >> 3) + 8 * j; const float* s = scr + (8 * c) * 33 + n;
        u32x4 o; o.x = pk2(s[0 * 33], s[1 * 33]); o.y = pk2(s[2 * 33], s[3 * 33]); o.z = pk2(s[4 * 33], s[5 * 33]); o.w = pk2(s[6 * 33], s[7 * 33]);
        *(u32x4*)(dst + (size_t)n * ldt + 8 * c) = o; }
    asm volatile("s_waitcnt lgkmcnt(0)" ::: "memory");
}

__device__ __forceinline__ int win_src_col(int n) {
    if (n < 3072) return n;
    if (n < 4096) return 3104 + (n - 3072);
    if (n < 5632) return 4128 + (n - 4096);
    if (n < 5664) return 3072 + (n - 5632);
    if (n < 5696) return 5664 + (n - 5664);
    return -1;
}

__device__ __forceinline__ void phase0(Ctx& C) {
    float* lds = (float*)C.lds;
    const int gw = C.bid * 8 + C.wave, NGW = C.G * 8;
    {
        float* scr = lds + 8192 + C.wave * (64 * 33);
        bf16_t* WinT = (bf16_t*)(C.ws + WS_WINT); bf16_t* WoutT = (bf16_t*)(C.ws + WS_WOUTT);
        constexpr int IT_IN = 16 * (NW_IN / 32), IT_OUT = 32 * 32;
        for (int it = gw; it < IT_IN + IT_OUT; it += NGW) {
            if (it < IT_IN) { const int kb = it / (NW_IN / 32), nb = it % (NW_IN / 32); const int sc = win_src_col(nb * 32);
                transpose_tile(C.in[I_WIN] + (size_t)(kb * 64) * 5696 + (sc < 0 ? 0 : sc), 5696, WinT + (size_t)(nb * 32) * 1024 + kb * 64, 1024, scr, C.lane, sc < 0); }
            else { const int r = it - IT_IN, kb = r / 32, nb = r % 32;
                transpose_tile(C.in[I_WOUT] + (size_t)(kb * 64) * 1024 + nb * 32, 1024, WoutT + (size_t)(nb * 32) * 2048 + kb * 64, 2048, scr, C.lane, false); }
        }
    }
    __syncthreads();
    for (int i = C.bid * NTHREADS + C.tid; i < MAX_SLOTS; i += C.G * NTHREADS) ((int*)(C.ws + WS_LIST))[i] = 0;
    float* sc = lds;
    float* red = lds + 5120;
    for (int i = C.tid; i < 5 * 1024; i += NTHREADS) { const int r = i >> 10, k = i & 1023; const float v = r < 4 ? C.in[I_C][r * 1024 + k] : C.in[I_CCTX][k]; sc[i] = siluf(v); }
    __syncthreads();
    float* MOD = (float*)(C.ws + WS_MOD); const float* wada = C.in[I_WADA]; const float* bada = C.in[I_BADA];
    for (int grp = C.bid; grp < 192; grp += C.G) {
        const int col = grp * 32 + (C.tid & 31), kg = C.tid >> 5;
        float acc[5] = {0.f, 0.f, 0.f, 0.f, 0.f};
#pragma unroll 8
        for (int kk = 0; kk < 64; ++kk) { const int k = kg + 16 * kk; const float w = wada[(size_t)k * 6144 + col];
#pragma unroll
            for (int i = 0; i < 5; ++i) acc[i] += sc[i * 1024 + k] * w; }
#pragma unroll
        for (int i = 0; i < 5; ++i) red[(kg * 5 + i) * 32 + (C.tid & 31)] = acc[i];
        __syncthreads();
        if (C.tid < 160) { const int i = C.tid >> 5, c = C.tid & 31; float s = 0.f;
            for (int g = 0; g < 16; ++g) s += red[(g * 5 + i) * 32 + c];
            MOD[i * 6144 + grp * 32 + c] = s + bada[grp * 32 + c]; }
        __syncthreads();
    }
}

__device__ __forceinline__ const float* tok_row(const float* xin, const float* cin, int row, int& mi) {
    if (row < T_CTX) { mi = 4; return cin + (size_t)row * DM; }
    mi = (row - T_CTX) >> 12; return xin + (size_t)(row - T_CTX) * DM;
}

__device__ __forceinline__ void phase1(Ctx& C) {
    const int gw = C.bid * 8 + C.wave, NGW = C.G * 8;
    const float* MOD = (const float*)(C.ws + WS_MOD); bf16_t* XN = (bf16_t*)(C.ws + WS_XN);
    const float* xin = C.in[I_X]; const float* cin = C.in[I_CTX]; const float* nmix = C.in[I_NMIX];
    constexpr int NR = 4;
    for (int r0 = gw; r0 < T_ALL; r0 += NGW * NR) {
        f32x4 v[NR][4]; float ss[NR]; int mi[NR];
#pragma unroll
        for (int u = 0; u < NR; ++u) { const int row = r0 + u * NGW; ss[u] = 0.f; mi[u] = 0;
            if (row < T_ALL) { const float* xr = tok_row(xin, cin, row, mi[u]);
#pragma unroll
                for (int j = 0; j < 4; ++j) v[u][j] = *(const f32x4*)(xr + j * 256 + C.lane * 4); } }
#pragma unroll
        for (int u = 0; u < NR; ++u) { const int row = r0 + u * NGW;
            if (row < T_ALL) {
#pragma unroll
                for (int j = 0; j < 4; ++j) ss[u] += v[u][j].x * v[u][j].x + v[u][j].y * v[u][j].y + v[u][j].z * v[u][j].z + v[u][j].w * v[u][j].w; } }
#pragma unroll
        for (int o = 1; o < 64; o <<= 1) {
#pragma unroll
            for (int u = 0; u < NR; ++u) ss[u] += __shfl_xor(ss[u], o); }
#pragma unroll
        for (int u = 0; u < NR; ++u) { const int row = r0 + u * NGW;
            if (row < T_ALL) { const float rs = rsqrtf(ss[u] * (1.f / DM) + EPS);
#pragma unroll
                for (int j = 0; j < 4; ++j) { const int c0 = j * 256 + C.lane * 4;
                    const f32x4 g = *(const f32x4*)(nmix + c0), sh = *(const f32x4*)(MOD + mi[u] * 6144 + c0), scl = *(const f32x4*)(MOD + mi[u] * 6144 + 1024 + c0);
                    const f32x4 y = v[u][j] * rs * g * (1.f + scl) + sh;
                    u32x2 o; o.x = pk2(y.x, y.y); o.y = pk2(y.z, y.w); *(u32x2*)(XN + (size_t)row * DM + c0) = o; } } }
    }
}

template <bool DUAL, class BSel, class Epi>
__device__ __forceinline__ void gemm_simple(Ctx& C, const bf16_t* A, int lda, int Mtiles, int Ntiles, int K, BSel bsel, Epi epi) {
    float* As = (float*)C.lds;
    float* Bs = As + 32 * 132;
    float* Bs2 = Bs + 32 * 132;
    const int ty = C.tid >> 4, tx = C.tid & 15;
    const int lr = C.tid >> 2, lk = (C.tid & 3) * 8;
    for (int tile = C.bid; tile < Mtiles * Ntiles; tile += C.G) {
        const int tm = tile / Ntiles, tn = tile % Ntiles;
        int ldb; const bf16_t* Bt = bsel(tm, tn, ldb);
        float acc[4][8], acc2[DUAL ? 4 : 1][8];
#pragma unroll
        for (int i = 0; i < 4; ++i)
#pragma unroll
            for (int j = 0; j < 8; ++j) { acc[i][j] = 0.f; if constexpr (DUAL) acc2[i][j] = 0.f; }
        const bf16_t* ap = A + (size_t)(tm * 128 + lr) * lda + lk;
        const bf16_t* bp = Bt + (size_t)lr * ldb + lk;
        for (int k0 = 0; k0 < K; k0 += 32) {
            const u16x8 av = *(const u16x8*)(ap + k0), bv = *(const u16x8*)(bp + k0);
            u16x8 bv2 = bv; if constexpr (DUAL) bv2 = *(const u16x8*)(bp + (size_t)128 * ldb + k0);
            __syncthreads();
#pragma unroll
            for (int j = 0; j < 8; ++j) { As[(lk + j) * 132 + lr] = bf2f(av[j]); Bs[(lk + j) * 132 + lr] = bf2f(bv[j]); if constexpr (DUAL) Bs2[(lk + j) * 132 + lr] = bf2f(bv2[j]); }
            __syncthreads();
#pragma unroll 8
            for (int k = 0; k < 32; ++k) {
                const f32x4 a = *(const f32x4*)(As + k * 132 + ty * 4);
                const f32x4 b0 = *(const f32x4*)(Bs + k * 132 + tx * 8), b1 = *(const f32x4*)(Bs + k * 132 + tx * 8 + 4);
                const float af[4] = {a.x, a.y, a.z, a.w}; const float bf[8] = {b0.x, b0.y, b0.z, b0.w, b1.x, b1.y, b1.z, b1.w};
#pragma unroll
                for (int i = 0; i < 4; ++i)
#pragma unroll
                    for (int j = 0; j < 8; ++j) acc[i][j] += af[i] * bf[j];
                if constexpr (DUAL) {
                    const f32x4 c0 = *(const f32x4*)(Bs2 + k * 132 + tx * 8), c1 = *(const f32x4*)(Bs2 + k * 132 + tx * 8 + 4);
                    const float cf[8] = {c0.x, c0.y, c0.z, c0.w, c1.x, c1.y, c1.z, c1.w};
#pragma unroll
                    for (int i = 0; i < 4; ++i)
#pragma unroll
                        for (int j = 0; j < 8; ++j) acc2[i][j] += af[i] * cf[j];
                }
            }
        }
#pragma unroll
        for (int i = 0; i < 4; ++i)
#pragma unroll
            for (int j = 0; j < 8; ++j) { float a2 = 0.f; if constexpr (DUAL) a2 = acc2[i][j]; epi(tm * 128 + ty * 4 + i, tn, tx * 8 + j, acc[i][j], a2); }
        __syncthreads();
    }
}


namespace pg8 {
#define PG8_LAS __attribute__((address_space(3)))
typedef short bf16x8 __attribute__((ext_vector_type(8)));
constexpr int BM = 256, BK = 64, HALF = 128, HTB = HALF * BK * 2  , STAGE_BYTES = 8 * HTB, NXCD = 8, WGM = 8;
__host__ __device__ __forceinline__ int lds_byte(int r, int c) { const int st = (r >> 4) * 2 + (c >> 5), rr = r & 15, cc = c & 31, ob = rr * 64 + cc * 2; return st * 1024 + (ob ^ (((ob >> 9) & 1) << 5)); }
__host__ __device__ __forceinline__ void stage_rc(int b, int& R, int& C) { const int st = b / 1024, sb = b % 1024, swz = sb ^ (((sb >> 9) & 1) << 5); R = (st >> 1) * 16 + swz / 64; C = (st & 1) * 32 + (swz % 64) / 2; }
__host__ __device__ __forceinline__ int perm32(int rho) { const int n = rho >> 4, i = rho & 15; return 8 * (i >> 2) + 4 * n + (i & 3); }
struct Unit { int pm, pn, rd; };
__device__ __forceinline__ unsigned cvt_pk_bf16(float lo, float hi) { unsigned r; asm volatile("v_cvt_pk_bf16_f32 %0, %1, %2" : "=v"(r) : "v"(lo), "v"(hi)); return r; }
__device__ __forceinline__ int xcd_remap(int L, int nwg) { const int q = nwg / NXCD, r = nwg % NXCD, xcd = L % NXCD, off = L / NXCD; return (xcd < r ? xcd * (q + 1) : r * (q + 1) + (xcd - r) * q) + off; }
template <class Epi, class Sched, bool ALIGN_EPI = false, bool SP2 = false>
__device__ __forceinline__ void gemm_phase(PG8_LAS unsigned char* lds, const int K_, const Sched& S, const Epi& E) {
    const int tid = threadIdx.x, wid = __builtin_amdgcn_readfirstlane(tid >> 6), lane = tid & 63, wr = wid >> 2, wc = wid & 3, fr = lane & 15, fq = lane >> 4;
    const int K = K_, nt = K / BK;
    unsigned voffA[2], voffB[2];
#pragma unroll
    for (int i = 0; i < 2; ++i) { int R, C; stage_rc(tid * 16 + i * 8192, R, C); const int Rb = Epi::PERM ? ((R & ~31) + perm32(R & 31)) : R;
        voffA[i] = (unsigned)(R * K + C) * 2u; voffB[i] = (unsigned)(Rb * K + C) * 2u; }
    int gR[2], gC[2];
#pragma unroll
    for (int i = 0; i < 2; ++i) stage_rc(tid * 16 + i * 8192, gR[i], gC[i]);
    unsigned vc0[2], vc1[2], vn0[2], vn1[2];
#pragma unroll
    for (int i = 0; i < 2; ++i) { vc0[i] = vc1[i] = vn0[i] = vn1[i] = voffA[i]; }
    const size_t kstep = (size_t)(BK * 2);
    const size_t hstep = (size_t)HALF * K * 2;
    const size_t hsA = Sched::GATHER ? 0 : hstep;
    const unsigned ldsw = (unsigned)wid * 1024u;
    const int aoff = lds_byte(wr * 64 + fr, fq * 8), boff = lds_byte(wc * 32 + fr, fq * 8);
#define PG8_SA(b, h) (((b) * 2 + (h)) * HTB)
#define PG8_SB(b, h) ((4 + (b) * 2 + (h)) * HTB)
#define PG8_STAGE(bufoff, gbase, voff) do { _Pragma("unroll") for (int _i = 0; _i < 2; ++_i) \
        __builtin_amdgcn_global_load_lds((const unsigned*)((const char*)(gbase) + (voff)[_i]), (PG8_LAS unsigned*)(lds + (bufoff) + ldsw + _i * 8192), 16, 0, 0); } while (0)
#define PG8_LDA(dst, b, h) do { _Pragma("unroll") for (int m = 0; m < 4; ++m) _Pragma("unroll") for (int k = 0; k < 2; ++k) dst[m][k] = *(const PG8_LAS bf16x8*)(lds + PG8_SA(b, h) + aoff + m * 2048 + k * 1024); } while (0)
#define PG8_LDB(dst, b, h) do { _Pragma("unroll") for (int n = 0; n < 2; ++n) _Pragma("unroll") for (int k = 0; k < 2; ++k) dst[n][k] = *(const PG8_LAS bf16x8*)(lds + PG8_SB(b, h) + boff + n * 2048 + k * 1024); } while (0)
#define PG8_MMA(ai, bj, At, Bt) do { __builtin_amdgcn_s_setprio(1); _Pragma("unroll") for (int m = 0; m < 4; ++m) _Pragma("unroll") for (int n = 0; n < 2; ++n) _Pragma("unroll") for (int k = 0; k < 2; ++k) \
        acc[ai][bj][m][n] = __builtin_amdgcn_mfma_f32_16x16x32_bf16(Bt[n][k], At[m][k], acc[ai][bj][m][n], 0, 0, 0); __builtin_amdgcn_s_setprio(0); } while (0)
#define PG8_WAIT_V(n) asm volatile("s_waitcnt vmcnt(" #n ")" ::: "memory")
#define PG8_WAIT_L(n) asm volatile("s_waitcnt lgkmcnt(" #n ")" ::: "memory")
#define PG8_BAR __builtin_amdgcn_s_barrier()
#define PG8_SCHED __builtin_amdgcn_sched_barrier(0)
    Unit cur, nxt; int ui = 0;
    if (!S.next(0, cur)) return;
    f32x4 acc[2][2][4][2];
#pragma unroll
    for (int a = 0; a < 2; ++a)
#pragma unroll
        for (int b = 0; b < 2; ++b)
#pragma unroll
            for (int m = 0; m < 4; ++m)
#pragma unroll
                for (int n = 0; n < 2; ++n) acc[a][b][m][n] = (f32x4){0.f, 0.f, 0.f, 0.f};
    bf16x8 At[4][2], B0[2][2], B1[2][2];
    const char* cA = S.a_ptr(cur); const char* cB = S.b_ptr(cur);
    if constexpr (Sched::GATHER) {
#pragma unroll
        for (int i = 0; i < 2; ++i) { vc0[i] = (unsigned)(S.a_row(0, gR[i]) * K + gC[i]) * 2u; vc1[i] = (unsigned)(S.a_row(0, 128 + gR[i]) * K + gC[i]) * 2u; } }
    S.a_ready(cur);
    if constexpr (SP2) {
        PG8_STAGE(PG8_SB(0, 0), cB, voffB); PG8_STAGE(PG8_SB(0, 1), cB + hstep, voffB); PG8_STAGE(PG8_SA(0, 0), cA, vc0); PG8_STAGE(PG8_SA(0, 1), cA + hsA, vc1);
        if (wr == 1) PG8_BAR;
        PG8_WAIT_V(2); PG8_BAR;
        PG8_STAGE(PG8_SB(1, 0), cB + kstep, voffB); PG8_STAGE(PG8_SA(1, 0), cA + kstep, vc0); PG8_STAGE(PG8_SB(1, 1), cB + hstep + kstep, voffB);
        PG8_WAIT_V(6); PG8_BAR;
    } else {
        PG8_STAGE(PG8_SB(0, 0), cB, voffB); PG8_STAGE(PG8_SA(0, 0), cA, vc0); PG8_STAGE(PG8_SB(0, 1), cB + hstep, voffB); PG8_STAGE(PG8_SA(0, 1), cA + hsA, vc1);
        if (wr == 1) PG8_BAR;
        PG8_WAIT_V(4); PG8_BAR;
        PG8_STAGE(PG8_SB(1, 0), cB + kstep, voffB); PG8_STAGE(PG8_SA(1, 0), cA + kstep, vc0); PG8_STAGE(PG8_SB(1, 1), cB + hstep + kstep, voffB);
        PG8_WAIT_V(6); PG8_BAR;
    }
    for (;;) {
        const bool has_next = S.next(ui + 1, nxt);
        if constexpr (Sched::GATHER) {
#pragma unroll
            for (int i = 0; i < 2; ++i) { vn0[i] = has_next ? (unsigned)(S.a_row(ui + 1, gR[i]) * K + gC[i]) * 2u : vc0[i]; vn1[i] = has_next ? (unsigned)(S.a_row(ui + 1, 128 + gR[i]) * K + gC[i]) * 2u : vc1[i]; } }
        const char* nA = has_next ? S.a_ptr(nxt) : cA; const char* nB = has_next ? S.b_ptr(nxt) : cB;
        for (int t = 0; t < nt; t += 2) {
            const bool last = (t == nt - 2);
            unsigned vs0[2], vs1[2];
#pragma unroll
            for (int i = 0; i < 2; ++i) { vs0[i] = (Sched::GATHER && last) ? vn0[i] : vc0[i]; vs1[i] = (Sched::GATHER && last) ? vn1[i] : vc1[i]; }
            const char* a1 = cA + (size_t)(t + 1) * kstep;
            const char* a2 = last ? nA : cA + (size_t)(t + 2) * kstep; const char* b2 = last ? nB : cB + (size_t)(t + 2) * kstep;
            const char* a3 = a2 + kstep; const char* b3 = b2 + kstep;
            if (last && has_next) S.a_ready(nxt);
            if constexpr (SP2) {
            PG8_LDB(B0, 0, 0); PG8_LDB(B1, 0, 1); PG8_SCHED; PG8_LDA(At, 0, 0); PG8_STAGE(PG8_SA(1, 1), a1 + hsA, vc1);
            PG8_WAIT_V(8); PG8_WAIT_L(0); PG8_BAR; PG8_MMA(0, 0, At, B0); PG8_MMA(0, 1, At, B1); PG8_BAR; PG8_SCHED;
            PG8_LDA(At, 0, 1); PG8_STAGE(PG8_SB(0, 0), b2, voffB); PG8_STAGE(PG8_SB(0, 1), b2 + hstep, voffB); PG8_STAGE(PG8_SA(0, 0), a2, vs0);
            PG8_WAIT_V(8); PG8_WAIT_L(0); PG8_BAR; PG8_MMA(1, 0, At, B0); PG8_MMA(1, 1, At, B1); PG8_BAR; PG8_SCHED;
            PG8_LDB(B0, 1, 0); PG8_LDB(B1, 1, 1); PG8_SCHED; PG8_LDA(At, 1, 0); PG8_STAGE(PG8_SA(0, 1), a2 + hsA, vs1);
            PG8_WAIT_V(8); PG8_WAIT_L(0); PG8_BAR; PG8_MMA(0, 0, At, B0); PG8_MMA(0, 1, At, B1); PG8_BAR; PG8_SCHED;
            PG8_LDA(At, 1, 1); PG8_STAGE(PG8_SB(1, 0), b3, voffB); PG8_STAGE(PG8_SB(1, 1), b3 + hstep, voffB); PG8_STAGE(PG8_SA(1, 0), a3, vs0);
            PG8_WAIT_V(8); PG8_WAIT_L(0); PG8_BAR; PG8_MMA(1, 0, At, B0); PG8_MMA(1, 1, At, B1); PG8_BAR; PG8_SCHED;
            } else {
            PG8_LDB(B0, 0, 0); PG8_SCHED; PG8_LDA(At, 0, 0); PG8_STAGE(PG8_SA(1, 1), a1 + hsA, vc1);
            PG8_WAIT_L(8); PG8_BAR; PG8_WAIT_L(0); PG8_MMA(0, 0, At, B0); PG8_BAR; PG8_SCHED;
            PG8_LDB(B1, 0, 1); PG8_STAGE(PG8_SB(0, 0), b2, voffB);
            PG8_BAR; PG8_WAIT_L(0); PG8_MMA(0, 1, At, B1); PG8_BAR;
            PG8_LDA(At, 0, 1); PG8_STAGE(PG8_SA(0, 0), a2, vs0);
            PG8_BAR; PG8_WAIT_L(0); PG8_MMA(1, 0, At, B0); PG8_BAR; PG8_SCHED;
            PG8_STAGE(PG8_SB(0, 1), b2 + hstep, voffB);
            PG8_WAIT_V(6); PG8_BAR; PG8_MMA(1, 1, At, B1); PG8_BAR;
            PG8_LDB(B0, 1, 0); PG8_SCHED; PG8_LDA(At, 1, 0); PG8_STAGE(PG8_SA(0, 1), a2 + hsA, vs1);
            PG8_WAIT_L(8); PG8_BAR; PG8_WAIT_L(0); PG8_MMA(0, 0, At, B0); PG8_BAR; PG8_SCHED;
            PG8_LDB(B1, 1, 1); PG8_STAGE(PG8_SB(1, 0), b3, voffB);
            PG8_BAR; PG8_WAIT_L(0); PG8_MMA(0, 1, At, B1); PG8_BAR;
            PG8_LDA(At, 1, 1); PG8_STAGE(PG8_SA(1, 0), a3, vs0);
            PG8_BAR; PG8_WAIT_L(0); PG8_MMA(1, 0, At, B0); PG8_BAR; PG8_SCHED;
            PG8_STAGE(PG8_SB(1, 1), b3 + hstep, voffB);
            PG8_WAIT_V(6); PG8_BAR; PG8_MMA(1, 1, At, B1); PG8_BAR;
            }
        }
        if constexpr (ALIGN_EPI) { if (wr == 0) PG8_BAR; }
        if constexpr (!Epi::AFTER_DRAIN) { E(acc, cur, wr, wc, fr, fq); S.done(cur); }
        if (!has_next) break;
#pragma unroll
        for (int a = 0; a < 2; ++a)
#pragma unroll
            for (int b = 0; b < 2; ++b)
#pragma unroll
                for (int m = 0; m < 4; ++m)
#pragma unroll
                    for (int n = 0; n < 2; ++n) acc[a][b][m][n] = (f32x4){0.f, 0.f, 0.f, 0.f};
        cur = nxt; cA = nA; cB = nB; ++ui;
        if constexpr (Sched::GATHER) {
#pragma unroll
            for (int i = 0; i < 2; ++i) { vc0[i] = vn0[i]; vc1[i] = vn1[i]; } }
        if constexpr (ALIGN_EPI) { if (wr == 1) PG8_BAR; }
    }
    PG8_WAIT_V(0);
    if constexpr (!ALIGN_EPI) { if (wr == 0) PG8_BAR; }
    PG8_BAR;
    if constexpr (Epi::AFTER_DRAIN) { E.fused(acc, cur, wr, wc, fr, fq, lds, wid, lane); S.done(cur); }
#undef PG8_SA
#undef PG8_SB
#undef PG8_STAGE
#undef PG8_LDA
#undef PG8_LDB
#undef PG8_MMA
#undef PG8_WAIT_V
#undef PG8_WAIT_L
#undef PG8_BAR
#undef PG8_SCHED
}
}

__device__ __forceinline__ bf16_t* wgu_ptr(unsigned char* ws, int e) { return (bf16_t*)(ws + (e < 16 ? WS_WGU_LO : WS_WGU_HI)) + (size_t)(e & 15) * 1024 * 1024; }

#ifndef PG8_MASK
#define PG8_MASK 15
#endif

struct SchedIn {
    static constexpr bool GATHER = false;
    const char* A; const char* Bt; int G, c;
    __device__ __forceinline__ bool next(int i, pg8::Unit& u) const {
        const int L0 = i * G + c; if (L0 >= 1532) return false;
        const int L = pg8::xcd_remap(L0, 1532);
        if (L < 60) { const int pi = L >> 2; u.pm = L & 3; u.pn = pi < 8 ? pi : pi + 8; }
        else { const int l2 = L - 60, g = l2 / 184, r = l2 % 184; u.pn = r >> 3; u.pm = 4 + 8 * g + (r & 7); }
        u.rd = i; return true;
    }
    __device__ __forceinline__ const char* a_ptr(const pg8::Unit& u) const { return A + (size_t)u.pm * (256 * 1024 * 2); }
    __device__ __forceinline__ const char* b_ptr(const pg8::Unit& u) const { return Bt + (size_t)u.pn * (256 * 1024 * 2); }
    __device__ __forceinline__ void a_ready(const pg8::Unit&) const {}
    __device__ __forceinline__ void done(const pg8::Unit&) const {}
};
struct SchedOut {
    static constexpr bool GATHER = false;
    const char* A; const char* Bt; int G, c;
    __device__ __forceinline__ bool next(int i, pg8::Unit& u) const {
        const int L0 = i * G + c; if (L0 >= 256) return false;
        const int w = pg8::xcd_remap(L0, 256), gid = w >> 5, r = w & 31;
        u.pm = gid * 8 + (r & 7); u.pn = r >> 3; u.rd = i;
        return true;
    }
    __device__ __forceinline__ const char* a_ptr(const pg8::Unit& u) const { return A + (size_t)u.pm * (256 * 2048 * 2); }
    __device__ __forceinline__ const char* b_ptr(const pg8::Unit& u) const { return Bt + (size_t)u.pn * (256 * 2048 * 2); }
    __device__ __forceinline__ void a_ready(const pg8::Unit&) const {}
    __device__ __forceinline__ void done(const pg8::Unit&) const {}
};
template <bool UP>
struct SchedMoe {
    static constexpr bool GATHER = UP;
    const char* A; unsigned char* ws; const int* tile_e; const int* lcache; int NT, G, c, K;
    __device__ __forceinline__ bool next(int i, pg8::Unit& u) const {
        const int nwg = NT * 4; const int L0 = i * G + c; if (L0 >= nwg) return false;
        const int w = pg8::xcd_remap(L0, nwg);
        u.pm = w >> 2; u.pn = w & 3; u.rd = i;
        return true;
    }
    __device__ __forceinline__ const char* a_ptr(const pg8::Unit& u) const { return UP ? A : A + (size_t)u.pm * 256 * K * 2; }
    __device__ __forceinline__ int a_row(int round, int r) const { return lcache[round * 256 + r]; }
    __device__ __forceinline__ const char* b_ptr(const pg8::Unit& u) const {
        const int e = __builtin_amdgcn_readfirstlane(tile_e[u.pm]);
        return UP ? (const char*)wgu_ptr(ws, e) + (size_t)u.pn * 256 * 1024 * 2
                  : (const char*)(ws + WS_WDT) + ((size_t)e * 1024 * 512 + (size_t)u.pn * 256 * 512) * 2;
    }
    __device__ __forceinline__ void a_ready(const pg8::Unit&) const {}
    __device__ __forceinline__ void done(const pg8::Unit&) const {}
};

struct EpiIn {
    static constexpr bool PERM = true, AFTER_DRAIN = false;
    unsigned char* ws;
    __device__ __forceinline__ void operator()(const f32x4 (&acc)[2][2][4][2], const pg8::Unit& u, int wr, int wc, int fr, int fq) const {
        const int pn = u.pn; const int row0 = u.pm * 256 + wr * 64 + fr; const int ct = wc * 32 + 8 * fq;
        if (pn == 22) {
            if (wc < 2) { float* GDT = (float*)(ws + WS_GDT);
#pragma unroll
                for (int ai = 0; ai < 2; ++ai)
#pragma unroll
                    for (int m = 0; m < 4; ++m) { float* p = GDT + (size_t)(row0 + ai * 128 + m * 16) * 64 + ct; *(f32x4*)p = acc[ai][0][m][0]; *(f32x4*)(p + 4) = acc[ai][0][m][1]; } }
            return;
        }
        bf16_t* base; int ld; int roff = 0; bool act = false;
        if (pn < 4) { base = (bf16_t*)(ws + WS_QK) + pn * 256; ld = 1024; }
        else if (pn < 8) { base = (bf16_t*)(ws + WS_V) + (pn - 4) * 256; ld = 1024; }
        else if (pn < 16) { base = (bf16_t*)(ws + WS_RZ) + (pn - 8) * 256; ld = 2048; roff = T_CTX; act = true; }
        else { base = (bf16_t*)(ws + WS_XBC) + (pn - 16) * 256; ld = 1536; }
#pragma unroll
        for (int ai = 0; ai < 2; ++ai)
#pragma unroll
            for (int m = 0; m < 4; ++m) { bf16_t* rowp = base + (size_t)(row0 - roff + ai * 128 + m * 16) * ld + ct;
#pragma unroll
                for (int bj = 0; bj < 2; ++bj) { f32x4 v0 = acc[ai][bj][m][0], v1 = acc[ai][bj][m][1];
                    if (act) { v0.x = siluf(v0.x); v0.y = siluf(v0.y); v0.z = siluf(v0.z); v0.w = siluf(v0.w); v1.x = siluf(v1.x); v1.y = siluf(v1.y); v1.z = siluf(v1.z); v1.w = siluf(v1.w); }
                    u32x4 w; w.x = pg8::cvt_pk_bf16(v0.x, v0.y); w.y = pg8::cvt_pk_bf16(v0.z, v0.w); w.z = pg8::cvt_pk_bf16(v1.x, v1.y); w.w = pg8::cvt_pk_bf16(v1.z, v1.w);
                    *(u32x4*)(rowp + bj * 128) = w; } }
    }
};
struct EpiOut {
    static constexpr bool PERM = false, AFTER_DRAIN = false;
    const float* X; const float* MOD; float* HL;
    __device__ __forceinline__ void operator()(const f32x4 (&acc)[2][2][4][2], const pg8::Unit& u, int wr, int wc, int fr, int fq) const {
        const int b = u.pm >> 4; const int col0 = u.pn * 256 + wc * 32 + 4 * fq;
        f32x4 g1[2][2];
#pragma unroll
        for (int bj = 0; bj < 2; ++bj)
#pragma unroll
            for (int n = 0; n < 2; ++n) g1[bj][n] = *(const f32x4*)(MOD + b * 6144 + 2048 + col0 + bj * 128 + n * 16);
#pragma unroll
        for (int ai = 0; ai < 2; ++ai)
#pragma unroll
            for (int m = 0; m < 4; ++m) { const size_t off = (size_t)(u.pm * 256 + ai * 128 + wr * 64 + m * 16 + fr) * 1024 + col0;
#pragma unroll
                for (int bj = 0; bj < 2; ++bj)
#pragma unroll
                    for (int n = 0; n < 2; ++n) { const f32x4 xv = *(const f32x4*)(X + off + bj * 128 + n * 16); *(f32x4*)(HL + off + bj * 128 + n * 16) = xv + g1[bj][n] * acc[ai][bj][m][n]; }
                if (m & 1) asm volatile("" ::: "memory"); }
    }
};
struct EpiUp {
    static constexpr bool PERM = true, AFTER_DRAIN = false;
    bf16_t* H;
    __device__ __forceinline__ void operator()(const f32x4 (&acc)[2][2][4][2], const pg8::Unit& u, int wr, int wc, int fr, int fq) const {
        const int row0 = u.pm * 256 + wr * 64 + fr; const int col = u.pn * 128 + wc * 32 + 8 * fq;
#pragma unroll
        for (int ai = 0; ai < 2; ++ai)
#pragma unroll
            for (int m = 0; m < 4; ++m) { const f32x4 g0 = acc[ai][0][m][0], g1 = acc[ai][0][m][1], u0 = acc[ai][1][m][0], u1 = acc[ai][1][m][1];
                u32x4 w; w.x = pg8::cvt_pk_bf16(siluf(g0.x) * u0.x, siluf(g0.y) * u0.y); w.y = pg8::cvt_pk_bf16(siluf(g0.z) * u0.z, siluf(g0.w) * u0.w);
                w.z = pg8::cvt_pk_bf16(siluf(g1.x) * u1.x, siluf(g1.y) * u1.y); w.w = pg8::cvt_pk_bf16(siluf(g1.z) * u1.z, siluf(g1.w) * u1.w);
                *(u32x4*)(H + (size_t)(row0 + ai * 128 + m * 16) * 512 + col) = w; }
    }
};
struct EpiDown {
    static constexpr bool PERM = true, AFTER_DRAIN = false;
    bf16_t* Y; const int* pcache; const float* wcache;
    __device__ __forceinline__ void operator()(const f32x4 (&acc)[2][2][4][2], const pg8::Unit& u, int wr, int wc, int fr, int fq) const {
        const int rl0 = wr * 64 + fr; const int col = u.pn * 256 + wc * 32 + 8 * fq;
#pragma unroll
        for (int ai = 0; ai < 2; ++ai)
#pragma unroll
            for (int m = 0; m < 4; ++m) { const int rl = u.rd * 256 + rl0 + ai * 128 + m * 16; const int pr = pcache[rl]; const float sw = wcache[rl];
                if (pr >= 0) {
#pragma unroll
                    for (int bj = 0; bj < 2; ++bj) { const f32x4 v0 = acc[ai][bj][m][0] * sw, v1 = acc[ai][bj][m][1] * sw;
                        u32x4 w; w.x = pg8::cvt_pk_bf16(v0.x, v0.y); w.y = pg8::cvt_pk_bf16(v0.z, v0.w); w.z = pg8::cvt_pk_bf16(v1.x, v1.y); w.w = pg8::cvt_pk_bf16(v1.z, v1.w);
                        *(u32x4*)(Y + (size_t)pr * 1024 + col + bj * 128) = w; } } }
    }
};

__device__ __forceinline__ void phase2(Ctx& C) {
    const bf16_t* XN = (const bf16_t*)(C.ws + WS_XN); const bf16_t* WinT = (const bf16_t*)(C.ws + WS_WINT);
    bf16_t* QK = (bf16_t*)(C.ws + WS_QK); bf16_t* V = (bf16_t*)(C.ws + WS_V); bf16_t* RZ = (bf16_t*)(C.ws + WS_RZ); bf16_t* XBC = (bf16_t*)(C.ws + WS_XBC);
    float* GDT = (float*)(C.ws + WS_GDT);
    auto bsel = [=](int, int tn, int& ldb) { ldb = 1024; return WinT + (size_t)tn * 128 * 1024; };
    auto epi = [=](int row, int tn, int cc, float v, float) {
        const int col = tn * 128 + cc;
        if (col < 1024) QK[(size_t)row * 1024 + col] = (bf16_t)f2bf(v);
        else if (col < 2048) V[(size_t)row * 1024 + col - 1024] = (bf16_t)f2bf(v);
        else if (col < 4096) { if (row >= T_CTX) RZ[(size_t)(row - T_CTX) * 2048 + col - 2048] = (bf16_t)f2bf(siluf(v)); }
        else if (col < 5632) XBC[(size_t)row * 1536 + col - 4096] = (bf16_t)f2bf(v);
        else if (col < 5696) GDT[(size_t)row * 64 + col - 5632] = v;
    };
#if PG8_MASK & 1
    (void)bsel; (void)epi;
    SchedIn S{(const char*)XN, (const char*)WinT, C.G, C.bid}; EpiIn E{C.ws};
    pg8::gemm_phase<EpiIn, SchedIn, true, true>((lds_ptr_t)C.lds, 1024, S, E);
#else
    gemm_simple<false>(C, XN, 1024, T_ALL / 128, NW_IN / 128, 1024, bsel, epi);
#endif
}

__device__ __forceinline__ void phase3(Ctx& C, int sec) {
    if (sec & 1) {
        lds_ptr_t L = (lds_ptr_t)C.lds;
        constexpr int IN_O = 0, OUT_O = 32768, GS_O = 98304, TOT_O = 106496;
        LASQ float* gs = (LASQ float*)(L + GS_O); LASQ float* tot = (LASQ float*)(L + TOT_O);
        bf16_t* QK = (bf16_t*)(C.ws + WS_QK); bf16_t* QKF = (bf16_t*)(C.ws + WS_QKF);
        const float* GDT = (const float*)(C.ws + WS_GDT); float* GLAD = (float*)(C.ws + WS_GLAD);
        const float* gwup = C.in[I_GWUP]; const float* gbias = C.in[I_GB];
        const int tid = C.tid, c = tid & 127, tg = tid >> 7;
        for (int item = C.bid; item < 272 * 4; item += C.G) {
            const int rc = item >> 2, h = item & 3, row0 = rc * 64;
            __syncthreads();
#pragma unroll
            for (int i = 0; i < 4; ++i) { const int id = tid + 512 * i, arr = id >> 10, r = (id >> 4) & 63, ch = id & 15;
                *(LASQ u32x4*)(L + IN_O + arr * 16384 + r * 256 + ch * 16) = *(const u32x4*)(QK + (size_t)(row0 + r) * 1024 + arr * 512 + h * 128 + ch * 8); }
            *(LASQ f32x4*)(gs + (tid >> 3) * 32 + (tid & 7) * 4) = *(const f32x4*)(GDT + (size_t)(row0 + (tid >> 3)) * 64 + (tid & 7) * 4);
            float wf[16], wb[16];
#pragma unroll
            for (int r = 0; r < 16; ++r) { wf[r] = gwup[r * 512 + h * 128 + c]; wb[r] = gwup[(16 + r) * 512 + h * 128 + c]; }
            const float bfv = gbias[h * 128 + c], bbv = gbias[512 + h * 128 + c];
            __syncthreads();
            float pf[16], pb[16];
#pragma unroll
            for (int tt = 0; tt < 16; ++tt) { const LASQ float* g = gs + (tg * 16 + tt) * 32; float sf = bfv, sb = bbv;
#pragma unroll
                for (int r4 = 0; r4 < 4; ++r4) { const f32x4 gf = *(const LASQ f32x4*)(g + r4 * 4), gb = *(const LASQ f32x4*)(g + 16 + r4 * 4);
                    sf += gf.x * wf[r4 * 4] + gf.y * wf[r4 * 4 + 1] + gf.z * wf[r4 * 4 + 2] + gf.w * wf[r4 * 4 + 3];
                    sb += gb.x * wb[r4 * 4] + gb.y * wb[r4 * 4 + 1] + gb.z * wb[r4 * 4 + 2] + gb.w * wb[r4 * 4 + 3]; }
                pf[tt] = logsig_fast(sf) * (1.f / 16.f); pb[tt] = logsig_fast(sb) * (1.f / 16.f); }
#pragma unroll
            for (int tt = 1; tt < 16; ++tt) pf[tt] += pf[tt - 1];
#pragma unroll
            for (int tt = 14; tt >= 0; --tt) pb[tt] += pb[tt + 1];
            tot[(0 * 4 + tg) * 128 + c] = pf[15]; tot[(1 * 4 + tg) * 128 + c] = pb[0];
            __syncthreads();
            float offf = 0.f, offb = 0.f, totf = 0.f, totb = 0.f;
#pragma unroll
            for (int g = 0; g < 4; ++g) { const float a = tot[(0 * 4 + g) * 128 + c], bq = tot[(1 * 4 + g) * 128 + c]; if (g < tg) offf += a; if (g > tg) offb += bq; totf += a; totb += bq; }
            if (tg == 0) { GLAD[((size_t)(rc * 4 + h) * 2 + 0) * 128 + c] = __expf(totf); GLAD[((size_t)(rc * 4 + h) * 2 + 1) * 128 + c] = __expf(totb); }
            const float qscale = 0.08838834764831845f;
#pragma unroll
            for (int tt = 0; tt < 16; ++tt) { const int r = tg * 16 + tt;
                const float q = bf2f(*(const LASQ bf16_t*)(L + IN_O + r * 256 + c * 2)) * qscale, k = bf2f(*(const LASQ bf16_t*)(L + IN_O + 16384 + r * 256 + c * 2));
                const float ef = pf[tt] + offf, eb = pb[tt] + offb;
                *(LASQ bf16_t*)(L + OUT_O + 0 * 16384 + r * 256 + c * 2) = (bf16_t)f2bf(q * __expf(ef));
                *(LASQ bf16_t*)(L + OUT_O + 1 * 16384 + r * 256 + c * 2) = (bf16_t)f2bf(k * __expf(-ef));
                *(LASQ bf16_t*)(L + OUT_O + 2 * 16384 + r * 256 + c * 2) = (bf16_t)f2bf(q * __expf(eb));
                *(LASQ bf16_t*)(L + OUT_O + 3 * 16384 + r * 256 + c * 2) = (bf16_t)f2bf(k * __expf(-eb)); }
            __syncthreads();
#pragma unroll
            for (int i = 0; i < 8; ++i) { const int id = tid + 512 * i, arr = id >> 10, r = (id >> 4) & 63, ch = id & 15;
                bf16_t* dst = (arr < 2 ? QKF : QK) + (size_t)(row0 + r) * 1024 + (arr & 1) * 512 + h * 128 + ch * 8;
                *(u32x4*)dst = *(const LASQ u32x4*)(L + OUT_O + arr * 16384 + r * 256 + ch * 16); }
        }
        __syncthreads();
    }
    if (sec & 2) {
        const bf16_t* XBC = (const bf16_t*)(C.ws + WS_XBC); bf16_t* XC = (bf16_t*)(C.ws + WS_XC);
        const float* cw = C.in[I_CONVW]; const float* cb = C.in[I_CONVB];
        const int total = 272 * 4 * 192;
        for (int it = C.bid * NTHREADS + C.tid; it < total; it += C.G * NTHREADS) {
            const int cg8 = it % 192, st = it / 192, rc = st >> 2, x0 = (st & 3) * 16, c0 = cg8 * 8;
            int base, y, xb, H, W;
            if (rc < 16) { base = (rc >> 2) * 256; y = 0; xb = (rc & 3) * 64; H = 1; W = 256; }
            else { const int lr = rc - 16; base = T_CTX + (lr >> 6) * 4096; y = lr & 63; xb = 0; H = 64; W = 64; }
            float wt[9][8], bias[8];
#pragma unroll
            for (int t = 0; t < 9; ++t) { const f32x4 a = *(const f32x4*)(cw + (size_t)t * 1536 + c0), bq = *(const f32x4*)(cw + (size_t)t * 1536 + c0 + 4);
                wt[t][0] = a.x; wt[t][1] = a.y; wt[t][2] = a.z; wt[t][3] = a.w; wt[t][4] = bq.x; wt[t][5] = bq.y; wt[t][6] = bq.z; wt[t][7] = bq.w; }
            { const f32x4 a = *(const f32x4*)(cb + c0), bq = *(const f32x4*)(cb + c0 + 4); bias[0] = a.x; bias[1] = a.y; bias[2] = a.z; bias[3] = a.w; bias[4] = bq.x; bias[5] = bq.y; bias[6] = bq.z; bias[7] = bq.w; }
            const bool vy[3] = {y - 1 >= 0, true, y + 1 < H};
            u16x8 win[3][3];
            auto ldcol = [&](int i, int xx) -> u16x8 { u16x8 z = {0, 0, 0, 0, 0, 0, 0, 0};
                if (!vy[i] || xx < 0 || xx >= W) return z;
                return *(const u16x8*)(XBC + (size_t)(base + (y + i - 1) * W + xx) * 1536 + c0); };
            const int xs = xb + x0;
            u16x8 nxt[3];
#pragma unroll
            for (int i = 0; i < 3; ++i) { win[i][0] = ldcol(i, xs - 1); win[i][1] = ldcol(i, xs); nxt[i] = ldcol(i, xs + 1); }
            for (int dx = 0; dx < 16; ++dx) { const int x = xs + dx;
#pragma unroll
                for (int i = 0; i < 3; ++i) { win[i][2] = nxt[i]; nxt[i] = ldcol(i, x + 2 <= xs + 16 ? x + 2 : -1); }
                float acc[8];
#pragma unroll
                for (int j = 0; j < 8; ++j) acc[j] = bias[j];
#pragma unroll
                for (int i = 0; i < 3; ++i)
#pragma unroll
                    for (int jx = 0; jx < 3; ++jx)
#pragma unroll
                        for (int j = 0; j < 8; ++j) acc[j] += bf2f(win[i][jx][j]) * wt[i * 3 + jx][j];
                u32x4 o; o.x = pk2(siluf(acc[0]), siluf(acc[1])); o.y = pk2(siluf(acc[2]), siluf(acc[3])); o.z = pk2(siluf(acc[4]), siluf(acc[5])); o.w = pk2(siluf(acc[6]), siluf(acc[7]));
                *(u32x4*)(XC + (size_t)(base + y * W + x) * 1536 + c0) = o;
#pragma unroll
                for (int i = 0; i < 3; ++i) { win[i][0] = win[i][1]; win[i][1] = win[i][2]; }
            }
        }
    }
    if (sec & 4) {
        float* GDT = (float*)(C.ws + WS_GDT); float* ACUM = (float*)(C.ws + WS_ACUM);
        const float* alog = C.in[I_ALOG]; const float* dtbias = C.in[I_DTB];
        const int gw = C.bid * 8 + C.wave, NGW = C.G * 8, l = C.lane;
        for (int it = gw; it < 272 * 32; it += NGW) {
            const int rc = it >> 5, dh = it & 31, dir = dh >> 4; const size_t row = (size_t)rc * 64 + l;
            const float dtv = softplusf(GDT[row * 64 + 32 + dh] + dtbias[dh]);
            float sa = dtv * (-__expf(alog[dh])) * 1.4426950408889634f;
#pragma unroll
            for (int o = 1; o < 64; o <<= 1) { const float t = dir ? __shfl_down(sa, o) : __shfl_up(sa, o); if (dir ? (l + o < 64) : (l >= o)) sa += t; }
            GDT[row * 64 + 32 + dh] = dtv; ACUM[row * 32 + dh] = sa;
        }
    }
}

__device__ __forceinline__ int scan_row(int b, int dir, int s) {
    if (s < CTXL) return b * CTXL + (dir ? CTXL - 1 - s : s);
    const int t = s - CTXL; return T_CTX + b * SEQ + (dir ? SEQ - 1 - t : t);
}

__device__ __forceinline__ void phase4_naive(Ctx& C) {
    bf16_t* OF = (bf16_t*)C.out;
    bf16_t* OB = (bf16_t*)(C.ws + WS_OB);
    bf16_t* YB = (bf16_t*)(C.ws + WS_YB);
    const bf16_t* V = (const bf16_t*)(C.ws + WS_V); const bf16_t* XC = (const bf16_t*)(C.ws + WS_XC);
    const float* GDT = (const float*)(C.ws + WS_GDT); const float* GLAD = (const float*)(C.ws + WS_GLAD);
    for (int gt = C.bid * NTHREADS + C.tid; gt < 65536; gt += C.G * NTHREADS) {
        if (gt < 32768) {
            const int chain = gt >> 10, rem = gt & 1023, dv = rem >> 2, dq = rem & 3;
            const int b = chain >> 3, h = (chain >> 1) & 3, dir = chain & 1;
            const bf16_t* QKp = (const bf16_t*)(C.ws + (dir ? WS_QK : WS_QKF));
            float S[32];
#pragma unroll
            for (int i = 0; i < 32; ++i) S[i] = 0.f;
            for (int s = 0; s < CTXL + SEQ; ++s) {
                const int row = scan_row(b, dir, s);
                const float v = bf2f(V[(size_t)row * 1024 + h * 256 + dv]);
                const bf16_t* qp = QKp + (size_t)row * 1024 + h * 128 + dq * 32;
                float o = 0.f;
#pragma unroll
                for (int i8 = 0; i8 < 4; ++i8) { const u16x8 kv = *(const u16x8*)(qp + 512 + i8 * 8), qv = *(const u16x8*)(qp + i8 * 8);
#pragma unroll
                    for (int j = 0; j < 8; ++j) { S[i8 * 8 + j] += bf2f(kv[j]) * v; o += bf2f(qv[j]) * S[i8 * 8 + j]; } }
                o += __shfl_xor(o, 1); o += __shfl_xor(o, 2);
                if (row >= T_CTX && dq == 0) { const size_t l = row - T_CTX; if (dir) OB[l * 1024 + h * 256 + dv] = (bf16_t)f2bf(o); else OF[l * 2048 + h * 256 + dv] = (bf16_t)f2bf(o); }
                if ((s & 63) == 63) { const float* d = GLAD + ((size_t)((row >> 6) * 4 + h) * 2 + dir) * 128 + dq * 32;
#pragma unroll
                    for (int i = 0; i < 32; ++i) S[i] *= d[i]; }
            }
        } else {
            const int g2 = gt - 32768, chain = g2 >> 8, rem = g2 & 255, p = rem >> 2, nq = rem & 3;
            const int b = chain >> 5, head = (chain >> 1) & 15, dir = chain & 1, grp = head >> 3;
            const float Aneg = -__expf(C.in[I_ALOG][dir * 16 + head]), dtb = C.in[I_DTB][dir * 16 + head];
            float S[32];
#pragma unroll
            for (int i = 0; i < 32; ++i) S[i] = 0.f;
            for (int s = 0; s < CTXL + SEQ; ++s) {
                const int row = scan_row(b, dir, s);
                const float dt = GDT[(size_t)row * 64 + 32 + dir * 16 + head], a = __expf(dt * Aneg); (void)dtb;
                const float xd = bf2f(XC[(size_t)row * 1536 + head * 64 + p]) * dt;
                const bf16_t* bp = XC + (size_t)row * 1536 + 1024 + grp * 128 + nq * 32;
                float y = 0.f;
#pragma unroll
                for (int i8 = 0; i8 < 4; ++i8) { const u16x8 bv = *(const u16x8*)(bp + i8 * 8), cv = *(const u16x8*)(bp + 256 + i8 * 8);
#pragma unroll
                    for (int j = 0; j < 8; ++j) { S[i8 * 8 + j] = a * S[i8 * 8 + j] + xd * bf2f(bv[j]); y += S[i8 * 8 + j] * bf2f(cv[j]); } }
                y += __shfl_xor(y, 1); y += __shfl_xor(y, 2);
                if (row >= T_CTX && nq == 0) { const size_t l = row - T_CTX; if (dir) YB[l * 1024 + head * 64 + p] = (bf16_t)f2bf(y); else OF[l * 2048 + 1024 + head * 64 + p] = (bf16_t)f2bf(y); }
            }
        }
    }
}


typedef short bf16x8 __attribute__((ext_vector_type(8)));
typedef short s16x4 __attribute__((ext_vector_type(4)));
typedef __attribute__((address_space(3))) s16x4* lds_s16x4_p;
__device__ __forceinline__ bf16x8 lds_row_frag(lds_ptr_t L, int off, int rs, int r0, int kb, int c, int g) {
    return *(const LASQ bf16x8*)(L + off + (r0 + c) * rs + kb + g * 16);
}
__device__ __forceinline__ bf16x8 lds_tr_frag(lds_ptr_t L, int off, int rs, int k0, int n0, int g, int q, int p) {
    const s16x4 lo = __builtin_amdgcn_ds_read_tr16_b64_v4i16((lds_s16x4_p)(L + off + (k0 + 8 * g + q) * rs + (n0 + 4 * p) * 2));
    const s16x4 hi = __builtin_amdgcn_ds_read_tr16_b64_v4i16((lds_s16x4_p)(L + off + (k0 + 8 * g + 4 + q) * rs + (n0 + 4 * p) * 2));
    bf16x8 r; r[0] = lo[0]; r[1] = lo[1]; r[2] = lo[2]; r[3] = lo[3]; r[4] = hi[0]; r[5] = hi[1]; r[6] = hi[2]; r[7] = hi[3]; return r;
}
template <bool GLA>
__device__ __forceinline__ void scan_unit(Ctx& C, int uid) {
    lds_ptr_t L = (lds_ptr_t)C.lds;
    constexpr int INB = 44032, KS_O = 17408, VS_O = 34816, ST_OFF = 88064, STB = 17408, PS_OFF = 122880, SC_OFF = 132096, SCB = 1280;
    const int tid = C.tid, w = C.wave, l = C.lane, g = l >> 4, c = l & 15, q = c >> 2, p = c & 3;
    int b, dir, ldqk, ldv, ldo; const bf16_t *Qg, *Kg, *Vg; bf16_t* Og; const float* Sg; const float* dtg = nullptr;
    if (GLA) { b = uid >> 5; const int h = (uid >> 3) & 3; dir = (uid >> 2) & 1; const int sl = uid & 3;
        const bf16_t* QKp = (const bf16_t*)(C.ws + (dir ? WS_QK : WS_QKF));
        Qg = QKp + h * 128; Kg = QKp + 512 + h * 128; ldqk = 1024; Vg = (const bf16_t*)(C.ws + WS_V) + h * 256 + sl * 64; ldv = 1024;
        Og = dir ? (bf16_t*)(C.ws + WS_OB) + h * 256 + sl * 64 : (bf16_t*)C.out + h * 256 + sl * 64; ldo = dir ? 1024 : 2048;
        Sg = (const float*)(C.ws + WS_GLAD) + (h * 2 + dir) * 128;
    } else { b = uid >> 5; const int head = (uid >> 1) & 15; dir = uid & 1; const int grp = head >> 3;
        const bf16_t* XC = (const bf16_t*)(C.ws + WS_XC);
        Qg = XC + 1280 + grp * 128; Kg = XC + 1024 + grp * 128; ldqk = 1536; Vg = XC + head * 64; ldv = 1536;
        Og = dir ? (bf16_t*)(C.ws + WS_YB) + head * 64 : (bf16_t*)C.out + 1024 + head * 64; ldo = dir ? 1024 : 2048;
        Sg = (const float*)(C.ws + WS_ACUM) + dir * 16 + head;
        dtg = (const float*)(C.ws + WS_GDT) + 32 + dir * 16 + head;
    }
    f32x4 S[4];
#pragma unroll
    for (int t = 0; t < 4; ++t) S[t] = (f32x4){0.f, 0.f, 0.f, 0.f};
    u32x4 pq0, pq1, pk0, pk1, pv; float ps0 = 0.f, ps1 = 0.f, ptot = 0.f;
    auto chunk_rc = [&](int n) { return n < 4 ? 4 * b + (dir ? 3 - n : n) : 16 + 64 * b + (dir ? 67 - n : n - 4); };
    auto prefetch = [&](int n) {
        const int rc = chunk_rc(n), row0 = rc * 64;
        const bf16_t* qp = Qg + (size_t)(row0 + (tid >> 4)) * ldqk + (tid & 15) * 8; const bf16_t* kp = Kg + (size_t)(row0 + (tid >> 4)) * ldqk + (tid & 15) * 8;
        pq0 = *(const u32x4*)qp; pq1 = *(const u32x4*)(qp + (size_t)32 * ldqk); pk0 = *(const u32x4*)kp; pk1 = *(const u32x4*)(kp + (size_t)32 * ldqk);
        pv = *(const u32x4*)(Vg + (size_t)(row0 + (tid >> 3)) * ldv + (tid & 7) * 8);
        if (GLA) { ps0 = Sg[(size_t)rc * 1024 + (tid & 127)]; }
        else { ps0 = Sg[(size_t)(row0 + (tid & 63)) * 32]; ps1 = dtg[(size_t)(row0 + (tid & 63)) * 64]; ptot = Sg[(size_t)(row0 + (dir ? 0 : 63)) * 32]; }
    };
    float dtot = 1.f;
    auto stageW = [&](int n) {
        const int ib = (n & 1) * INB; LASQ float* sc = (LASQ float*)(L + SC_OFF + (n & 1) * SCB);
        *(LASQ u32x4*)(L + ib + (tid >> 4) * 272 + (tid & 15) * 16) = pq0; *(LASQ u32x4*)(L + ib + ((tid >> 4) + 32) * 272 + (tid & 15) * 16) = pq1;
        *(LASQ u32x4*)(L + ib + KS_O + (tid >> 4) * 272 + (tid & 15) * 16) = pk0; *(LASQ u32x4*)(L + ib + KS_O + ((tid >> 4) + 32) * 272 + (tid & 15) * 16) = pk1;
        *(LASQ u32x4*)(L + ib + VS_O + (tid >> 3) * 144 + (tid & 7) * 16) = pv;
        if (GLA) { if (tid < 128) sc[tid] = ps0; }
        else { if (tid < 64) { sc[tid] = ps0; sc[64 + tid] = ps1; sc[128 + tid] = ps1 * __builtin_amdgcn_exp2f(ptot - ps0); } }
    };
    prefetch(0);
    stageW(0);
    float dcur = GLA ? 1.f : __builtin_amdgcn_exp2f(ptot);
    prefetch(1);
    __syncthreads();
    for (int n = 0; n < 68; ++n) {
        const int rc = chunk_rc(n); const bool lat = n >= 4;
        const int ib = (n & 1) * INB; LASQ float* sc = (LASQ float*)(L + SC_OFF + (n & 1) * SCB);
        float dnext = 1.f; bf16x8 qfr[2][4], vfr[2];
        if (n + 1 < 68) { stageW(n + 1); if (!GLA) dnext = __builtin_amdgcn_exp2f(ptot); if (n + 2 < 68) prefetch(n + 2); }
        if (lat) {
            const int tj = w >> 1, ti0 = 2 * (w & 1);
            bf16x8 ka[4];
#pragma unroll
            for (int ks = 0; ks < 4; ++ks) ka[ks] = lds_row_frag(L, ib + KS_O, 272, 16 * tj, 64 * ks, c, g);
#pragma unroll
            for (int t2 = 0; t2 < 2; ++t2) { const int ti = ti0 + t2; f32x4 acc = (f32x4){0.f, 0.f, 0.f, 0.f};
#pragma unroll
                for (int ks = 0; ks < 4; ++ks) { qfr[t2][ks] = lds_row_frag(L, ib, 272, 16 * ti, 64 * ks, c, g); acc = __builtin_amdgcn_mfma_f32_16x16x32_bf16(ka[ks], qfr[t2][ks], acc, 0, 0, 0); }
                const int i = 16 * ti + c, j0 = 16 * tj + 4 * g; float pvv[4];
                if (GLA) {
#pragma unroll
                    for (int r = 0; r < 4; ++r) { const bool ok = dir ? (j0 + r >= i) : (j0 + r <= i); pvv[r] = ok ? acc[r] : 0.f; }
                } else { const float ai = sc[i]; const f32x4 aj = *(const LASQ f32x4*)(sc + j0), dj = *(const LASQ f32x4*)(sc + 64 + j0);
#pragma unroll
                    for (int r = 0; r < 4; ++r) { const bool ok = dir ? (j0 + r >= i) : (j0 + r <= i); const float x = ok ? ai - aj[r] : 0.f; pvv[r] = ok ? acc[r] * __builtin_amdgcn_exp2f(x) * dj[r] : 0.f; } }
                u32x2 o; o.x = pk2(pvv[0], pvv[1]); o.y = pk2(pvv[2], pvv[3]); *(LASQ u32x2*)(L + PS_OFF + i * 144 + j0 * 2) = o; }
        }
        {
            bf16x8 ka[2];
#pragma unroll
            for (int ks = 0; ks < 2; ++ks) ka[ks] = lds_tr_frag(L, ib + KS_O, 272, 32 * ks, 16 * w, g, q, p);
            if (!GLA) {
#pragma unroll
                for (int ks = 0; ks < 2; ++ks) { const f32x4 u0 = *(const LASQ f32x4*)(sc + 128 + 32 * ks + 8 * g), u1 = *(const LASQ f32x4*)(sc + 128 + 32 * ks + 8 * g + 4);
                    const float uu[8] = {u0.x, u0.y, u0.z, u0.w, u1.x, u1.y, u1.z, u1.w}; u32x4 pk;
                    pk.x = pk2(bf2f((bf16_t)ka[ks][0]) * uu[0], bf2f((bf16_t)ka[ks][1]) * uu[1]); pk.y = pk2(bf2f((bf16_t)ka[ks][2]) * uu[2], bf2f((bf16_t)ka[ks][3]) * uu[3]);
                    pk.z = pk2(bf2f((bf16_t)ka[ks][4]) * uu[4], bf2f((bf16_t)ka[ks][5]) * uu[5]); pk.w = pk2(bf2f((bf16_t)ka[ks][6]) * uu[6], bf2f((bf16_t)ka[ks][7]) * uu[7]);
                    ka[ks] = __builtin_bit_cast(bf16x8, pk); }
#pragma unroll
                for (int t = 0; t < 4; ++t) S[t] = S[t] * dcur;
            }
#pragma unroll
            for (int t = 0; t < 4; ++t)
#pragma unroll
                for (int ks = 0; ks < 2; ++ks) { const bf16x8 vb = lds_tr_frag(L, ib + VS_O, 144, 32 * ks, 16 * t, g, q, p); if (t == (w >> 1)) vfr[ks] = vb; S[t] = __builtin_amdgcn_mfma_f32_16x16x32_bf16(ka[ks], vb, S[t], 0, 0, 0); }
            if (GLA) { const f32x4 d = *(const LASQ f32x4*)(sc + 16 * w + 4 * g);
#pragma unroll
                for (int t = 0; t < 4; ++t) S[t] = S[t] * d; }
            if (n + 1 >= 4 && n + 1 < 68) {
                const int so = ST_OFF + ((n + 1) & 1) * STB;
#pragma unroll
                for (int t = 0; t < 4; ++t) { u32x2 o; o.x = pk2(S[t].x, S[t].y); o.y = pk2(S[t].z, S[t].w); *(LASQ u32x2*)(L + so + (16 * t + c) * 272 + (16 * w + 4 * g) * 2) = o; }
            }
        }
        dcur = dnext;
        __syncthreads();
        if (lat) {
            const int tdv = w >> 1, ti0 = 2 * (w & 1), so = ST_OFF + (n & 1) * STB;
            bf16x8 sa[4];
#pragma unroll
            for (int ks = 0; ks < 4; ++ks) sa[ks] = lds_row_frag(L, so, 272, 16 * tdv, 64 * ks, c, g);
            const size_t lrow0 = (size_t)(rc * 64 - T_CTX);
#pragma unroll
            for (int t2 = 0; t2 < 2; ++t2) { const int ti = ti0 + t2; f32x4 a1 = (f32x4){0.f, 0.f, 0.f, 0.f}, a2 = (f32x4){0.f, 0.f, 0.f, 0.f};
#pragma unroll
                for (int ks = 0; ks < 2; ++ks) { const bf16x8 pb = lds_row_frag(L, PS_OFF, 144, 16 * ti, 64 * ks, c, g); a1 = __builtin_amdgcn_mfma_f32_16x16x32_bf16(vfr[ks], pb, a1, 0, 0, 0); }
#pragma unroll
                for (int ks = 0; ks < 4; ++ks) a2 = __builtin_amdgcn_mfma_f32_16x16x32_bf16(sa[ks], qfr[t2][ks], a2, 0, 0, 0);
                const int i = 16 * ti + c; f32x4 o4;
                if (GLA) o4 = a1 + a2; else o4 = a1 + a2 * __builtin_amdgcn_exp2f(sc[i]);
                u32x2 o; o.x = pk2(o4.x, o4.y); o.y = pk2(o4.z, o4.w);
                *(u32x2*)(Og + (lrow0 + i) * ldo + 16 * tdv + 4 * g) = o; }
        }
        __syncthreads();
    }
}
__device__ __forceinline__ void phase4(Ctx& C) {
    for (int uid = C.bid; uid < 256; uid += C.G) { if (uid < 128) scan_unit<true>(C, uid); else scan_unit<false>(C, uid - 128); }
}

__device__ __forceinline__ void phase5(Ctx& C) {
    const int gw = C.bid * 8 + C.wave, NGW = C.G * 8;
    const bf16_t* OF = (const bf16_t*)C.out; const bf16_t* OB = (const bf16_t*)(C.ws + WS_OB); const bf16_t* YB = (const bf16_t*)(C.ws + WS_YB);
    const bf16_t* RZ = (const bf16_t*)(C.ws + WS_RZ); const bf16_t* XC = (const bf16_t*)(C.ws + WS_XC); bf16_t* YX = (bf16_t*)(C.ws + WS_YX);
    const float* ssdd = C.in[I_SSDD]; const float* ssdn = C.in[I_SSDN]; const f32x4 gn = *(const f32x4*)(C.in[I_GNORM] + C.lane * 4);
    const int ln = C.lane;
    float nw[2][8], dsk[2];
#pragma unroll
    for (int g = 0; g < 2; ++g) { const int c0 = g * 512 + ln * 8; dsk[g] = ssdd[c0 >> 6];
        const f32x4 a = *(const f32x4*)(ssdn + c0), bq = *(const f32x4*)(ssdn + c0 + 4);
        nw[g][0] = a.x; nw[g][1] = a.y; nw[g][2] = a.z; nw[g][3] = a.w; nw[g][4] = bq.x; nw[g][5] = bq.y; nw[g][6] = bq.z; nw[g][7] = bq.w; }
    constexpr int NR = 2;
    for (int l0 = gw; l0 < T_LAT; l0 += NGW * NR) {
        u16x4 ga[NR][4], gb[NR][4], gr[NR][4]; u16x8 sa[NR][2], sb[NR][2], sz[NR][2], sx[NR][2];
#pragma unroll
        for (int u = 0; u < NR; ++u) { const int l = l0 + u * NGW; if (l < T_LAT) {
#pragma unroll
            for (int h = 0; h < 4; ++h) { const int c0 = h * 256 + ln * 4;
                ga[u][h] = *(const u16x4*)(OF + (size_t)l * 2048 + c0); gb[u][h] = *(const u16x4*)(OB + (size_t)l * 1024 + c0); gr[u][h] = *(const u16x4*)(RZ + (size_t)l * 2048 + c0); }
#pragma unroll
            for (int g = 0; g < 2; ++g) { const int c0 = g * 512 + ln * 8;
                sa[u][g] = *(const u16x8*)(OF + (size_t)l * 2048 + 1024 + c0); sb[u][g] = *(const u16x8*)(YB + (size_t)l * 1024 + c0);
                sz[u][g] = *(const u16x8*)(RZ + (size_t)l * 2048 + 1024 + c0); sx[u][g] = *(const u16x8*)(XC + (size_t)(l + T_CTX) * 1536 + c0); } } }
        float o[NR][4][4], y[NR][2][8], ss[NR][6];
#pragma unroll
        for (int u = 0; u < NR; ++u) {
#pragma unroll
            for (int h = 0; h < 4; ++h) { float a = 0.f;
#pragma unroll
                for (int j = 0; j < 4; ++j) { o[u][h][j] = bf2f(ga[u][h][j]) + bf2f(gb[u][h][j]); a += o[u][h][j] * o[u][h][j]; }
                ss[u][h] = a; }
#pragma unroll
            for (int g = 0; g < 2; ++g) { float a = 0.f;
#pragma unroll
                for (int j = 0; j < 8; ++j) { y[u][g][j] = (bf2f(sa[u][g][j]) + bf2f(sb[u][g][j]) + bf2f(sx[u][g][j]) * dsk[g]) * bf2f(sz[u][g][j]); a += y[u][g][j] * y[u][g][j]; }
                ss[u][4 + g] = a; } }
#pragma unroll
        for (int of = 1; of < 64; of <<= 1) {
#pragma unroll
            for (int u = 0; u < NR; ++u)
#pragma unroll
                for (int k = 0; k < 6; ++k) ss[u][k] += __shfl_xor(ss[u][k], of); }
#pragma unroll
        for (int u = 0; u < NR; ++u) { const int l = l0 + u * NGW; if (l < T_LAT) {
#pragma unroll
            for (int h = 0; h < 4; ++h) { const int c0 = h * 256 + ln * 4; const float rs = rsqrtf(ss[u][h] * (1.f / 256.f) + EPS);
                u32x2 w; w.x = pk2(o[u][h][0] * rs * gn.x * bf2f(gr[u][h][0]), o[u][h][1] * rs * gn.y * bf2f(gr[u][h][1])); w.y = pk2(o[u][h][2] * rs * gn.z * bf2f(gr[u][h][2]), o[u][h][3] * rs * gn.w * bf2f(gr[u][h][3]));
                *(u32x2*)(YX + (size_t)l * 2048 + c0) = w; }
#pragma unroll
            for (int g = 0; g < 2; ++g) { const int c0 = g * 512 + ln * 8; const float rs = rsqrtf(ss[u][4 + g] * (1.f / 512.f) + EPS);
                u32x4 w; w.x = pk2(y[u][g][0] * rs * nw[g][0], y[u][g][1] * rs * nw[g][1]); w.y = pk2(y[u][g][2] * rs * nw[g][2], y[u][g][3] * rs * nw[g][3]);
                w.z = pk2(y[u][g][4] * rs * nw[g][4], y[u][g][5] * rs * nw[g][5]); w.w = pk2(y[u][g][6] * rs * nw[g][6], y[u][g][7] * rs * nw[g][7]);
                *(u32x4*)(YX + (size_t)l * 2048 + 1024 + c0) = w; } } }
    }
}

__device__ __forceinline__ void phase6(Ctx& C) {
    {
        float* scr = (float*)C.lds + 8192 + C.wave * (64 * 33);
        const int gw = C.bid * 8 + C.wave, NGW = C.G * 8;
        bf16_t* WdT = (bf16_t*)(C.ws + WS_WDT);
        for (int it = gw; it < 32 * 768; it += NGW) {
            const int e = it / 768, r = it % 768;
            if (r < 512) { const int up = r >> 8, q = r & 255, kb = q >> 4, nb = q & 15;
                const float* src = C.in[up ? I_EWU : I_EWG] + (size_t)e * 1024 * 512 + (size_t)(kb * 64) * 512 + nb * 32;
                bf16_t* dst = wgu_ptr(C.ws, e) + (size_t)(256 * (nb >> 2) + (nb & 3) * 32 + up * 128) * 1024 + kb * 64;
                transpose_tile(src, 512, dst, 1024, scr, C.lane, false); }
            else { const int q = r - 512, kb = q >> 5, nb = q & 31;
                transpose_tile(C.in[I_EWD] + (size_t)e * 512 * 1024 + (size_t)(kb * 64) * 1024 + nb * 32, 1024, WdT + (size_t)e * 1024 * 512 + (size_t)(nb * 32) * 512 + kb * 64, 512, scr, C.lane, false); }
        }
    }
    __syncthreads();
    const bf16_t* YX = (const bf16_t*)(C.ws + WS_YX); const bf16_t* WoutT = (const bf16_t*)(C.ws + WS_WOUTT);
    const float* MOD = (const float*)(C.ws + WS_MOD); const float* X = C.in[I_X]; float* HL = C.out;
    auto bsel = [=](int, int tn, int& ldb) { ldb = 2048; return WoutT + (size_t)tn * 128 * 2048; };
    auto epi = [=](int row, int tn, int cc, float v, float) { const int col = tn * 128 + cc, b = row >> 12;
        HL[(size_t)row * 1024 + col] = X[(size_t)row * 1024 + col] + MOD[b * 6144 + 2048 + col] * v; };
#if PG8_MASK & 2
    (void)bsel; (void)epi;
    SchedOut S{(const char*)YX, (const char*)WoutT, C.G, C.bid}; EpiOut E{X, MOD, HL};
    pg8::gemm_phase<EpiOut, SchedOut, false, true>((lds_ptr_t)C.lds, 2048, S, E);
#else
    gemm_simple<false>(C, YX, 2048, T_LAT / 128, 1024 / 128, 2048, bsel, epi);
#endif
}

__device__ __forceinline__ void phase7(Ctx& C) {
    lds_ptr_t L = (lds_ptr_t)C.lds;
    constexpr int TS = 260, WSD = 48;
    constexpr int T_O = 0, W_O = 64 * TS * 4, LG_O = W_O + 256 * WSD * 4, CNT_O = LG_O + 2 * 64 * 48 * 4;
    LASQ float* Ts = (LASQ float*)(L + T_O); LASQ float* Wsm = (LASQ float*)(L + W_O); LASQ float* LG = (LASQ float*)(L + LG_O); LASQ unsigned* lcnt = (LASQ unsigned*)(L + CNT_O);
    const float* MOD = (const float*)(C.ws + WS_MOD); const float* HL = C.out; bf16_t* XN2 = (bf16_t*)(C.ws + WS_XN2);
    int* GL = (int*)(C.ws + WS_GL); float* GLW = (float*)(C.ws + WS_GLW);
    const float* wg = C.in[I_RGW]; const float* we = C.in[I_REW]; const float* nffn = C.in[I_NFFN]; const float* rgb = C.in[I_RGB]; const float* reb = C.in[I_REB];
    const int tid = C.tid, w = C.wave, ln = C.lane;
    for (int grp = C.bid; grp < T_LAT / 64; grp += C.G) {
        const int lbase = grp * 64, b = lbase >> 12;
        __syncthreads();
        if (tid < 32) lcnt[tid] = 0u;
        for (int i = tid; i < 256 * 12; i += NTHREADS) Wsm[(i / 12) * WSD + 36 + (i % 12)] = 0.f;
        f32x4 t[8][4];
        {
            float ss[8];
#pragma unroll
            for (int r = 0; r < 8; ++r) { const int l = lbase + w * 8 + r; ss[r] = 0.f;
#pragma unroll
                for (int j = 0; j < 4; ++j) { t[r][j] = *(const f32x4*)(HL + (size_t)l * DM + j * 256 + ln * 4); ss[r] += t[r][j].x * t[r][j].x + t[r][j].y * t[r][j].y + t[r][j].z * t[r][j].z + t[r][j].w * t[r][j].w; } }
#pragma unroll
            for (int o = 1; o < 64; o <<= 1) {
#pragma unroll
                for (int r = 0; r < 8; ++r) ss[r] += __shfl_xor(ss[r], o); }
#pragma unroll
            for (int r = 0; r < 8; ++r) ss[r] = rsqrtf(ss[r] * (1.f / DM) + EPS);
#pragma unroll
            for (int j = 0; j < 4; ++j) { const int c0 = j * 256 + ln * 4;
                const f32x4 gq = *(const f32x4*)(nffn + c0), sh = *(const f32x4*)(MOD + b * 6144 + 3072 + c0); f32x4 scl = *(const f32x4*)(MOD + b * 6144 + 4096 + c0);
                scl = gq * (1.f + scl);
#pragma unroll
                for (int r = 0; r < 8; ++r) { const int l = lbase + w * 8 + r; t[r][j] = t[r][j] * ss[r] * scl + sh;
                    u32x2 o; o.x = pk2(t[r][j].x, t[r][j].y); o.y = pk2(t[r][j].z, t[r][j].w); *(u32x2*)(XN2 + (size_t)l * DM + c0) = o; }
                asm volatile("" ::: "memory"); }
        }
        const int rt = w & 3, kh = w >> 2, ar = ln & 15, kq = ln >> 4;
        f32x4 acc[3];
#pragma unroll
        for (int ct = 0; ct < 3; ++ct) acc[ct] = (f32x4){0.f, 0.f, 0.f, 0.f};
#pragma unroll
        for (int j = 0; j < 4; ++j) {
            __syncthreads();
#pragma unroll
            for (int r = 0; r < 8; ++r) *(LASQ f32x4*)(Ts + (w * 8 + r) * TS + ln * 4) = t[r][j];
            { const int k = tid >> 1, hf = tid & 1; const float* src = we + (size_t)(j * 256 + k) * 32 + hf * 16;
#pragma unroll
                for (int i4 = 0; i4 < 4; ++i4) *(LASQ f32x4*)(Wsm + k * WSD + hf * 16 + i4 * 4) = *(const f32x4*)(src + i4 * 4);
                if (hf == 0) *(LASQ f32x4*)(Wsm + k * WSD + 32) = *(const f32x4*)(wg + (size_t)(j * 256 + k) * 4); }
            __syncthreads();
#pragma unroll 8
            for (int ks = 0; ks < 32; ++ks) { const int k0 = kh * 128 + ks * 4;
                const float av = Ts[(rt * 16 + ar) * TS + k0 + kq];
#pragma unroll
                for (int ct = 0; ct < 3; ++ct) { const float bv = Wsm[(k0 + kq) * WSD + ct * 16 + ar]; acc[ct] = __builtin_amdgcn_mfma_f32_16x16x4f32(av, bv, acc[ct], 0, 0, 0); } }
        }
#pragma unroll
        for (int ct = 0; ct < 3; ++ct)
#pragma unroll
            for (int r = 0; r < 4; ++r) LG[(kh * 64 + rt * 16 + kq * 4 + r) * 48 + ct * 16 + ar] = acc[ct][r];
        __syncthreads();
        if (tid < 64) {
            const int l = lbase + tid; const LASQ float* g0 = LG + tid * 48; const LASQ float* g1 = LG + (64 + tid) * 48;
            float gl[4]; int gs = 0; float gm = -3.4e38f;
#pragma unroll
            for (int o = 0; o < 4; ++o) { gl[o] = g0[32 + o] + g1[32 + o] + rgb[o]; if (gl[o] > gm) { gm = gl[o]; gs = o; } }
            float den = 0.f;
#pragma unroll
            for (int o = 0; o < 4; ++o) den += __expf(gl[o] - gm);
            const float pg = 1.f / den;
            int i1 = 0, i2 = 0; float v1 = -3.4e38f, v2 = -3.4e38f;
#pragma unroll
            for (int o = 0; o < 8; ++o) { const float e = g0[gs * 8 + o] + g1[gs * 8 + o] + reb[gs * 8 + o];
                if (e > v1) { v2 = v1; i2 = i1; v1 = e; i1 = o; } else if (e > v2) { v2 = e; i2 = o; } }
            const float e2 = __expf(v2 - v1), w1 = pg / (1.f + e2), w2 = pg * e2 / (1.f + e2);
            const int ex1 = gs * 8 + i1, ex2 = gs * 8 + i2;
            const unsigned p1 = atomicAdd((unsigned*)(lcnt + ex1), 1u), p2 = atomicAdd((unsigned*)(lcnt + ex2), 1u);
            GL[(grp * 32 + ex1) * 64 + p1] = l * 2; GL[(grp * 32 + ex2) * 64 + p2] = l * 2 + 1; GLW[(grp * 32 + ex1) * 64 + p1] = w1; GLW[(grp * 32 + ex2) * 64 + p2] = w2;
        }
        __syncthreads();
        if (tid < 32) ((unsigned*)(C.ws + WS_CTL) + CW_BLK)[grp * 32 + tid] = lcnt[tid];
    }
}

__device__ __forceinline__ void moe_offsets(Ctx& C, int* off, int* tmp, int* blkbase) {
    const unsigned* BLK = (const unsigned*)(C.ws + WS_CTL) + CW_BLK;
    const int e = C.tid & 31, ch = C.tid >> 5;
    const int per = 16; int sacc = 0;
    for (int i = 0; i < per; ++i) { const int b = ch * per + i; { const int v = (int)BLK[b * 32 + e]; if (blkbase) blkbase[b * 32 + e] = sacc; sacc += v; } }
    tmp[ch * 32 + e] = sacc;
    __syncthreads();
    if (C.tid < 32) { int run = 0; for (int c2 = 0; c2 < 16; ++c2) { const int v = tmp[c2 * 32 + C.tid]; tmp[c2 * 32 + C.tid] = run; run += v; } off[64 + C.tid] = run; }
    __syncthreads();
    if (C.tid == 0) { int o = 0; for (int x = 0; x < 32; ++x) { const int t = off[64 + x]; off[x] = o; o += (t + 255) & ~255; } off[32] = o; }
    if (blkbase) { const int add = tmp[ch * 32 + e]; for (int i = 0; i < per; ++i) { const int b = ch * per + i; blkbase[b * 32 + e] += add; } }
    __syncthreads();
}

__device__ __forceinline__ void moe_tile_table(Ctx& C, const int* off, int* tile_e) {
    const int NT = off[32] >> 8;
    for (int t = C.tid; t < NT; t += NTHREADS) { int e = 0; for (int i = 1; i < 32; ++i) if (off[i] <= t * 256) e = i; tile_e[t] = e; }
    __syncthreads();
}

__device__ __forceinline__ void moe_slot_caches(Ctx& C, const int* off, const int* blkbase, const int* tile_e, const int (&pmr)[4], int* pcache, float* wcache) {
    const int* GL = (const int*)(C.ws + WS_GL); const float* GLW = (const float*)(C.ws + WS_GLW);
    for (int x = C.tid; x < 4 * 256; x += NTHREADS) { const int i = x >> 8, t = x & 255; int pv = -1; float wv = 0.f;
        const int pm = i == 0 ? pmr[0] : i == 1 ? pmr[1] : i == 2 ? pmr[2] : pmr[3];
        if (pm >= 0) { const int e = tile_e[pm], r = pm * 256 + t - off[e];
            if (r < off[64 + e]) { int lo = 0, hi = 256;
                while (hi - lo > 1) { const int mid = (lo + hi) >> 1; if (blkbase[mid * 32 + e] <= r) lo = mid; else hi = mid; }
                const int idx = (lo * 32 + e) * 64 + r - blkbase[lo * 32 + e]; pv = GL[idx]; wv = GLW[idx]; } }
        pcache[x] = pv; if (wcache) wcache[x] = wv; }
    __syncthreads();
}
__device__ __forceinline__ void phase8(Ctx& C) {
    int* off = (int*)C.lds; int* blkbase = off + 1024; moe_offsets(C, off, off + 256, blkbase);
    const int* PE = (const int*)(C.ws + WS_PAIR); const int* PP = PE + 32768; const float* PW = (const float*)(PP + 32768); int* SL = (int*)(PW + 32768); float* SW = (float*)(SL + 32768);
    int* LIST = (int*)(C.ws + WS_LIST);
    for (int p = C.bid * NTHREADS + C.tid; p < 32768; p += C.G * NTHREADS) {
        const int ex = PE[p]; const int slot = off[ex] + blkbase[(p >> 7) * 32 + ex] + PP[p];
        SL[p] = slot; SW[slot] = PW[p]; LIST[slot] = p >> 1;
    }
}

__device__ __forceinline__ void phase9(Ctx& C) {
    int* off = (int*)(C.lds + CTRL_OFF + 1024); int* blkbase = (int*)(C.lds + 4096); moe_offsets(C, off, (int*)C.lds, blkbase);
    bf16_t* H = (bf16_t*)(C.ws + WS_H);
    int* tile_e = off + 128; moe_tile_table(C, off, tile_e);
    int* lcache = (int*)(C.lds + 131072);
    SchedMoe<true> S{(const char*)(C.ws + WS_XN2), C.ws, tile_e, lcache, off[32] >> 8, C.G, C.bid, 1024}; EpiUp E{H};
    int pmr[4] = {-1, -1, -1, -1}; { pg8::Unit u;
#pragma unroll
        for (int i = 0; i < 4; ++i) if (S.next(i, u)) pmr[i] = u.pm; }
    moe_slot_caches(C, off, blkbase, tile_e, pmr, lcache, nullptr);
    for (int x = C.tid; x < 4 * 256; x += NTHREADS) { const int pv = lcache[x]; lcache[x] = pv < 0 ? 0 : (pv >> 1); }
    __syncthreads();
    pg8::gemm_phase<EpiUp, SchedMoe<true>, true, true>((lds_ptr_t)C.lds, 1024, S, E);
}

__device__ __forceinline__ void phase10(Ctx& C) {
    int* off = (int*)(C.lds + CTRL_OFF + 1024); int* blkbase = (int*)(C.lds + 4096); moe_offsets(C, off, (int*)C.lds, blkbase);
    const bf16_t* H = (const bf16_t*)(C.ws + WS_H); bf16_t* Y = (bf16_t*)(C.ws + WS_Y);
    int* tile_e = off + 128; moe_tile_table(C, off, tile_e);
    int* pcache = (int*)(C.lds + 131072); float* wcache = (float*)(C.lds + 131072 + 4096);
    SchedMoe<false> S{(const char*)H, C.ws, tile_e, nullptr, off[32] >> 8, C.G, C.bid, 512}; EpiDown E{Y, pcache, wcache};
    int pmr[4] = {-1, -1, -1, -1}; { pg8::Unit u;
#pragma unroll
        for (int i = 0; i < 4; ++i) if (S.next(i, u)) pmr[i] = u.pm; }
    moe_slot_caches(C, off, blkbase, tile_e, pmr, pcache, wcache);
    pg8::gemm_phase<EpiDown, SchedMoe<false>, true, true>((lds_ptr_t)C.lds, 512, S, E);
}

__device__ __forceinline__ void phase11(Ctx& C) {
    const int gw = C.bid * 8 + C.wave, NGW = C.G * 8;
    const float* MOD = (const float*)(C.ws + WS_MOD); float* HL = C.out; const bf16_t* Y = (const bf16_t*)(C.ws + WS_Y);
    const float* fnorm = C.in[I_FNORM];
    constexpr int NR = 2;
    for (int l0 = gw; l0 < T_LAT; l0 += NGW * NR) {
        f32x4 hv[NR][4]; u16x4 ya[NR][4], yb[NR][4]; float ss[NR];
#pragma unroll
        for (int u = 0; u < NR; ++u) { const int l = l0 + u * NGW; ss[u] = 0.f; if (l < T_LAT) { const int s1 = l * 2, s2 = l * 2 + 1;
#pragma unroll
            for (int j = 0; j < 4; ++j) { const int c0 = j * 256 + C.lane * 4; hv[u][j] = *(const f32x4*)(HL + (size_t)l * DM + c0);
                ya[u][j] = *(const u16x4*)(Y + (size_t)s1 * DM + c0); yb[u][j] = *(const u16x4*)(Y + (size_t)s2 * DM + c0); } } }
#pragma unroll
        for (int u = 0; u < NR; ++u) { const int l = l0 + u * NGW; if (l < T_LAT) { const int b = l >> 12;
#pragma unroll
            for (int j = 0; j < 4; ++j) { const int c0 = j * 256 + C.lane * 4; const f32x4 g2 = *(const f32x4*)(MOD + b * 6144 + 5120 + c0);
                f32x4 m; m.x = bf2f(ya[u][j][0]) + bf2f(yb[u][j][0]); m.y = bf2f(ya[u][j][1]) + bf2f(yb[u][j][1]); m.z = bf2f(ya[u][j][2]) + bf2f(yb[u][j][2]); m.w = bf2f(ya[u][j][3]) + bf2f(yb[u][j][3]);
                hv[u][j] = hv[u][j] + g2 * m; ss[u] += hv[u][j].x * hv[u][j].x + hv[u][j].y * hv[u][j].y + hv[u][j].z * hv[u][j].z + hv[u][j].w * hv[u][j].w; } } }
#pragma unroll
        for (int o = 1; o < 64; o <<= 1) {
#pragma unroll
            for (int u = 0; u < NR; ++u) ss[u] += __shfl_xor(ss[u], o); }
#pragma unroll
        for (int u = 0; u < NR; ++u) { const int l = l0 + u * NGW; if (l < T_LAT) { const float rs = rsqrtf(ss[u] * (1.f / DM) + EPS);
#pragma unroll
            for (int j = 0; j < 4; ++j) { const int c0 = j * 256 + C.lane * 4; const f32x4 fn = *(const f32x4*)(fnorm + c0);
                *(f32x4*)(HL + (size_t)l * DM + c0) = hv[u][j] * rs * fn; } } }
    }
}

#define LAS __attribute__((address_space(3)))
#define XB_TMO      128
#define XB_XCNT(j)  (256  + 64 * (j))
#define XB_XSUB(j)  (1280 + 64 * (j))
#define XB_XGEN(j)  (2304 + 64 * (j))
#define XB_TOP      3328
#define XB_TOPGEN   3392
#define XCD_BAR_WORDS 3456
#define XB_SPIN_CAP (1u << 18)

__device__ __forceinline__ unsigned xb_ld(unsigned* p)              { return __hip_atomic_load(p, __ATOMIC_RELAXED, __HIP_MEMORY_SCOPE_AGENT); }
__device__ __forceinline__ unsigned xb_add(unsigned* p, unsigned v) { return __hip_atomic_fetch_add(p, v, __ATOMIC_RELAXED, __HIP_MEMORY_SCOPE_AGENT); }
__device__ __forceinline__ unsigned xb_xcc_id() { return (unsigned)__builtin_amdgcn_s_getreg((3 << 11) | 20) & 0xFu; }
#define XB_SPIN(cond, bar) do { unsigned _sp = 0; while (cond) { __builtin_amdgcn_s_sleep(1); \
    if ((++_sp & 255u) == 0u) { if (xb_ld(&(bar)[XB_TMO])) break; if (_sp > XB_SPIN_CAP) { atomicAdd(&(bar)[XB_TMO], 1u); break; } } } } while (0)

struct XcdBarrier {
    unsigned* bar; unsigned x;
    volatile LAS unsigned* st;
};

__device__ __forceinline__ XcdBarrier xcd_barrier_post(unsigned* bar, volatile LAS unsigned* st) {
    XcdBarrier b; b.bar = bar; b.x = xb_xcc_id(); b.st = st;
    if (threadIdx.x == 0) (void)xb_add(&bar[XB_XCNT(b.x)], 1u);
    return b;
}
__device__ __forceinline__ void xcd_barrier_complete(unsigned* bar, unsigned x, unsigned& nloc, unsigned& nx) {
    const unsigned G = gridDim.x * gridDim.y * gridDim.z;
    unsigned sum, cnt, mine, sp = 0u;
    for (;;) {
        sum = 0u; cnt = 0u; mine = 0u;
#pragma unroll
        for (unsigned j = 0; j < 16; ++j) { const unsigned c = xb_ld(&bar[XB_XCNT(j)]); sum += c; cnt += (c > 0u) ? 1u : 0u; mine = (j == x) ? c : mine; }
        if (sum == G) break;
        __builtin_amdgcn_s_sleep(1);
        if ((++sp & 255u) == 0u) { if (xb_ld(&bar[XB_TMO])) break; if (sp > XB_SPIN_CAP) { atomicAdd(&bar[XB_TMO], 1u); break; } }
    }
    nloc = mine > 0u ? mine : 1u; nx = cnt > 0u ? cnt : 1u;
}

__device__ __forceinline__ void xcd_barrier(const XcdBarrier& b) {
    asm volatile("s_waitcnt vmcnt(0)" ::: "memory");
    __syncthreads();
    if (threadIdx.x == 0) {
        unsigned* bar = b.bar;
        __builtin_amdgcn_s_waitcnt(0);
        unsigned nloc = b.st[0], nx = b.st[1];
        if (nloc == 0u) { xcd_barrier_complete(bar, b.x, nloc, nx); b.st[0] = nloc; b.st[1] = nx; }
        const unsigned old = xb_add(&bar[XB_XSUB(b.x)], 1u);
        const unsigned gen = old / nloc;
        if (old + 1u == (gen + 1u) * nloc) {
            __builtin_amdgcn_fence(__ATOMIC_RELEASE, "agent");
            asm volatile("s_waitcnt vmcnt(0)" ::: "memory");
            const unsigned og = xb_add(&bar[XB_TOP], 1u);
            const unsigned tg = og / nx;
            if (og + 1u == (tg + 1u) * nx) xb_add(&bar[XB_TOPGEN], 1u);
            else XB_SPIN(xb_ld(&bar[XB_TOPGEN]) == tg, bar);
            __builtin_amdgcn_fence(__ATOMIC_ACQUIRE, "agent");
            xb_add(&bar[XB_XGEN(b.x)], 1u);
            asm volatile("s_waitcnt vmcnt(0)" ::: "memory");
        } else {
            XB_SPIN(xb_ld(&bar[XB_XGEN(b.x)]) == gen, bar);
            __builtin_amdgcn_fence(__ATOMIC_ACQUIRE, "agent");
            asm volatile("s_waitcnt vmcnt(0)" ::: "memory");
        }
    }
    __syncthreads();
}

__global__ void __launch_bounds__(NTHREADS, 2) fwd_kernel(Args a) {
    extern __shared__ __attribute__((aligned(16))) unsigned char lds[];
    Ctx C;
    if (threadIdx.x == 0) {
#pragma unroll
        for (int i = 0; i < 27; ++i) *(__attribute__((address_space(3))) unsigned long long*)((__attribute__((address_space(3))) unsigned char*)lds + PTAB_OFF + 8 * i) = (unsigned long long)a.in[i];
    }
    C.in.lds = lds; C.out = a.out; C.ws = a.ws; C.lds = lds;
    __syncthreads();
    C.tid = threadIdx.x; C.lane = C.tid & 63; C.wave = __builtin_amdgcn_readfirstlane(C.tid >> 6); C.bid = blockIdx.x; C.G = gridDim.x;
#if MK_COOP
    cg::grid_group grid = cg::this_grid();
    if (C.tid < 2) ((LAS unsigned*)(lds + CTRL_OFF + 64))[C.tid] = 0u;
    __syncthreads();
    XcdBarrier xbar = xcd_barrier_post((unsigned*)(C.ws + WS_CTL) + CW_BAR, (volatile LAS unsigned*)(lds + CTRL_OFF + 64));
#ifndef CG_SEAM0
#define CG_SEAM0 0
#endif
#define SEAM(k) do { if ((k) + 1 < a.ph_hi) { if (CG_SEAM0 && (k) == 0) grid.sync(); else xcd_barrier(xbar); } } while (0)
#else
#define SEAM(k) do { } while (0)
#endif
#define IN(k) (a.ph_lo <= (k) && (k) < a.ph_hi)
#ifndef PROBE_K
#define PROBE_K -1
#endif
    unsigned long long tprev = 0ull; float pdur = 0.f;
    if (PROBE_K >= 0 && blockIdx.x == 0 && threadIdx.x == 0) tprev = __builtin_amdgcn_s_memrealtime();
#define STAMP(k) do { if (PROBE_K >= 0 && blockIdx.x == 0 && threadIdx.x == 0) { const unsigned long long tn = __builtin_amdgcn_s_memrealtime(); if ((k) == PROBE_K) pdur = (float)(tn - tprev) * 0.01f; tprev = tn; } } while (0)
    if (IN(0)) { phase0(C); SEAM(0); STAMP(0); }
    if (IN(1)) { phase1(C); SEAM(1); STAMP(1); }
    if (IN(2)) { phase2(C); SEAM(2); STAMP(2); }
    if (IN(3)) { phase3(C, 1); STAMP(30); phase3(C, 2); STAMP(31); phase3(C, 4); SEAM(3); STAMP(3); }
#ifdef SCAN_NAIVE
    if (IN(4)) { phase4_naive(C); SEAM(4); STAMP(4); }
#else
    if (IN(4)) { phase4(C); SEAM(4); STAMP(4); }
#endif
    if (IN(5)) { phase5(C); SEAM(5); STAMP(5); }
    if (IN(6)) { phase6(C); SEAM(6); STAMP(6); }
    if (IN(7)) { phase7(C); SEAM(7); STAMP(7); }
    if (IN(9)) { phase9(C); SEAM(9); STAMP(9); }
    if (IN(10)) { phase10(C); SEAM(10); STAMP(10); }
    if (IN(11)) { phase11(C); STAMP(11); }
    if (PROBE_K >= 0 && blockIdx.x == 0 && threadIdx.x == 0) { asm volatile("s_waitcnt vmcnt(0)" ::: "memory"); a.out[0] += sqrtf(16.78f * pdur); }
}

extern "C" void kernel_launch(void* const* d_in, const int* in_sizes, int n_in, void* d_out, int out_size, void* d_ws, size_t ws_size, hipStream_t stream) {
    static int grid = 0;
    if (grid == 0) {
        if (n_in != 27 || out_size != T_LAT * DM || ws_size < WS_END) { fprintf(stderr, "kernel_launch: unexpected shapes: n_in %d out %d ws %zu (need %zu)\n", n_in, out_size, ws_size, (size_t)WS_END); grid = -1; return; }
        int dev = 0, cus = 0, per_cu = 0;
        hipGetDevice(&dev); hipDeviceGetAttribute(&cus, hipDeviceAttributeMultiprocessorCount, dev);
        hipFuncSetAttribute((const void*)fwd_kernel, hipFuncAttributeMaxDynamicSharedMemorySize, LDS_BYTES);
        hipOccupancyMaxActiveBlocksPerMultiprocessor(&per_cu, (const void*)fwd_kernel, NTHREADS, LDS_BYTES);
        if (per_cu < 1) { fprintf(stderr, "kernel_launch: occupancy query says %d blocks per CU\n", per_cu); per_cu = 1; }
        (void)hipGetLastError();
        grid = cus;
        fprintf(stderr, "kernel_launch: grid %d, per_cu %d, ws %zu\n", grid, per_cu, ws_size);
    }
    if (grid < 0) return;
    hipMemsetAsync((char*)d_ws + WS_CTL, 0, CTL_BYTES, stream);
    Args a{};
    for (int i = 0; i < 27; ++i) a.in[i] = (const float*)d_in[i];
    a.out = (float*)d_out; a.ws = (unsigned char*)d_ws;
#if MK_COOP
    a.ph_lo = 0; a.ph_hi = NPH;
    void* args[] = {&a};
    hipError_t e = hipLaunchCooperativeKernel((const void*)fwd_kernel, dim3(grid), dim3(NTHREADS), args, LDS_BYTES, stream);
    if (e != hipSuccess) fprintf(stderr, "cooperative launch failed: %s (grid %d)\n", hipGetErrorString(e), grid);
#else
    for (int p = 0; p < NPH; ++p) { a.ph_lo = p; a.ph_hi = p + 1; hipLaunchKernelGGL(fwd_kernel, dim3(grid), dim3(NTHREADS), LDS_BYTES, stream, a); }
#endif
}
```

```cpp
#include <hip/hip_runtime.h>
#include <hip/hip_cooperative_groups.h>
#include <cstdio>
#include <cstdint>
namespace cg = cooperative_groups;

#ifndef MK_COOP
#define MK_COOP 1
#endif

constexpr int NB = 4, SEQ = 4096, DM = 1024, CTXL = 256;
constexpr int T_CTX = NB * CTXL, T_LAT = NB * SEQ, T_ALL = T_CTX + T_LAT;
constexpr float EPS = 1e-6f;
constexpr int NW_IN = 5888;
constexpr int NPH = 12;
constexpr int NTHREADS = 512;
constexpr int LDS_BYTES = 147456;

typedef unsigned short bf16_t;
typedef float f32x4 __attribute__((ext_vector_type(4)));
typedef unsigned u32x4 __attribute__((ext_vector_type(4)));
typedef unsigned u32x2 __attribute__((ext_vector_type(2)));
typedef unsigned short u16x8 __attribute__((ext_vector_type(8)));
typedef unsigned short u16x4 __attribute__((ext_vector_type(4)));
#define LASQ __attribute__((address_space(3)))
typedef __attribute__((address_space(3))) unsigned char* lds_ptr_t;

constexpr size_t MiB = 1u << 20;
constexpr size_t WS_QK = 0;
constexpr size_t WS_XBC = 34 * MiB;
constexpr size_t WS_OB = 34 * MiB;
constexpr size_t WS_QKF = 85 * MiB;
constexpr size_t WS_XN = 85 * MiB;
constexpr size_t WS_YX = 85 * MiB;
constexpr size_t WS_V = 119 * MiB;
constexpr size_t WS_XC = 153 * MiB;
constexpr size_t WS_WINT = 153 * MiB;
constexpr size_t WS_RZ = 204 * MiB;
constexpr size_t WS_XN2 = 204 * MiB;
constexpr size_t WS_YB = 268 * MiB;
constexpr size_t WS_GDT = 300 * MiB;
constexpr size_t WS_WOUTT = 305 * MiB;
constexpr size_t WS_MOD = 309 * MiB;
constexpr size_t WS_GLAD = WS_MOD + 256 * 1024;
constexpr size_t WS_CTL = 311 * MiB;
constexpr size_t CTL_BYTES = 64 * 1024;
constexpr size_t WS_PAIR = WS_GLAD + 1088 * 1024;
constexpr size_t WS_ACUM = 311 * MiB + 64 * 1024;
constexpr size_t WS_LIST = WS_ACUM + (size_t)T_ALL * 32 * 4;
constexpr size_t WS_END = WS_LIST + 40960 * 4;
constexpr size_t WS_WDT = 0;
constexpr size_t WS_WGU_LO = 34 * MiB;
constexpr size_t WS_WGU_HI = 268 * MiB;
constexpr size_t WS_H = 66 * MiB;
constexpr size_t WS_XN2S = 106 * MiB;
constexpr size_t WS_Y = 106 * MiB;
constexpr int MAX_SLOTS = 40960;
constexpr size_t WS_GL = 176 * MiB;
constexpr size_t WS_GLW = 178 * MiB;
constexpr int CW_CNT = 0;
constexpr int CW_BLK = 8192;
constexpr int CW_BAR = 1024;

__device__ __forceinline__ float bf2f(bf16_t v) { return __uint_as_float((unsigned)v << 16); }
__device__ __forceinline__ unsigned f2bf(float f) { unsigned u = __float_as_uint(f); return (u + 0x7fffu + ((u >> 16) & 1u)) >> 16; }
typedef float f32x2 __attribute__((ext_vector_type(2)));
typedef __bf16 bf16x2_t __attribute__((ext_vector_type(2)));
__device__ __forceinline__ unsigned pk2(float lo, float hi) { const f32x2 v = {lo, hi}; return __builtin_bit_cast(unsigned, __builtin_convertvector(v, bf16x2_t)); }
__device__ __forceinline__ float siluf(float x) { return x / (1.f + __expf(-x)); }
__device__ __forceinline__ float softplusf(float x) { return fmaxf(x, 0.f) + log1pf(__expf(-fabsf(x))); }
__device__ __forceinline__ float logsigf(float x) { return fminf(x, 0.f) - log1pf(__expf(-fabsf(x))); }
__device__ __forceinline__ float logsig_fast(float x) { return fminf(x, 0.f) - 0.6931471805599453f * __builtin_amdgcn_logf(1.f + __builtin_amdgcn_exp2f(-1.4426950408889634f * fabsf(x))); }
__device__ __forceinline__ float wave_sum(float v) {
#pragma unroll
    for (int o = 1; o < 64; o <<= 1) v += __shfl_xor(v, o);
    return v;
}

struct Args { const float* in[27]; float* out; unsigned char* ws; int ph_lo, ph_hi; };
enum { I_X = 0, I_C, I_CTX, I_CCTX, I_WADA, I_BADA, I_NMIX, I_NFFN, I_WIN, I_GWUP, I_GB, I_GNORM, I_CONVW, I_CONVB, I_DTB, I_ALOG, I_SSDD, I_SSDN,
       I_WOUT, I_RGW, I_RGB, I_REW, I_REB, I_EWG, I_EWU, I_EWD, I_FNORM };

constexpr int CTRL_OFF = LDS_BYTES - 4096;
constexpr int PTAB_OFF = CTRL_OFF + 128;
struct InTab {
    unsigned char* lds;
    __device__ __forceinline__ const float* operator[](int i) const {
        const unsigned long long v = *(const __attribute__((address_space(3))) unsigned long long*)((__attribute__((address_space(3))) unsigned char*)lds + PTAB_OFF + 8 * i);
        const unsigned lo = __builtin_amdgcn_readfirstlane((unsigned)v), hi = __builtin_amdgcn_readfirstlane((unsigned)(v >> 32));
        return (const float*)(const __attribute__((address_space(1))) float*)(((unsigned long long)hi << 32) | lo);
    }
};
struct Ctx {
    InTab in; float* out; unsigned char* ws; unsigned char* lds;
    int tid, lane, wave, bid, G;
};

__device__ __forceinline__ void transpose_tile(const float* src  , int ldw, bf16_t* dst  , int ldt, float* scr, int lane, bool zero) {
    f32x4 v[8];
#pragma unroll
    for (int i = 0; i < 8; ++i) { const int kk = 8 * i + (lane >> 3); v[i] = zero ? (f32x4){0.f, 0.f, 0.f, 0.f} : *(const f32x4*)(src + (size_t)kk * ldw + (lane & 7) * 4); }
#pragma unroll
    for (int i = 0; i < 8; ++i) { const int kk = 8 * i + (lane >> 3); float* d = scr + kk * 33 + (lane & 7) * 4; d[0] = v[i].x; d[1] = v[i].y; d[2] = v[i].z; d[3] = v[i].w; }
    asm volatile("s_waitcnt lgkmcnt(0)" ::: "memory");
    const int c = lane & 7;
#pragma unroll
    for (int j = 0; j < 4; ++j) { const int n = (lane >> 3) + 8 * j; const float* s = scr + (8 * c) * 33 + n;
        u32x4 o; o.x = pk2(s[0 * 33], s[1 * 33]); o.y = pk2(s[2 * 33], s[3 * 33]); o.z = pk2(s[4 * 33], s[5 * 33]); o.w = pk2(s[6 * 33], s[7 * 33]);
        *(u32x4*)(dst + (size_t)n * ldt + 8 * c) = o; }
    asm volatile("s_waitcnt lgkmcnt(0)" ::: "memory");
}

__device__ __forceinline__ int win_src_col(int n) {
    if (n < 3072) return n;
    if (n < 4096) return 3104 + (n - 3072);
    if (n < 5632) return 4128 + (n - 4096);
    if (n < 5664) return 3072 + (n - 5632);
    if (n < 5696) return 5664 + (n - 5664);
    return -1;
}

__device__ __forceinline__ void phase0(Ctx& C) {
    float* lds = (float*)C.lds;
    for (int i = C.bid * NTHREADS + C.tid; i < MAX_SLOTS; i += C.G * NTHREADS) ((int*)(C.ws + WS_LIST))[i] = 0;
    float* sc = lds;
    for (int i = C.tid; i < 5 * 1024; i += NTHREADS) { const int r = i >> 10, k = i & 1023; const float v = r < 4 ? C.in[I_C][r * 1024 + k] : C.in[I_CCTX][k]; sc[i] = siluf(v); }
    __syncthreads();
    float* MOD = (float*)(C.ws + WS_MOD); const float* wada = C.in[I_WADA]; const float* bada = C.in[I_BADA];
    float* red = lds + 5120;
    for (int grp = C.bid; grp < 192; grp += C.G) {
        const int cg = C.tid & 7, ks = C.tid >> 3, col = grp * 32 + cg * 4;
        f32x4 w[16];
#pragma unroll
        for (int kk = 0; kk < 16; ++kk) w[kk] = *(const f32x4*)(wada + (size_t)(ks * 16 + kk) * 6144 + col);
        f32x4 acc[5];
#pragma unroll
        for (int i = 0; i < 5; ++i) acc[i] = (f32x4){0.f, 0.f, 0.f, 0.f};
#pragma unroll
        for (int kk = 0; kk < 16; ++kk)
#pragma unroll
            for (int i = 0; i < 5; ++i) acc[i] += w[kk] * sc[i * 1024 + ks * 16 + kk];
#pragma unroll
        for (int i = 0; i < 5; ++i) *(f32x4*)(red + (ks * 5 + i) * 32 + cg * 4) = acc[i];
        __syncthreads();
        if (C.tid < 160) { const int i = C.tid >> 5, c = C.tid & 31; float s = 0.f;
#pragma unroll 8
            for (int g = 0; g < 64; ++g) s += red[(g * 5 + i) * 32 + c];
            MOD[i * 6144 + grp * 32 + c] = s + bada[grp * 32 + c]; }
        __syncthreads();
    }
}

__device__ __forceinline__ const float* tok_row(const float* xin, const float* cin, int row, int& mi) {
    if (row < T_CTX) { mi = 4; return cin + (size_t)row * DM; }
    mi = (row - T_CTX) >> 12; return xin + (size_t)(row - T_CTX) * DM;
}

__device__ __forceinline__ void phase1(Ctx& C) {
    const int gw = C.bid * 8 + C.wave, NGW = C.G * 8;
    const float* MOD = (const float*)(C.ws + WS_MOD); bf16_t* XN = (bf16_t*)(C.ws + WS_XN);
    const float* xin = C.in[I_X]; const float* cin = C.in[I_CTX]; const float* nmix = C.in[I_NMIX];
    constexpr int NR = 4;
    for (int r0 = gw; r0 < T_ALL; r0 += NGW * NR) {
        f32x4 v[NR][4]; float ss[NR]; int mi[NR];
#pragma unroll
        for (int u = 0; u < NR; ++u) { const int row = r0 + u * NGW; ss[u] = 0.f; mi[u] = 0;
            if (row < T_ALL) { const float* xr = tok_row(xin, cin, row, mi[u]);
#pragma unroll
                for (int j = 0; j < 4; ++j) v[u][j] = *(const f32x4*)(xr + j * 256 + C.lane * 4); } }
#pragma unroll
        for (int u = 0; u < NR; ++u) { const int row = r0 + u * NGW;
            if (row < T_ALL) {
#pragma unroll
                for (int j = 0; j < 4; ++j) ss[u] += v[u][j].x * v[u][j].x + v[u][j].y * v[u][j].y + v[u][j].z * v[u][j].z + v[u][j].w * v[u][j].w; } }
#pragma unroll
        for (int o = 1; o < 64; o <<= 1) {
#pragma unroll
            for (int u = 0; u < NR; ++u) ss[u] += __shfl_xor(ss[u], o); }
#pragma unroll
        for (int u = 0; u < NR; ++u) { const int row = r0 + u * NGW;
            if (row < T_ALL) { const float rs = rsqrtf(ss[u] * (1.f / DM) + EPS);
#pragma unroll
                for (int j = 0; j < 4; ++j) { const int c0 = j * 256 + C.lane * 4;
                    const f32x4 g = *(const f32x4*)(nmix + c0), sh = *(const f32x4*)(MOD + mi[u] * 6144 + c0), scl = *(const f32x4*)(MOD + mi[u] * 6144 + 1024 + c0);
                    const f32x4 y = v[u][j] * rs * g * (1.f + scl) + sh;
                    u32x2 o; o.x = pk2(y.x, y.y); o.y = pk2(y.z, y.w); *(u32x2*)(XN + (size_t)row * DM + c0) = o; } } }
    }
    {
        float* scr = (float*)C.lds + C.wave * (64 * 33);
        bf16_t* WinT = (bf16_t*)(C.ws + WS_WINT); bf16_t* WoutT = (bf16_t*)(C.ws + WS_WOUTT);
        constexpr int IT_IN = 16 * (NW_IN / 32), IT_OUT = 32 * 32;
        for (int it = gw; it < IT_IN + IT_OUT; it += NGW) {
            if (it < IT_IN) { const int kb = it / (NW_IN / 32), nb = it % (NW_IN / 32); const int sc = win_src_col(nb * 32);
                transpose_tile(C.in[I_WIN] + (size_t)(kb * 64) * 5696 + (sc < 0 ? 0 : sc), 5696, WinT + (size_t)(nb * 32) * 1024 + kb * 64, 1024, scr, C.lane, sc < 0); }
            else { const int r = it - IT_IN, kb = r / 32, nb = r % 32;
                transpose_tile(C.in[I_WOUT] + (size_t)(kb * 64) * 1024 + nb * 32, 1024, WoutT + (size_t)(nb * 32) * 2048 + kb * 64, 2048, scr, C.lane, false); }
        }
    }
}

template <bool DUAL, class BSel, class Epi>
__device__ __forceinline__ void gemm_simple(Ctx& C, const bf16_t* A, int lda, int Mtiles, int Ntiles, int K, BSel bsel, Epi epi) {
    float* As = (float*)C.lds;
    float* Bs = As + 32 * 132;
    float* Bs2 = Bs + 32 * 132;
    const int ty = C.tid >> 4, tx = C.tid & 15;
    const int lr = C.tid >> 2, lk = (C.tid & 3) * 8;
    for (int tile = C.bid; tile < Mtiles * Ntiles; tile += C.G) {
        const int tm = tile / Ntiles, tn = tile % Ntiles;
        int ldb; const bf16_t* Bt = bsel(tm, tn, ldb);
        float acc[4][8], acc2[DUAL ? 4 : 1][8];
#pragma unroll
        for (int i = 0; i < 4; ++i)
#pragma unroll
            for (int j = 0; j < 8; ++j) { acc[i][j] = 0.f; if constexpr (DUAL) acc2[i][j] = 0.f; }
        const bf16_t* ap = A + (size_t)(tm * 128 + lr) * lda + lk;
        const bf16_t* bp = Bt + (size_t)lr * ldb + lk;
        for (int k0 = 0; k0 < K; k0 += 32) {
            const u16x8 av = *(const u16x8*)(ap + k0), bv = *(const u16x8*)(bp + k0);
            u16x8 bv2 = bv; if constexpr (DUAL) bv2 = *(const u16x8*)(bp + (size_t)128 * ldb + k0);
            __syncthreads();
#pragma unroll
            for (int j = 0; j < 8; ++j) { As[(lk + j) * 132 + lr] = bf2f(av[j]); Bs[(lk + j) * 132 + lr] = bf2f(bv[j]); if constexpr (DUAL) Bs2[(lk + j) * 132 + lr] = bf2f(bv2[j]); }
            __syncthreads();
#pragma unroll 8
            for (int k = 0; k < 32; ++k) {
                const f32x4 a = *(const f32x4*)(As + k * 132 + ty * 4);
                const f32x4 b0 = *(const f32x4*)(Bs + k * 132 + tx * 8), b1 = *(const f32x4*)(Bs + k * 132 + tx * 8 + 4);
                const float af[4] = {a.x, a.y, a.z, a.w}; const float bf[8] = {b0.x, b0.y, b0.z, b0.w, b1.x, b1.y, b1.z, b1.w};
#pragma unroll
                for (int i = 0; i < 4; ++i)
#pragma unroll
                    for (int j = 0; j < 8; ++j) acc[i][j] += af[i] * bf[j];
                if constexpr (DUAL) {
                    const f32x4 c0 = *(const f32x4*)(Bs2 + k * 132 + tx * 8), c1 = *(const f32x4*)(Bs2 + k * 132 + tx * 8 + 4);
                    const float cf[8] = {c0.x, c0.y, c0.z, c0.w, c1.x, c1.y, c1.z, c1.w};
#pragma unroll
                    for (int i = 0; i < 4; ++i)
#pragma unroll
                        for (int j = 0; j < 8; ++j) acc2[i][j] += af[i] * cf[j];
                }
            }
        }
#pragma unroll
        for (int i = 0; i < 4; ++i)
#pragma unroll
            for (int j = 0; j < 8; ++j) { float a2 = 0.f; if constexpr (DUAL) a2 = acc2[i][j]; epi(tm * 128 + ty * 4 + i, tn, tx * 8 + j, acc[i][j], a2); }
        __syncthreads();
    }
}


namespace pg8 {
#define PG8_LAS __attribute__((address_space(3)))
typedef short bf16x8 __attribute__((ext_vector_type(8)));
constexpr int BM = 256, BK = 64, HALF = 128, HTB = HALF * BK * 2  , STAGE_BYTES = 8 * HTB, NXCD = 8, WGM = 8;
__host__ __device__ __forceinline__ int lds_byte(int r, int c) { const int st = (r >> 4) * 2 + (c >> 5), rr = r & 15, cc = c & 31, ob = rr * 64 + cc * 2; return st * 1024 + (ob ^ (((ob >> 9) & 1) << 5)); }
__host__ __device__ __forceinline__ void stage_rc(int b, int& R, int& C) { const int st = b / 1024, sb = b % 1024, swz = sb ^ (((sb >> 9) & 1) << 5); R = (st >> 1) * 16 + swz / 64; C = (st & 1) * 32 + (swz % 64) / 2; }
__host__ __device__ __forceinline__ int perm32(int rho) { const int n = rho >> 4, i = rho & 15; return 8 * (i >> 2) + 4 * n + (i & 3); }
struct Unit { int pm, pn, rd; };
__device__ __forceinline__ unsigned cvt_pk_bf16(float lo, float hi) { unsigned r; asm volatile("v_cvt_pk_bf16_f32 %0, %1, %2" : "=v"(r) : "v"(lo), "v"(hi)); return r; }
__device__ __forceinline__ int xcd_remap(int L, int nwg) { const int q = nwg / NXCD, r = nwg % NXCD, xcd = L % NXCD, off = L / NXCD; return (xcd < r ? xcd * (q + 1) : r * (q + 1) + (xcd - r) * q) + off; }
template <class Epi, class Sched, bool ALIGN_EPI = false, bool SP2 = false>
__device__ __forceinline__ void gemm_phase(PG8_LAS unsigned char* lds, const int K_, const Sched& S, const Epi& E) {
    const int tid = threadIdx.x, wid = __builtin_amdgcn_readfirstlane(tid >> 6), lane = tid & 63, wr = wid >> 2, wc = wid & 3, fr = lane & 15, fq = lane >> 4;
    const int K = K_, nt = K / BK;
    unsigned voffA[2], voffB[2];
#pragma unroll
    for (int i = 0; i < 2; ++i) { int R, C; stage_rc(tid * 16 + i * 8192, R, C); const int Rb = Epi::PERM ? ((R & ~31) + perm32(R & 31)) : R;
        voffA[i] = (unsigned)(R * K + C) * 2u; voffB[i] = (unsigned)(Rb * K + C) * 2u; }
    int gR[2], gC[2];
#pragma unroll
    for (int i = 0; i < 2; ++i) stage_rc(tid * 16 + i * 8192, gR[i], gC[i]);
    unsigned vc0[2], vc1[2], vn0[2], vn1[2];
#pragma unroll
    for (int i = 0; i < 2; ++i) { vc0[i] = vc1[i] = vn0[i] = vn1[i] = voffA[i]; }
    const size_t kstep = (size_t)(BK * 2);
    const size_t hstep = (size_t)HALF * K * 2;
    const size_t hsA = Sched::GATHER ? 0 : hstep;
    const unsigned ldsw = (unsigned)wid * 1024u;
    const int aoff = lds_byte(wr * 64 + fr, fq * 8), boff = lds_byte(wc * 32 + fr, fq * 8);
#define PG8_SA(b, h) (((b) * 2 + (h)) * HTB)
#define PG8_SB(b, h) ((4 + (b) * 2 + (h)) * HTB)
#define PG8_STAGE(bufoff, gbase, voff) do { _Pragma("unroll") for (int _i = 0; _i < 2; ++_i) \
        __builtin_amdgcn_global_load_lds((const unsigned*)((const char*)(gbase) + (voff)[_i]), (PG8_LAS unsigned*)(lds + (bufoff) + ldsw + _i * 8192), 16, 0, 0); } while (0)
#define PG8_LDA(dst, b, h) do { _Pragma("unroll") for (int m = 0; m < 4; ++m) _Pragma("unroll") for (int k = 0; k < 2; ++k) dst[m][k] = *(const PG8_LAS bf16x8*)(lds + PG8_SA(b, h) + aoff + m * 2048 + k * 1024); } while (0)
#define PG8_LDB(dst, b, h) do { _Pragma("unroll") for (int n = 0; n < 2; ++n) _Pragma("unroll") for (int k = 0; k < 2; ++k) dst[n][k] = *(const PG8_LAS bf16x8*)(lds + PG8_SB(b, h) + boff + n * 2048 + k * 1024); } while (0)
#define PG8_MMA(ai, bj, At, Bt) do { __builtin_amdgcn_s_setprio(1); _Pragma("unroll") for (int m = 0; m < 4; ++m) _Pragma("unroll") for (int n = 0; n < 2; ++n) _Pragma("unroll") for (int k = 0; k < 2; ++k) \
        acc[ai][bj][m][n] = __builtin_amdgcn_mfma_f32_16x16x32_bf16(Bt[n][k], At[m][k], acc[ai][bj][m][n], 0, 0, 0); __builtin_amdgcn_s_setprio(0); } while (0)
#define PG8_WAIT_V(n) asm volatile("s_waitcnt vmcnt(" #n ")" ::: "memory")
#define PG8_WAIT_L(n) asm volatile("s_waitcnt lgkmcnt(" #n ")" ::: "memory")
#define PG8_BAR __builtin_amdgcn_s_barrier()
#define PG8_SCHED __builtin_amdgcn_sched_barrier(0)
    Unit cur, nxt; int ui = 0;
    if (!S.next(0, cur)) return;
    f32x4 acc[2][2][4][2];
#pragma unroll
    for (int a = 0; a < 2; ++a)
#pragma unroll
        for (int b = 0; b < 2; ++b)
#pragma unroll
            for (int m = 0; m < 4; ++m)
#pragma unroll
                for (int n = 0; n < 2; ++n) acc[a][b][m][n] = (f32x4){0.f, 0.f, 0.f, 0.f};
    bf16x8 At[4][2], B0[2][2], B1[2][2];
    const char* cA = S.a_ptr(cur); const char* cB = S.b_ptr(cur);
    if constexpr (Sched::GATHER) {
#pragma unroll
        for (int i = 0; i < 2; ++i) { vc0[i] = (unsigned)(S.a_row(0, gR[i]) * K + gC[i]) * 2u; vc1[i] = (unsigned)(S.a_row(0, 128 + gR[i]) * K + gC[i]) * 2u; } }
    S.a_ready(cur);
    if constexpr (SP2) {
        PG8_STAGE(PG8_SB(0, 0), cB, voffB); PG8_STAGE(PG8_SB(0, 1), cB + hstep, voffB); PG8_STAGE(PG8_SA(0, 0), cA, vc0); PG8_STAGE(PG8_SA(0, 1), cA + hsA, vc1);
        if (wr == 1) PG8_BAR;
        PG8_WAIT_V(2); PG8_BAR;
        PG8_STAGE(PG8_SB(1, 0), cB + kstep, voffB); PG8_STAGE(PG8_SA(1, 0), cA + kstep, vc0); PG8_STAGE(PG8_SB(1, 1), cB + hstep + kstep, voffB);
        PG8_WAIT_V(6); PG8_BAR;
    } else {
        PG8_STAGE(PG8_SB(0, 0), cB, voffB); PG8_STAGE(PG8_SA(0, 0), cA, vc0); PG8_STAGE(PG8_SB(0, 1), cB + hstep, voffB); PG8_STAGE(PG8_SA(0, 1), cA + hsA, vc1);
        if (wr == 1) PG8_BAR;
        PG8_WAIT_V(4); PG8_BAR;
        PG8_STAGE(PG8_SB(1, 0), cB + kstep, voffB); PG8_STAGE(PG8_SA(1, 0), cA + kstep, vc0); PG8_STAGE(PG8_SB(1, 1), cB + hstep + kstep, voffB);
        PG8_WAIT_V(6); PG8_BAR;
    }
    for (;;) {
        const bool has_next = S.next(ui + 1, nxt);
        if constexpr (Sched::GATHER) {
#pragma unroll
            for (int i = 0; i < 2; ++i) { vn0[i] = has_next ? (unsigned)(S.a_row(ui + 1, gR[i]) * K + gC[i]) * 2u : vc0[i]; vn1[i] = has_next ? (unsigned)(S.a_row(ui + 1, 128 + gR[i]) * K + gC[i]) * 2u : vc1[i]; } }
        const char* nA = has_next ? S.a_ptr(nxt) : cA; const char* nB = has_next ? S.b_ptr(nxt) : cB;
        for (int t = 0; t < nt; t += 2) {
            const bool last = (t == nt - 2);
            unsigned vs0[2], vs1[2];
#pragma unroll
            for (int i = 0; i < 2; ++i) { vs0[i] = (Sched::GATHER && last) ? vn0[i] : vc0[i]; vs1[i] = (Sched::GATHER && last) ? vn1[i] : vc1[i]; }
            const char* a1 = cA + (size_t)(t + 1) * kstep;
            const char* a2 = last ? nA : cA + (size_t)(t + 2) * kstep; const char* b2 = last ? nB : cB + (size_t)(t + 2) * kstep;
            const char* a3 = a2 + kstep; const char* b3 = b2 + kstep;
            if (last && has_next) S.a_ready(nxt);
            if constexpr (SP2) {
            PG8_LDB(B0, 0, 0); PG8_LDB(B1, 0, 1); PG8_SCHED; PG8_LDA(At, 0, 0); PG8_STAGE(PG8_SA(1, 1), a1 + hsA, vc1);
            PG8_WAIT_V(8); PG8_WAIT_L(0); PG8_BAR; PG8_MMA(0, 0, At, B0); PG8_MMA(0, 1, At, B1); PG8_BAR; PG8_SCHED;
            PG8_LDA(At, 0, 1); PG8_STAGE(PG8_SB(0, 0), b2, voffB); PG8_STAGE(PG8_SB(0, 1), b2 + hstep, voffB); PG8_STAGE(PG8_SA(0, 0), a2, vs0);
            PG8_WAIT_V(8); PG8_WAIT_L(0); PG8_BAR; PG8_MMA(1, 0, At, B0); PG8_MMA(1, 1, At, B1); PG8_BAR; PG8_SCHED;
            PG8_LDB(B0, 1, 0); PG8_LDB(B1, 1, 1); PG8_SCHED; PG8_LDA(At, 1, 0); PG8_STAGE(PG8_SA(0, 1), a2 + hsA, vs1);
            PG8_WAIT_V(8); PG8_WAIT_L(0); PG8_BAR; PG8_MMA(0, 0, At, B0); PG8_MMA(0, 1, At, B1); PG8_BAR; PG8_SCHED;
            PG8_LDA(At, 1, 1); PG8_STAGE(PG8_SB(1, 0), b3, voffB); PG8_STAGE(PG8_SB(1, 1), b3 + hstep, voffB); PG8_STAGE(PG8_SA(1, 0), a3, vs0);
            PG8_WAIT_V(8); PG8_WAIT_L(0); PG8_BAR; PG8_MMA(1, 0, At, B0); PG8_MMA(1, 1, At, B1); PG8_BAR; PG8_SCHED;
            } else {
            PG8_LDB(B0, 0, 0); PG8_SCHED; PG8_LDA(At, 0, 0); PG8_STAGE(PG8_SA(1, 1), a1 + hsA, vc1);
            PG8_WAIT_L(8); PG8_BAR; PG8_WAIT_L(0); PG8_MMA(0, 0, At, B0); PG8_BAR; PG8_SCHED;
            PG8_LDB(B1, 0, 1); PG8_STAGE(PG8_SB(0, 0), b2, voffB);
            PG8_BAR; PG8_WAIT_L(0); PG8_MMA(0, 1, At, B1); PG8_BAR;
            PG8_LDA(At, 0, 1); PG8_STAGE(PG8_SA(0, 0), a2, vs0);
            PG8_BAR; PG8_WAIT_L(0); PG8_MMA(1, 0, At, B0); PG8_BAR; PG8_SCHED;
            PG8_STAGE(PG8_SB(0, 1), b2 + hstep, voffB);
            PG8_WAIT_V(6); PG8_BAR; PG8_MMA(1, 1, At, B1); PG8_BAR;
            PG8_LDB(B0, 1, 0); PG8_SCHED; PG8_LDA(At, 1, 0); PG8_STAGE(PG8_SA(0, 1), a2 + hsA, vs1);
            PG8_WAIT_L(8); PG8_BAR; PG8_WAIT_L(0); PG8_MMA(0, 0, At, B0); PG8_BAR; PG8_SCHED;
            PG8_LDB(B1, 1, 1); PG8_STAGE(PG8_SB(1, 0), b3, voffB);
            PG8_BAR; PG8_WAIT_L(0); PG8_MMA(0, 1, At, B1); PG8_BAR;
            PG8_LDA(At, 1, 1); PG8_STAGE(PG8_SA(1, 0), a3, vs0);
            PG8_BAR; PG8_WAIT_L(0); PG8_MMA(1, 0, At, B0); PG8_BAR; PG8_SCHED;
            PG8_STAGE(PG8_SB(1, 1), b3 + hstep, voffB);
            PG8_WAIT_V(6); PG8_BAR; PG8_MMA(1, 1, At, B1); PG8_BAR;
            }
        }
        if constexpr (ALIGN_EPI) { if (wr == 0) PG8_BAR; }
        if constexpr (!Epi::AFTER_DRAIN) { E(acc, cur, wr, wc, fr, fq); S.done(cur); }
        if (!has_next) break;
#pragma unroll
        for (int a = 0; a < 2; ++a)
#pragma unroll
            for (int b = 0; b < 2; ++b)
#pragma unroll
                for (int m = 0; m < 4; ++m)
#pragma unroll
                    for (int n = 0; n < 2; ++n) acc[a][b][m][n] = (f32x4){0.f, 0.f, 0.f, 0.f};
        cur = nxt; cA = nA; cB = nB; ++ui;
        if constexpr (Sched::GATHER) {
#pragma unroll
            for (int i = 0; i < 2; ++i) { vc0[i] = vn0[i]; vc1[i] = vn1[i]; } }
        if constexpr (ALIGN_EPI) { if (wr == 1) PG8_BAR; }
    }
    PG8_WAIT_V(0);
    if constexpr (!ALIGN_EPI) { if (wr == 0) PG8_BAR; }
    PG8_BAR;
    if constexpr (Epi::AFTER_DRAIN) { E.fused(acc, cur, wr, wc, fr, fq, lds, wid, lane); S.done(cur); }
#undef PG8_SA
#undef PG8_SB
#undef PG8_STAGE
#undef PG8_LDA
#undef PG8_LDB
#undef PG8_MMA
#undef PG8_WAIT_V
#undef PG8_WAIT_L
#undef PG8_BAR
#undef PG8_SCHED
}
}

__device__ __forceinline__ bf16_t* wgu_ptr(unsigned char* ws, int e) { return (bf16_t*)(ws + (e < 16 ? WS_WGU_LO : WS_WGU_HI)) + (size_t)(e & 15) * 1024 * 1024; }

#ifndef PG8_MASK
#define PG8_MASK 15
#endif

struct SchedIn {
    static constexpr bool GATHER = false;
    const char* A; const char* Bt; int G, c;
    __device__ __forceinline__ bool next(int i, pg8::Unit& u) const {
        const int L0 = i * G + c; if (L0 >= 1532) return false;
        const int L = pg8::xcd_remap(L0, 1532);
        if (L < 60) { const int pi = L >> 2; u.pm = L & 3; u.pn = pi < 8 ? pi : pi + 8; }
        else { const int l2 = L - 60, g = l2 / 184, r = l2 % 184; u.pn = r >> 3; u.pm = 4 + 8 * g + (r & 7); }
        u.rd = i; return true;
    }
    __device__ __forceinline__ const char* a_ptr(const pg8::Unit& u) const { return A + (size_t)u.pm * (256 * 1024 * 2); }
    __device__ __forceinline__ const char* b_ptr(const pg8::Unit& u) const { return Bt + (size_t)u.pn * (256 * 1024 * 2); }
    __device__ __forceinline__ void a_ready(const pg8::Unit&) const {}
    __device__ __forceinline__ void done(const pg8::Unit&) const {}
};
struct SchedOut {
    static constexpr bool GATHER = false;
    const char* A; const char* Bt; int G, c;
    __device__ __forceinline__ bool next(int i, pg8::Unit& u) const {
        const int L0 = i * G + c; if (L0 >= 256) return false;
        const int w = pg8::xcd_remap(L0, 256), gid = w >> 5, r = w & 31;
        u.pm = gid * 8 + (r & 7); u.pn = r >> 3; u.rd = i;
        return true;
    }
    __device__ __forceinline__ const char* a_ptr(const pg8::Unit& u) const { return A + (size_t)u.pm * (256 * 2048 * 2); }
    __device__ __forceinline__ const char* b_ptr(const pg8::Unit& u) const { return Bt + (size_t)u.pn * (256 * 2048 * 2); }
    __device__ __forceinline__ void a_ready(const pg8::Unit&) const {}
    __device__ __forceinline__ void done(const pg8::Unit&) const {}
};
template <bool UP>
struct SchedMoe {
    static constexpr bool GATHER = UP;
    const char* A; unsigned char* ws; const int* tile_e; const int* lcache; int NT, G, c, K;
    __device__ __forceinline__ bool next(int i, pg8::Unit& u) const {
        const int nwg = NT * 4; const int L0 = i * G + c; if (L0 >= nwg) return false;
        const int w = pg8::xcd_remap(L0, nwg);
        u.pm = w >> 2; u.pn = w & 3; u.rd = i;
        return true;
    }
    __device__ __forceinline__ const char* a_ptr(const pg8::Unit& u) const { return UP ? A : A + (size_t)u.pm * 256 * K * 2; }
    __device__ __forceinline__ int a_row(int round, int r) const { return lcache[round * 256 + r]; }
    __device__ __forceinline__ const char* b_ptr(const pg8::Unit& u) const {
        const int e = __builtin_amdgcn_readfirstlane(tile_e[u.pm]);
        return UP ? (const char*)wgu_ptr(ws, e) + (size_t)u.pn * 256 * 1024 * 2
                  : (const char*)(ws + WS_WDT) + ((size_t)e * 1024 * 512 + (size_t)u.pn * 256 * 512) * 2;
    }
    __device__ __forceinline__ void a_ready(const pg8::Unit&) const {}
    __device__ __forceinline__ void done(const pg8::Unit&) const {}
};

struct EpiIn {
    static constexpr bool PERM = true, AFTER_DRAIN = false;
    unsigned char* ws;
    __device__ __forceinline__ void operator()(const f32x4 (&acc)[2][2][4][2], const pg8::Unit& u, int wr, int wc, int fr, int fq) const {
        const int pn = u.pn; const int row0 = u.pm * 256 + wr * 64 + fr; const int ct = wc * 32 + 8 * fq;
        if (pn == 22) {
            if (wc < 2) { float* GDT = (float*)(ws + WS_GDT);
#pragma unroll
                for (int ai = 0; ai < 2; ++ai)
#pragma unroll
                    for (int m = 0; m < 4; ++m) { float* p = GDT + (size_t)(row0 + ai * 128 + m * 16) * 64 + ct; *(f32x4*)p = acc[ai][0][m][0]; *(f32x4*)(p + 4) = acc[ai][0][m][1]; } }
            return;
        }
        bf16_t* base; int ld; int roff = 0; bool act = false;
        if (pn < 4) { base = (bf16_t*)(ws + WS_QK) + pn * 256; ld = 1024; }
        else if (pn < 8) { base = (bf16_t*)(ws + WS_V) + (pn - 4) * 256; ld = 1024; }
        else if (pn < 16) { base = (bf16_t*)(ws + WS_RZ) + (pn - 8) * 256; ld = 2048; roff = T_CTX; act = true; }
        else { base = (bf16_t*)(ws + WS_XBC) + (pn - 16) * 256; ld = 1536; }
#pragma unroll
        for (int ai = 0; ai < 2; ++ai)
#pragma unroll
            for (int m = 0; m < 4; ++m) { bf16_t* rowp = base + (size_t)(row0 - roff + ai * 128 + m * 16) * ld + ct;
#pragma unroll
                for (int bj = 0; bj < 2; ++bj) { f32x4 v0 = acc[ai][bj][m][0], v1 = acc[ai][bj][m][1];
                    if (act) { v0.x = siluf(v0.x); v0.y = siluf(v0.y); v0.z = siluf(v0.z); v0.w = siluf(v0.w); v1.x = siluf(v1.x); v1.y = siluf(v1.y); v1.z = siluf(v1.z); v1.w = siluf(v1.w); }
                    u32x4 w; w.x = pg8::cvt_pk_bf16(v0.x, v0.y); w.y = pg8::cvt_pk_bf16(v0.z, v0.w); w.z = pg8::cvt_pk_bf16(v1.x, v1.y); w.w = pg8::cvt_pk_bf16(v1.z, v1.w);
                    *(u32x4*)(rowp + bj * 128) = w; } }
    }
};
struct EpiOut {
    static constexpr bool PERM = false, AFTER_DRAIN = false;
    const float* X; const float* MOD; float* HL;
    __device__ __forceinline__ void operator()(const f32x4 (&acc)[2][2][4][2], const pg8::Unit& u, int wr, int wc, int fr, int fq) const {
        const int b = u.pm >> 4; const int col0 = u.pn * 256 + wc * 32 + 4 * fq;
        f32x4 g1[2][2];
#pragma unroll
        for (int bj = 0; bj < 2; ++bj)
#pragma unroll
            for (int n = 0; n < 2; ++n) g1[bj][n] = *(const f32x4*)(MOD + b * 6144 + 2048 + col0 + bj * 128 + n * 16);
#pragma unroll
        for (int ai = 0; ai < 2; ++ai)
#pragma unroll
            for (int m = 0; m < 4; ++m) { const size_t off = (size_t)(u.pm * 256 + ai * 128 + wr * 64 + m * 16 + fr) * 1024 + col0;
#pragma unroll
                for (int bj = 0; bj < 2; ++bj)
#pragma unroll
                    for (int n = 0; n < 2; ++n) { const f32x4 xv = *(const f32x4*)(X + off + bj * 128 + n * 16); *(f32x4*)(HL + off + bj * 128 + n * 16) = xv + g1[bj][n] * acc[ai][bj][m][n]; }
                if (m & 1) asm volatile("" ::: "memory"); }
    }
};
struct EpiUp {
    static constexpr bool PERM = true, AFTER_DRAIN = false;
    bf16_t* H;
    __device__ __forceinline__ void operator()(const f32x4 (&acc)[2][2][4][2], const pg8::Unit& u, int wr, int wc, int fr, int fq) const {
        const int row0 = u.pm * 256 + wr * 64 + fr; const int col = u.pn * 128 + wc * 32 + 8 * fq;
#pragma unroll
        for (int ai = 0; ai < 2; ++ai)
#pragma unroll
            for (int m = 0; m < 4; ++m) { const f32x4 g0 = acc[ai][0][m][0], g1 = acc[ai][0][m][1], u0 = acc[ai][1][m][0], u1 = acc[ai][1][m][1];
                u32x4 w; w.x = pg8::cvt_pk_bf16(siluf(g0.x) * u0.x, siluf(g0.y) * u0.y); w.y = pg8::cvt_pk_bf16(siluf(g0.z) * u0.z, siluf(g0.w) * u0.w);
                w.z = pg8::cvt_pk_bf16(siluf(g1.x) * u1.x, siluf(g1.y) * u1.y); w.w = pg8::cvt_pk_bf16(siluf(g1.z) * u1.z, siluf(g1.w) * u1.w);
                *(u32x4*)(H + (size_t)(row0 + ai * 128 + m * 16) * 512 + col) = w; }
    }
};
struct EpiDown {
    static constexpr bool PERM = true, AFTER_DRAIN = false;
    bf16_t* Y; const int* pcache; const float* wcache;
    __device__ __forceinline__ void operator()(const f32x4 (&acc)[2][2][4][2], const pg8::Unit& u, int wr, int wc, int fr, int fq) const {
        const int rl0 = wr * 64 + fr; const int col = u.pn * 256 + wc * 32 + 8 * fq;
#pragma unroll
        for (int ai = 0; ai < 2; ++ai)
#pragma unroll
            for (int m = 0; m < 4; ++m) { const int rl = u.rd * 256 + rl0 + ai * 128 + m * 16; const int pr = pcache[rl]; const float sw = wcache[rl];
                if (pr >= 0) {
#pragma unroll
                    for (int bj = 0; bj < 2; ++bj) { const f32x4 v0 = acc[ai][bj][m][0] * sw, v1 = acc[ai][bj][m][1] * sw;
                        u32x4 w; w.x = pg8::cvt_pk_bf16(v0.x, v0.y); w.y = pg8::cvt_pk_bf16(v0.z, v0.w); w.z = pg8::cvt_pk_bf16(v1.x, v1.y); w.w = pg8::cvt_pk_bf16(v1.z, v1.w);
                        *(u32x4*)(Y + (size_t)pr * 1024 + col + bj * 128) = w; } } }
    }
};

__device__ __forceinline__ void phase2(Ctx& C) {
    const bf16_t* XN = (const bf16_t*)(C.ws + WS_XN); const bf16_t* WinT = (const bf16_t*)(C.ws + WS_WINT);
    bf16_t* QK = (bf16_t*)(C.ws + WS_QK); bf16_t* V = (bf16_t*)(C.ws + WS_V); bf16_t* RZ = (bf16_t*)(C.ws + WS_RZ); bf16_t* XBC = (bf16_t*)(C.ws + WS_XBC);
    float* GDT = (float*)(C.ws + WS_GDT);
    auto bsel = [=](int, int tn, int& ldb) { ldb = 1024; return WinT + (size_t)tn * 128 * 1024; };
    auto epi = [=](int row, int tn, int cc, float v, float) {
        const int col = tn * 128 + cc;
        if (col < 1024) QK[(size_t)row * 1024 + col] = (bf16_t)f2bf(v);
        else if (col < 2048) V[(size_t)row * 1024 + col - 1024] = (bf16_t)f2bf(v);
        else if (col < 4096) { if (row >= T_CTX) RZ[(size_t)(row - T_CTX) * 2048 + col - 2048] = (bf16_t)f2bf(siluf(v)); }
        else if (col < 5632) XBC[(size_t)row * 1536 + col - 4096] = (bf16_t)f2bf(v);
        else if (col < 5696) GDT[(size_t)row * 64 + col - 5632] = v;
    };
#if PG8_MASK & 1
    (void)bsel; (void)epi;
    SchedIn S{(const char*)XN, (const char*)WinT, C.G, C.bid}; EpiIn E{C.ws};
    pg8::gemm_phase<EpiIn, SchedIn, true, true>((lds_ptr_t)C.lds, 1024, S, E);
#else
    gemm_simple<false>(C, XN, 1024, T_ALL / 128, NW_IN / 128, 1024, bsel, epi);
#endif
}

__device__ __forceinline__ void phase3(Ctx& C, int sec) {
    if (sec & 1) {
        lds_ptr_t L = (lds_ptr_t)C.lds;
        constexpr int IN_O = 0, OUT_O = 32768, GS_O = 98304, TOT_O = 106496;
        LASQ float* gs = (LASQ float*)(L + GS_O); LASQ float* tot = (LASQ float*)(L + TOT_O);
        bf16_t* QK = (bf16_t*)(C.ws + WS_QK); bf16_t* QKF = (bf16_t*)(C.ws + WS_QKF);
        const float* GDT = (const float*)(C.ws + WS_GDT); float* GLAD = (float*)(C.ws + WS_GLAD);
        const float* gwup = C.in[I_GWUP]; const float* gbias = C.in[I_GB];
        const int tid = C.tid, c = tid & 127, tg = tid >> 7;
        for (int item = C.bid; item < 272 * 4; item += C.G) {
            const int rc = item >> 2, h = item & 3, row0 = rc * 64;
            __syncthreads();
#pragma unroll
            for (int i = 0; i < 4; ++i) { const int id = tid + 512 * i, arr = id >> 10, r = (id >> 4) & 63, ch = id & 15;
                *(LASQ u32x4*)(L + IN_O + arr * 16384 + r * 256 + ch * 16) = *(const u32x4*)(QK + (size_t)(row0 + r) * 1024 + arr * 512 + h * 128 + ch * 8); }
            *(LASQ f32x4*)(gs + (tid >> 3) * 32 + (tid & 7) * 4) = *(const f32x4*)(GDT + (size_t)(row0 + (tid >> 3)) * 64 + (tid & 7) * 4);
            float wf[16], wb[16];
#pragma unroll
            for (int r = 0; r < 16; ++r) { wf[r] = gwup[r * 512 + h * 128 + c]; wb[r] = gwup[(16 + r) * 512 + h * 128 + c]; }
            const float bfv = gbias[h * 128 + c], bbv = gbias[512 + h * 128 + c];
            __syncthreads();
            float pf[16], pb[16];
#pragma unroll
            for (int tt = 0; tt < 16; ++tt) { const LASQ float* g = gs + (tg * 16 + tt) * 32; float sf = bfv, sb = bbv;
#pragma unroll
                for (int r4 = 0; r4 < 4; ++r4) { const f32x4 gf = *(const LASQ f32x4*)(g + r4 * 4), gb = *(const LASQ f32x4*)(g + 16 + r4 * 4);
                    sf += gf.x * wf[r4 * 4] + gf.y * wf[r4 * 4 + 1] + gf.z * wf[r4 * 4 + 2] + gf.w * wf[r4 * 4 + 3];
                    sb += gb.x * wb[r4 * 4] + gb.y * wb[r4 * 4 + 1] + gb.z * wb[r4 * 4 + 2] + gb.w * wb[r4 * 4 + 3]; }
                pf[tt] = logsig_fast(sf) * (1.f / 16.f); pb[tt] = logsig_fast(sb) * (1.f / 16.f); }
#pragma unroll
            for (int tt = 1; tt < 16; ++tt) pf[tt] += pf[tt - 1];
#pragma unroll
            for (int tt = 14; tt >= 0; --tt) pb[tt] += pb[tt + 1];
            tot[(0 * 4 + tg) * 128 + c] = pf[15]; tot[(1 * 4 + tg) * 128 + c] = pb[0];
            __syncthreads();
            float offf = 0.f, offb = 0.f, totf = 0.f, totb = 0.f;
#pragma unroll
            for (int g = 0; g < 4; ++g) { const float a = tot[(0 * 4 + g) * 128 + c], bq = tot[(1 * 4 + g) * 128 + c]; if (g < tg) offf += a; if (g > tg) offb += bq; totf += a; totb += bq; }
            if (tg == 0) { GLAD[((size_t)(rc * 4 + h) * 2 + 0) * 128 + c] = __expf(totf); GLAD[((size_t)(rc * 4 + h) * 2 + 1) * 128 + c] = __expf(totb); }
            const float qscale = 0.08838834764831845f;
#pragma unroll
            for (int tt = 0; tt < 16; ++tt) { const int r = tg * 16 + tt;
                const float q = bf2f(*(const LASQ bf16_t*)(L + IN_O + r * 256 + c * 2)) * qscale, k = bf2f(*(const LASQ bf16_t*)(L + IN_O + 16384 + r * 256 + c * 2));
                const float ef = pf[tt] + offf, eb = pb[tt] + offb;
                *(LASQ bf16_t*)(L + OUT_O + 0 * 16384 + r * 256 + c * 2) = (bf16_t)f2bf(q * __expf(ef));
                *(LASQ bf16_t*)(L + OUT_O + 1 * 16384 + r * 256 + c * 2) = (bf16_t)f2bf(k * __expf(-ef));
                *(LASQ bf16_t*)(L + OUT_O + 2 * 16384 + r * 256 + c * 2) = (bf16_t)f2bf(q * __expf(eb));
                *(LASQ bf16_t*)(L + OUT_O + 3 * 16384 + r * 256 + c * 2) = (bf16_t)f2bf(k * __expf(-eb)); }
            __syncthreads();
#pragma unroll
            for (int i = 0; i < 8; ++i) { const int id = tid + 512 * i, arr = id >> 10, r = (id >> 4) & 63, ch = id & 15;
                bf16_t* dst = (arr < 2 ? QKF : QK) + (size_t)(row0 + r) * 1024 + (arr & 1) * 512 + h * 128 + ch * 8;
                *(u32x4*)dst = *(const LASQ u32x4*)(L + OUT_O + arr * 16384 + r * 256 + ch * 16); }
        }
        __syncthreads();
    }
    if (sec & 2) {
        const bf16_t* XBC = (const bf16_t*)(C.ws + WS_XBC); bf16_t* XC = (bf16_t*)(C.ws + WS_XC);
        const float* cw = C.in[I_CONVW]; const float* cb = C.in[I_CONVB];
        const int total = 272 * 4 * 192;
        for (int it = C.bid * NTHREADS + C.tid; it < total; it += C.G * NTHREADS) {
            const int cg8 = it % 192, st = it / 192, rc = st >> 2, x0 = (st & 3) * 16, c0 = cg8 * 8;
            int base, y, xb, H, W;
            if (rc < 16) { base = (rc >> 2) * 256; y = 0; xb = (rc & 3) * 64; H = 1; W = 256; }
            else { const int lr = rc - 16; base = T_CTX + (lr >> 6) * 4096; y = lr & 63; xb = 0; H = 64; W = 64; }
            float wt[9][8], bias[8];
#pragma unroll
            for (int t = 0; t < 9; ++t) { const f32x4 a = *(const f32x4*)(cw + (size_t)t * 1536 + c0), bq = *(const f32x4*)(cw + (size_t)t * 1536 + c0 + 4);
                wt[t][0] = a.x; wt[t][1] = a.y; wt[t][2] = a.z; wt[t][3] = a.w; wt[t][4] = bq.x; wt[t][5] = bq.y; wt[t][6] = bq.z; wt[t][7] = bq.w; }
            { const f32x4 a = *(const f32x4*)(cb + c0), bq = *(const f32x4*)(cb + c0 + 4); bias[0] = a.x; bias[1] = a.y; bias[2] = a.z; bias[3] = a.w; bias[4] = bq.x; bias[5] = bq.y; bias[6] = bq.z; bias[7] = bq.w; }
            const bool vy[3] = {y - 1 >= 0, true, y + 1 < H};
            u16x8 win[3][3];
            auto ldcol = [&](int i, int xx) -> u16x8 { u16x8 z = {0, 0, 0, 0, 0, 0, 0, 0};
                if (!vy[i] || xx < 0 || xx >= W) return z;
                return *(const u16x8*)(XBC + (size_t)(base + (y + i - 1) * W + xx) * 1536 + c0); };
            const int xs = xb + x0;
            u16x8 nxt[3];
#pragma unroll
            for (int i = 0; i < 3; ++i) { win[i][0] = ldcol(i, xs - 1); win[i][1] = ldcol(i, xs); nxt[i] = ldcol(i, xs + 1); }
            for (int dx = 0; dx < 16; ++dx) { const int x = xs + dx;
#pragma unroll
                for (int i = 0; i < 3; ++i) { win[i][2] = nxt[i]; nxt[i] = ldcol(i, x + 2 <= xs + 16 ? x + 2 : -1); }
                float acc[8];
#pragma unroll
                for (int j = 0; j < 8; ++j) acc[j] = bias[j];
#pragma unroll
                for (int i = 0; i < 3; ++i)
#pragma unroll
                    for (int jx = 0; jx < 3; ++jx)
#pragma unroll
                        for (int j = 0; j < 8; ++j) acc[j] += bf2f(win[i][jx][j]) * wt[i * 3 + jx][j];
                u32x4 o; o.x = pk2(siluf(acc[0]), siluf(acc[1])); o.y = pk2(siluf(acc[2]), siluf(acc[3])); o.z = pk2(siluf(acc[4]), siluf(acc[5])); o.w = pk2(siluf(acc[6]), siluf(acc[7]));
                *(u32x4*)(XC + (size_t)(base + y * W + x) * 1536 + c0) = o;
#pragma unroll
                for (int i = 0; i < 3; ++i) { win[i][0] = win[i][1]; win[i][1] = win[i][2]; }
            }
        }
    }
    if (sec & 4) {
        float* GDT = (float*)(C.ws + WS_GDT); float* ACUM = (float*)(C.ws + WS_ACUM);
        const float* alog = C.in[I_ALOG]; const float* dtbias = C.in[I_DTB];
        const int gw = C.bid * 8 + C.wave, NGW = C.G * 8, l = C.lane;
        for (int it = gw; it < 272 * 32; it += NGW) {
            const int rc = it >> 5, dh = it & 31, dir = dh >> 4; const size_t row = (size_t)rc * 64 + l;
            const float dtv = softplusf(GDT[row * 64 + 32 + dh] + dtbias[dh]);
            float sa = dtv * (-__expf(alog[dh])) * 1.4426950408889634f;
#pragma unroll
            for (int o = 1; o < 64; o <<= 1) { const float t = dir ? __shfl_down(sa, o) : __shfl_up(sa, o); if (dir ? (l + o < 64) : (l >= o)) sa += t; }
            GDT[row * 64 + 32 + dh] = dtv; ACUM[row * 32 + dh] = sa;
        }
    }
}

__device__ __forceinline__ int scan_row(int b, int dir, int s) {
    if (s < CTXL) return b * CTXL + (dir ? CTXL - 1 - s : s);
    const int t = s - CTXL; return T_CTX + b * SEQ + (dir ? SEQ - 1 - t : t);
}

__device__ __forceinline__ void phase4_naive(Ctx& C) {
    bf16_t* OF = (bf16_t*)C.out;
    bf16_t* OB = (bf16_t*)(C.ws + WS_OB);
    bf16_t* YB = (bf16_t*)(C.ws + WS_YB);
    const bf16_t* V = (const bf16_t*)(C.ws + WS_V); const bf16_t* XC = (const bf16_t*)(C.ws + WS_XC);
    const float* GDT = (const float*)(C.ws + WS_GDT); const float* GLAD = (const float*)(C.ws + WS_GLAD);
    for (int gt = C.bid * NTHREADS + C.tid; gt < 65536; gt += C.G * NTHREADS) {
        if (gt < 32768) {
            const int chain = gt >> 10, rem = gt & 1023, dv = rem >> 2, dq = rem & 3;
            const int b = chain >> 3, h = (chain >> 1) & 3, dir = chain & 1;
            const bf16_t* QKp = (const bf16_t*)(C.ws + (dir ? WS_QK : WS_QKF));
            float S[32];
#pragma unroll
            for (int i = 0; i < 32; ++i) S[i] = 0.f;
            for (int s = 0; s < CTXL + SEQ; ++s) {
                const int row = scan_row(b, dir, s);
                const float v = bf2f(V[(size_t)row * 1024 + h * 256 + dv]);
                const bf16_t* qp = QKp + (size_t)row * 1024 + h * 128 + dq * 32;
                float o = 0.f;
#pragma unroll
                for (int i8 = 0; i8 < 4; ++i8) { const u16x8 kv = *(const u16x8*)(qp + 512 + i8 * 8), qv = *(const u16x8*)(qp + i8 * 8);
#pragma unroll
                    for (int j = 0; j < 8; ++j) { S[i8 * 8 + j] += bf2f(kv[j]) * v; o += bf2f(qv[j]) * S[i8 * 8 + j]; } }
                o += __shfl_xor(o, 1); o += __shfl_xor(o, 2);
                if (row >= T_CTX && dq == 0) { const size_t l = row - T_CTX; if (dir) OB[l * 1024 + h * 256 + dv] = (bf16_t)f2bf(o); else OF[l * 2048 + h * 256 + dv] = (bf16_t)f2bf(o); }
                if ((s & 63) == 63) { const float* d = GLAD + ((size_t)((row >> 6) * 4 + h) * 2 + dir) * 128 + dq * 32;
#pragma unroll
                    for (int i = 0; i < 32; ++i) S[i] *= d[i]; }
            }
        } else {
            const int g2 = gt - 32768, chain = g2 >> 8, rem = g2 & 255, p = rem >> 2, nq = rem & 3;
            const int b = chain >> 5, head = (chain >> 1) & 15, dir = chain & 1, grp = head >> 3;
            const float Aneg = -__expf(C.in[I_ALOG][dir * 16 + head]), dtb = C.in[I_DTB][dir * 16 + head];
            float S[32];
#pragma unroll
            for (int i = 0; i < 32; ++i) S[i] = 0.f;
            for (int s = 0; s < CTXL + SEQ; ++s) {
                const int row = scan_row(b, dir, s);
                const float dt = GDT[(size_t)row * 64 + 32 + dir * 16 + head], a = __expf(dt * Aneg); (void)dtb;
                const float xd = bf2f(XC[(size_t)row * 1536 + head * 64 + p]) * dt;
                const bf16_t* bp = XC + (size_t)row * 1536 + 1024 + grp * 128 + nq * 32;
                float y = 0.f;
#pragma unroll
                for (int i8 = 0; i8 < 4; ++i8) { const u16x8 bv = *(const u16x8*)(bp + i8 * 8), cv = *(const u16x8*)(bp + 256 + i8 * 8);
#pragma unroll
                    for (int j = 0; j < 8; ++j) { S[i8 * 8 + j] = a * S[i8 * 8 + j] + xd * bf2f(bv[j]); y += S[i8 * 8 + j] * bf2f(cv[j]); } }
                y += __shfl_xor(y, 1); y += __shfl_xor(y, 2);
                if (row >= T_CTX && nq == 0) { const size_t l = row - T_CTX; if (dir) YB[l * 1024 + head * 64 + p] = (bf16_t)f2bf(y); else OF[l * 2048 + 1024 + head * 64 + p] = (bf16_t)f2bf(y); }
            }
        }
    }
}


typedef short bf16x8 __attribute__((ext_vector_type(8)));
typedef short s16x4 __attribute__((ext_vector_type(4)));
typedef __attribute__((address_space(3))) s16x4* lds_s16x4_p;
__device__ __forceinline__ bf16x8 lds_row_frag(lds_ptr_t L, int off, int rs, int r0, int kb, int c, int g) {
    return *(const LASQ bf16x8*)(L + off + (r0 + c) * rs + kb + g * 16);
}
__device__ __forceinline__ bf16x8 lds_tr_frag(lds_ptr_t L, int off, int rs, int k0, int n0, int g, int q, int p) {
    const s16x4 lo = __builtin_amdgcn_ds_read_tr16_b64_v4i16((lds_s16x4_p)(L + off + (k0 + 8 * g + q) * rs + (n0 + 4 * p) * 2));
    const s16x4 hi = __builtin_amdgcn_ds_read_tr16_b64_v4i16((lds_s16x4_p)(L + off + (k0 + 8 * g + 4 + q) * rs + (n0 + 4 * p) * 2));
    bf16x8 r; r[0] = lo[0]; r[1] = lo[1]; r[2] = lo[2]; r[3] = lo[3]; r[4] = hi[0]; r[5] = hi[1]; r[6] = hi[2]; r[7] = hi[3]; return r;
}
template <bool GLA>
__device__ __forceinline__ void scan_unit(Ctx& C, int uid) {
    lds_ptr_t L = (lds_ptr_t)C.lds;
    constexpr int INB = 44032, KS_O = 17408, VS_O = 34816, ST_OFF = 88064, STB = 17408, PS_OFF = 122880, SC_OFF = 132096, SCB = 1280;
    const int tid = C.tid, w = C.wave, l = C.lane, g = l >> 4, c = l & 15, q = c >> 2, p = c & 3;
    int b, dir, ldqk, ldv, ldo; const bf16_t *Qg, *Kg, *Vg; bf16_t* Og; const float* Sg; const float* dtg = nullptr;
    if (GLA) { b = uid >> 5; const int h = (uid >> 3) & 3; dir = (uid >> 2) & 1; const int sl = uid & 3;
        const bf16_t* QKp = (const bf16_t*)(C.ws + (dir ? WS_QK : WS_QKF));
        Qg = QKp + h * 128; Kg = QKp + 512 + h * 128; ldqk = 1024; Vg = (const bf16_t*)(C.ws + WS_V) + h * 256 + sl * 64; ldv = 1024;
        Og = dir ? (bf16_t*)(C.ws + WS_OB) + h * 256 + sl * 64 : (bf16_t*)C.out + h * 256 + sl * 64; ldo = dir ? 1024 : 2048;
        Sg = (const float*)(C.ws + WS_GLAD) + (h * 2 + dir) * 128;
    } else { b = uid >> 5; const int head = (uid >> 1) & 15; dir = uid & 1; const int grp = head >> 3;
        const bf16_t* XC = (const bf16_t*)(C.ws + WS_XC);
        Qg = XC + 1280 + grp * 128; Kg = XC + 1024 + grp * 128; ldqk = 1536; Vg = XC + head * 64; ldv = 1536;
        Og = dir ? (bf16_t*)(C.ws + WS_YB) + head * 64 : (bf16_t*)C.out + 1024 + head * 64; ldo = dir ? 1024 : 2048;
        Sg = (const float*)(C.ws + WS_ACUM) + dir * 16 + head;
        dtg = (const float*)(C.ws + WS_GDT) + 32 + dir * 16 + head;
    }
    f32x4 S[4];
#pragma unroll
    for (int t = 0; t < 4; ++t) S[t] = (f32x4){0.f, 0.f, 0.f, 0.f};
    u32x4 pq0, pq1, pk0, pk1, pv; float ps0 = 0.f, ps1 = 0.f, ptot = 0.f;
    auto chunk_rc = [&](int n) { return n < 4 ? 4 * b + (dir ? 3 - n : n) : 16 + 64 * b + (dir ? 67 - n : n - 4); };
    auto prefetch = [&](int n) {
        const int rc = chunk_rc(n), row0 = rc * 64;
        const bf16_t* qp = Qg + (size_t)(row0 + (tid >> 4)) * ldqk + (tid & 15) * 8; const bf16_t* kp = Kg + (size_t)(row0 + (tid >> 4)) * ldqk + (tid & 15) * 8;
        pq0 = *(const u32x4*)qp; pq1 = *(const u32x4*)(qp + (size_t)32 * ldqk); pk0 = *(const u32x4*)kp; pk1 = *(const u32x4*)(kp + (size_t)32 * ldqk);
        pv = *(const u32x4*)(Vg + (size_t)(row0 + (tid >> 3)) * ldv + (tid & 7) * 8);
        if (GLA) { ps0 = Sg[(size_t)rc * 1024 + (tid & 127)]; }
        else { ps0 = Sg[(size_t)(row0 + (tid & 63)) * 32]; ps1 = dtg[(size_t)(row0 + (tid & 63)) * 64]; ptot = Sg[(size_t)(row0 + (dir ? 0 : 63)) * 32]; }
    };
    float dtot = 1.f;
    auto stageW = [&](int n) {
        const int ib = (n & 1) * INB; LASQ float* sc = (LASQ float*)(L + SC_OFF + (n & 1) * SCB);
        *(LASQ u32x4*)(L + ib + (tid >> 4) * 272 + (tid & 15) * 16) = pq0; *(LASQ u32x4*)(L + ib + ((tid >> 4) + 32) * 272 + (tid & 15) * 16) = pq1;
        *(LASQ u32x4*)(L + ib + KS_O + (tid >> 4) * 272 + (tid & 15) * 16) = pk0; *(LASQ u32x4*)(L + ib + KS_O + ((tid >> 4) + 32) * 272 + (tid & 15) * 16) = pk1;
        *(LASQ u32x4*)(L + ib + VS_O + (tid >> 3) * 144 + (tid & 7) * 16) = pv;
        if (GLA) { if (tid < 128) sc[tid] = ps0; }
        else { if (tid < 64) { sc[tid] = ps0; sc[64 + tid] = ps1; sc[128 + tid] = ps1 * __builtin_amdgcn_exp2f(ptot - ps0); } }
    };
    prefetch(0);
    stageW(0);
    float dcur = GLA ? 1.f : __builtin_amdgcn_exp2f(ptot);
    prefetch(1);
    __syncthreads();
    for (int n = 0; n < 68; ++n) {
        const int rc = chunk_rc(n); const bool lat = n >= 4;
        const int ib = (n & 1) * INB; LASQ float* sc = (LASQ float*)(L + SC_OFF + (n & 1) * SCB);
        float dnext = 1.f; bf16x8 qfr[2][4], vfr[2];
        if (n + 1 < 68) { stageW(n + 1); if (!GLA) dnext = __builtin_amdgcn_exp2f(ptot); if (n + 2 < 68) prefetch(n + 2); }
        if (lat) {
            const int tj = w >> 1, ti0 = 2 * (w & 1);
            bf16x8 ka[4];
#pragma unroll
            for (int ks = 0; ks < 4; ++ks) ka[ks] = lds_row_frag(L, ib + KS_O, 272, 16 * tj, 64 * ks, c, g);
#pragma unroll
            for (int t2 = 0; t2 < 2; ++t2) { const int ti = ti0 + t2; f32x4 acc = (f32x4){0.f, 0.f, 0.f, 0.f};
#pragma unroll
                for (int ks = 0; ks < 4; ++ks) { qfr[t2][ks] = lds_row_frag(L, ib, 272, 16 * ti, 64 * ks, c, g); acc = __builtin_amdgcn_mfma_f32_16x16x32_bf16(ka[ks], qfr[t2][ks], acc, 0, 0, 0); }
                const int i = 16 * ti + c, j0 = 16 * tj + 4 * g; float pvv[4];
                if (GLA) {
#pragma unroll
                    for (int r = 0; r < 4; ++r) { const bool ok = dir ? (j0 + r >= i) : (j0 + r <= i); pvv[r] = ok ? acc[r] : 0.f; }
                } else { const float ai = sc[i]; const f32x4 aj = *(const LASQ f32x4*)(sc + j0), dj = *(const LASQ f32x4*)(sc + 64 + j0);
#pragma unroll
                    for (int r = 0; r < 4; ++r) { const bool ok = dir ? (j0 + r >= i) : (j0 + r <= i); const float x = ok ? ai - aj[r] : 0.f; pvv[r] = ok ? acc[r] * __builtin_amdgcn_exp2f(x) * dj[r] : 0.f; } }
                u32x2 o; o.x = pk2(pvv[0], pvv[1]); o.y = pk2(pvv[2], pvv[3]); *(LASQ u32x2*)(L + PS_OFF + i * 144 + j0 * 2) = o; }
        }
        {
            bf16x8 ka[2];
#pragma unroll
            for (int ks = 0; ks < 2; ++ks) ka[ks] = lds_tr_frag(L, ib + KS_O, 272, 32 * ks, 16 * w, g, q, p);
            if (!GLA) {
#pragma unroll
                for (int ks = 0; ks < 2; ++ks) { const f32x4 u0 = *(const LASQ f32x4*)(sc + 128 + 32 * ks + 8 * g), u1 = *(const LASQ f32x4*)(sc + 128 + 32 * ks + 8 * g + 4);
                    const float uu[8] = {u0.x, u0.y, u0.z, u0.w, u1.x, u1.y, u1.z, u1.w}; u32x4 pk;
                    pk.x = pk2(bf2f((bf16_t)ka[ks][0]) * uu[0], bf2f((bf16_t)ka[ks][1]) * uu[1]); pk.y = pk2(bf2f((bf16_t)ka[ks][2]) * uu[2], bf2f((bf16_t)ka[ks][3]) * uu[3]);
                    pk.z = pk2(bf2f((bf16_t)ka[ks][4]) * uu[4], bf2f((bf16_t)ka[ks][5]) * uu[5]); pk.w = pk2(bf2f((bf16_t)ka[ks][6]) * uu[6], bf2f((bf16_t)ka[ks][7]) * uu[7]);
                    ka[ks] = __builtin_bit_cast(bf16x8, pk); }
#pragma unroll
                for (int t = 0; t < 4; ++t) S[t] = S[t] * dcur;
            }
#pragma unroll
            for (int t = 0; t < 4; ++t)
#pragma unroll
                for (int ks = 0; ks < 2; ++ks) { const bf16x8 vb = lds_tr_frag(L, ib + VS_O, 144, 32 * ks, 16 * t, g, q, p); if (t == (w >> 1)) vfr[ks] = vb; S[t] = __builtin_amdgcn_mfma_f32_16x16x32_bf16(ka[ks], vb, S[t], 0, 0, 0); }
            if (GLA) { const f32x4 d = *(const LASQ f32x4*)(sc + 16 * w + 4 * g);
#pragma unroll
                for (int t = 0; t < 4; ++t) S[t] = S[t] * d; }
            if (n + 1 >= 4 && n + 1 < 68) {
                const int so = ST_OFF + ((n + 1) & 1) * STB;
#pragma unroll
                for (int t = 0; t < 4; ++t) { u32x2 o; o.x = pk2(S[t].x, S[t].y); o.y = pk2(S[t].z, S[t].w); *(LASQ u32x2*)(L + so + (16 * t + c) * 272 + (16 * w + 4 * g) * 2) = o; }
            }
        }
        dcur = dnext;
        __syncthreads();
        if (lat) {
            const int tdv = w >> 1, ti0 = 2 * (w & 1), so = ST_OFF + (n & 1) * STB;
            bf16x8 sa[4];
#pragma unroll
            for (int ks = 0; ks < 4; ++ks) sa[ks] = lds_row_frag(L, so, 272, 16 * tdv, 64 * ks, c, g);
            const size_t lrow0 = (size_t)(rc * 64 - T_CTX);
#pragma unroll
            for (int t2 = 0; t2 < 2; ++t2) { const int ti = ti0 + t2; f32x4 a1 = (f32x4){0.f, 0.f, 0.f, 0.f}, a2 = (f32x4){0.f, 0.f, 0.f, 0.f};
#pragma unroll
                for (int ks = 0; ks < 2; ++ks) { const bf16x8 pb = lds_row_frag(L, PS_OFF, 144, 16 * ti, 64 * ks, c, g); a1 = __builtin_amdgcn_mfma_f32_16x16x32_bf16(vfr[ks], pb, a1, 0, 0, 0); }
#pragma unroll
                for (int ks = 0; ks < 4; ++ks) a2 = __builtin_amdgcn_mfma_f32_16x16x32_bf16(sa[ks], qfr[t2][ks], a2, 0, 0, 0);
                const int i = 16 * ti + c; f32x4 o4;
                if (GLA) o4 = a1 + a2; else o4 = a1 + a2 * __builtin_amdgcn_exp2f(sc[i]);
                u32x2 o; o.x = pk2(o4.x, o4.y); o.y = pk2(o4.z, o4.w);
                *(u32x2*)(Og + (lrow0 + i) * ldo + 16 * tdv + 4 * g) = o; }
        }
        __syncthreads();
    }
}
__device__ __forceinline__ void phase4(Ctx& C) {
    for (int uid = C.bid; uid < 256; uid += C.G) { if (uid < 128) scan_unit<true>(C, uid); else scan_unit<false>(C, uid - 128); }
}

__device__ __forceinline__ void phase5(Ctx& C) {
    const int gw = C.bid * 8 + C.wave, NGW = C.G * 8;
    const bf16_t* OF = (const bf16_t*)C.out; const bf16_t* OB = (const bf16_t*)(C.ws + WS_OB); const bf16_t* YB = (const bf16_t*)(C.ws + WS_YB);
    const bf16_t* RZ = (const bf16_t*)(C.ws + WS_RZ); const bf16_t* XC = (const bf16_t*)(C.ws + WS_XC); bf16_t* YX = (bf16_t*)(C.ws + WS_YX);
    const float* ssdd = C.in[I_SSDD]; const float* ssdn = C.in[I_SSDN]; const f32x4 gn = *(const f32x4*)(C.in[I_GNORM] + C.lane * 4);
    const int ln = C.lane;
    float nw[2][8], dsk[2];
#pragma unroll
    for (int g = 0; g < 2; ++g) { const int c0 = g * 512 + ln * 8; dsk[g] = ssdd[c0 >> 6];
        const f32x4 a = *(const f32x4*)(ssdn + c0), bq = *(const f32x4*)(ssdn + c0 + 4);
        nw[g][0] = a.x; nw[g][1] = a.y; nw[g][2] = a.z; nw[g][3] = a.w; nw[g][4] = bq.x; nw[g][5] = bq.y; nw[g][6] = bq.z; nw[g][7] = bq.w; }
    constexpr int NR = 2;
    for (int l0 = gw; l0 < T_LAT; l0 += NGW * NR) {
        u16x4 ga[NR][4], gb[NR][4], gr[NR][4]; u16x8 sa[NR][2], sb[NR][2], sz[NR][2], sx[NR][2];
#pragma unroll
        for (int u = 0; u < NR; ++u) { const int l = l0 + u * NGW; if (l < T_LAT) {
#pragma unroll
            for (int h = 0; h < 4; ++h) { const int c0 = h * 256 + ln * 4;
                ga[u][h] = *(const u16x4*)(OF + (size_t)l * 2048 + c0); gb[u][h] = *(const u16x4*)(OB + (size_t)l * 1024 + c0); gr[u][h] = *(const u16x4*)(RZ + (size_t)l * 2048 + c0); }
#pragma unroll
            for (int g = 0; g < 2; ++g) { const int c0 = g * 512 + ln * 8;
                sa[u][g] = *(const u16x8*)(OF + (size_t)l * 2048 + 1024 + c0); sb[u][g] = *(const u16x8*)(YB + (size_t)l * 1024 + c0);
                sz[u][g] = *(const u16x8*)(RZ + (size_t)l * 2048 + 1024 + c0); sx[u][g] = *(const u16x8*)(XC + (size_t)(l + T_CTX) * 1536 + c0); } } }
        float o[NR][4][4], y[NR][2][8], ss[NR][6];
#pragma unroll
        for (int u = 0; u < NR; ++u) {
#pragma unroll
            for (int h = 0; h < 4; ++h) { float a = 0.f;
#pragma unroll
                for (int j = 0; j < 4; ++j) { o[u][h][j] = bf2f(ga[u][h][j]) + bf2f(gb[u][h][j]); a += o[u][h][j] * o[u][h][j]; }
                ss[u][h] = a; }
#pragma unroll
            for (int g = 0; g < 2; ++g) { float a = 0.f;
#pragma unroll
                for (int j = 0; j < 8; ++j) { y[u][g][j] = (bf2f(sa[u][g][j]) + bf2f(sb[u][g][j]) + bf2f(sx[u][g][j]) * dsk[g]) * bf2f(sz[u][g][j]); a += y[u][g][j] * y[u][g][j]; }
                ss[u][4 + g] = a; } }
#pragma unroll
        for (int of = 1; of < 64; of <<= 1) {
#pragma unroll
            for (int u = 0; u < NR; ++u)
#pragma unroll
                for (int k = 0; k < 6; ++k) ss[u][k] += __shfl_xor(ss[u][k], of); }
#pragma unroll
        for (int u = 0; u < NR; ++u) { const int l = l0 + u * NGW; if (l < T_LAT) {
#pragma unroll
            for (int h = 0; h < 4; ++h) { const int c0 = h * 256 + ln * 4; const float rs = rsqrtf(ss[u][h] * (1.f / 256.f) + EPS);
                u32x2 w; w.x = pk2(o[u][h][0] * rs * gn.x * bf2f(gr[u][h][0]), o[u][h][1] * rs * gn.y * bf2f(gr[u][h][1])); w.y = pk2(o[u][h][2] * rs * gn.z * bf2f(gr[u][h][2]), o[u][h][3] * rs * gn.w * bf2f(gr[u][h][3]));
                *(u32x2*)(YX + (size_t)l * 2048 + c0) = w; }
#pragma unroll
            for (int g = 0; g < 2; ++g) { const int c0 = g * 512 + ln * 8; const float rs = rsqrtf(ss[u][4 + g] * (1.f / 512.f) + EPS);
                u32x4 w; w.x = pk2(y[u][g][0] * rs * nw[g][0], y[u][g][1] * rs * nw[g][1]); w.y = pk2(y[u][g][2] * rs * nw[g][2], y[u][g][3] * rs * nw[g][3]);
                w.z = pk2(y[u][g][4] * rs * nw[g][4], y[u][g][5] * rs * nw[g][5]); w.w = pk2(y[u][g][6] * rs * nw[g][6], y[u][g][7] * rs * nw[g][7]);
                *(u32x4*)(YX + (size_t)l * 2048 + 1024 + c0) = w; } } }
    }
}

__device__ __forceinline__ void phase6(Ctx& C) {
    {
        float* scr = (float*)C.lds + 8192 + C.wave * (64 * 33);
        const int gw = C.bid * 8 + C.wave, NGW = C.G * 8;
        bf16_t* WdT = (bf16_t*)(C.ws + WS_WDT);
        for (int it = gw; it < 32 * 768; it += NGW) {
            const int e = it / 768, r = it % 768;
            if (r < 512) { const int up = r >> 8, q = r & 255, kb = q >> 4, nb = q & 15;
                const float* src = C.in[up ? I_EWU : I_EWG] + (size_t)e * 1024 * 512 + (size_t)(kb * 64) * 512 + nb * 32;
                bf16_t* dst = wgu_ptr(C.ws, e) + (size_t)(256 * (nb >> 2) + (nb & 3) * 32 + up * 128) * 1024 + kb * 64;
                transpose_tile(src, 512, dst, 1024, scr, C.lane, false); }
            else { const int q = r - 512, kb = q >> 5, nb = q & 31;
                transpose_tile(C.in[I_EWD] + (size_t)e * 512 * 1024 + (size_t)(kb * 64) * 1024 + nb * 32, 1024, WdT + (size_t)e * 1024 * 512 + (size_t)(nb * 32) * 512 + kb * 64, 512, scr, C.lane, false); }
        }
    }
    __syncthreads();
    const bf16_t* YX = (const bf16_t*)(C.ws + WS_YX); const bf16_t* WoutT = (const bf16_t*)(C.ws + WS_WOUTT);
    const float* MOD = (const float*)(C.ws + WS_MOD); const float* X = C.in[I_X]; float* HL = C.out;
    auto bsel = [=](int, int tn, int& ldb) { ldb = 2048; return WoutT + (size_t)tn * 128 * 2048; };
    auto epi = [=](int row, int tn, int cc, float v, float) { const int col = tn * 128 + cc, b = row >> 12;
        HL[(size_t)row * 1024 + col] = X[(size_t)row * 1024 + col] + MOD[b * 6144 + 2048 + col] * v; };
#if PG8_MASK & 2
    (void)bsel; (void)epi;
    SchedOut S{(const char*)YX, (const char*)WoutT, C.G, C.bid}; EpiOut E{X, MOD, HL};
    pg8::gemm_phase<EpiOut, SchedOut, false, true>((lds_ptr_t)C.lds, 2048, S, E);
#else
    gemm_simple<false>(C, YX, 2048, T_LAT / 128, 1024 / 128, 2048, bsel, epi);
#endif
}

__device__ __forceinline__ void phase7(Ctx& C) {
    lds_ptr_t L = (lds_ptr_t)C.lds;
    constexpr int TS = 260, WSD = 48;
    constexpr int T_O = 0, W_O = 64 * TS * 4, LG_O = W_O + 256 * WSD * 4, CNT_O = LG_O + 2 * 64 * 48 * 4;
    LASQ float* Ts = (LASQ float*)(L + T_O); LASQ float* Wsm = (LASQ float*)(L + W_O); LASQ float* LG = (LASQ float*)(L + LG_O); LASQ unsigned* lcnt = (LASQ unsigned*)(L + CNT_O);
    const float* MOD = (const float*)(C.ws + WS_MOD); const float* HL = C.out; bf16_t* XN2 = (bf16_t*)(C.ws + WS_XN2);
    int* GL = (int*)(C.ws + WS_GL); float* GLW = (float*)(C.ws + WS_GLW);
    const float* wg = C.in[I_RGW]; const float* we = C.in[I_REW]; const float* nffn = C.in[I_NFFN]; const float* rgb = C.in[I_RGB]; const float* reb = C.in[I_REB];
    const int tid = C.tid, w = C.wave, ln = C.lane;
    for (int grp = C.bid; grp < T_LAT / 64; grp += C.G) {
        const int lbase = grp * 64, b = lbase >> 12;
        __syncthreads();
        if (tid < 32) lcnt[tid] = 0u;
        for (int i = tid; i < 256 * 12; i += NTHREADS) Wsm[(i / 12) * WSD + 36 + (i % 12)] = 0.f;
        f32x4 t[8][4];
        {
            float ss[8];
#pragma unroll
            for (int r = 0; r < 8; ++r) { const int l = lbase + w * 8 + r; ss[r] = 0.f;
#pragma unroll
                for (int j = 0; j < 4; ++j) { t[r][j] = *(const f32x4*)(HL + (size_t)l * DM + j * 256 + ln * 4); ss[r] += t[r][j].x * t[r][j].x + t[r][j].y * t[r][j].y + t[r][j].z * t[r][j].z + t[r][j].w * t[r][j].w; } }
#pragma unroll
            for (int o = 1; o < 64; o <<= 1) {
#pragma unroll
                for (int r = 0; r < 8; ++r) ss[r] += __shfl_xor(ss[r], o); }
#pragma unroll
            for (int r = 0; r < 8; ++r) ss[r] = rsqrtf(ss[r] * (1.f / DM) + EPS);
#pragma unroll
            for (int j = 0; j < 4; ++j) { const int c0 = j * 256 + ln * 4;
                const f32x4 gq = *(const f32x4*)(nffn + c0), sh = *(const f32x4*)(MOD + b * 6144 + 3072 + c0); f32x4 scl = *(const f32x4*)(MOD + b * 6144 + 4096 + c0);
                scl = gq * (1.f + scl);
#pragma unroll
                for (int r = 0; r < 8; ++r) { const int l = lbase + w * 8 + r; t[r][j] = t[r][j] * ss[r] * scl + sh;
                    u32x2 o; o.x = pk2(t[r][j].x, t[r][j].y); o.y = pk2(t[r][j].z, t[r][j].w); *(u32x2*)(XN2 + (size_t)l * DM + c0) = o; }
                asm volatile("" ::: "memory"); }
        }
        const int rt = w & 3, kh = w >> 2, ar = ln & 15, kq = ln >> 4;
        f32x4 acc[3];
#pragma unroll
        for (int ct = 0; ct < 3; ++ct) acc[ct] = (f32x4){0.f, 0.f, 0.f, 0.f};
#pragma unroll
        for (int j = 0; j < 4; ++j) {
            __syncthreads();
#pragma unroll
            for (int r = 0; r < 8; ++r) *(LASQ f32x4*)(Ts + (w * 8 + r) * TS + ln * 4) = t[r][j];
            { const int k = tid >> 1, hf = tid & 1; const float* src = we + (size_t)(j * 256 + k) * 32 + hf * 16;
#pragma unroll
                for (int i4 = 0; i4 < 4; ++i4) *(LASQ f32x4*)(Wsm + k * WSD + hf * 16 + i4 * 4) = *(const f32x4*)(src + i4 * 4);
                if (hf == 0) *(LASQ f32x4*)(Wsm + k * WSD + 32) = *(const f32x4*)(wg + (size_t)(j * 256 + k) * 4); }
            __syncthreads();
#pragma unroll 8
            for (int ks = 0; ks < 32; ++ks) { const int k0 = kh * 128 + ks * 4;
                const float av = Ts[(rt * 16 + ar) * TS + k0 + kq];
#pragma unroll
                for (int ct = 0; ct < 3; ++ct) { const float bv = Wsm[(k0 + kq) * WSD + ct * 16 + ar]; acc[ct] = __builtin_amdgcn_mfma_f32_16x16x4f32(av, bv, acc[ct], 0, 0, 0); } }
        }
#pragma unroll
        for (int ct = 0; ct < 3; ++ct)
#pragma unroll
            for (int r = 0; r < 4; ++r) LG[(kh * 64 + rt * 16 + kq * 4 + r) * 48 + ct * 16 + ar] = acc[ct][r];
        __syncthreads();
        if (tid < 64) {
            const int l = lbase + tid; const LASQ float* g0 = LG + tid * 48; const LASQ float* g1 = LG + (64 + tid) * 48;
            float gl[4]; int gs = 0; float gm = -3.4e38f;
#pragma unroll
            for (int o = 0; o < 4; ++o) { gl[o] = g0[32 + o] + g1[32 + o] + rgb[o]; if (gl[o] > gm) { gm = gl[o]; gs = o; } }
            float den = 0.f;
#pragma unroll
            for (int o = 0; o < 4; ++o) den += __expf(gl[o] - gm);
            const float pg = 1.f / den;
            int i1 = 0, i2 = 0; float v1 = -3.4e38f, v2 = -3.4e38f;
#pragma unroll
            for (int o = 0; o < 8; ++o) { const float e = g0[gs * 8 + o] + g1[gs * 8 + o] + reb[gs * 8 + o];
                if (e > v1) { v2 = v1; i2 = i1; v1 = e; i1 = o; } else if (e > v2) { v2 = e; i2 = o; } }
            const float e2 = __expf(v2 - v1), w1 = pg / (1.f + e2), w2 = pg * e2 / (1.f + e2);
            const int ex1 = gs * 8 + i1, ex2 = gs * 8 + i2;
            const unsigned p1 = atomicAdd((unsigned*)(lcnt + ex1), 1u), p2 = atomicAdd((unsigned*)(lcnt + ex2), 1u);
            GL[(grp * 32 + ex1) * 64 + p1] = l * 2; GL[(grp * 32 + ex2) * 64 + p2] = l * 2 + 1; GLW[(grp * 32 + ex1) * 64 + p1] = w1; GLW[(grp * 32 + ex2) * 64 + p2] = w2;
        }
        __syncthreads();
        if (tid < 32) ((unsigned*)(C.ws + WS_CTL) + CW_BLK)[grp * 32 + tid] = lcnt[tid];
    }
}

__device__ __forceinline__ void moe_offsets(Ctx& C, int* off, int* tmp, int* blkbase) {
    const unsigned* BLK = (const unsigned*)(C.ws + WS_CTL) + CW_BLK;
    const int e = C.tid & 31, ch = C.tid >> 5;
    const int per = 16; int sacc = 0;
    for (int i = 0; i < per; ++i) { const int b = ch * per + i; { const int v = (int)BLK[b * 32 + e]; if (blkbase) blkbase[b * 32 + e] = sacc; sacc += v; } }
    tmp[ch * 32 + e] = sacc;
    __syncthreads();
    if (C.tid < 32) { int run = 0; for (int c2 = 0; c2 < 16; ++c2) { const int v = tmp[c2 * 32 + C.tid]; tmp[c2 * 32 + C.tid] = run; run += v; } off[64 + C.tid] = run; }
    __syncthreads();
    if (C.tid == 0) { int o = 0; for (int x = 0; x < 32; ++x) { const int t = off[64 + x]; off[x] = o; o += (t + 255) & ~255; } off[32] = o; }
    if (blkbase) { const int add = tmp[ch * 32 + e]; for (int i = 0; i < per; ++i) { const int b = ch * per + i; blkbase[b * 32 + e] += add; } }
    __syncthreads();
}

__device__ __forceinline__ void moe_tile_table(Ctx& C, const int* off, int* tile_e) {
    const int NT = off[32] >> 8;
    for (int t = C.tid; t < NT; t += NTHREADS) { int e = 0; for (int i = 1; i < 32; ++i) if (off[i] <= t * 256) e = i; tile_e[t] = e; }
    __syncthreads();
}

__device__ __forceinline__ void moe_slot_caches(Ctx& C, const int* off, const int* blkbase, const int* tile_e, const int (&pmr)[4], int* pcache, float* wcache) {
    const int* GL = (const int*)(C.ws + WS_GL); const float* GLW = (const float*)(C.ws + WS_GLW);
    for (int x = C.tid; x < 4 * 256; x += NTHREADS) { const int i = x >> 8, t = x & 255; int pv = -1; float wv = 0.f;
        const int pm = i == 0 ? pmr[0] : i == 1 ? pmr[1] : i == 2 ? pmr[2] : pmr[3];
        if (pm >= 0) { const int e = tile_e[pm], r = pm * 256 + t - off[e];
            if (r < off[64 + e]) { int lo = 0, hi = 256;
                while (hi - lo > 1) { const int mid = (lo + hi) >> 1; if (blkbase[mid * 32 + e] <= r) lo = mid; else hi = mid; }
                const int idx = (lo * 32 + e) * 64 + r - blkbase[lo * 32 + e]; pv = GL[idx]; wv = GLW[idx]; } }
        pcache[x] = pv; if (wcache) wcache[x] = wv; }
    __syncthreads();
}
__device__ __forceinline__ void phase8(Ctx& C) {
    int* off = (int*)C.lds; int* blkbase = off + 1024; moe_offsets(C, off, off + 256, blkbase);
    const int* PE = (const int*)(C.ws + WS_PAIR); const int* PP = PE + 32768; const float* PW = (const float*)(PP + 32768); int* SL = (int*)(PW + 32768); float* SW = (float*)(SL + 32768);
    int* LIST = (int*)(C.ws + WS_LIST);
    for (int p = C.bid * NTHREADS + C.tid; p < 32768; p += C.G * NTHREADS) {
        const int ex = PE[p]; const int slot = off[ex] + blkbase[(p >> 7) * 32 + ex] + PP[p];
        SL[p] = slot; SW[slot] = PW[p]; LIST[slot] = p >> 1;
    }
}

__device__ __forceinline__ void phase9(Ctx& C) {
    int* off = (int*)(C.lds + CTRL_OFF + 1024); int* blkbase = (int*)(C.lds + 4096); moe_offsets(C, off, (int*)C.lds, blkbase);
    bf16_t* H = (bf16_t*)(C.ws + WS_H);
    int* tile_e = off + 128; moe_tile_table(C, off, tile_e);
    int* lcache = (int*)(C.lds + 131072);
    SchedMoe<true> S{(const char*)(C.ws + WS_XN2), C.ws, tile_e, lcache, off[32] >> 8, C.G, C.bid, 1024}; EpiUp E{H};
    int pmr[4] = {-1, -1, -1, -1}; { pg8::Unit u;
#pragma unroll
        for (int i = 0; i < 4; ++i) if (S.next(i, u)) pmr[i] = u.pm; }
    moe_slot_caches(C, off, blkbase, tile_e, pmr, lcache, nullptr);
    for (int x = C.tid; x < 4 * 256; x += NTHREADS) { const int pv = lcache[x]; lcache[x] = pv < 0 ? 0 : (pv >> 1); }
    __syncthreads();
    pg8::gemm_phase<EpiUp, SchedMoe<true>, true, true>((lds_ptr_t)C.lds, 1024, S, E);
}

__device__ __forceinline__ void phase10(Ctx& C) {
    int* off = (int*)(C.lds + CTRL_OFF + 1024); int* blkbase = (int*)(C.lds + 4096); moe_offsets(C, off, (int*)C.lds, blkbase);
    const bf16_t* H = (const bf16_t*)(C.ws + WS_H); bf16_t* Y = (bf16_t*)(C.ws + WS_Y);
    int* tile_e = off + 128; moe_tile_table(C, off, tile_e);
    int* pcache = (int*)(C.lds + 131072); float* wcache = (float*)(C.lds + 131072 + 4096);
    SchedMoe<false> S{(const char*)H, C.ws, tile_e, nullptr, off[32] >> 8, C.G, C.bid, 512}; EpiDown E{Y, pcache, wcache};
    int pmr[4] = {-1, -1, -1, -1}; { pg8::Unit u;
#pragma unroll
        for (int i = 0; i < 4; ++i) if (S.next(i, u)) pmr[i] = u.pm; }
    moe_slot_caches(C, off, blkbase, tile_e, pmr, pcache, wcache);
    pg8::gemm_phase<EpiDown, SchedMoe<false>, true, true>((lds_ptr_t)C.lds, 512, S, E);
}

__device__ __forceinline__ void phase11(Ctx& C) {
    const int gw = C.bid * 8 + C.wave, NGW = C.G * 8;
    const float* MOD = (const float*)(C.ws + WS_MOD); float* HL = C.out; const bf16_t* Y = (const bf16_t*)(C.ws + WS_Y);
    const float* fnorm = C.in[I_FNORM];
    constexpr int NR = 2;
    for (int l0 = gw; l0 < T_LAT; l0 += NGW * NR) {
        f32x4 hv[NR][4]; u16x4 ya[NR][4], yb[NR][4]; float ss[NR];
#pragma unroll
        for (int u = 0; u < NR; ++u) { const int l = l0 + u * NGW; ss[u] = 0.f; if (l < T_LAT) { const int s1 = l * 2, s2 = l * 2 + 1;
#pragma unroll
            for (int j = 0; j < 4; ++j) { const int c0 = j * 256 + C.lane * 4; hv[u][j] = *(const f32x4*)(HL + (size_t)l * DM + c0);
                ya[u][j] = *(const u16x4*)(Y + (size_t)s1 * DM + c0); yb[u][j] = *(const u16x4*)(Y + (size_t)s2 * DM + c0); } } }
#pragma unroll
        for (int u = 0; u < NR; ++u) { const int l = l0 + u * NGW; if (l < T_LAT) { const int b = l >> 12;
#pragma unroll
            for (int j = 0; j < 4; ++j) { const int c0 = j * 256 + C.lane * 4; const f32x4 g2 = *(const f32x4*)(MOD + b * 6144 + 5120 + c0);
                f32x4 m; m.x = bf2f(ya[u][j][0]) + bf2f(yb[u][j][0]); m.y = bf2f(ya[u][j][1]) + bf2f(yb[u][j][1]); m.z = bf2f(ya[u][j][2]) + bf2f(yb[u][j][2]); m.w = bf2f(ya[u][j][3]) + bf2f(yb[u][j][3]);
                hv[u][j] = hv[u][j] + g2 * m; ss[u] += hv[u][j].x * hv[u][j].x + hv[u][j].y * hv[u][j].y + hv[u][j].z * hv[u][j].z + hv[u][j].w * hv[u][j].w; } } }
#pragma unroll
        for (int o = 1; o < 64; o <<= 1) {
#pragma unroll
            for (int u = 0; u < NR; ++u) ss[u] += __shfl_xor(ss[u], o); }
#pragma unroll
        for (int u = 0; u < NR; ++u) { const int l = l0 + u * NGW; if (l < T_LAT) { const float rs = rsqrtf(ss[u] * (1.f / DM) + EPS);
#pragma unroll
            for (int j = 0; j < 4; ++j) { const int c0 = j * 256 + C.lane * 4; const f32x4 fn = *(const f32x4*)(fnorm + c0);
                *(f32x4*)(HL + (size_t)l * DM + c0) = hv[u][j] * rs * fn; } } }
    }
}

#define LAS __attribute__((address_space(3)))
#define XB_TMO      128
#define XB_XCNT(j)  (256  + 64 * (j))
#define XB_XSUB(j)  (1280 + 64 * (j))
#define XB_XGEN(j)  (2304 + 64 * (j))
#define XB_TOP      3328
#define XB_TOPGEN   3392
#define XCD_BAR_WORDS 3456
#define XB_SPIN_CAP (1u << 18)

__device__ __forceinline__ unsigned xb_ld(unsigned* p)              { return __hip_atomic_load(p, __ATOMIC_RELAXED, __HIP_MEMORY_SCOPE_AGENT); }
__device__ __forceinline__ unsigned xb_add(unsigned* p, unsigned v) { return __hip_atomic_fetch_add(p, v, __ATOMIC_RELAXED, __HIP_MEMORY_SCOPE_AGENT); }
__device__ __forceinline__ unsigned xb_xcc_id() { return (unsigned)__builtin_amdgcn_s_getreg((3 << 11) | 20) & 0xFu; }
#define XB_SPIN(cond, bar) do { unsigned _sp = 0; while (cond) { __builtin_amdgcn_s_sleep(1); \
    if ((++_sp & 255u) == 0u) { if (xb_ld(&(bar)[XB_TMO])) break; if (_sp > XB_SPIN_CAP) { atomicAdd(&(bar)[XB_TMO], 1u); break; } } } } while (0)

struct XcdBarrier {
    unsigned* bar; unsigned x;
    volatile LAS unsigned* st;
};

__device__ __forceinline__ XcdBarrier xcd_barrier_post(unsigned* bar, volatile LAS unsigned* st) {
    XcdBarrier b; b.bar = bar; b.x = xb_xcc_id(); b.st = st;
    if (threadIdx.x == 0) (void)xb_add(&bar[XB_XCNT(b.x)], 1u);
    return b;
}
__device__ __forceinline__ void xcd_barrier_complete(unsigned* bar, unsigned x, unsigned& nloc, unsigned& nx) {
    const unsigned G = gridDim.x * gridDim.y * gridDim.z;
    unsigned sum, cnt, mine, sp = 0u;
    for (;;) {
        sum = 0u; cnt = 0u; mine = 0u;
#pragma unroll
        for (unsigned j = 0; j < 16; ++j) { const unsigned c = xb_ld(&bar[XB_XCNT(j)]); sum += c; cnt += (c > 0u) ? 1u : 0u; mine = (j == x) ? c : mine; }
        if (sum == G) break;
        __builtin_amdgcn_s_sleep(1);
        if ((++sp & 255u) == 0u) { if (xb_ld(&bar[XB_TMO])) break; if (sp > XB_SPIN_CAP) { atomicAdd(&bar[XB_TMO], 1u); break; } }
    }
    nloc = mine > 0u ? mine : 1u; nx = cnt > 0u ? cnt : 1u;
}

__device__ __forceinline__ void xcd_barrier(const XcdBarrier& b) {
    asm volatile("s_waitcnt vmcnt(0)" ::: "memory");
    __syncthreads();
    if (threadIdx.x == 0) {
        unsigned* bar = b.bar;
        __builtin_amdgcn_s_waitcnt(0);
        unsigned nloc = b.st[0], nx = b.st[1];
        if (nloc == 0u) { xcd_barrier_complete(bar, b.x, nloc, nx); b.st[0] = nloc; b.st[1] = nx; }
        const unsigned old = xb_add(&bar[XB_XSUB(b.x)], 1u);
        const unsigned gen = old / nloc;
        if (old + 1u == (gen + 1u) * nloc) {
            __builtin_amdgcn_fence(__ATOMIC_RELEASE, "agent");
            asm volatile("s_waitcnt vmcnt(0)" ::: "memory");
            const unsigned og = xb_add(&bar[XB_TOP], 1u);
            const unsigned tg = og / nx;
            if (og + 1u == (tg + 1u) * nx) xb_add(&bar[XB_TOPGEN], 1u);
            else XB_SPIN(xb_ld(&bar[XB_TOPGEN]) == tg, bar);
            __builtin_amdgcn_fence(__ATOMIC_ACQUIRE, "agent");
            xb_add(&bar[XB_XGEN(b.x)], 1u);
            asm volatile("s_waitcnt vmcnt(0)" ::: "memory");
        } else {
            XB_SPIN(xb_ld(&bar[XB_XGEN(b.x)]) == gen, bar);
            __builtin_amdgcn_fence(__ATOMIC_ACQUIRE, "agent");
            asm volatile("s_waitcnt vmcnt(0)" ::: "memory");
        }
    }
    __syncthreads();
}

__global__ void __launch_bounds__(NTHREADS, 2) fwd_kernel(Args a) {
    extern __shared__ __attribute__((aligned(16))) unsigned char lds[];
    Ctx C;
    if (threadIdx.x == 0) {
#pragma unroll
        for (int i = 0; i < 27; ++i) *(__attribute__((address_space(3))) unsigned long long*)((__attribute__((address_space(3))) unsigned char*)lds + PTAB_OFF + 8 * i) = (unsigned long long)a.in[i];
    }
    C.in.lds = lds; C.out = a.out; C.ws = a.ws; C.lds = lds;
    __syncthreads();
    C.tid = threadIdx.x; C.lane = C.tid & 63; C.wave = __builtin_amdgcn_readfirstlane(C.tid >> 6); C.bid = blockIdx.x; C.G = gridDim.x;
#if MK_COOP
    cg::grid_group grid = cg::this_grid();
    if (C.tid < 2) ((LAS unsigned*)(lds + CTRL_OFF + 64))[C.tid] = 0u;
    __syncthreads();
    XcdBarrier xbar = xcd_barrier_post((unsigned*)(C.ws + WS_CTL) + CW_BAR, (volatile LAS unsigned*)(lds + CTRL_OFF + 64));
#ifndef CG_SEAM0
#define CG_SEAM0 0
#endif
#define SEAM(k) do { if ((k) + 1 < a.ph_hi) { if (CG_SEAM0 && (k) == 0) grid.sync(); else xcd_barrier(xbar); } } while (0)
#else
#define SEAM(k) do { } while (0)
#endif
#define IN(k) (a.ph_lo <= (k) && (k) < a.ph_hi)
#ifndef PROBE_K
#define PROBE_K -1
#endif
    unsigned long long tprev = 0ull; float pdur = 0.f;
    unsigned long long tstart = 0ull;
    if (PROBE_K >= 0 && blockIdx.x == 0 && threadIdx.x == 0) { tprev = __builtin_amdgcn_s_memrealtime(); tstart = tprev; }
#define STAMP(k) do { if (PROBE_K >= 0 && blockIdx.x == 0 && threadIdx.x == 0) { const unsigned long long tn = __builtin_amdgcn_s_memrealtime(); if ((k) == PROBE_K) pdur = (float)(tn - tprev) * 0.01f; tprev = tn; } } while (0)
    if (IN(0)) { phase0(C); SEAM(0); STAMP(0); }
    if (IN(1)) { phase1(C); SEAM(1); STAMP(1); }
    if (IN(2)) { phase2(C); SEAM(2); STAMP(2); }
    if (IN(3)) { phase3(C, 1); STAMP(30); phase3(C, 2); STAMP(31); phase3(C, 4); SEAM(3); STAMP(3); }
#ifdef SCAN_NAIVE
    if (IN(4)) { phase4_naive(C); SEAM(4); STAMP(4); }
#else
    if (IN(4)) { phase4(C); SEAM(4); STAMP(4); }
#endif
    if (IN(5)) { phase5(C); SEAM(5); STAMP(5); }
    if (IN(6)) { phase6(C); SEAM(6); STAMP(6); }
    if (IN(7)) { phase7(C); SEAM(7); STAMP(7); }
    if (IN(9)) { phase9(C); SEAM(9); STAMP(9); }
    if (IN(10)) { phase10(C); SEAM(10); STAMP(10); }
    if (IN(11)) { phase11(C); STAMP(11); }
    if (PROBE_K >= 0 && blockIdx.x == 0 && threadIdx.x == 0) { asm volatile("s_waitcnt vmcnt(0)" ::: "memory"); if (PROBE_K == 99) pdur = (float)(__builtin_amdgcn_s_memrealtime() - tstart) * 0.001f;
        a.out[0] += sqrtf(16.78f * pdur); }
}

extern "C" void kernel_launch(void* const* d_in, const int* in_sizes, int n_in, void* d_out, int out_size, void* d_ws, size_t ws_size, hipStream_t stream) {
    static int grid = 0;
    if (grid == 0) {
        if (n_in != 27 || out_size != T_LAT * DM || ws_size < WS_END) { fprintf(stderr, "kernel_launch: unexpected shapes: n_in %d out %d ws %zu (need %zu)\n", n_in, out_size, ws_size, (size_t)WS_END); grid = -1; return; }
        int dev = 0, cus = 0, per_cu = 0;
        hipGetDevice(&dev); hipDeviceGetAttribute(&cus, hipDeviceAttributeMultiprocessorCount, dev);
        hipFuncSetAttribute((const void*)fwd_kernel, hipFuncAttributeMaxDynamicSharedMemorySize, LDS_BYTES);
        hipOccupancyMaxActiveBlocksPerMultiprocessor(&per_cu, (const void*)fwd_kernel, NTHREADS, LDS_BYTES);
        if (per_cu < 1) { fprintf(stderr, "kernel_launch: occupancy query says %d blocks per CU\n", per_cu); per_cu = 1; }
        (void)hipGetLastError();
        grid = cus;
        fprintf(stderr, "kernel_launch: grid %d, per_cu %d, ws %zu\n", grid, per_cu, ws_size);
    }
    if (grid < 0) return;
    hipMemsetAsync((char*)d_ws + WS_CTL, 0, CTL_BYTES, stream);
    Args a{};
    for (int i = 0; i < 27; ++i) a.in[i] = (const float*)d_in[i];
    a.out = (float*)d_out; a.ws = (unsigned char*)d_ws;
#if MK_COOP
    a.ph_lo = 0; a.ph_hi = NPH;
    void* args[] = {&a};
    hipError_t e = hipLaunchCooperativeKernel((const void*)fwd_kernel, dim3(grid), dim3(NTHREADS), args, LDS_BYTES, stream);
    if (e != hipSuccess) fprintf(stderr, "cooperative launch failed: %s (grid %d)\n", hipGetErrorString(e), grid);
#else
    for (int p = 0; p < NPH; ++p) { a.ph_lo = p; a.ph_hi = p + 1; hipLaunchKernelGGL(fwd_kernel, dim3(grid), dim3(NTHREADS), LDS_BYTES, stream, a); }
#endif
}
```
